# Optimizing an MI355X kernel written in HIP

```python
import math
import jax
import jax.numpy as jnp
from jax import lax
import numpy as np

D_MODEL = 2048
BATCH = 4
SEQ = 4096
DEPTH = 4
DEC_BATCH = 8
DEC_SEQ = 4096
PAST_LEN = 128

HEAD_DIM = 128
N_HEADS = D_MODEL // HEAD_DIM
A_Q_HEADS = N_HEADS // 4
A_KV_HEADS = A_Q_HEADS // 2
B_PAIRS = ((128, 1), (512, 4), (2048, 16))
B_HEADS_PER_PAIR = (N_HEADS - A_Q_HEADS) // 2 // len(B_PAIRS)
B_HEADS = B_HEADS_PER_PAIR * len(B_PAIRS)
C_HEADS = N_HEADS - A_Q_HEADS - B_HEADS
A_QW = A_Q_HEADS * HEAD_DIM
A_KVW = A_KV_HEADS * HEAD_DIM
B_W = B_HEADS * HEAD_DIM
C_W = C_HEADS * HEAD_DIM
MIX_W = A_QW + B_W + C_W
IN_W = A_QW + 2 * A_KVW + 3 * B_W + 3 * C_W
GRID_W = 64
NA_ROWS = 8
NA_COLS = 16
NA_QCOLS = 16
NA_KCOLS = 32
Q_BLOCK = 128
D_FF = 4 * D_MODEL
ROPE_THETA = 10000.0
EPS = 1e-6
NEG = -1e30
DEEPNORM_ALPHA = (2 * DEPTH) ** 0.25
DEEPNORM_BETA = (8 * DEPTH) ** -0.25

kernel_name = 'hybrid_bidir_encoder_gqa_dilated_natten'


def _rms_unit(x):
    xf = x.astype(jnp.float32)
    y = xf * lax.rsqrt(jnp.mean(xf * xf, axis=-1, keepdims=True) + EPS)
    return y.astype(x.dtype)


def _layernorm(x, g, b):
    xf = x.astype(jnp.float32)
    mu = jnp.mean(xf, axis=-1, keepdims=True)
    var = jnp.mean(jnp.square(xf - mu), axis=-1, keepdims=True)
    y = (xf - mu) * lax.rsqrt(var + EPS) * g.astype(jnp.float32) + b.astype(jnp.float32)
    return y.astype(x.dtype)


def _rope_angles(pos, dim):
    inv = ROPE_THETA ** (-(jnp.arange(dim // 2, dtype=jnp.float32) * 2.0 / dim))
    return pos.astype(jnp.float32)[:, None] * inv[None, :]


def _rope(x, ang):
    n = x.shape[-1] // 2
    xf = x.astype(jnp.float32)
    x1, x2 = xf[..., :n], xf[..., n:]
    c = jnp.cos(ang)[None, :, None, :]
    s = jnp.sin(ang)[None, :, None, :]
    return jnp.concatenate([x1 * c - x2 * s, x2 * c + x1 * s], axis=-1).astype(x.dtype)


def _axial_rope(x, row_ang, col_ang):
    half = HEAD_DIM // 2
    return jnp.concatenate([_rope(x[..., :half], row_ang), _rope(x[..., half:], col_ang)], axis=-1)


def _global_gqa(q, k, v):
    Bsz, S = q.shape[:2]
    rep = A_Q_HEADS // A_KV_HEADS
    scale = HEAD_DIM ** -0.5
    qb = q.reshape(Bsz, S // Q_BLOCK, Q_BLOCK, A_KV_HEADS, rep, HEAD_DIM)
    qb = jnp.moveaxis(qb, 1, 0)

    def block(qi):
        s = jnp.einsum('bqgrd,bkgd->bgrqk', qi, k, preferred_element_type=jnp.float32) * scale
        p = jax.nn.softmax(s, axis=-1)
        return jnp.einsum('bgrqk,bkgd->bqgrd', p.astype(v.dtype), v)

    o = lax.map(block, qb)
    return jnp.moveaxis(o, 0, 1).reshape(Bsz, S, A_QW)


def _dilated_window_attention(q, k, v, window, dilation):
    Bsz, S, H, D = q.shape
    n_side = (window // 2) // dilation
    L = S // dilation

    def strided(z):
        return z.reshape(Bsz, L, dilation, H, D).transpose(0, 2, 1, 3, 4)

    qs, ks, vs = strided(q), strided(k), strided(v)
    blk = math.gcd(L, Q_BLOCK)
    nb = L // blk
    kw = blk + 2 * n_side
    pad = ((0, 0), (0, 0), (n_side, n_side), (0, 0), (0, 0))
    kp = jnp.pad(ks, pad)
    vp = jnp.pad(vs, pad)
    starts = jnp.arange(nb) * blk
    idx = starts[:, None] + jnp.arange(kw)[None, :]
    kg = kp[:, :, idx]
    vg = vp[:, :, idx]
    qb = qs.reshape(Bsz, dilation, nb, blk, H, D)
    s = jnp.einsum('bznqhd,bznkhd->bznhqk', qb, kg, preferred_element_type=jnp.float32) * (HEAD_DIM ** -0.5)
    qi = jnp.arange(blk)[:, None]
    kj = jnp.arange(kw)[None, :]
    rel = kj - qi
    kpos = starts[:, None, None] + kj[None] - n_side
    valid = (rel >= 0)[None] & (rel <= 2 * n_side)[None] & (kpos >= 0) & (kpos < L)
    s = jnp.where(valid[None, None, :, None], s, NEG)
    lse = jax.nn.logsumexp(s, axis=-1)
    p = jnp.exp(s - lse[..., None])
    o = jnp.einsum('bznhqk,bznkhd->bznqhd', p.astype(v.dtype), vg)
    o = o.reshape(Bsz, dilation, L, H, D).transpose(0, 2, 1, 3, 4).reshape(Bsz, S, H, D)
    lse = lse.transpose(0, 1, 2, 4, 3).reshape(Bsz, dilation, L, H).transpose(0, 2, 1, 3).reshape(Bsz, S, H)
    return o, lse


def _dilated_mixture(q, k, v):
    Bsz, S = q.shape[:2]
    shp = (Bsz, S, len(B_PAIRS), B_HEADS_PER_PAIR, HEAD_DIM)
    q, k, v = q.reshape(shp), k.reshape(shp), v.reshape(shp)
    outs, lses = [], []
    for g, (window, dilation) in enumerate(B_PAIRS):
        o, lse = _dilated_window_attention(q[:, :, g], k[:, :, g], v[:, :, g], window, dilation)
        outs.append(o)
        lses.append(lse)
    o = jnp.stack(outs, axis=2)
    alpha = jax.nn.softmax(jnp.stack(lses, axis=2), axis=2)
    return (o.astype(jnp.float32) * alpha[..., None]).astype(q.dtype).reshape(Bsz, S, B_W)


def _neighbourhood_attention(q, k, v, rel_bias):
    Bsz, S, H, D = q.shape
    rows = S // GRID_W
    win_r = min(NA_ROWS, rows)
    n_cb = GRID_W // NA_QCOLS
    qg = q.reshape(Bsz, rows, n_cb, NA_QCOLS, H, D)
    kg = k.reshape(Bsz, rows, GRID_W, H, D)
    vg = v.reshape(Bsz, rows, GRID_W, H, D)
    cb = jnp.arange(n_cb)
    kc0 = jnp.clip(cb * NA_QCOLS - NA_COLS // 2, 0, GRID_W - NA_KCOLS)
    kcols = kc0[:, None] + jnp.arange(NA_KCOLS)[None, :]
    qcols = cb[:, None] * NA_QCOLS + jnp.arange(NA_QCOLS)[None, :]
    sc = jnp.clip(qcols - NA_COLS // 2, 0, GRID_W - NA_COLS)
    col_ok = (kcols[:, None, :] >= sc[..., None]) & (kcols[:, None, :] < sc[..., None] + NA_COLS)
    dcol = jnp.clip(kcols[:, None, :] - qcols[..., None] + NA_COLS - 1, 0, 2 * NA_COLS - 2)
    scale = HEAD_DIM ** -0.5

    def row_block(r):
        r0 = jnp.clip(r - win_r // 2, 0, rows - win_r)
        kr = lax.dynamic_slice_in_dim(kg, r0, win_r, axis=1)[:, :, kcols]
        vr = lax.dynamic_slice_in_dim(vg, r0, win_r, axis=1)[:, :, kcols]
        qr = lax.dynamic_index_in_dim(qg, r, axis=1, keepdims=False)
        s = jnp.einsum('bcqhd,bjckhd->bhcqjk', qr, kr, preferred_element_type=jnp.float32) * scale
        drow = r0 + jnp.arange(win_r) - r + NA_ROWS - 1
        bias = rel_bias[:, drow[None, None, :, None], dcol[:, :, None, :]]
        s = s + bias.astype(jnp.float32)[None]
        s = jnp.where(col_ok[None, None, :, :, None, :], s, NEG)
        p = jax.nn.softmax(s.reshape(s.shape[:4] + (win_r * NA_KCOLS,)), axis=-1).reshape(s.shape)
        return jnp.einsum('bhcqjk,bjckhd->bcqhd', p.astype(v.dtype), vr)

    o = lax.map(row_block, jnp.arange(rows))
    return jnp.moveaxis(o, 0, 1).reshape(Bsz, S, C_W)


def _layer(x, w_in, a_q_gain, a_k_gain, c_rel_bias, mix_gain, w_out, ln1_g, ln1_b, w_ff1, w_ff2, ln2_g, ln2_b):
    Bsz, S, _ = x.shape
    t = jnp.arange(S)
    sizes = [A_QW, A_KVW, A_KVW, B_W, B_W, B_W, C_W, C_W, C_W]
    splits = [int(c) for c in np.cumsum(sizes)[:-1]]
    proj = jnp.einsum('bsd,de->bse', x, w_in)
    aq, ak, av, bq, bk, bv, cq, ck, cv = jnp.split(proj, splits, axis=-1)

    def heads(z):
        return z.reshape(Bsz, S, -1, HEAD_DIM)

    row_ang = _rope_angles(t // GRID_W, HEAD_DIM // 2)
    col_ang = _rope_angles(t % GRID_W, HEAD_DIM // 2)
    qa = _axial_rope(_rms_unit(heads(aq)) * a_q_gain, row_ang, col_ang)
    ka = _axial_rope(_rms_unit(heads(ak)) * a_k_gain, row_ang, col_ang)
    o_a = _global_gqa(qa, ka, heads(av))
    ang = _rope_angles(t, HEAD_DIM)
    o_b = _dilated_mixture(_rope(heads(bq), ang), _rope(heads(bk), ang), heads(bv))
    o_c = _neighbourhood_attention(heads(cq), heads(ck), heads(cv), c_rel_bias)

    mixed = jnp.concatenate([_rms_unit(o_a), _rms_unit(o_b), _rms_unit(o_c)], axis=-1) * mix_gain
    y = jnp.einsum('bse,ed->bsd', mixed, w_out)
    x = _layernorm(DEEPNORM_ALPHA * x + y, ln1_g, ln1_b)
    h = jnp.einsum('bsf,fd->bsd', jnp.square(jax.nn.relu(jnp.einsum('bsd,df->bsf', x, w_ff1))), w_ff2)
    return _layernorm(DEEPNORM_ALPHA * x + h, ln2_g, ln2_b)


def _trunk(x, w_in, a_q_gain, a_k_gain, c_rel_bias, mix_gain, w_out, ln1_g, ln1_b, w_ff1, w_ff2, ln2_g, ln2_b):
    for l in range(DEPTH):
        x = _layer(x, w_in[l], a_q_gain[l], a_k_gain[l], c_rel_bias[l], mix_gain[l], w_out[l],
                   ln1_g[l], ln1_b[l], w_ff1[l], w_ff2[l], ln2_g[l], ln2_b[l])
    return x


def setup_inputs(seed: int = 0) -> dict:
    key = jax.random.key(seed)
    ks = jax.random.split(key, 15)
    nrm = jax.random.normal
    f32 = jnp.float32
    return {
        'x_prompt': nrm(ks[0], (BATCH, SEQ, D_MODEL), f32),
        'x_sample': nrm(ks[1], (DEC_BATCH, DEC_SEQ, D_MODEL), f32),
        'w_in': nrm(ks[2], (DEPTH, D_MODEL, IN_W), f32) * D_MODEL ** -0.5,
        'a_q_gain': 1.0 + 0.02 * nrm(ks[3], (DEPTH, HEAD_DIM), f32),
        'a_k_gain': 1.0 + 0.02 * nrm(ks[4], (DEPTH, HEAD_DIM), f32),
        'c_rel_bias': 0.02 * nrm(ks[5], (DEPTH, C_HEADS, 2 * NA_ROWS - 1, 2 * NA_COLS - 1), f32),
        'mix_gain': 1.0 + 0.02 * nrm(ks[6], (DEPTH, MIX_W), f32),
        'w_out': nrm(ks[7], (DEPTH, MIX_W, D_MODEL), f32) * (MIX_W ** -0.5 * DEEPNORM_BETA),
        'ln1_g': 1.0 + 0.02 * nrm(ks[8], (DEPTH, D_MODEL), f32),
        'ln1_b': 0.02 * nrm(ks[9], (DEPTH, D_MODEL), f32),
        'w_ff1': nrm(ks[10], (DEPTH, D_MODEL, D_FF), f32) * D_MODEL ** -0.5,
        'w_ff2': nrm(ks[11], (DEPTH, D_FF, D_MODEL), f32) * (D_FF ** -0.5 * DEEPNORM_BETA),
        'ln2_g': 1.0 + 0.02 * nrm(ks[12], (DEPTH, D_MODEL), f32),
        'ln2_b': 0.02 * nrm(ks[13], (DEPTH, D_MODEL), f32),
    }


def reference(x_prompt, x_sample, w_in, a_q_gain, a_k_gain, c_rel_bias, mix_gain, w_out,
              ln1_g, ln1_b, w_ff1, w_ff2, ln2_g, ln2_b):
    y_prompt = _trunk(x_prompt, w_in, a_q_gain, a_k_gain, c_rel_bias, mix_gain, w_out,
                      ln1_g, ln1_b, w_ff1, w_ff2, ln2_g, ln2_b)
    y_sample = _trunk(x_sample, w_in, a_q_gain, a_k_gain, c_rel_bias, mix_gain, w_out,
                      ln1_g, ln1_b, w_ff1, w_ff2, ln2_g, ln2_b)
    return (y_prompt, y_sample)
```

```cpp
#include <hip/hip_runtime.h>
#include <hip/hip_bf16.h>
#include <cstdio>
#include <cstdint>
#include <cmath>
__device__ __forceinline__ int lane_id() { int l; asm volatile("v_mbcnt_lo_u32_b32 %0, -1, 0\n\tv_mbcnt_hi_u32_b32 %0, -1, %0" : "=v"(l)); return l; }
namespace pg8 {
#define PG8_LAS __attribute__((address_space(3)))
typedef unsigned short bf16_t;
typedef short bf16x8 __attribute__((ext_vector_type(8)));
typedef float f32x4 __attribute__((ext_vector_type(4)));
typedef unsigned u32x4 __attribute__((ext_vector_type(4)));
constexpr int BM = 256, BK = 64, HALF = 128, HTB = HALF * BK * 2  , STAGE_BYTES = 8 * HTB, NXCD = 8, WGM = 8;

__host__ __device__ __forceinline__ int lds_byte(int r, int c) { const int st = (r >> 4) * 2 + (c >> 5), rr = r & 15, cc = c & 31, ob = rr * 64 + cc * 2; return st * 1024 + (ob ^ (((ob >> 9) & 1) << 5)); }
__host__ __device__ __forceinline__ void stage_rc(int b, int& R, int& C) { const int st = b / 1024, sb = b % 1024, swz = sb ^ (((sb >> 9) & 1) << 5); R = (st >> 1) * 16 + swz / 64; C = (st & 1) * 32 + (swz % 64) / 2; }
__host__ __device__ __forceinline__ int perm32(int rho) { const int n = rho >> 4, i = rho & 15; return 8 * (i >> 2) + 4 * n + (i & 3); }

struct Unit { int pm, pn; };
struct Gemm { const bf16_t* A; const bf16_t* Bt; int M, N, K; };

struct StaticOrder {
    int nM, nN, nwg, G, c;
    __host__ __device__ void init(int M, int N, int G_, int c_) { nM = M / BM; nN = N / BM; nwg = nM * nN; G = G_; c = c_; }
    __host__ __device__ bool next(int i, Unit& u) const {
        const long L = (long)i * G + c; if (L >= nwg) return false;
        int wgid = (int)L; { const int q = nwg / NXCD, r = nwg % NXCD, xcd = wgid % NXCD, off = wgid / NXCD; wgid = (xcd < r ? xcd * (q + 1) : r * (q + 1) + (xcd - r) * q) + off; }
        const int nig = WGM * nN, gid = wgid / nig, fm = gid * WGM, gsz = (nM - fm) < WGM ? (nM - fm) : WGM;
        u.pm = fm + ((wgid % nig) % gsz); u.pn = (wgid % nig) / gsz; return true;
    }
    __device__ __forceinline__ void a_ready(const Unit&) const {}
    __device__ __forceinline__ void done(const Unit&) const {}
};

__device__ __forceinline__ unsigned cvt_pk_bf16(float lo, float hi) { unsigned r; asm volatile("v_cvt_pk_bf16_f32 %0, %1, %2" : "=v"(r) : "v"(lo), "v"(hi)); return r; }
typedef float f32x2 __attribute__((ext_vector_type(2)));
__device__ __forceinline__ f32x2 gelu_pk(f32x2 v) {
    const f32x2 av = __builtin_elementwise_abs(v), d = av * 0.2316418882f + 1.0f;
    f32x2 t; t.x = __builtin_amdgcn_rcpf(d.x); t.y = __builtin_amdgcn_rcpf(d.y);
    f32x2 q = t * 0.5307027145f + (-0.7265760135f); q = q * t + 0.7107068705f; q = q * t + (-0.142248368f); q = q * t + 0.127414796f; q = q * t;
    const f32x2 s = (v * v) * (-0.72134752044f);
    f32x2 e; e.x = __builtin_amdgcn_exp2f(s.x); e.y = __builtin_amdgcn_exp2f(s.y);
    const f32x2 m = v * (q * e), r = v - m;
    f32x2 o; o.x = v.x < 0.f ? m.x : r.x; o.y = v.y < 0.f ? m.y : r.y; return o;
}

template <int ACT  > struct EpiBf16 {
    static constexpr bool PERM = true, AFTER_DRAIN = false; static_assert(ACT == 0 || ACT == 1, "EpiBf16: ACT is 0 (none) or 1 (gelu_pk)");
    bf16_t* O; int ldc; const float* bias; int split_cols; size_t split_stride; float scale0;
    __device__ __forceinline__ void operator()(const f32x4 (&acc)[2][2][4][2], const Unit& u, int wr, int wc, int fr, int fq) const {
        const int row0 = u.pm * BM + wr * 64 + fr; int colt = u.pn * BM; bf16_t* base = O;
        float sc = 1.f; if (split_cols) { const int t = colt / split_cols; base += (size_t)t * split_stride; colt -= t * split_cols; if (t == 0) sc = scale0; }
        const int col0 = colt + wc * 32 + 8 * fq, bcol0 = u.pn * BM + wc * 32 + 8 * fq;
        f32x4 bv[2][2];
#pragma unroll
        for (int bj = 0; bj < 2; ++bj)
#pragma unroll
            for (int n = 0; n < 2; ++n) bv[bj][n] = bias ? *(const f32x4*)(bias + bcol0 + bj * HALF + 4 * n) : (f32x4){0.f, 0.f, 0.f, 0.f};
#pragma unroll
        for (int ai = 0; ai < 2; ++ai)
#pragma unroll
            for (int m = 0; m < 4; ++m) { bf16_t* rowp = base + (size_t)(row0 + ai * HALF + m * 16) * ldc + col0;
#pragma unroll
                for (int bj = 0; bj < 2; ++bj) { f32x4 v0 = acc[ai][bj][m][0] + bv[bj][0], v1 = acc[ai][bj][m][1] + bv[bj][1];
                    if (ACT == 1) { f32x2 a = gelu_pk((f32x2){v0[0], v0[1]}), b = gelu_pk((f32x2){v0[2], v0[3]}), c = gelu_pk((f32x2){v1[0], v1[1]}), d = gelu_pk((f32x2){v1[2], v1[3]});
                        v0 = (f32x4){a.x, a.y, b.x, b.y}; v1 = (f32x4){c.x, c.y, d.x, d.y}; }
                    v0 = v0 * sc; v1 = v1 * sc; u32x4 w; w.x = cvt_pk_bf16(v0[0], v0[1]); w.y = cvt_pk_bf16(v0[2], v0[3]); w.z = cvt_pk_bf16(v1[0], v1[1]); w.w = cvt_pk_bf16(v1[2], v1[3]);
                    *(u32x4*)(rowp + bj * HALF) = w; } }
    }
};


struct EpiRelu2Bf16 {
    static constexpr bool PERM = true, AFTER_DRAIN = false;
    bf16_t* O; int ldc;
    __device__ __forceinline__ void operator()(const f32x4 (&acc)[2][2][4][2], const Unit& u, int wr, int wc, int fr, int fq) const {
        const int row0 = u.pm * BM + wr * 64 + fr; const int col0 = u.pn * BM + wc * 32 + 8 * fq;
#pragma unroll
        for (int ai = 0; ai < 2; ++ai)
#pragma unroll
            for (int m = 0; m < 4; ++m) { bf16_t* rowp = O + (size_t)(row0 + ai * HALF + m * 16) * ldc + col0;
#pragma unroll
                for (int bj = 0; bj < 2; ++bj) { f32x4 v0 = acc[ai][bj][m][0], v1 = acc[ai][bj][m][1];
#pragma unroll
                    for (int e = 0; e < 4; ++e) { const float a = fmaxf(v0[e], 0.f), b = fmaxf(v1[e], 0.f); v0[e] = a * a; v1[e] = b * b; }
                    u32x4 w; w.x = cvt_pk_bf16(v0[0], v0[1]); w.y = cvt_pk_bf16(v0[2], v0[3]); w.z = cvt_pk_bf16(v1[0], v1[1]); w.w = cvt_pk_bf16(v1[2], v1[3]);
                    *(u32x4*)(rowp + bj * HALF) = w; } }
    }
};
struct EpiResF32 {
    static constexpr bool PERM = false, AFTER_DRAIN = false;
    const float* X; float* Z; int ldc; float alpha;
    __device__ __forceinline__ void operator()(const f32x4 (&acc)[2][2][4][2], const Unit& u, int wr, int wc, int fr, int fq) const {
        const int row0 = u.pm * BM + wr * 64 + fr, col0 = u.pn * BM + wc * 32 + 4 * fq;
#pragma unroll
        for (int ai = 0; ai < 2; ++ai)
#pragma unroll
            for (int m = 0; m < 4; ++m) { const size_t off = (size_t)(row0 + ai * HALF + m * 16) * ldc + col0;
#pragma unroll
                for (int bj = 0; bj < 2; ++bj)
#pragma unroll
                    for (int n = 0; n < 2; ++n) { const f32x4 xv = *(const f32x4*)(X + off + bj * HALF + n * 16);
                        *(f32x4*)(Z + off + bj * HALF + n * 16) = xv * alpha + acc[ai][bj][m][n]; } }
    }
};

template <class Epi, class Sched, bool ALIGN_EPI = false, bool SP2 = false>
__device__ __forceinline__ void gemm_phase(PG8_LAS unsigned char* lds, const Gemm g, const Sched& S, const Epi& E, const int wid  ) {
    const int lane = lane_id(), tid = wid * 64 + lane, wr = wid >> 2, wc = wid & 3, fr = lane & 15, fq = lane >> 4;
    const int K = g.K, nt = K / BK;
    unsigned voffA[2], voffB[2];
#pragma unroll
    for (int i = 0; i < 2; ++i) { int R, C; stage_rc(tid * 16 + i * 8192, R, C); const int Rb = Epi::PERM ? ((R & ~31) + perm32(R & 31)) : R;
        voffA[i] = (unsigned)(R * K + C) * 2u; voffB[i] = (unsigned)(Rb * K + C) * 2u; }
    const size_t kstep = (size_t)(BK * 2);
    const size_t hstep = (size_t)HALF * K * 2;
    const size_t tstep = 2 * hstep;
    const unsigned ldsw = (unsigned)wid * 1024u;
    const int aoff = lds_byte(wr * 64 + fr, fq * 8), boff = lds_byte(wc * 32 + fr, fq * 8);
#define PG8_SA(b, h) (((b) * 2 + (h)) * HTB)
#define PG8_SB(b, h) ((4 + (b) * 2 + (h)) * HTB)
#define PG8_STAGE(bufoff, gbase, voff) do { _Pragma("unroll") for (int _i = 0; _i < 2; ++_i) \
        __builtin_amdgcn_global_load_lds((const unsigned*)((const char*)(gbase) + (voff)[_i]), (PG8_LAS unsigned*)(lds + (bufoff) + ldsw + _i * 8192), 16, 0, 0); } while (0)
#define PG8_LDA(dst, b, h) do { _Pragma("unroll") for (int m = 0; m < 4; ++m) _Pragma("unroll") for (int k = 0; k < 2; ++k) dst[m][k] = *(const PG8_LAS bf16x8*)(lds + PG8_SA(b, h) + aoff + m * 2048 + k * 1024); } while (0)
#define PG8_LDB(dst, b, h) do { _Pragma("unroll") for (int n = 0; n < 2; ++n) _Pragma("unroll") for (int k = 0; k < 2; ++k) dst[n][k] = *(const PG8_LAS bf16x8*)(lds + PG8_SB(b, h) + boff + n * 2048 + k * 1024); } while (0)
#define PG8_MMA(ai, bj, At, Bt) do { __builtin_amdgcn_s_setprio(1); _Pragma("unroll") for (int m = 0; m < 4; ++m) _Pragma("unroll") for (int n = 0; n < 2; ++n) _Pragma("unroll") for (int k = 0; k < 2; ++k) \
        acc[ai][bj][m][n] = __builtin_amdgcn_mfma_f32_16x16x32_bf16(Bt[n][k], At[m][k], acc[ai][bj][m][n], 0, 0, 0); __builtin_amdgcn_s_setprio(0); } while (0)
#define PG8_WAIT_V(n) asm volatile("s_waitcnt vmcnt(" #n ")" ::: "memory")
#define PG8_WAIT_L(n) asm volatile("s_waitcnt lgkmcnt(" #n ")" ::: "memory")
#define PG8_BAR __builtin_amdgcn_s_barrier()
#define PG8_SCHED __builtin_amdgcn_sched_barrier(0)
    Unit cur, nxt; int ui = 0;
    if (!S.next(0, cur)) return;
    f32x4 acc[2][2][4][2];
#pragma unroll
    for (int a = 0; a < 2; ++a)
#pragma unroll
        for (int b = 0; b < 2; ++b)
#pragma unroll
            for (int m = 0; m < 4; ++m)
#pragma unroll
                for (int n = 0; n < 2; ++n) acc[a][b][m][n] = (f32x4){0.f, 0.f, 0.f, 0.f};
    bf16x8 At[4][2], B0[2][2], B1[2][2];
    const char* cA = (const char*)g.A + (size_t)cur.pm * tstep; const char* cB = (const char*)g.Bt + (size_t)cur.pn * tstep;
    S.a_ready(cur);
    if constexpr (SP2) {
        PG8_STAGE(PG8_SB(0, 0), cB, voffB); PG8_STAGE(PG8_SB(0, 1), cB + hstep, voffB); PG8_STAGE(PG8_SA(0, 0), cA, voffA); PG8_STAGE(PG8_SA(0, 1), cA + hstep, voffA);
        if (wr == 1) PG8_BAR;
        PG8_WAIT_V(2); PG8_BAR;
        PG8_STAGE(PG8_SB(1, 0), cB + kstep, voffB); PG8_STAGE(PG8_SA(1, 0), cA + kstep, voffA); PG8_STAGE(PG8_SB(1, 1), cB + hstep + kstep, voffB);
        PG8_WAIT_V(6); PG8_BAR;
    } else {
        PG8_STAGE(PG8_SB(0, 0), cB, voffB); PG8_STAGE(PG8_SA(0, 0), cA, voffA); PG8_STAGE(PG8_SB(0, 1), cB + hstep, voffB); PG8_STAGE(PG8_SA(0, 1), cA + hstep, voffA);
        if (wr == 1) PG8_BAR;
        PG8_WAIT_V(4); PG8_BAR;
        PG8_STAGE(PG8_SB(1, 0), cB + kstep, voffB); PG8_STAGE(PG8_SA(1, 0), cA + kstep, voffA); PG8_STAGE(PG8_SB(1, 1), cB + hstep + kstep, voffB);
        PG8_WAIT_V(6); PG8_BAR;
    }
    for (;;) {
        const bool has_next = S.next(ui + 1, nxt);
        const char* nA = has_next ? (const char*)g.A + (size_t)nxt.pm * tstep : cA; const char* nB = has_next ? (const char*)g.Bt + (size_t)nxt.pn * tstep : cB;
        for (int t = 0; t < nt; t += 2) {
            const bool last = (t == nt - 2);
            const char* a1 = cA + (size_t)(t + 1) * kstep;
            const char* a2 = last ? nA : cA + (size_t)(t + 2) * kstep; const char* b2 = last ? nB : cB + (size_t)(t + 2) * kstep;
            const char* a3 = a2 + kstep; const char* b3 = b2 + kstep;
            if (last && has_next) S.a_ready(nxt);
            if constexpr (SP2) {
            PG8_LDB(B0, 0, 0); PG8_LDB(B1, 0, 1); PG8_SCHED; PG8_LDA(At, 0, 0); PG8_STAGE(PG8_SA(1, 1), a1 + hstep, voffA);
            PG8_WAIT_V(8); PG8_WAIT_L(0); PG8_BAR; PG8_MMA(0, 0, At, B0); PG8_MMA(0, 1, At, B1); PG8_BAR; PG8_SCHED;
            PG8_LDA(At, 0, 1); PG8_STAGE(PG8_SB(0, 0), b2, voffB); PG8_STAGE(PG8_SB(0, 1), b2 + hstep, voffB); PG8_STAGE(PG8_SA(0, 0), a2, voffA);
            PG8_WAIT_V(8); PG8_WAIT_L(0); PG8_BAR; PG8_MMA(1, 0, At, B0); PG8_MMA(1, 1, At, B1); PG8_BAR; PG8_SCHED;
            PG8_LDB(B0, 1, 0); PG8_LDB(B1, 1, 1); PG8_SCHED; PG8_LDA(At, 1, 0); PG8_STAGE(PG8_SA(0, 1), a2 + hstep, voffA);
            PG8_WAIT_V(8); PG8_WAIT_L(0); PG8_BAR; PG8_MMA(0, 0, At, B0); PG8_MMA(0, 1, At, B1); PG8_BAR; PG8_SCHED;
            PG8_LDA(At, 1, 1); PG8_STAGE(PG8_SB(1, 0), b3, voffB); PG8_STAGE(PG8_SB(1, 1), b3 + hstep, voffB); PG8_STAGE(PG8_SA(1, 0), a3, voffA);
            PG8_WAIT_V(8); PG8_WAIT_L(0); PG8_BAR; PG8_MMA(1, 0, At, B0); PG8_MMA(1, 1, At, B1); PG8_BAR; PG8_SCHED;
            } else {
            PG8_LDB(B0, 0, 0); PG8_SCHED; PG8_LDA(At, 0, 0); PG8_STAGE(PG8_SA(1, 1), a1 + hstep, voffA);
            PG8_WAIT_L(8); PG8_BAR; PG8_WAIT_L(0); PG8_MMA(0, 0, At, B0); PG8_BAR; PG8_SCHED;
            PG8_LDB(B1, 0, 1); PG8_STAGE(PG8_SB(0, 0), b2, voffB);
            PG8_BAR; PG8_WAIT_L(0); PG8_MMA(0, 1, At, B1); PG8_BAR;
            PG8_LDA(At, 0, 1); PG8_STAGE(PG8_SA(0, 0), a2, voffA);
            PG8_BAR; PG8_WAIT_L(0); PG8_MMA(1, 0, At, B0); PG8_BAR; PG8_SCHED;
            PG8_STAGE(PG8_SB(0, 1), b2 + hstep, voffB);
            PG8_WAIT_V(6); PG8_BAR; PG8_MMA(1, 1, At, B1); PG8_BAR;
            PG8_LDB(B0, 1, 0); PG8_SCHED; PG8_LDA(At, 1, 0); PG8_STAGE(PG8_SA(0, 1), a2 + hstep, voffA);
            PG8_WAIT_L(8); PG8_BAR; PG8_WAIT_L(0); PG8_MMA(0, 0, At, B0); PG8_BAR; PG8_SCHED;
            PG8_LDB(B1, 1, 1); PG8_STAGE(PG8_SB(1, 0), b3, voffB);
            PG8_BAR; PG8_WAIT_L(0); PG8_MMA(0, 1, At, B1); PG8_BAR;
            PG8_LDA(At, 1, 1); PG8_STAGE(PG8_SA(1, 0), a3, voffA);
            PG8_BAR; PG8_WAIT_L(0); PG8_MMA(1, 0, At, B0); PG8_BAR; PG8_SCHED;
            PG8_STAGE(PG8_SB(1, 1), b3 + hstep, voffB);
            PG8_WAIT_V(6); PG8_BAR; PG8_MMA(1, 1, At, B1); PG8_BAR;
            }
        }
        if constexpr (ALIGN_EPI) { if (wr == 0) PG8_BAR; }
        if constexpr (!Epi::AFTER_DRAIN) { E(acc, cur, wr, wc, fr, fq); S.done(cur); }
        if (!has_next) break;
#pragma unroll
        for (int a = 0; a < 2; ++a)
#pragma unroll
            for (int b = 0; b < 2; ++b)
#pragma unroll
                for (int m = 0; m < 4; ++m)
#pragma unroll
                    for (int n = 0; n < 2; ++n) acc[a][b][m][n] = (f32x4){0.f, 0.f, 0.f, 0.f};
        cur = nxt; cA = nA; cB = nB; ++ui;
        if constexpr (ALIGN_EPI) { if (wr == 1) PG8_BAR; }
    }
    PG8_WAIT_V(0);
    if constexpr (!ALIGN_EPI) { if (wr == 0) PG8_BAR; }
    PG8_BAR;
    if constexpr (Epi::AFTER_DRAIN) { E.fused(acc, cur, wr, wc, fr, fq, lds, wid, lane); S.done(cur); }
#undef PG8_SA
#undef PG8_SB
#undef PG8_STAGE
#undef PG8_LDA
#undef PG8_LDB
#undef PG8_MMA
#undef PG8_WAIT_V
#undef PG8_WAIT_L
#undef PG8_BAR
#undef PG8_SCHED
}
}
#define GAS __attribute__((address_space(1)))
#define LAS __attribute__((address_space(3)))
typedef unsigned short bf16;
typedef unsigned v4u __attribute__((ext_vector_type(4)));
typedef float f32x4 __attribute__((ext_vector_type(4)));
typedef short bf16x8 __attribute__((ext_vector_type(8)));
typedef GAS unsigned gu32;
typedef GAS unsigned long long gu64;
#define RLX_AGENT __ATOMIC_RELAXED, __HIP_MEMORY_SCOPE_AGENT
#define LDS_WAIT() asm volatile("s_waitcnt lgkmcnt(0)" ::: "memory")
#define VM_WAIT() asm volatile("s_waitcnt vmcnt(0)" ::: "memory")
__device__ __forceinline__ unsigned long long rt() { return __builtin_amdgcn_s_memrealtime(); }
__device__ __forceinline__ unsigned f2bf(float f) { unsigned u = __builtin_bit_cast(unsigned, f); return (u + 0x7fffu + ((u >> 16) & 1u)) >> 16; }
__device__ __forceinline__ unsigned pk2(float lo, float hi) { return f2bf(lo) | (f2bf(hi) << 16); }

#define XB_TMO      128
#define XB_XCNT(j)  (256  + 64 * (j))
#define XB_XSUB(j)  (1280 + 64 * (j))
#define XB_XGEN(j)  (2304 + 64 * (j))
#define XB_TOP      3328
#define XB_TOPGEN   3392
#define XCD_BAR_WORDS 3456
#define XB_SPIN_CAP (1u << 18)

__device__ __forceinline__ unsigned xb_ld(unsigned* p)              { return __hip_atomic_load(p, __ATOMIC_RELAXED, __HIP_MEMORY_SCOPE_AGENT); }
__device__ __forceinline__ unsigned xb_add(unsigned* p, unsigned v) { return __hip_atomic_fetch_add(p, v, __ATOMIC_RELAXED, __HIP_MEMORY_SCOPE_AGENT); }
__device__ __forceinline__ unsigned xb_xcc_id() { return (unsigned)__builtin_amdgcn_s_getreg((3 << 11) | 20) & 0xFu; }
#define XB_SPIN(cond, bar) do { unsigned _sp = 0; while (cond) { __builtin_amdgcn_s_sleep(1); \
    if ((++_sp & 255u) == 0u) { if (xb_ld(&(bar)[XB_TMO])) break; if (_sp > XB_SPIN_CAP) { atomicAdd(&(bar)[XB_TMO], 1u); break; } } } } while (0)

struct XcdBarrier {
    unsigned* bar; unsigned x;
    volatile LAS unsigned* st;
};

__device__ __forceinline__ XcdBarrier xcd_barrier_post(unsigned* bar, volatile LAS unsigned* st, const bool t0  ) {
    XcdBarrier b; b.bar = bar; b.x = xb_xcc_id(); b.st = st;
    if (t0) (void)xb_add(&bar[XB_XCNT(b.x)], 1u);
    return b;
}
__device__ __forceinline__ void xcd_barrier_complete(unsigned* bar, unsigned x, unsigned& nloc, unsigned& nx) {
    const unsigned G = gridDim.x * gridDim.y * gridDim.z;
    unsigned sum, cnt, mine, sp = 0u;
    for (;;) {
        sum = 0u; cnt = 0u; mine = 0u;
#pragma unroll
        for (unsigned j = 0; j < 16; ++j) { const unsigned c = xb_ld(&bar[XB_XCNT(j)]); sum += c; cnt += (c > 0u) ? 1u : 0u; mine = (j == x) ? c : mine; }
        if (sum == G) break;
        __builtin_amdgcn_s_sleep(1);
        if ((++sp & 255u) == 0u) { if (xb_ld(&bar[XB_TMO])) break; if (sp > XB_SPIN_CAP) { atomicAdd(&bar[XB_TMO], 1u); break; } }
    }
    nloc = mine > 0u ? mine : 1u; nx = cnt > 0u ? cnt : 1u;
}

__device__ __forceinline__ void xcd_barrier(const XcdBarrier& b, const bool t0  ) {
    asm volatile("s_waitcnt vmcnt(0)" ::: "memory");
    __syncthreads();
    if (t0) {
        unsigned* bar = b.bar;
        __builtin_amdgcn_s_waitcnt(0);
        unsigned nloc = b.st[0], nx = b.st[1];
        if (nloc == 0u) { xcd_barrier_complete(bar, b.x, nloc, nx); b.st[0] = nloc; b.st[1] = nx; }
        const unsigned old = xb_add(&bar[XB_XSUB(b.x)], 1u);
        const unsigned gen = old / nloc;
        if (old + 1u == (gen + 1u) * nloc) {
            __builtin_amdgcn_fence(__ATOMIC_RELEASE, "agent");
            asm volatile("s_waitcnt vmcnt(0)" ::: "memory");
            const unsigned og = xb_add(&bar[XB_TOP], 1u);
            const unsigned tg = og / nx;
            if (og + 1u == (tg + 1u) * nx) xb_add(&bar[XB_TOPGEN], 1u);
            else XB_SPIN(xb_ld(&bar[XB_TOPGEN]) == tg, bar);
            __builtin_amdgcn_fence(__ATOMIC_ACQUIRE, "agent");
            xb_add(&bar[XB_XGEN(b.x)], 1u);
            asm volatile("s_waitcnt vmcnt(0)" ::: "memory");
        } else {
            XB_SPIN(xb_ld(&bar[XB_XGEN(b.x)]) == gen, bar);
            __builtin_amdgcn_fence(__ATOMIC_ACQUIRE, "agent");
            asm volatile("s_waitcnt vmcnt(0)" ::: "memory");
        }
    }
    __syncthreads();
}
namespace att {
typedef unsigned short bf16;
constexpr int NW = 8, QBLK = 32, KVBLK = 64, D = 128;
constexpr float SCALE = 0.088388347648318440f;
constexpr float THR = 8.f;
using bf16x8 = __attribute__((ext_vector_type(8))) short;
using s16x4  = __attribute__((ext_vector_type(4))) short;
using f32x16 = __attribute__((ext_vector_type(16))) float;
using f32x8  = __attribute__((ext_vector_type(8))) float;
using u32x4  = __attribute__((ext_vector_type(4))) unsigned;
#define KSWZ(row, colB) ((row) * 256 + ((colB) ^ (((row) & 7) << 4)))
#define SBAR() __builtin_amdgcn_sched_barrier(0)
__device__ __forceinline__ int crow(int r, int hi) { return (r & 3) + 8 * (r >> 2) + 4 * hi; }
__device__ __forceinline__ unsigned cvtpk(float lo, float hi) {
  unsigned r; asm volatile("v_cvt_pk_bf16_f32 %0, %1, %2" : "=v"(r) : "v"(lo), "v"(hi)); return r;
}
__device__ __forceinline__ void partialSM(f32x16& p0, f32x16& p1, float& m_reg, float& mn, float& alpha) {
  constexpr float C = SCALE * 1.4426950408889634f;
  float pmax = p0[0]; for (int r = 1; r < 16; ++r) pmax = fmaxf(pmax, p0[r]); for (int r = 0; r < 16; ++r) pmax = fmaxf(pmax, p1[r]);
  { auto rr = __builtin_amdgcn_permlane32_swap(__float_as_uint(pmax), __float_as_uint(pmax), false, false);
    pmax = fmaxf(__uint_as_float(rr[0]), __uint_as_float(rr[1])); }
  if (__builtin_expect(__all(pmax - m_reg <= THR / SCALE), 1)) { mn = m_reg; alpha = 1.f; }
  else { mn = fmaxf(m_reg, pmax); alpha = __builtin_amdgcn_exp2f((m_reg - mn) * C); m_reg = mn; }
  float mnC = -mn * C;
  for (int r = 0; r < 16; ++r) p0[r] = fmaf(p0[r], C, mnC); for (int r = 0; r < 16; ++r) p1[r] = fmaf(p1[r], C, mnC);
  for (int r = 0; r < 16; ++r) p0[r] = __builtin_amdgcn_exp2f(p0[r]);
}
__device__ __forceinline__ void finishSM(f32x16& p0, f32x16& p1, float alpha, float& l_reg, bf16x8& pa0, bf16x8& pa1, bf16x8& pa2, bf16x8& pa3) {
  for (int r = 0; r < 16; ++r) p1[r] = __builtin_amdgcn_exp2f(p1[r]);
  float ps = 0; for (int r = 0; r < 16; ++r) ps += p0[r]; for (int r = 0; r < 16; ++r) ps += p1[r];
  { auto rr = __builtin_amdgcn_permlane32_swap(__float_as_uint(ps), __float_as_uint(ps), false, false);
    ps = __uint_as_float(rr[0]) + __uint_as_float(rr[1]); }
  l_reg = l_reg * alpha + ps;
#define PK4(P, BASE, OUT) do { unsigned a0 = cvtpk(P[BASE + 0], P[BASE + 1]), a1 = cvtpk(P[BASE + 2], P[BASE + 3]);   \
    unsigned b0 = cvtpk(P[BASE + 4], P[BASE + 5]), b1 = cvtpk(P[BASE + 6], P[BASE + 7]);                              \
    auto r0 = __builtin_amdgcn_permlane32_swap(a0, b0, false, false); auto r1 = __builtin_amdgcn_permlane32_swap(a1, b1, false, false); \
    u32x4 w = {r0[0], r1[0], r0[1], r1[1]}; OUT = *reinterpret_cast<bf16x8*>(&w); } while (0)
  PK4(p0, 0, pa0); PK4(p0, 8, pa1); PK4(p1, 0, pa2); PK4(p1, 8, pa3);
#undef PK4
}
__device__ __forceinline__ void qkt(f32x16& p0, f32x16& p1, const bf16* Ks, const bf16x8* qr, int r32, int hi) {
  p0 = f32x16{}; p1 = f32x16{};
  for (int d0 = 0; d0 < 8; ++d0) { int cb = (d0 * 16 + hi * 8) * 2;
    bf16x8 b0 = *reinterpret_cast<const bf16x8*>((const char*)Ks + KSWZ(r32, cb));
    bf16x8 b1 = *reinterpret_cast<const bf16x8*>((const char*)Ks + KSWZ(32 + r32, cb));
    p0 = __builtin_amdgcn_mfma_f32_32x32x16_bf16(b0, qr[d0], p0, 0, 0, 0);
    p1 = __builtin_amdgcn_mfma_f32_32x32x16_bf16(b1, qr[d0], p1, 0, 0, 0); }
}
__device__ __forceinline__ int v_st(int k, int c) { const int kk = (k & ~0xC) | ((k & 4) << 1) | ((k & 8) >> 1); return ((kk >> 3) * 4 + (c >> 5)) * 512 + ((kk & 7) * 32 + (c & 31)) * 2; }
__device__ __forceinline__ int v_rd_base(int lane) { return ((lane & 3) << 3) | (((lane >> 2) & 3) << 6) | (((lane >> 4) & 1) << 5) | (((lane >> 5) & 1) << 8); }
constexpr int v_rd_off(int d0, int ks, int half) { return d0 * 512 + ks * 4096 + half * 2048; }
template <int OFF> __device__ __forceinline__ s16x4 tr_read(int vb) {
  s16x4 r; asm volatile("ds_read_b64_tr_b16 %0, %1 offset:%2" : "=&v"(r) : "v"(vb), "i"(OFF) : "memory"); return r;
}
template <int D0> __device__ __forceinline__ void pv_one(f32x16& od, int vb, bf16x8 pa0, bf16x8 pa1, bf16x8 pa2, bf16x8 pa3) {
  const s16x4 l0 = tr_read<v_rd_off(D0, 0, 0)>(vb), h0 = tr_read<v_rd_off(D0, 0, 1)>(vb), l1 = tr_read<v_rd_off(D0, 1, 0)>(vb), h1 = tr_read<v_rd_off(D0, 1, 1)>(vb);
  const s16x4 l2 = tr_read<v_rd_off(D0, 2, 0)>(vb), h2 = tr_read<v_rd_off(D0, 2, 1)>(vb), l3 = tr_read<v_rd_off(D0, 3, 0)>(vb), h3 = tr_read<v_rd_off(D0, 3, 1)>(vb);
  asm volatile("s_waitcnt lgkmcnt(0)" ::: "memory"); SBAR();
#define PK(L, H) (bf16x8){L[0], L[1], L[2], L[3], H[0], H[1], H[2], H[3]}
  od = __builtin_amdgcn_mfma_f32_32x32x16_bf16(pa0, PK(l0, h0), od, 0, 0, 0);
  od = __builtin_amdgcn_mfma_f32_32x32x16_bf16(pa1, PK(l1, h1), od, 0, 0, 0);
  od = __builtin_amdgcn_mfma_f32_32x32x16_bf16(pa2, PK(l2, h2), od, 0, 0, 0);
  od = __builtin_amdgcn_mfma_f32_32x32x16_bf16(pa3, PK(l3, h3), od, 0, 0, 0);
#undef PK
}
__device__ __forceinline__ void pv_d0(f32x16* o, int vb, bf16x8 pa0, bf16x8 pa1, bf16x8 pa2, bf16x8 pa3) {
  pv_one<0>(o[0], vb, pa0, pa1, pa2, pa3); pv_one<1>(o[1], vb, pa0, pa1, pa2, pa3); pv_one<2>(o[2], vb, pa0, pa1, pa2, pa3); pv_one<3>(o[3], vb, pa0, pa1, pa2, pa3);
}

constexpr size_t SHM_V = KVBLK * D * 2, SHM_K = KVBLK * D * 2, SHM_ATTN = 2 * SHM_V + 2 * SHM_K + NW * 64 * 4;
constexpr float NEG_INF = -__builtin_inff();

template <class Cfg>
__device__ __forceinline__ void attn_unit(const Cfg& cfg, char* lds, const int wid  ) {
  const int lane = lane_id(), tid = wid * 64 + lane, r32 = lane & 31, hi = lane >> 5;
  bf16* V_lds = (bf16*)lds; bf16* K_lds = (bf16*)(lds + 2 * SHM_V);
  float* ws = (float*)(lds + 2 * SHM_V + 2 * SHM_K) + wid * 64; float* li_l = ws; float* al_l = ws + 32;
  float m_reg = -1e30f, l_reg = 0; f32x16 o[4] = {}; bf16x8 qr[8];
  const bf16* Qw = cfg.proj + cfg.q_off(wid * QBLK + r32) + hi * 8;
#pragma unroll
  for (int d0 = 0; d0 < 8; ++d0) qr[d0] = *reinterpret_cast<const bf16x8*>(Qw + d0 * 16);
  const int sr = tid >> 4, sc = (tid & 15) * 8, vst0 = v_st(sr, sc), vst1 = v_st(32 + sr, sc);
  const int vb0 = (int)(uintptr_t)V_lds + v_rd_base(lane);
  struct { bf16x8 vs0, vs1, ks0, ks1; } sr_[2];
#define SLOAD(i, t) do { const unsigned o0_ = cfg.kv_off((t), sr) + sc, o1_ = cfg.kv_off((t), 32 + sr) + sc; \
    sr_[i].vs0 = *reinterpret_cast<const bf16x8*>(cfg.proj + cfg.vcol + o0_); sr_[i].vs1 = *reinterpret_cast<const bf16x8*>(cfg.proj + cfg.vcol + o1_); \
    sr_[i].ks0 = *reinterpret_cast<const bf16x8*>(cfg.proj + cfg.kcol + o0_); sr_[i].ks1 = *reinterpret_cast<const bf16x8*>(cfg.proj + cfg.kcol + o1_); } while (0)
#define SWRITE(b, i) do { *(bf16x8*)((char*)V_lds + (b) * SHM_V + vst0) = sr_[i].vs0;          \
    *(bf16x8*)((char*)V_lds + (b) * SHM_V + vst1) = sr_[i].vs1; int kc = sc * 2;               \
    *(bf16x8*)((char*)K_lds + (b) * SHM_K + KSWZ(sr, kc)) = sr_[i].ks0;                       \
    *(bf16x8*)((char*)K_lds + (b) * SHM_K + KSWZ(32 + sr, kc)) = sr_[i].ks1; } while (0)
#define SWAIT() asm volatile("s_waitcnt vmcnt(4)" ::: "memory")
#define RESC(a) do { if (__any((a) < 1.f)) { if (hi == 0) al_l[r32] = (a); asm volatile("s_waitcnt lgkmcnt(0)" ::: "memory"); \
    for (int d = 0; d < 4; ++d) for (int r = 0; r < 16; ++r) o[d][r] *= al_l[crow(r, hi)]; } } while (0)
#define QK(P0, P1, KB, T, MN, AL) do { if (cfg.active((T), wid)) { qkt(P0, P1, (KB), qr, r32, hi); cfg.mask(P0, P1, (T), wid, r32, hi); partialSM(P0, P1, m_reg, MN, AL); } else { AL = 1.f; } } while (0)
#define QK1(P0, P1, KB, T) do { if (cfg.active((T), wid)) { qkt(P0, P1, (KB), qr, r32, hi); cfg.mask(P0, P1, (T), wid, r32, hi); } } while (0)
#define PSM(P0, P1, T, MN, AL) do { if (cfg.active((T), wid)) { partialSM(P0, P1, m_reg, MN, AL); } else { AL = 1.f; } } while (0)
#define FPV(P0, P1, AL, VB, T) do { if (cfg.active((T), wid)) { finishSM(P0, P1, AL, l_reg, pa0, pa1, pa2, pa3); SBAR(); pv_d0(o, (VB), pa0, pa1, pa2, pa3); } } while (0)
  f32x16 pA0, pA1, pB0, pB1; float mnA, mnB, alA, alB; bf16x8 pa0, pa1, pa2, pa3; const int NT = Cfg::NT;
  constexpr int SE = 0, SO = 1;
  SLOAD(SE, 0); asm volatile("s_waitcnt vmcnt(0)" ::: "memory"); SWRITE(0, SE); __syncthreads();
  QK(pA0, pA1, K_lds, 0, mnA, alA);
  SLOAD(SO, 1); if (2 < NT) SLOAD(SE, 2);
  SWAIT(); SWRITE(1, SO); __syncthreads();
  for (int j = 1; j + 1 < NT; j += 2) {
    SBAR(); QK1(pB0, pB1, (bf16*)((char*)K_lds + SHM_K), j);
    if (cfg.active(j - 1, wid)) { finishSM(pA0, pA1, alA, l_reg, pa0, pa1, pa2, pa3); } SBAR();
    SLOAD(SO, j + 2); SBAR();
    if (cfg.active(j - 1, wid)) { pv_d0(o, vb0, pa0, pa1, pa2, pa3); }
    PSM(pB0, pB1, j, mnB, alB);
    __syncthreads(); SWAIT(); SWRITE(0, SE);
    RESC(alB); __syncthreads();
    SBAR(); QK1(pA0, pA1, K_lds, j + 1);
    if (cfg.active(j, wid)) { finishSM(pB0, pB1, alB, l_reg, pa0, pa1, pa2, pa3); } SBAR();
    if (j + 3 < NT) SLOAD(SE, j + 3); SBAR();
    if (cfg.active(j, wid)) { pv_d0(o, vb0 + (int)SHM_V, pa0, pa1, pa2, pa3); }
    PSM(pA0, pA1, j + 1, mnA, alA);
    __syncthreads(); SWAIT(); SWRITE(1, SO);
    RESC(alA); __syncthreads();
  }
  SBAR(); QK1(pB0, pB1, (bf16*)((char*)K_lds + SHM_K), NT - 1);
  if (cfg.active(NT - 2, wid)) { finishSM(pA0, pA1, alA, l_reg, pa0, pa1, pa2, pa3); SBAR(); pv_d0(o, vb0, pa0, pa1, pa2, pa3); }
  PSM(pB0, pB1, NT - 1, mnB, alB);
  __syncthreads(); RESC(alB);
  if (cfg.active(NT - 1, wid)) { finishSM(pB0, pB1, alB, l_reg, pa0, pa1, pa2, pa3); SBAR(); pv_d0(o, vb0 + (int)SHM_V, pa0, pa1, pa2, pa3); }
  if (hi == 0) li_l[r32] = l_reg; asm volatile("s_waitcnt lgkmcnt(0)" ::: "memory");
  if (Cfg::HAS_LSE) { if (hi == 0) cfg.store_lse(wid * QBLK + r32, m_reg * SCALE + __logf(l_reg)); }
#pragma unroll
  for (int r = 0; r < 16; ++r) { const int orow = crow(r, hi); const float rl = __builtin_amdgcn_rcpf(li_l[orow]); bf16* op = cfg.obuf + cfg.o_off(wid * QBLK + orow) + r32;
#pragma unroll
    for (int d0 = 0; d0 < 4; ++d0) op[d0 * 32] = (bf16)(cvtpk(o[d0][r] * rl, 0.f) & 0xffffu); }
  __syncthreads();
#undef SLOAD
#undef SWRITE
#undef SWAIT
#undef RESC
#undef QK
#undef QK1
#undef PSM
#undef FPV
}
#undef KSWZ
#undef SBAR
}

constexpr int NWAVES = 8;
constexpr int NTOK = 49152, SEQ = 4096, NSEQ = 12, NTOK_P = 16384;
constexpr int DM = 2048, INW = 5632, DFF = 8192, NLAYER = 4, HD = 128;
constexpr int COL_AQ = 0, COL_AK = 512, COL_AV = 768, COL_BQ = 1024, COL_BK = 1792, COL_BV = 2560, COL_CQ = 3328, COL_CK = 4096, COL_CV = 4864;
constexpr int OCOL_A = 0, OCOL_B = 512, OCOL_C = 1280;
constexpr float DN_ALPHA = 1.681792830507429f;
constexpr float EPS = 1e-6f;
constexpr float ATT_SCALE = 0.08838834764831845f;

constexpr size_t MiB = 1u << 20;
constexpr size_t WS_CTL = 0, CTL_ZERO_BYTES = 1 * MiB;
constexpr size_t WS_ROPE_B = 1 * MiB;
constexpr size_t WS_ROPE_A = 3 * MiB;
constexpr size_t WS_LSE    = 4 * MiB;
constexpr size_t WS_WIN    = 6 * MiB;
constexpr size_t WS_WOUT   = 28 * MiB;
constexpr size_t WS_WFF1   = 36 * MiB;
constexpr size_t WS_WFF2   = 68 * MiB;
constexpr size_t WS_XB     = 100 * MiB;
constexpr size_t WS_PROJ   = 292 * MiB;
constexpr size_t WS_O      = 820 * MiB;
constexpr size_t WS_H      = 292 * MiB;
constexpr size_t WS_END    = 1060 * MiB;
static_assert(WS_PROJ + (size_t)NTOK * INW * 2 == WS_O && WS_O + (size_t)NTOK * DM * 2 <= WS_END && WS_H + (size_t)NTOK * DFF * 2 == WS_END && WS_XB + (size_t)NTOK * DM * 2 == WS_PROJ, "d_ws map");
constexpr int CW_TMO = 0, CW_CODE = 1, CW_BAR = 4096;

constexpr int RING_OFF = 0, RING_BYTES = 131072;
constexpr int LDSCTL_OFF = RING_BYTES, MISC_OFF = LDSCTL_OFF + 320;
constexpr int LDS_BYTES = 147456;
static_assert(MISC_OFF + 128 <= LDS_BYTES, "LDS map");

struct Frame {
    LAS unsigned char* lds;
    volatile LAS unsigned* MISC;
    gu32* ctl;
    int wave;
    int vcu, G;
    int gw, NGW;
    const float *x_prompt, *x_sample, *w_in, *a_q_gain, *a_k_gain, *c_rel_bias, *mix_gain, *w_out, *ln1_g, *ln1_b, *w_ff1, *w_ff2, *ln2_g, *ln2_b;
    float* X;
    bf16 *Win_t, *Wout_t, *Wff1_t, *Wff2_t;
    bf16 *XB, *PROJ, *O, *H;
    float* LSE; float* ROPE_B; float* ROPE_A;
};

__device__ __forceinline__ float wave_sum(float v) {
#pragma unroll
    for (int o = 1; o < 64; o <<= 1) v += __shfl_xor(v, o);
    return v;
}
__device__ __forceinline__ float wave_max(float v) {
#pragma unroll
    for (int o = 1; o < 64; o <<= 1) v = fmaxf(v, __shfl_xor(v, o));
    return v;
}
__device__ __forceinline__ float bf2f(unsigned short b) { return __builtin_bit_cast(float, (unsigned)b << 16); }
__device__ __forceinline__ float bflo(unsigned w) { return __builtin_bit_cast(float, w << 16); }
__device__ __forceinline__ float bfhi(unsigned w) { return __builtin_bit_cast(float, w & 0xffff0000u); }

__device__ __forceinline__ void transpose_item(const float* W, int K, int N, bf16* WT, LAS float* scr, int item, int lane) {
    const int nblk = N / 32, kb = item / nblk, nb = item % nblk, k0 = 64 * kb, n0 = 32 * nb;
#pragma unroll 8
    for (int i = 0; i < 32; ++i) { const int kk = 2 * i + (lane >> 5); scr[kk * 33 + (lane & 31)] = W[(size_t)(k0 + kk) * N + n0 + (lane & 31)]; }
    LDS_WAIT(); asm volatile("" ::: "memory");
    const int c = lane & 7;
#pragma unroll
    for (int j = 0; j < 4; ++j) { const int n = (lane >> 3) + 8 * j; const LAS float* s = scr + (8 * c) * 33 + n;
        v4u o; o.x = pk2(s[0 * 33], s[1 * 33]); o.y = pk2(s[2 * 33], s[3 * 33]); o.z = pk2(s[4 * 33], s[5 * 33]); o.w = pk2(s[6 * 33], s[7 * 33]);
        *(GAS v4u*)(WT + (size_t)(n0 + n) * K + k0 + 8 * c) = o; }
    LDS_WAIT(); asm volatile("" ::: "memory");
}
__device__ __forceinline__ void convert_weights(Frame& F, int l) {
    const int lane = lane_id();
    LAS float* scr = (LAS float*)(F.lds + RING_OFF + F.wave * 16384);
    constexpr int I_IN = (DM / 64) * (INW / 32), I_OUT = (DM / 64) * (DM / 32), I_F1 = (DM / 64) * (DFF / 32), I_F2 = (DFF / 64) * (DM / 32);
    constexpr int NITEMS = I_IN + I_OUT + I_F1 + I_F2;
    const float* w_in = F.w_in + (size_t)l * DM * INW; const float* w_out = F.w_out + (size_t)l * DM * DM;
    const float* w_ff1 = F.w_ff1 + (size_t)l * DM * DFF; const float* w_ff2 = F.w_ff2 + (size_t)l * DFF * DM;
    for (int it = F.gw; it < NITEMS; it += F.NGW) {
        int r = it;
        if (r < I_IN) { transpose_item(w_in, DM, INW, F.Win_t, scr, r, lane); continue; } r -= I_IN;
        if (r < I_OUT) { transpose_item(w_out, DM, DM, F.Wout_t, scr, r, lane); continue; } r -= I_OUT;
        if (r < I_F1) { transpose_item(w_ff1, DM, DFF, F.Wff1_t, scr, r, lane); continue; } r -= I_F1;
        transpose_item(w_ff2, DFF, DM, F.Wff2_t, scr, r, lane);
    }
}

__device__ __forceinline__ void sincos_d(double a, float& c, float& s) {
    const double k = __builtin_rint(a * 0.6366197723675814);
    const double r = __builtin_fma(-k, 1.5707963267948966, a) - k * 6.123233995736766e-17;
    const double r2 = r * r;
    double sp = -1.0 / 1307674368000.0;
    sp = sp * r2 + 1.0 / 6227020800.0; sp = sp * r2 - 1.0 / 39916800.0; sp = sp * r2 + 1.0 / 362880.0; sp = sp * r2 - 1.0 / 5040.0; sp = sp * r2 + 1.0 / 120.0; sp = sp * r2 - 1.0 / 6.0; sp = sp * r2 + 1.0;
    sp *= r;
    double cp = 1.0 / 20922789888000.0;
    cp = cp * r2 - 1.0 / 87178291200.0; cp = cp * r2 + 1.0 / 479001600.0; cp = cp * r2 - 1.0 / 3628800.0; cp = cp * r2 + 1.0 / 40320.0; cp = cp * r2 - 1.0 / 720.0; cp = cp * r2 + 1.0 / 24.0; cp = cp * r2 - 0.5; cp = cp * r2 + 1.0;
    const int q = ((int)k) & 3;
    const double ss = (q == 0) ? sp : (q == 1) ? cp : (q == 2) ? -sp : -cp;
    const double cc = (q == 0) ? cp : (q == 1) ? -sp : (q == 2) ? -cp : sp;
    c = (float)cc; s = (float)ss;
}

__device__ __forceinline__ void phase_prologue(Frame& F) {
    const int lane = lane_id();
    const int gt = F.gw * 64 + lane, NGT = F.NGW * 64;
    for (int e = gt; e < SEQ * 64 + 64 * 32; e += NGT) {
        int t, i; double inv = 1.0; float* dst;
        if (e < SEQ * 64) { t = e >> 6; i = e & 63; dst = F.ROPE_B + 2 * (size_t)e; for (int j = 0; j < i; ++j) inv *= 0.8659643233600653; }
        else { const int e2 = e - SEQ * 64; t = e2 >> 5; i = e2 & 31; dst = F.ROPE_A + 2 * (size_t)e2; for (int j = 0; j < 2 * i; ++j) inv *= 0.8659643233600653; }
        float c, s; sincos_d((double)t * inv, c, s);
        dst[0] = c; dst[1] = s;
    }
    for (int m = F.gw; m < NTOK; m += F.NGW) {
        const float* src = (m < NTOK_P) ? F.x_prompt + (size_t)m * DM : F.x_sample + (size_t)(m - NTOK_P) * DM;
        const GAS f32x4* xr = (const GAS f32x4*)src + lane; GAS f32x4* xo = (GAS f32x4*)(F.X + (size_t)m * DM) + lane;
        GAS unsigned long long* o8 = (GAS unsigned long long*)(F.XB + (size_t)m * DM) + lane;
#pragma unroll
        for (int j = 0; j < 8; ++j) { const f32x4 v = xr[64 * j]; xo[64 * j] = v; o8[64 * j] = (unsigned long long)pk2(v.x, v.y) | ((unsigned long long)pk2(v.z, v.w) << 32); }
    }
    convert_weights(F, 0);
}

__device__ __forceinline__ void phase_prep(Frame& F, int l) {
    const int lane = lane_id();
    const float* gq = F.a_q_gain + l * HD; const float* gk = F.a_k_gain + l * HD;
    const long NIT = (long)NTOK * 18 * 8;
    for (long ti = (long)F.gw * 64 + lane; ti < NIT; ti += (long)F.NGW * 64) {
        const int c = (int)(ti & 7); const int th = (int)(ti >> 3); const int m = th / 18, hs = th - m * 18; const int t = m & (SEQ - 1);
        int col, lo_off, hi_off; const float* tab; const float* gain = nullptr;
        if (hs < 6) {
            col = (hs < 4) ? COL_AQ + hs * HD : COL_AK + (hs - 4) * HD; gain = (hs < 4) ? gq : gk;
            const int cc = c & 3, half = c >> 2; lo_off = half * 64 + cc * 8; hi_off = lo_off + 32;
            const int pos = half ? (t & 63) : (t >> 6); tab = F.ROPE_A + 2 * (size_t)(pos * 32 + cc * 8);
        } else {
            col = (hs < 12) ? COL_BQ + (hs - 6) * HD : COL_BK + (hs - 12) * HD;
            lo_off = c * 8; hi_off = 64 + c * 8; tab = F.ROPE_B + 2 * (size_t)(t * 64 + c * 8);
        }
        bf16* p = F.PROJ + (size_t)m * INW + col;
        const v4u lo4 = *(const v4u*)(p + lo_off), hi4 = *(const v4u*)(p + hi_off);
        float lo[8], hv[8];
        lo[0] = bflo(lo4.x); lo[1] = bfhi(lo4.x); lo[2] = bflo(lo4.y); lo[3] = bfhi(lo4.y); lo[4] = bflo(lo4.z); lo[5] = bfhi(lo4.z); lo[6] = bflo(lo4.w); lo[7] = bfhi(lo4.w);
        hv[0] = bflo(hi4.x); hv[1] = bfhi(hi4.x); hv[2] = bflo(hi4.y); hv[3] = bfhi(hi4.y); hv[4] = bflo(hi4.z); hv[5] = bfhi(hi4.z); hv[6] = bflo(hi4.w); hv[7] = bfhi(hi4.w);
        float ss = 0.f;
#pragma unroll
        for (int j = 0; j < 8; ++j) ss += lo[j] * lo[j] + hv[j] * hv[j];
        ss += __shfl_xor(ss, 1); ss += __shfl_xor(ss, 2); ss += __shfl_xor(ss, 4);
        if (hs < 6) { const float rs = 1.0f / sqrtf(ss * (1.0f / HD) + EPS);
#pragma unroll
            for (int j = 0; j < 8; ++j) { lo[j] = lo[j] * rs * gain[lo_off + j]; hv[j] = hv[j] * rs * gain[hi_off + j]; } }
        float ol[8], oh[8];
#pragma unroll
        for (int j = 0; j < 8; ++j) { const float cs = tab[2 * j], sn = tab[2 * j + 1]; ol[j] = lo[j] * cs - hv[j] * sn; oh[j] = hv[j] * cs + lo[j] * sn; }
        v4u w; w.x = pk2(ol[0], ol[1]); w.y = pk2(ol[2], ol[3]); w.z = pk2(ol[4], ol[5]); w.w = pk2(ol[6], ol[7]); *(v4u*)(p + lo_off) = w;
        w.x = pk2(oh[0], oh[1]); w.y = pk2(oh[2], oh[3]); w.z = pk2(oh[4], oh[5]); w.w = pk2(oh[6], oh[7]); *(v4u*)(p + hi_off) = w;
    }
}

struct CfgA {
    static constexpr int NT = SEQ / 64; static constexpr bool HAS_LSE = false;
    const bf16* proj; bf16* obuf; unsigned qbase, kvbase, obase; int kcol, vcol;
    __device__ __forceinline__ unsigned q_off(int row) const { return qbase + (unsigned)row * INW; }
    __device__ __forceinline__ unsigned kv_off(int t, int row) const { return kvbase + (unsigned)(t * 64 + row) * INW; }
    __device__ __forceinline__ bool active(int, int) const { return true; }
    __device__ __forceinline__ void mask(att::f32x16&, att::f32x16&, int, int, int, int) const {}
    __device__ __forceinline__ unsigned o_off(int row) const { return obase + (unsigned)row * DM; }
    __device__ __forceinline__ void store_lse(int, float) const {}
};
__device__ __forceinline__ void phase_attn_A(Frame& F, char* lds) {
    const int x = F.vcu / (F.G / 8), j = F.vcu % (F.G / 8);
    for (int u = F.vcu; u < NSEQ * 4 * 16; u += F.G) {
        int combo, hq2, qb;
        if (F.G == 256) { const int i = u / 256; combo = i * 8 + x; hq2 = j >> 4; qb = j & 15; } else { combo = u / 32; hq2 = (u >> 4) & 1; qb = u & 15; }
        const int s = combo >> 1, kvh = combo & 1, hq = kvh * 2 + hq2;
        const unsigned row0 = (unsigned)s * SEQ;
        CfgA cfg; cfg.proj = F.PROJ; cfg.obuf = F.O; cfg.qbase = (row0 + (unsigned)qb * 256) * INW + COL_AQ + hq * HD; cfg.kvbase = row0 * INW; cfg.kcol = COL_AK + kvh * HD; cfg.vcol = COL_AV + kvh * HD;
        cfg.obase = (row0 + (unsigned)qb * 256) * DM + OCOL_A + hq * HD;
        att::attn_unit<CfgA>(cfg, lds, F.wave);
    }
}

__device__ __forceinline__ float dot8(v4u a, v4u b) {
    return bflo(a.x) * bflo(b.x) + bfhi(a.x) * bfhi(b.x) + bflo(a.y) * bflo(b.y) + bfhi(a.y) * bfhi(b.y) + bflo(a.z) * bflo(b.z) + bfhi(a.z) * bfhi(b.z) + bflo(a.w) * bflo(b.w) + bfhi(a.w) * bfhi(b.w);
}
__device__ __forceinline__ void naive_B(Frame& F, int m, int hb) {
    const int lane = lane_id(); const int t = m & (SEQ - 1); const size_t sbase = (size_t)(m - t);
    const int g = hb >> 1, sh = 2 * g, dil = 1 << sh, i = t >> sh, r = t & (dil - 1), L = SEQ >> sh;
    const bf16* qp = F.PROJ + (size_t)m * INW + COL_BQ + hb * HD;
    const bf16* kb = F.PROJ + sbase * INW + COL_BK + hb * HD; const bf16* vb = F.PROJ + sbase * INW + COL_BV + hb * HD;
    float dot[3] = {0.f, 0.f, 0.f}; bool valid[3]; const bf16* kp[3];
#pragma unroll
    for (int j3 = 0; j3 < 3; ++j3) { const int jj = lane + 64 * j3, ik = i - 64 + jj; valid[j3] = (jj <= 128) && (ik >= 0) && (ik < L);
        const int ikc = valid[j3] ? ik : i; kp[j3] = kb + (size_t)(ikc * dil + r) * INW; }
#pragma unroll
    for (int ch = 0; ch < 16; ++ch) { const v4u qv = *(const v4u*)(qp + ch * 8);
#pragma unroll
        for (int j3 = 0; j3 < 3; ++j3) { const v4u kv = *(const v4u*)(kp[j3] + ch * 8); dot[j3] += dot8(qv, kv); } }
    float s[3];
#pragma unroll
    for (int j3 = 0; j3 < 3; ++j3) s[j3] = valid[j3] ? dot[j3] * ATT_SCALE : -__builtin_inff();
    const float mx = wave_max(fmaxf(s[0], fmaxf(s[1], s[2])));
    float p[3];
#pragma unroll
    for (int j3 = 0; j3 < 3; ++j3) p[j3] = valid[j3] ? __expf(s[j3] - mx) : 0.f;
    const float lsum = wave_sum(p[0] + p[1] + p[2]);
    float a0 = 0.f, a1 = 0.f;
#pragma unroll
    for (int j3 = 0; j3 < 3; ++j3) {
        const int nj = (j3 == 2) ? 1 : 64;
        for (int jl = 0; jl < nj; ++jl) { const float pj = __shfl(p[j3], jl); const int ik = i - 64 + jl + 64 * j3;
            if (ik >= 0 && ik < L) { const unsigned w = *(const unsigned*)(vb + (size_t)(ik * dil + r) * INW + 2 * lane); a0 += pj * bflo(w); a1 += pj * bfhi(w); } } }
    const float rl = 1.0f / lsum;
    *(unsigned*)(F.O + (size_t)m * DM + OCOL_B + hb * HD + 2 * lane) = pk2(a0 * rl, a1 * rl);
    if (lane == 0) F.LSE[(size_t)m * 8 + hb] = mx + __logf(lsum);
}
__device__ __forceinline__ void naive_C(Frame& F, int l, int m, int hc) {
    const int lane = lane_id(); const int t = m & (SEQ - 1); const size_t sbase = (size_t)(m - t);
    const int r = t >> 6, c = t & 63; const int r0 = min(max(r - 4, 0), 56), sc = min(max(c - 8, 0), 48);
    const bf16* qp = F.PROJ + (size_t)m * INW + COL_CQ + hc * HD;
    const bf16* kb = F.PROJ + sbase * INW + COL_CK + hc * HD; const bf16* vb = F.PROJ + sbase * INW + COL_CV + hc * HD;
    const float* rel = F.c_rel_bias + ((size_t)l * 6 + hc) * (15 * 31);
    float dot[2] = {0.f, 0.f}; const bf16* kp[2]; float bias[2];
#pragma unroll
    for (int j2 = 0; j2 < 2; ++j2) { const int kk = lane + 64 * j2, jr = kk >> 4, jc = kk & 15; kp[j2] = kb + (size_t)((r0 + jr) * 64 + sc + jc) * INW;
        bias[j2] = rel[(r0 + jr - r + 7) * 31 + (sc + jc - c + 15)]; }
#pragma unroll
    for (int ch = 0; ch < 16; ++ch) { const v4u qv = *(const v4u*)(qp + ch * 8);
#pragma unroll
        for (int j2 = 0; j2 < 2; ++j2) { const v4u kv = *(const v4u*)(kp[j2] + ch * 8); dot[j2] += dot8(qv, kv); } }
    const float s0 = dot[0] * ATT_SCALE + bias[0], s1 = dot[1] * ATT_SCALE + bias[1];
    const float mx = wave_max(fmaxf(s0, s1));
    const float p0 = __expf(s0 - mx), p1 = __expf(s1 - mx);
    const float lsum = wave_sum(p0 + p1);
    float a0 = 0.f, a1 = 0.f;
    for (int kk = 0; kk < 128; ++kk) { const float pj = (kk < 64) ? __shfl(p0, kk) : __shfl(p1, kk - 64); const int jr = kk >> 4, jc = kk & 15;
        const unsigned w = *(const unsigned*)(vb + (size_t)((r0 + jr) * 64 + sc + jc) * INW + 2 * lane); a0 += pj * bflo(w); a1 += pj * bfhi(w); }
    const float rl = 1.0f / lsum;
    *(unsigned*)(F.O + (size_t)m * DM + OCOL_C + hc * HD + 2 * lane) = pk2(a0 * rl, a1 * rl);
}
__device__ __forceinline__ void phase_attn_BC_naive(Frame& F, int l) {
    for (int it = F.gw; it < NTOK * 12; it += F.NGW) { const int m = it / 12, h = it - m * 12;
        if (h < 6) naive_B(F, m, h); else naive_C(F, l, m, h - 6); }
}

__device__ __forceinline__ void phase_mix(Frame& F, int l) {
    const int lane = lane_id();
    const float* gain = F.mix_gain + (size_t)l * DM;
    for (int m = F.gw; m < NTOK; m += F.NGW) {
        bf16* row = F.O + (size_t)m * DM; const float* lse = F.LSE + (size_t)m * 8;
        float al[6];
#pragma unroll
        for (int h = 0; h < 2; ++h) { const float l0 = lse[h], l1 = lse[2 + h], l2 = lse[4 + h]; const float mx = fmaxf(l0, fmaxf(l1, l2));
            const float e0 = __expf(l0 - mx), e1 = __expf(l1 - mx), e2 = __expf(l2 - mx); const float inv = 1.0f / (e0 + e1 + e2); al[h] = e0 * inv; al[2 + h] = e1 * inv; al[4 + h] = e2 * inv; }
        float v[4][8]; float ssA = 0.f, ssB = 0.f, ssC = 0.f;
#pragma unroll
        for (int j = 0; j < 4; ++j) { const int col = 8 * lane + 512 * j; const v4u w = *(const v4u*)(row + col);
            v[j][0] = bflo(w.x); v[j][1] = bfhi(w.x); v[j][2] = bflo(w.y); v[j][3] = bfhi(w.y); v[j][4] = bflo(w.z); v[j][5] = bfhi(w.z); v[j][6] = bflo(w.w); v[j][7] = bfhi(w.w);
            float a = 1.f;
            if (col >= OCOL_B && col < OCOL_C) { const int hb = (col - OCOL_B) >> 7; a = (hb == 0) ? al[0] : (hb == 1) ? al[1] : (hb == 2) ? al[2] : (hb == 3) ? al[3] : (hb == 4) ? al[4] : al[5]; }
            float ss = 0.f;
#pragma unroll
            for (int e = 0; e < 8; ++e) { v[j][e] *= a; ss += v[j][e] * v[j][e]; }
            if (col < OCOL_B) ssA += ss; else if (col < OCOL_C) ssB += ss; else ssC += ss; }
        ssA = wave_sum(ssA); ssB = wave_sum(ssB); ssC = wave_sum(ssC);
        const float rA = 1.0f / sqrtf(ssA * (1.0f / 512.f) + EPS), rB = 1.0f / sqrtf(ssB * (1.0f / 768.f) + EPS), rC = 1.0f / sqrtf(ssC * (1.0f / 768.f) + EPS);
#pragma unroll
        for (int j = 0; j < 4; ++j) { const int col = 8 * lane + 512 * j; const float rr = (col < OCOL_B) ? rA : (col < OCOL_C) ? rB : rC;
            const f32x4 g0 = *(const f32x4*)(gain + col), g1 = *(const f32x4*)(gain + col + 4);
            v4u w; w.x = pk2(v[j][0] * rr * g0.x, v[j][1] * rr * g0.y); w.y = pk2(v[j][2] * rr * g0.z, v[j][3] * rr * g0.w);
            w.z = pk2(v[j][4] * rr * g1.x, v[j][5] * rr * g1.y); w.w = pk2(v[j][6] * rr * g1.z, v[j][7] * rr * g1.w);
            *(v4u*)(row + col) = w; }
    }
}

__device__ __forceinline__ void phase_ln(Frame& F, const float* g, const float* b) {
    const int lane = lane_id();
    for (int m = F.gw; m < NTOK; m += F.NGW) {
        GAS f32x4* xr = (GAS f32x4*)(F.X + (size_t)m * DM) + lane;
        f32x4 v[8]; float s = 0.f;
#pragma unroll
        for (int j = 0; j < 8; ++j) { v[j] = xr[64 * j]; s += (v[j].x + v[j].y) + (v[j].z + v[j].w); }
        const float mean = wave_sum(s) * (1.f / DM); float s2 = 0.f;
#pragma unroll
        for (int j = 0; j < 8; ++j) { v[j] = v[j] - mean; s2 += (v[j].x * v[j].x + v[j].y * v[j].y) + (v[j].z * v[j].z + v[j].w * v[j].w); }
        const float rstd = 1.f / sqrtf(wave_sum(s2) * (1.f / DM) + EPS);
        GAS unsigned long long* o8 = (GAS unsigned long long*)(F.XB + (size_t)m * DM) + lane;
#pragma unroll
        for (int j = 0; j < 8; ++j) { const f32x4 gg = *((const f32x4*)g + lane + 64 * j), bb = *((const f32x4*)b + lane + 64 * j);
            const f32x4 y = v[j] * rstd * gg + bb; xr[64 * j] = y;
            o8[64 * j] = (unsigned long long)pk2(y.x, y.y) | ((unsigned long long)pk2(y.z, y.w) << 32); }
    }
}

#ifndef MK_PER_PHASE
#define MK_PER_PHASE 0
#endif
constexpr int PH_PER_LAYER = 9, N_PHASES = 1 + PH_PER_LAYER * NLAYER;
struct Args { const float* in[14]; float* out; unsigned char* ws; int ph_lo, ph_hi; };
static_assert(sizeof(Args) == 14 * 8 + 8 + 8 + 8, "Args has no padding");

__global__ void __launch_bounds__(NWAVES * 64, 2) trunk_fwd(Args args) {
    extern __shared__ __attribute__((aligned(16))) unsigned char lds[];
    Frame F;
    F.lds = (LAS unsigned char*)lds;
    F.MISC = (volatile LAS unsigned*)(F.lds + MISC_OFF);
    F.wave = __builtin_amdgcn_readfirstlane((int)threadIdx.x >> 6);
    F.G = gridDim.x; { const int bx = blockIdx.x; F.vcu = (F.G % 8 == 0) ? (bx % 8) * (F.G / 8) + bx / 8 : bx; }
    F.gw = F.vcu * NWAVES + F.wave; F.NGW = F.G * NWAVES;
    unsigned char* ws = args.ws;
    F.ctl = (gu32*)(ws + WS_CTL);
    F.x_prompt = args.in[0]; F.x_sample = args.in[1]; F.w_in = args.in[2]; F.a_q_gain = args.in[3]; F.a_k_gain = args.in[4]; F.c_rel_bias = args.in[5]; F.mix_gain = args.in[6];
    F.w_out = args.in[7]; F.ln1_g = args.in[8]; F.ln1_b = args.in[9]; F.w_ff1 = args.in[10]; F.w_ff2 = args.in[11]; F.ln2_g = args.in[12]; F.ln2_b = args.in[13];
    F.X = args.out;
    F.Win_t = (bf16*)(ws + WS_WIN); F.Wout_t = (bf16*)(ws + WS_WOUT); F.Wff1_t = (bf16*)(ws + WS_WFF1); F.Wff2_t = (bf16*)(ws + WS_WFF2);
    F.XB = (bf16*)(ws + WS_XB); F.PROJ = (bf16*)(ws + WS_PROJ); F.O = (bf16*)(ws + WS_O); F.H = (bf16*)(ws + WS_H);
    F.LSE = (float*)(ws + WS_LSE); F.ROPE_B = (float*)(ws + WS_ROPE_B); F.ROPE_A = (float*)(ws + WS_ROPE_A);
    for (int u = F.wave * 64 + lane_id(); u < (LDS_BYTES - LDSCTL_OFF) / 4; u += NWAVES * 64) ((LAS unsigned*)(F.lds + LDSCTL_OFF))[u] = 0u;
    __syncthreads();
    XcdBarrier bar; bar.bar = (unsigned*)(F.ctl + CW_BAR); bar.x = 0; bar.st = nullptr;
    if (!MK_PER_PHASE) bar = xcd_barrier_post((unsigned*)(F.ctl + CW_BAR), F.MISC + 8, F.wave == 0 && lane_id() == 0);
    const int lo = args.ph_lo, hi = args.ph_hi;
#define IN(k) (lo <= (k) && (k) < hi)
#define SEAM(k) do { if (IN(k) && IN((k) + 1)) { if (MK_PER_PHASE) { if (F.wave == 0 && lane_id() == 0) __hip_atomic_store(F.ctl + CW_TMO, 0xBADBA0u, RLX_AGENT); } else xcd_barrier(bar, F.wave == 0 && lane_id() == 0); } } while (0)

    if (IN(0)) { phase_prologue(F); } SEAM(0);
#define LAYER_BODY(l) do { \
        const int pb = 1 + PH_PER_LAYER * l; \
        if (IN(pb + 0)) { \
            pg8::Gemm g{F.XB, F.Win_t, NTOK, INW, DM}; pg8::StaticOrder S; S.init(NTOK, INW, F.G, (int)blockIdx.x); \
            pg8::EpiBf16<0> E{F.PROJ, INW, nullptr, 0, 0, 1.f}; \
            pg8::gemm_phase<pg8::EpiBf16<0>, pg8::StaticOrder, true, true>(F.lds + RING_OFF, g, S, E, F.wave); \
        } SEAM(pb + 0); \
        if (IN(pb + 1)) { phase_prep(F, l); } SEAM(pb + 1); \
        if (IN(pb + 2)) { phase_attn_A(F, (char*)lds + RING_OFF); phase_attn_BC_naive(F, l); } SEAM(pb + 2); \
        if (IN(pb + 3)) { phase_mix(F, l); } SEAM(pb + 3); \
        if (IN(pb + 4)) { \
            pg8::Gemm g{F.O, F.Wout_t, NTOK, DM, DM}; pg8::StaticOrder S; S.init(NTOK, DM, F.G, (int)blockIdx.x); \
            pg8::EpiResF32 E{F.X, F.X, DM, DN_ALPHA}; \
            pg8::gemm_phase<pg8::EpiResF32, pg8::StaticOrder, true, true>(F.lds + RING_OFF, g, S, E, F.wave); \
        } SEAM(pb + 4); \
        if (IN(pb + 5)) { phase_ln(F, F.ln1_g + (size_t)l * DM, F.ln1_b + (size_t)l * DM); } SEAM(pb + 5); \
        if (IN(pb + 6)) { \
            pg8::Gemm g{F.XB, F.Wff1_t, NTOK, DFF, DM}; pg8::StaticOrder S; S.init(NTOK, DFF, F.G, (int)blockIdx.x); \
            pg8::EpiRelu2Bf16 E{F.H, DFF}; \
            pg8::gemm_phase<pg8::EpiRelu2Bf16, pg8::StaticOrder, true, true>(F.lds + RING_OFF, g, S, E, F.wave); \
        } SEAM(pb + 6); \
        if (IN(pb + 7)) { \
            pg8::Gemm g{F.H, F.Wff2_t, NTOK, DM, DFF}; pg8::StaticOrder S; S.init(NTOK, DM, F.G, (int)blockIdx.x); \
            pg8::EpiResF32 E{F.X, F.X, DM, DN_ALPHA}; \
            pg8::gemm_phase<pg8::EpiResF32, pg8::StaticOrder, true, true>(F.lds + RING_OFF, g, S, E, F.wave); \
        } SEAM(pb + 7); \
        if (IN(pb + 8)) { phase_ln(F, F.ln2_g + (size_t)l * DM, F.ln2_b + (size_t)l * DM); if (l + 1 < NLAYER) convert_weights(F, l + 1); } SEAM(pb + 8); \
    } while (0)
    LAYER_BODY(0); LAYER_BODY(1); LAYER_BODY(2); LAYER_BODY(3);
#undef LAYER_BODY
#undef IN
#undef SEAM
}

extern "C" void kernel_launch(void* const* d_in, const int* in_sizes, int n_in, void* d_out, int out_size, void* d_ws, size_t ws_size, hipStream_t stream) {
    static int grid = 0;
    if (grid == 0) {
        if (n_in != 14 || in_sizes[0] != NTOK_P * DM || out_size != NTOK * DM || ws_size < WS_END) { fprintf(stderr, "kernel_launch: shape/workspace mismatch (n_in %d, out %d, ws %zu < %zu); nothing launched\n", n_in, out_size, ws_size, (size_t)WS_END); grid = -1; return; }
        int dev = 0, cus = 0, per_cu = 0;
        if (hipGetDevice(&dev) != hipSuccess || hipDeviceGetAttribute(&cus, hipDeviceAttributeMultiprocessorCount, dev) != hipSuccess) { grid = -1; return; }
        if (hipFuncSetAttribute((const void*)trunk_fwd, hipFuncAttributeMaxDynamicSharedMemorySize, LDS_BYTES) != hipSuccess) { fprintf(stderr, "kernel_launch: hipFuncSetAttribute failed\n"); grid = -1; return; }
        if (hipOccupancyMaxActiveBlocksPerMultiprocessor(&per_cu, (const void*)trunk_fwd, NWAVES * 64, LDS_BYTES) != hipSuccess || per_cu < 1) { fprintf(stderr, "kernel_launch: occupancy query says %d blocks per CU\n", per_cu); }
        (void)hipGetLastError();
        grid = cus;
    }
    if (grid < 0) return;
    if (hipMemsetAsync((char*)d_ws + WS_CTL, 0, CTL_ZERO_BYTES, stream) != hipSuccess) return;
    Args a{};
    for (int i = 0; i < 14; ++i) a.in[i] = (const float*)d_in[i];
    a.out = (float*)d_out; a.ws = (unsigned char*)d_ws;
#if MK_PER_PHASE
    for (int p = 0; p < N_PHASES; ++p) { a.ph_lo = p; a.ph_hi = p + 1; hipLaunchKernelGGL(trunk_fwd, dim3(grid), dim3(NWAVES * 64), LDS_BYTES, stream, a); }
#else
    a.ph_lo = 0; a.ph_hi = N_PHASES;
    hipLaunchKernelGGL(trunk_fwd, dim3(grid), dim3(NWAVES * 64), LDS_BYTES, stream, a);
#endif
    const hipError_t le = hipPeekAtLastError();
    if (le != hipSuccess) fprintf(stderr, "kernel_launch: launch failed: %s\n", hipGetErrorName(le));
}
```

```cpp
#include <hip/hip_runtime.h>
#include <hip/hip_bf16.h>
#include <cstdio>
#include <cstdint>
#include <cmath>
__device__ __forceinline__ int lane_id() { int l; asm volatile("v_mbcnt_lo_u32_b32 %0, -1, 0\n\tv_mbcnt_hi_u32_b32 %0, -1, %0" : "=v"(l)); return l; }
#ifndef MK_NT_H
#define MK_NT_H 1
#endif
#ifndef MK_NT_PROJ
#define MK_NT_PROJ 0
#endif
#ifndef MK_NT_HLOAD
#define MK_NT_HLOAD 0
#endif
namespace pg8 {
#define PG8_LAS __attribute__((address_space(3)))
typedef unsigned short bf16_t;
typedef short bf16x8 __attribute__((ext_vector_type(8)));
typedef float f32x4 __attribute__((ext_vector_type(4)));
typedef unsigned u32x4 __attribute__((ext_vector_type(4)));
constexpr int BM = 256, BK = 64, HALF = 128, HTB = HALF * BK * 2  , STAGE_BYTES = 8 * HTB, NXCD = 8, WGM = 8;

__host__ __device__ __forceinline__ int lds_byte(int r, int c) { const int st = (r >> 4) * 2 + (c >> 5), rr = r & 15, cc = c & 31, ob = rr * 64 + cc * 2; return st * 1024 + (ob ^ (((ob >> 9) & 1) << 5)); }
__host__ __device__ __forceinline__ void stage_rc(int b, int& R, int& C) { const int st = b / 1024, sb = b % 1024, swz = sb ^ (((sb >> 9) & 1) << 5); R = (st >> 1) * 16 + swz / 64; C = (st & 1) * 32 + (swz % 64) / 2; }
__host__ __device__ __forceinline__ int perm32(int rho) { const int n = rho >> 4, i = rho & 15; return 8 * (i >> 2) + 4 * n + (i & 3); }

struct Unit { int pm, pn; };
struct Gemm { const bf16_t* A; const bf16_t* Bt; int M, N, K; };

struct StaticOrder {
    int nM, nN, nwg, G, c, wgm;
    __host__ __device__ __forceinline__ void init(int M, int N, int G_, int c_, int wgm_ = WGM) { nM = M / BM; nN = N / BM; nwg = nM * nN; G = G_; c = c_; wgm = wgm_; }
    __host__ __device__ __forceinline__ bool next(int i, Unit& u) const {
        const long L = (long)i * G + c; if (L >= nwg) return false;
        int wgid = (int)L; { const int q = nwg / NXCD, r = nwg % NXCD, xcd = wgid % NXCD, off = wgid / NXCD; wgid = (xcd < r ? xcd * (q + 1) : r * (q + 1) + (xcd - r) * q) + off; }
        const int nig = wgm * nN, gid = wgid / nig, fm = gid * wgm, gsz = (nM - fm) < wgm ? (nM - fm) : wgm;
        u.pm = fm + ((wgid % nig) % gsz); u.pn = (wgid % nig) / gsz; return true;
    }
    __device__ __forceinline__ void a_ready(const Unit&) const {}
    __device__ __forceinline__ void done(const Unit&) const {}
};

__device__ __forceinline__ unsigned cvt_pk_bf16(float lo, float hi) { unsigned r; asm volatile("v_cvt_pk_bf16_f32 %0, %1, %2" : "=v"(r) : "v"(lo), "v"(hi)); return r; }
typedef float f32x2 __attribute__((ext_vector_type(2)));
__device__ __forceinline__ f32x2 gelu_pk(f32x2 v) {
    const f32x2 av = __builtin_elementwise_abs(v), d = av * 0.2316418882f + 1.0f;
    f32x2 t; t.x = __builtin_amdgcn_rcpf(d.x); t.y = __builtin_amdgcn_rcpf(d.y);
    f32x2 q = t * 0.5307027145f + (-0.7265760135f); q = q * t + 0.7107068705f; q = q * t + (-0.142248368f); q = q * t + 0.127414796f; q = q * t;
    const f32x2 s = (v * v) * (-0.72134752044f);
    f32x2 e; e.x = __builtin_amdgcn_exp2f(s.x); e.y = __builtin_amdgcn_exp2f(s.y);
    const f32x2 m = v * (q * e), r = v - m;
    f32x2 o; o.x = v.x < 0.f ? m.x : r.x; o.y = v.y < 0.f ? m.y : r.y; return o;
}

template <int ACT  > struct EpiBf16 {
    static constexpr bool PERM = true, AFTER_DRAIN = false; static_assert(ACT == 0 || ACT == 1, "EpiBf16: ACT is 0 (none) or 1 (gelu_pk)");
    bf16_t* O; int ldc; const float* bias; int split_cols; size_t split_stride; float scale0;
    __device__ __forceinline__ void operator()(const f32x4 (&acc)[2][2][4][2], const Unit& u, int wr, int wc, int fr, int fq) const {
        const int row0 = u.pm * BM + wr * 64 + fr; int colt = u.pn * BM; bf16_t* base = O;
        float sc = 1.f; if (split_cols) { const int t = colt / split_cols; base += (size_t)t * split_stride; colt -= t * split_cols; if (t == 0) sc = scale0; }
        const int col0 = colt + wc * 32 + 8 * fq, bcol0 = u.pn * BM + wc * 32 + 8 * fq;
        f32x4 bv[2][2];
#pragma unroll
        for (int bj = 0; bj < 2; ++bj)
#pragma unroll
            for (int n = 0; n < 2; ++n) bv[bj][n] = bias ? *(const f32x4*)(bias + bcol0 + bj * HALF + 4 * n) : (f32x4){0.f, 0.f, 0.f, 0.f};
#pragma unroll
        for (int ai = 0; ai < 2; ++ai)
#pragma unroll
            for (int m = 0; m < 4; ++m) { bf16_t* rowp = base + (size_t)(row0 + ai * HALF + m * 16) * ldc + col0;
#pragma unroll
                for (int bj = 0; bj < 2; ++bj) { f32x4 v0 = acc[ai][bj][m][0] + bv[bj][0], v1 = acc[ai][bj][m][1] + bv[bj][1];
                    if (ACT == 1) { f32x2 a = gelu_pk((f32x2){v0[0], v0[1]}), b = gelu_pk((f32x2){v0[2], v0[3]}), c = gelu_pk((f32x2){v1[0], v1[1]}), d = gelu_pk((f32x2){v1[2], v1[3]});
                        v0 = (f32x4){a.x, a.y, b.x, b.y}; v1 = (f32x4){c.x, c.y, d.x, d.y}; }
                    v0 = v0 * sc; v1 = v1 * sc; u32x4 w; w.x = cvt_pk_bf16(v0[0], v0[1]); w.y = cvt_pk_bf16(v0[2], v0[3]); w.z = cvt_pk_bf16(v1[0], v1[1]); w.w = cvt_pk_bf16(v1[2], v1[3]);
                    *(u32x4*)(rowp + bj * HALF) = w; } }
    }
};


struct EpiRelu2Bf16 {
    static constexpr bool PERM = true, AFTER_DRAIN = false;
    bf16_t* O; int ldc;
    __device__ __forceinline__ void operator()(const f32x4 (&acc)[2][2][4][2], const Unit& u, int wr, int wc, int fr, int fq) const {
        const int row0 = u.pm * BM + wr * 64 + fr; const int col0 = u.pn * BM + wc * 32 + 8 * fq;
#pragma unroll
        for (int ai = 0; ai < 2; ++ai)
#pragma unroll
            for (int m = 0; m < 4; ++m) { bf16_t* rowp = O + (size_t)(row0 + ai * HALF + m * 16) * ldc + col0;
#pragma unroll
                for (int bj = 0; bj < 2; ++bj) { f32x4 v0 = acc[ai][bj][m][0], v1 = acc[ai][bj][m][1];
#pragma unroll
                    for (int e = 0; e < 4; ++e) { const float a = fmaxf(v0[e], 0.f), b = fmaxf(v1[e], 0.f); v0[e] = a * a; v1[e] = b * b; }
                    u32x4 w; w.x = cvt_pk_bf16(v0[0], v0[1]); w.y = cvt_pk_bf16(v0[2], v0[3]); w.z = cvt_pk_bf16(v1[0], v1[1]); w.w = cvt_pk_bf16(v1[2], v1[3]);
                    *(u32x4*)(rowp + bj * HALF) = w; } }
    }
};
struct EpiResF32 {
    static constexpr bool PERM = false, AFTER_DRAIN = false;
    const float* X; float* Z; int ldc; float alpha;
    __device__ __forceinline__ void operator()(const f32x4 (&acc)[2][2][4][2], const Unit& u, int wr, int wc, int fr, int fq) const {
        const int row0 = u.pm * BM + wr * 64 + fr, col0 = u.pn * BM + wc * 32 + 4 * fq;
#pragma unroll
        for (int ai = 0; ai < 2; ++ai)
#pragma unroll
            for (int m = 0; m < 4; ++m) { const size_t off = (size_t)(row0 + ai * HALF + m * 16) * ldc + col0;
#pragma unroll
                for (int bj = 0; bj < 2; ++bj)
#pragma unroll
                    for (int n = 0; n < 2; ++n) { const f32x4 xv = *(const f32x4*)(X + off + bj * HALF + n * 16);
                        *(f32x4*)(Z + off + bj * HALF + n * 16) = xv * alpha + acc[ai][bj][m][n]; } }
    }
};

template <int ACT, bool TILED = false> struct EpiBf16Fold {
    static constexpr bool PERM = true, AFTER_DRAIN = false;
    bf16_t* O; int ldc; const f32x2* stat; const float* cs; const float* bw;
    __device__ __forceinline__ void operator()(const f32x4 (&acc)[2][2][4][2], const Unit& u, int wr, int wc, int fr, int fq) const {
        const int row0 = u.pm * BM + wr * 64 + fr; const int col0 = u.pn * BM + wc * 32 + 8 * fq;
        f32x4 cv[2][2], bv[2][2]; f32x2 st[2][4];
#pragma unroll
        for (int ai = 0; ai < 2; ++ai)
#pragma unroll
            for (int m = 0; m < 4; ++m) st[ai][m] = stat[row0 + ai * HALF + m * 16];
#pragma unroll
        for (int bj = 0; bj < 2; ++bj)
#pragma unroll
            for (int n = 0; n < 2; ++n) { cv[bj][n] = *(const f32x4*)(cs + col0 + bj * HALF + 4 * n); bv[bj][n] = *(const f32x4*)(bw + col0 + bj * HALF + 4 * n); }
#pragma unroll
        for (int ai = 0; ai < 2; ++ai)
#pragma unroll
            for (int m = 0; m < 4; ++m) { const int row = row0 + ai * HALF + m * 16; const float rs = st[ai][m].y, nm = -st[ai][m].x * st[ai][m].y;
                bf16_t* rowp = TILED ? O + ((size_t)(row >> 8) * (ldc >> 6) + (col0 >> 6)) * 16384 + (row & 255) * 64 + (col0 & 63) : O + (size_t)row * ldc + col0;
#pragma unroll
                for (int bj = 0; bj < 2; ++bj) { f32x4 v0 = acc[ai][bj][m][0] * rs + (cv[bj][0] * nm + bv[bj][0]), v1 = acc[ai][bj][m][1] * rs + (cv[bj][1] * nm + bv[bj][1]);
                    if (ACT == 3) {
#pragma unroll
                        for (int e = 0; e < 4; ++e) { const float a = fmaxf(v0[e], 0.f), b = fmaxf(v1[e], 0.f); v0[e] = a * a; v1[e] = b * b; } }
                    u32x4 w; w.x = cvt_pk_bf16(v0[0], v0[1]); w.y = cvt_pk_bf16(v0[2], v0[3]); w.z = cvt_pk_bf16(v1[0], v1[1]); w.w = cvt_pk_bf16(v1[2], v1[3]);
                    if (TILED && MK_NT_H) __builtin_nontemporal_store(w, (u32x4*)(rowp + bj * 2 * 16384)); else *(u32x4*)(rowp + (TILED ? bj * 2 * 16384 : bj * HALF)) = w; } }
    }
};
struct EpiResLnFold {
    static constexpr bool PERM = false, AFTER_DRAIN = false;
    const float* Xp; const float* Xs; int split_pm;
    float* Z; bf16_t* ZB; int ldc; const f32x2* stat; const float* g; const float* b; f32x2* part; float alpha;
    __device__ __forceinline__ void operator()(const f32x4 (&acc)[2][2][4][2], const Unit& u, int wr, int wc, int fr, int fq) const {
        typedef unsigned u32x2v __attribute__((ext_vector_type(2)));
        const int row0 = u.pm * BM + wr * 64 + fr, col0 = u.pn * BM + wc * 32 + 4 * fq;
        const float* xbase = (u.pm < split_pm) ? Xp : Xs - (size_t)split_pm * BM * ldc;
        f32x4 gv[2][2], bv[2][2]; f32x2 st[2][4];
#pragma unroll
        for (int ai = 0; ai < 2; ++ai)
#pragma unroll
            for (int m = 0; m < 4; ++m) st[ai][m] = stat[row0 + ai * HALF + m * 16];
#pragma unroll
        for (int bj = 0; bj < 2; ++bj)
#pragma unroll
            for (int n = 0; n < 2; ++n) { gv[bj][n] = *(const f32x4*)(g + col0 + bj * HALF + n * 16); bv[bj][n] = *(const f32x4*)(b + col0 + bj * HALF + n * 16); }
        f32x4 xv[2][2][2];
#define RLF_LOAD(buf, rg) do { const size_t off_ = (size_t)(row0 + ((rg) >> 2) * HALF + ((rg) & 3) * 16) * ldc + col0; \
            _Pragma("unroll") for (int bj = 0; bj < 2; ++bj) _Pragma("unroll") for (int n = 0; n < 2; ++n) xv[buf][bj][n] = *(const f32x4*)(xbase + off_ + bj * HALF + n * 16); } while (0)
        RLF_LOAD(0, 0);
#pragma unroll
        for (int rg = 0; rg < 8; ++rg) { const int ai = rg >> 2, m = rg & 3, cur = rg & 1;
            if (rg + 1 < 8) RLF_LOAD(cur ^ 1, rg + 1);
            asm volatile("" ::: "memory");
            const int row = row0 + ai * HALF + m * 16; const size_t off = (size_t)row * ldc + col0; const float mu = st[ai][m].x, rs = st[ai][m].y;
            float s = 0.f, q = 0.f;
#pragma unroll
            for (int bj = 0; bj < 2; ++bj)
#pragma unroll
                for (int n = 0; n < 2; ++n) {
                    const f32x4 xn = (xv[cur][bj][n] - mu) * rs * gv[bj][n] + bv[bj][n]; const f32x4 z = xn * alpha + acc[ai][bj][m][n];
                    *(f32x4*)(Z + off + bj * HALF + n * 16) = z;
                    u32x2v w; w.x = cvt_pk_bf16(z[0], z[1]); w.y = cvt_pk_bf16(z[2], z[3]); *(u32x2v*)(ZB + off + bj * HALF + n * 16) = w;
                    s += (z[0] + z[1]) + (z[2] + z[3]); q += (z[0] * z[0] + z[1] * z[1]) + (z[2] * z[2] + z[3] * z[3]); }
            s += __shfl_xor(s, 16); s += __shfl_xor(s, 32); q += __shfl_xor(q, 16); q += __shfl_xor(q, 32);
            if (fq == 0) part[(size_t)row * 32 + u.pn * 4 + wc] = (f32x2){s, q};
            asm volatile("" ::: "memory");
        }
#undef RLF_LOAD
    }
};

struct EpiInProj {
    static constexpr bool PERM = true, AFTER_DRAIN = false;
    bf16_t* O; int ldc; const f32x2* stat; const float* cs; const float* bw;
    const float* gq; const float* gk; const float* ropeA; const float* ropeB; PG8_LAS float* xch;
    float qscale;
    __device__ __forceinline__ void operator()(const f32x4 (&acc_)[2][2][4][2], const Unit& u, int wr, int wc, int fr, int fq) const {
        f32x4 (&acc)[2][2][4][2] = const_cast<f32x4 (&)[2][2][4][2]>(acc_);
        const int row0 = u.pm * BM + wr * 64 + fr; const int col0 = u.pn * BM + wc * 32 + 8 * fq;
        const int kind = (u.pn < 3) ? 1 : (u.pn >= 4 && u.pn < 10) ? 2 : 0;
        { f32x4 cv[2][2], bv[2][2]; f32x2 st[2][4];
#pragma unroll
          for (int ai = 0; ai < 2; ++ai)
#pragma unroll
            for (int m = 0; m < 4; ++m) st[ai][m] = stat[row0 + ai * HALF + m * 16];
#pragma unroll
          for (int bj = 0; bj < 2; ++bj)
#pragma unroll
            for (int n = 0; n < 2; ++n) { cv[bj][n] = *(const f32x4*)(cs + col0 + bj * HALF + 4 * n); bv[bj][n] = *(const f32x4*)(bw + col0 + bj * HALF + 4 * n); }
#pragma unroll
          for (int ai = 0; ai < 2; ++ai)
#pragma unroll
            for (int m = 0; m < 4; ++m) { const float rs = st[ai][m].y, nm = -st[ai][m].x * st[ai][m].y;
#pragma unroll
                for (int bj = 0; bj < 2; ++bj)
#pragma unroll
                    for (int n = 0; n < 2; ++n) acc[ai][bj][m][n] = acc[ai][bj][m][n] * rs + (cv[bj][n] * nm + bv[bj][n]); } }
        if (kind == 0) {
#pragma unroll
            for (int ai = 0; ai < 2; ++ai)
#pragma unroll
                for (int m = 0; m < 4; ++m) { bf16_t* rowp = O + (size_t)(row0 + ai * HALF + m * 16) * ldc + col0;
#pragma unroll
                    for (int bj = 0; bj < 2; ++bj) { const f32x4 v0 = acc[ai][bj][m][0], v1 = acc[ai][bj][m][1];
                        u32x4 w; w.x = cvt_pk_bf16(v0[0], v0[1]); w.y = cvt_pk_bf16(v0[2], v0[3]); w.z = cvt_pk_bf16(v1[0], v1[1]); w.w = cvt_pk_bf16(v1[2], v1[3]);
                        if (MK_NT_PROJ) __builtin_nontemporal_store(w, (u32x4*)(rowp + bj * HALF)); else *(u32x4*)(rowp + bj * HALF) = w; } }
            return;
        }
        const float qs = (u.pn < 2) ? qscale : 1.f;
        const int half = wc >> 1;
        const int i0 = (kind == 1) ? 4 * (4 * (wc & 1) + fq) : 16 * wc + 4 * fq;
        f32x4 g_lo = {1.f, 1.f, 1.f, 1.f}, g_hi = {1.f, 1.f, 1.f, 1.f};
        if (kind == 1) {
            const float* gain = (u.pn < 2) ? gq : gk; g_lo = *(const f32x4*)(gain + 64 * half + i0); g_hi = *(const f32x4*)(gain + 64 * half + i0 + 32);
#pragma unroll
            for (int ai = 0; ai < 2; ++ai)
#pragma unroll
                for (int m = 0; m < 4; ++m)
#pragma unroll
                    for (int bj = 0; bj < 2; ++bj) { const f32x4 a = acc[ai][bj][m][0], b = acc[ai][bj][m][1];
                        float ss = ((a[0] * a[0] + a[1] * a[1]) + (a[2] * a[2] + a[3] * a[3])) + ((b[0] * b[0] + b[1] * b[1]) + (b[2] * b[2] + b[3] * b[3]));
                        ss += __shfl_xor(ss, 16); ss += __shfl_xor(ss, 32);
                        if (fq == 0) xch[((ai * HALF + wr * 64 + m * 16 + fr) * 2 + bj) * 4 + wc] = ss; }
            asm volatile("s_waitcnt lgkmcnt(0)" ::: "memory"); __builtin_amdgcn_s_barrier(); asm volatile("" ::: "memory");
        }
        f32x4 tb[2][2][2];
#define EIP_LOAD(buf, sg) do { _Pragma("unroll") for (int h = 0; h < 2; ++h) { const int rg_ = 2 * (sg) + h; const int t_ = (row0 + (rg_ >> 2) * HALF + (rg_ & 3) * 16) & 4095; \
            const float* tp_ = (kind == 1) ? ropeA + 2 * ((half ? (t_ & 63) : (t_ >> 6)) * 32 + i0) : ropeB + 2 * (t_ * 64 + i0); \
            tb[buf][h][0] = *(const f32x4*)tp_; tb[buf][h][1] = *(const f32x4*)(tp_ + 4); } } while (0)
        EIP_LOAD(0, 0);
#pragma unroll
        for (int sg = 0; sg < 4; ++sg) { const int cur = sg & 1;
            if (sg + 1 < 4) EIP_LOAD(cur ^ 1, sg + 1);
            asm volatile("" ::: "memory");
#pragma unroll
            for (int h = 0; h < 2; ++h) { const int rg = 2 * sg + h, ai = rg >> 2, m = rg & 3; const int rl = ai * HALF + wr * 64 + m * 16 + fr;
                bf16_t* rowp = O + (size_t)(u.pm * BM + rl) * ldc + col0;
                const f32x4 t0 = tb[cur][h][0], t1 = tb[cur][h][1];
                const f32x4 cs4 = {t0[0], t0[2], t1[0], t1[2]}, sn4 = {t0[1], t0[3], t1[1], t1[3]};
#pragma unroll
                for (int bj = 0; bj < 2; ++bj) { f32x4 lo = acc[ai][bj][m][0], hi = acc[ai][bj][m][1];
                    if (kind == 1) { const f32x4 pq = *(const PG8_LAS f32x4*)(xch + (rl * 2 + bj) * 4); const float rs = 1.0f / sqrtf(((pq[0] + pq[1]) + (pq[2] + pq[3])) * (1.0f / 128.f) + 1e-6f);
                        lo = lo * (rs * qs) * g_lo; hi = hi * (rs * qs) * g_hi; }
                    const f32x4 ol = lo * cs4 - hi * sn4, oh = hi * cs4 + lo * sn4;
                    u32x4 w; w.x = cvt_pk_bf16(ol[0], ol[1]); w.y = cvt_pk_bf16(ol[2], ol[3]); w.z = cvt_pk_bf16(oh[0], oh[1]); w.w = cvt_pk_bf16(oh[2], oh[3]);
                    if (MK_NT_PROJ) __builtin_nontemporal_store(w, (u32x4*)(rowp + bj * HALF)); else *(u32x4*)(rowp + bj * HALF) = w; } }
            asm volatile("" ::: "memory");
        }
#undef EIP_LOAD
        if (kind == 1) { asm volatile("s_waitcnt lgkmcnt(0)" ::: "memory"); __builtin_amdgcn_s_barrier(); asm volatile("" ::: "memory"); }
    }
};

struct EpiResLnFoldB {
    static constexpr bool PERM = false, AFTER_DRAIN = false;
    bf16_t* ZB; int ldc; const f32x2* stat; const float* g; const float* b; f32x2* part; float alpha;
    __device__ __forceinline__ void operator()(const f32x4 (&acc)[2][2][4][2], const Unit& u, int wr, int wc, int fr, int fq) const {
        typedef unsigned u32x2v __attribute__((ext_vector_type(2)));
        const int row0 = u.pm * BM + wr * 64 + fr, col0 = u.pn * BM + wc * 32 + 4 * fq;
        f32x4 gv[2][2], bv[2][2]; f32x2 st[2]; u32x2v xv[2][2][2];
#pragma unroll
        for (int bj = 0; bj < 2; ++bj)
#pragma unroll
            for (int n = 0; n < 2; ++n) { gv[bj][n] = *(const f32x4*)(g + col0 + bj * HALF + n * 16); bv[bj][n] = *(const f32x4*)(b + col0 + bj * HALF + n * 16); }
#define RLB_LOAD(buf, rg) do { const int row_ = row0 + ((rg) >> 2) * HALF + ((rg) & 3) * 16; const size_t off_ = (size_t)row_ * ldc + col0; st[buf] = stat[row_]; \
            _Pragma("unroll") for (int bj = 0; bj < 2; ++bj) _Pragma("unroll") for (int n = 0; n < 2; ++n) xv[buf][bj][n] = *(const u32x2v*)(ZB + off_ + bj * HALF + n * 16); } while (0)
        RLB_LOAD(0, 0);
#pragma unroll
        for (int rg = 0; rg < 8; ++rg) { const int cur = rg & 1, ai = rg >> 2, m = rg & 3;
            if (rg + 1 < 8) RLB_LOAD(cur ^ 1, rg + 1);
            asm volatile("" ::: "memory");
            const int row = row0 + ai * HALF + m * 16; const size_t off = (size_t)row * ldc + col0; const float mu = st[cur].x, rs = st[cur].y;
            float s = 0.f, q = 0.f;
#pragma unroll
            for (int bj = 0; bj < 2; ++bj)
#pragma unroll
                for (int n = 0; n < 2; ++n) { const u32x2v xw = xv[cur][bj][n];
                    const f32x4 xf = {__builtin_bit_cast(float, xw.x << 16), __builtin_bit_cast(float, xw.x & 0xffff0000u), __builtin_bit_cast(float, xw.y << 16), __builtin_bit_cast(float, xw.y & 0xffff0000u)};
                    const f32x4 xn = (xf - mu) * rs * gv[bj][n] + bv[bj][n]; const f32x4 z = xn * alpha + acc[ai][bj][m][n];
                    u32x2v w; w.x = cvt_pk_bf16(z[0], z[1]); w.y = cvt_pk_bf16(z[2], z[3]); *(u32x2v*)(ZB + off + bj * HALF + n * 16) = w;
                    s += (z[0] + z[1]) + (z[2] + z[3]); q += (z[0] * z[0] + z[1] * z[1]) + (z[2] * z[2] + z[3] * z[3]); }
            s += __shfl_xor(s, 16); s += __shfl_xor(s, 32); q += __shfl_xor(q, 16); q += __shfl_xor(q, 32);
            if (fq == 0) part[(size_t)row * 32 + u.pn * 4 + wc] = (f32x2){s, q};
            asm volatile("" ::: "memory");
        }
#undef RLB_LOAD
    }
};

struct EpiNull {
    static constexpr bool PERM = true, AFTER_DRAIN = false;
    float* sink;
    __device__ __forceinline__ void operator()(const f32x4 (&acc)[2][2][4][2], const Unit& u, int wr, int wc, int fr, int fq) const {
        float s = 0.f;
#pragma unroll
        for (int ai = 0; ai < 2; ++ai)
#pragma unroll
            for (int bj = 0; bj < 2; ++bj)
#pragma unroll
                for (int m = 0; m < 4; ++m)
#pragma unroll
                    for (int n = 0; n < 2; ++n) s += (acc[ai][bj][m][n][0] + acc[ai][bj][m][n][1]) + (acc[ai][bj][m][n][2] + acc[ai][bj][m][n][3]);
        if (s == 1.2345678e33f) sink[u.pm * 8 + u.pn + wr + wc + fr + fq] = s;
    }
};

struct EpiResCopy {
    static constexpr bool PERM = false, AFTER_DRAIN = false;
    float* Z; bf16_t* ZB; int ldc;
    __device__ __forceinline__ void operator()(const f32x4 (&acc)[2][2][4][2], const Unit& u, int wr, int wc, int fr, int fq) const {
        typedef unsigned u32x2v __attribute__((ext_vector_type(2)));
        const int row0 = u.pm * BM + wr * 64 + fr, col0 = u.pn * BM + wc * 32 + 4 * fq;
        float s = 0.f;
#pragma unroll
        for (int ai = 0; ai < 2; ++ai)
#pragma unroll
            for (int bj = 0; bj < 2; ++bj)
#pragma unroll
                for (int m = 0; m < 4; ++m)
#pragma unroll
                    for (int n = 0; n < 2; ++n) s += acc[ai][bj][m][n][0] + acc[ai][bj][m][n][3];
        const bool never = (s == 1.2345678e33f);
        f32x4 xv[2][2][2]; u32x2v bvv[2][2][2];
#define RC_LOAD(buf, rg) do { const size_t off_ = (size_t)(row0 + ((rg) >> 2) * HALF + ((rg) & 3) * 16) * ldc + col0; \
            _Pragma("unroll") for (int bj = 0; bj < 2; ++bj) _Pragma("unroll") for (int n = 0; n < 2; ++n) { xv[buf][bj][n] = *(const f32x4*)(Z + off_ + bj * HALF + n * 16); bvv[buf][bj][n] = *(const u32x2v*)(ZB + off_ + bj * HALF + n * 16); } } while (0)
        RC_LOAD(0, 0);
#pragma unroll
        for (int rg = 0; rg < 8; ++rg) { const int ai = rg >> 2, m = rg & 3, cur = rg & 1;
            if (rg + 1 < 8) RC_LOAD(cur ^ 1, rg + 1);
            asm volatile("" ::: "memory");
            const size_t off = (size_t)(row0 + ai * HALF + m * 16) * ldc + col0;
#pragma unroll
            for (int bj = 0; bj < 2; ++bj)
#pragma unroll
                for (int n = 0; n < 2; ++n) { f32x4 z = xv[cur][bj][n]; if (never) z[0] = s; *(f32x4*)(Z + off + bj * HALF + n * 16) = z; *(u32x2v*)(ZB + off + bj * HALF + n * 16) = bvv[cur][bj][n]; }
            asm volatile("" ::: "memory");
        }
#undef RC_LOAD
    }
};

struct EpiResCopyB {
    static constexpr bool PERM = false, AFTER_DRAIN = false;
    bf16_t* ZB; int ldc;
    __device__ __forceinline__ void operator()(const f32x4 (&acc)[2][2][4][2], const Unit& u, int wr, int wc, int fr, int fq) const {
        typedef unsigned u32x2v __attribute__((ext_vector_type(2)));
        const int row0 = u.pm * BM + wr * 64 + fr, col0 = u.pn * BM + wc * 32 + 4 * fq;
        float s = 0.f;
#pragma unroll
        for (int ai = 0; ai < 2; ++ai)
#pragma unroll
            for (int bj = 0; bj < 2; ++bj)
#pragma unroll
                for (int m = 0; m < 4; ++m)
#pragma unroll
                    for (int n = 0; n < 2; ++n) s += acc[ai][bj][m][n][0] + acc[ai][bj][m][n][3];
        const bool never = (s == 1.2345678e33f);
        u32x2v xv[2][2][2];
#define RCB_LOAD(buf, rg) do { const size_t off_ = (size_t)(row0 + ((rg) >> 2) * HALF + ((rg) & 3) * 16) * ldc + col0; \
            _Pragma("unroll") for (int bj = 0; bj < 2; ++bj) _Pragma("unroll") for (int n = 0; n < 2; ++n) xv[buf][bj][n] = *(const u32x2v*)(ZB + off_ + bj * HALF + n * 16); } while (0)
        RCB_LOAD(0, 0);
#pragma unroll
        for (int rg = 0; rg < 8; ++rg) { const int ai = rg >> 2, m = rg & 3, cur = rg & 1;
            if (rg + 1 < 8) RCB_LOAD(cur ^ 1, rg + 1);
            asm volatile("" ::: "memory");
            const size_t off = (size_t)(row0 + ai * HALF + m * 16) * ldc + col0;
#pragma unroll
            for (int bj = 0; bj < 2; ++bj)
#pragma unroll
                for (int n = 0; n < 2; ++n) { u32x2v z = xv[cur][bj][n]; if (never) z.x ^= 1u; *(u32x2v*)(ZB + off + bj * HALF + n * 16) = z; }
            asm volatile("" ::: "memory");
        }
#undef RCB_LOAD
    }
};

template <class Epi, class Sched, bool ALIGN_EPI = false, bool SP2 = false, bool TILED_A = false>
__device__ __forceinline__ void gemm_phase(PG8_LAS unsigned char* lds, const Gemm g, const Sched& S, const Epi& E, const int wid  ) {
    const int lane = lane_id(), tid = wid * 64 + lane, wr = wid >> 2, wc = wid & 3, fr = lane & 15, fq = lane >> 4;
    const int K = g.K, nt = K / BK;
    unsigned voffA[2], voffB[2];
#pragma unroll
    for (int i = 0; i < 2; ++i) { int R, C; stage_rc(tid * 16 + i * 8192, R, C); const int Rb = Epi::PERM ? ((R & ~31) + perm32(R & 31)) : R;
        voffA[i] = (unsigned)(R * (TILED_A ? 64 : K) + C) * 2u; voffB[i] = (unsigned)(Rb * K + C) * 2u; }
    const size_t kstep = (size_t)(BK * 2);
    const size_t hstep = (size_t)HALF * K * 2;
    const size_t tstep = 2 * hstep;
    const size_t kstepA = TILED_A ? (size_t)32768 : kstep, hstepA = TILED_A ? (size_t)HALF * 64 * 2 : hstep;
    const unsigned ldsw = (unsigned)wid * 1024u;
    const int aoff = lds_byte(wr * 64 + fr, fq * 8), boff = lds_byte(wc * 32 + fr, fq * 8);
#define PG8_SA(b, h) (((b) * 2 + (h)) * HTB)
#define PG8_SB(b, h) ((4 + (b) * 2 + (h)) * HTB)
#define PG8_STAGE(bufoff, gbase, voff) do { _Pragma("unroll") for (int _i = 0; _i < 2; ++_i) \
        __builtin_amdgcn_global_load_lds((const unsigned*)((const char*)(gbase) + (voff)[_i]), (PG8_LAS unsigned*)(lds + (bufoff) + ldsw + _i * 8192), 16, 0, 0); } while (0)
#define PG8_STAGE_A(bufoff, gbase, voff) do { _Pragma("unroll") for (int _i = 0; _i < 2; ++_i) { \
        if constexpr (TILED_A && MK_NT_HLOAD) __builtin_amdgcn_global_load_lds((const unsigned*)((const char*)(gbase) + (voff)[_i]), (PG8_LAS unsigned*)(lds + (bufoff) + ldsw + _i * 8192), 16, 0, 2); \
        else __builtin_amdgcn_global_load_lds((const unsigned*)((const char*)(gbase) + (voff)[_i]), (PG8_LAS unsigned*)(lds + (bufoff) + ldsw + _i * 8192), 16, 0, 0); } } while (0)
#define PG8_LDA(dst, b, h) do { _Pragma("unroll") for (int m = 0; m < 4; ++m) _Pragma("unroll") for (int k = 0; k < 2; ++k) dst[m][k] = *(const PG8_LAS bf16x8*)(lds + PG8_SA(b, h) + aoff + m * 2048 + k * 1024); } while (0)
#define PG8_LDB(dst, b, h) do { _Pragma("unroll") for (int n = 0; n < 2; ++n) _Pragma("unroll") for (int k = 0; k < 2; ++k) dst[n][k] = *(const PG8_LAS bf16x8*)(lds + PG8_SB(b, h) + boff + n * 2048 + k * 1024); } while (0)
#define PG8_MMA(ai, bj, At, Bt) do { __builtin_amdgcn_s_setprio(1); _Pragma("unroll") for (int m = 0; m < 4; ++m) _Pragma("unroll") for (int n = 0; n < 2; ++n) _Pragma("unroll") for (int k = 0; k < 2; ++k) \
        acc[ai][bj][m][n] = __builtin_amdgcn_mfma_f32_16x16x32_bf16(Bt[n][k], At[m][k], acc[ai][bj][m][n], 0, 0, 0); __builtin_amdgcn_s_setprio(0); } while (0)
#define PG8_WAIT_V(n) asm volatile("s_waitcnt vmcnt(" #n ")" ::: "memory")
#define PG8_WAIT_L(n) asm volatile("s_waitcnt lgkmcnt(" #n ")" ::: "memory")
#define PG8_BAR __builtin_amdgcn_s_barrier()
#define PG8_SCHED __builtin_amdgcn_sched_barrier(0)
    Unit cur, nxt; int ui = 0;
    if (!S.next(0, cur)) return;
    f32x4 acc[2][2][4][2];
#pragma unroll
    for (int a = 0; a < 2; ++a)
#pragma unroll
        for (int b = 0; b < 2; ++b)
#pragma unroll
            for (int m = 0; m < 4; ++m)
#pragma unroll
                for (int n = 0; n < 2; ++n) acc[a][b][m][n] = (f32x4){0.f, 0.f, 0.f, 0.f};
    bf16x8 At[4][2], B0[2][2], B1[2][2];
    const char* cA = (const char*)g.A + (size_t)cur.pm * tstep; const char* cB = (const char*)g.Bt + (size_t)cur.pn * tstep;
    S.a_ready(cur);
    if constexpr (SP2) {
        PG8_STAGE(PG8_SB(0, 0), cB, voffB); PG8_STAGE(PG8_SB(0, 1), cB + hstep, voffB); PG8_STAGE_A(PG8_SA(0, 0), cA, voffA); PG8_STAGE_A(PG8_SA(0, 1), cA + hstepA, voffA);
        if (wr == 1) PG8_BAR;
        PG8_WAIT_V(2); PG8_BAR;
        PG8_STAGE(PG8_SB(1, 0), cB + kstep, voffB); PG8_STAGE_A(PG8_SA(1, 0), cA + kstepA, voffA); PG8_STAGE(PG8_SB(1, 1), cB + hstep + kstep, voffB);
        PG8_WAIT_V(6); PG8_BAR;
    } else {
        PG8_STAGE(PG8_SB(0, 0), cB, voffB); PG8_STAGE_A(PG8_SA(0, 0), cA, voffA); PG8_STAGE(PG8_SB(0, 1), cB + hstep, voffB); PG8_STAGE_A(PG8_SA(0, 1), cA + hstepA, voffA);
        if (wr == 1) PG8_BAR;
        PG8_WAIT_V(4); PG8_BAR;
        PG8_STAGE(PG8_SB(1, 0), cB + kstep, voffB); PG8_STAGE_A(PG8_SA(1, 0), cA + kstepA, voffA); PG8_STAGE(PG8_SB(1, 1), cB + hstep + kstep, voffB);
        PG8_WAIT_V(6); PG8_BAR;
    }
    for (;;) {
        const bool has_next = S.next(ui + 1, nxt);
        const char* nA = has_next ? (const char*)g.A + (size_t)nxt.pm * tstep : cA; const char* nB = has_next ? (const char*)g.Bt + (size_t)nxt.pn * tstep : cB;
        for (int t = 0; t < nt; t += 2) {
            const bool last = (t == nt - 2);
            const char* a1 = cA + (size_t)(t + 1) * kstepA;
            const char* a2 = last ? nA : cA + (size_t)(t + 2) * kstepA; const char* b2 = last ? nB : cB + (size_t)(t + 2) * kstep;
            const char* a3 = a2 + kstepA; const char* b3 = b2 + kstep;
            if (last && has_next) S.a_ready(nxt);
            if constexpr (SP2) {
            PG8_LDB(B0, 0, 0); PG8_LDB(B1, 0, 1); PG8_SCHED; PG8_LDA(At, 0, 0); PG8_STAGE_A(PG8_SA(1, 1), a1 + hstepA, voffA);
            PG8_WAIT_V(8); PG8_WAIT_L(0); PG8_BAR; PG8_MMA(0, 0, At, B0); PG8_MMA(0, 1, At, B1); PG8_BAR; PG8_SCHED;
            PG8_LDA(At, 0, 1); PG8_STAGE(PG8_SB(0, 0), b2, voffB); PG8_STAGE(PG8_SB(0, 1), b2 + hstep, voffB); PG8_STAGE_A(PG8_SA(0, 0), a2, voffA);
            PG8_WAIT_V(8); PG8_WAIT_L(0); PG8_BAR; PG8_MMA(1, 0, At, B0); PG8_MMA(1, 1, At, B1); PG8_BAR; PG8_SCHED;
            PG8_LDB(B0, 1, 0); PG8_LDB(B1, 1, 1); PG8_SCHED; PG8_LDA(At, 1, 0); PG8_STAGE_A(PG8_SA(0, 1), a2 + hstepA, voffA);
            PG8_WAIT_V(8); PG8_WAIT_L(0); PG8_BAR; PG8_MMA(0, 0, At, B0); PG8_MMA(0, 1, At, B1); PG8_BAR; PG8_SCHED;
            PG8_LDA(At, 1, 1); PG8_STAGE(PG8_SB(1, 0), b3, voffB); PG8_STAGE(PG8_SB(1, 1), b3 + hstep, voffB); PG8_STAGE_A(PG8_SA(1, 0), a3, voffA);
            PG8_WAIT_V(8); PG8_WAIT_L(0); PG8_BAR; PG8_MMA(1, 0, At, B0); PG8_MMA(1, 1, At, B1); PG8_BAR; PG8_SCHED;
            } else {
            PG8_LDB(B0, 0, 0); PG8_SCHED; PG8_LDA(At, 0, 0); PG8_STAGE_A(PG8_SA(1, 1), a1 + hstepA, voffA);
            PG8_WAIT_L(8); PG8_BAR; PG8_WAIT_L(0); PG8_MMA(0, 0, At, B0); PG8_BAR; PG8_SCHED;
            PG8_LDB(B1, 0, 1); PG8_STAGE(PG8_SB(0, 0), b2, voffB);
            PG8_BAR; PG8_WAIT_L(0); PG8_MMA(0, 1, At, B1); PG8_BAR;
            PG8_LDA(At, 0, 1); PG8_STAGE_A(PG8_SA(0, 0), a2, voffA);
            PG8_BAR; PG8_WAIT_L(0); PG8_MMA(1, 0, At, B0); PG8_BAR; PG8_SCHED;
            PG8_STAGE(PG8_SB(0, 1), b2 + hstep, voffB);
            PG8_WAIT_V(6); PG8_BAR; PG8_MMA(1, 1, At, B1); PG8_BAR;
            PG8_LDB(B0, 1, 0); PG8_SCHED; PG8_LDA(At, 1, 0); PG8_STAGE_A(PG8_SA(0, 1), a2 + hstepA, voffA);
            PG8_WAIT_L(8); PG8_BAR; PG8_WAIT_L(0); PG8_MMA(0, 0, At, B0); PG8_BAR; PG8_SCHED;
            PG8_LDB(B1, 1, 1); PG8_STAGE(PG8_SB(1, 0), b3, voffB);
            PG8_BAR; PG8_WAIT_L(0); PG8_MMA(0, 1, At, B1); PG8_BAR;
            PG8_LDA(At, 1, 1); PG8_STAGE_A(PG8_SA(1, 0), a3, voffA);
            PG8_BAR; PG8_WAIT_L(0); PG8_MMA(1, 0, At, B0); PG8_BAR; PG8_SCHED;
            PG8_STAGE(PG8_SB(1, 1), b3 + hstep, voffB);
            PG8_WAIT_V(6); PG8_BAR; PG8_MMA(1, 1, At, B1); PG8_BAR;
            }
        }
        if constexpr (ALIGN_EPI) { if (wr == 0) PG8_BAR; }
        if constexpr (!Epi::AFTER_DRAIN) { E(acc, cur, wr, wc, fr, fq); S.done(cur); }
        if (!has_next) break;
#pragma unroll
        for (int a = 0; a < 2; ++a)
#pragma unroll
            for (int b = 0; b < 2; ++b)
#pragma unroll
                for (int m = 0; m < 4; ++m)
#pragma unroll
                    for (int n = 0; n < 2; ++n) acc[a][b][m][n] = (f32x4){0.f, 0.f, 0.f, 0.f};
        cur = nxt; cA = nA; cB = nB; ++ui;
        if constexpr (ALIGN_EPI) { if (wr == 1) PG8_BAR; }
    }
    PG8_WAIT_V(0);
    if constexpr (!ALIGN_EPI) { if (wr == 0) PG8_BAR; }
    PG8_BAR;
    if constexpr (Epi::AFTER_DRAIN) { E.fused(acc, cur, wr, wc, fr, fq, lds, wid, lane); S.done(cur); }
#undef PG8_SA
#undef PG8_SB
#undef PG8_STAGE
#undef PG8_STAGE_A
#undef PG8_LDA
#undef PG8_LDB
#undef PG8_MMA
#undef PG8_WAIT_V
#undef PG8_WAIT_L
#undef PG8_BAR
#undef PG8_SCHED
}
}
#define GAS __attribute__((address_space(1)))
#define LAS __attribute__((address_space(3)))
typedef unsigned short bf16;
typedef unsigned v4u __attribute__((ext_vector_type(4)));
typedef float f32x4 __attribute__((ext_vector_type(4)));
typedef short bf16x8 __attribute__((ext_vector_type(8)));
typedef GAS unsigned gu32;
typedef GAS unsigned long long gu64;
#define RLX_AGENT __ATOMIC_RELAXED, __HIP_MEMORY_SCOPE_AGENT
#define LDS_WAIT() asm volatile("s_waitcnt lgkmcnt(0)" ::: "memory")
#define VM_WAIT() asm volatile("s_waitcnt vmcnt(0)" ::: "memory")
__device__ __forceinline__ unsigned long long rt() { return __builtin_amdgcn_s_memrealtime(); }
__device__ __forceinline__ unsigned f2bf(float f) { unsigned u = __builtin_bit_cast(unsigned, f); return (u + 0x7fffu + ((u >> 16) & 1u)) >> 16; }
__device__ __forceinline__ unsigned pk2(float lo, float hi) { return f2bf(lo) | (f2bf(hi) << 16); }

#define XB_TMO      128
#define XB_XCNT(j)  (256  + 64 * (j))
#define XB_XSUB(j)  (1280 + 64 * (j))
#define XB_XGEN(j)  (2304 + 64 * (j))
#define XB_TOP      3328
#define XB_TOPGEN   3392
#define XCD_BAR_WORDS 3456
#define XB_SPIN_CAP (1u << 18)

__device__ __forceinline__ unsigned xb_ld(unsigned* p)              { return __hip_atomic_load(p, __ATOMIC_RELAXED, __HIP_MEMORY_SCOPE_AGENT); }
__device__ __forceinline__ unsigned xb_add(unsigned* p, unsigned v) { return __hip_atomic_fetch_add(p, v, __ATOMIC_RELAXED, __HIP_MEMORY_SCOPE_AGENT); }
__device__ __forceinline__ unsigned xb_xcc_id() { return (unsigned)__builtin_amdgcn_s_getreg((3 << 11) | 20) & 0xFu; }
#define XB_SPIN(cond, bar) do { unsigned _sp = 0; while (cond) { __builtin_amdgcn_s_sleep(1); \
    if ((++_sp & 255u) == 0u) { if (xb_ld(&(bar)[XB_TMO])) break; if (_sp > XB_SPIN_CAP) { atomicAdd(&(bar)[XB_TMO], 1u); break; } } } } while (0)

struct XcdBarrier {
    unsigned* bar; unsigned x;
    volatile LAS unsigned* st;
};

__device__ __forceinline__ XcdBarrier xcd_barrier_post(unsigned* bar, volatile LAS unsigned* st, const bool t0  ) {
    XcdBarrier b; b.bar = bar; b.x = xb_xcc_id(); b.st = st;
    if (t0) (void)xb_add(&bar[XB_XCNT(b.x)], 1u);
    return b;
}
__device__ __forceinline__ void xcd_barrier_complete(unsigned* bar, unsigned x, unsigned& nloc, unsigned& nx) {
    const unsigned G = gridDim.x * gridDim.y * gridDim.z;
    unsigned sum, cnt, mine, sp = 0u;
    for (;;) {
        sum = 0u; cnt = 0u; mine = 0u;
#pragma unroll
        for (unsigned j = 0; j < 16; ++j) { const unsigned c = xb_ld(&bar[XB_XCNT(j)]); sum += c; cnt += (c > 0u) ? 1u : 0u; mine = (j == x) ? c : mine; }
        if (sum == G) break;
        __builtin_amdgcn_s_sleep(1);
        if ((++sp & 255u) == 0u) { if (xb_ld(&bar[XB_TMO])) break; if (sp > XB_SPIN_CAP) { atomicAdd(&bar[XB_TMO], 1u); break; } }
    }
    nloc = mine > 0u ? mine : 1u; nx = cnt > 0u ? cnt : 1u;
}

__device__ __forceinline__ void xcd_barrier(const XcdBarrier& b, const bool t0  ) {
    asm volatile("s_waitcnt vmcnt(0)" ::: "memory");
    __syncthreads();
    if (t0) {
        unsigned* bar = b.bar;
        __builtin_amdgcn_s_waitcnt(0);
        unsigned nloc = b.st[0], nx = b.st[1];
        if (nloc == 0u) { xcd_barrier_complete(bar, b.x, nloc, nx); b.st[0] = nloc; b.st[1] = nx; }
        const unsigned old = xb_add(&bar[XB_XSUB(b.x)], 1u);
        const unsigned gen = old / nloc;
        if (old + 1u == (gen + 1u) * nloc) {
            __builtin_amdgcn_fence(__ATOMIC_RELEASE, "agent");
            asm volatile("s_waitcnt vmcnt(0)" ::: "memory");
            const unsigned og = xb_add(&bar[XB_TOP], 1u);
            const unsigned tg = og / nx;
            if (og + 1u == (tg + 1u) * nx) xb_add(&bar[XB_TOPGEN], 1u);
            else XB_SPIN(xb_ld(&bar[XB_TOPGEN]) == tg, bar);
            __builtin_amdgcn_fence(__ATOMIC_ACQUIRE, "agent");
            xb_add(&bar[XB_XGEN(b.x)], 1u);
            asm volatile("s_waitcnt vmcnt(0)" ::: "memory");
        } else {
            XB_SPIN(xb_ld(&bar[XB_XGEN(b.x)]) == gen, bar);
            __builtin_amdgcn_fence(__ATOMIC_ACQUIRE, "agent");
            asm volatile("s_waitcnt vmcnt(0)" ::: "memory");
        }
    }
    __syncthreads();
}
namespace att {
typedef unsigned short bf16;
constexpr int NW = 8, QBLK = 32, KVBLK = 64, D = 128;
constexpr float SCALE = 0.088388347648318440f;
constexpr float THR = 8.f;
using bf16x8 = __attribute__((ext_vector_type(8))) short;
using s16x4  = __attribute__((ext_vector_type(4))) short;
using f32x16 = __attribute__((ext_vector_type(16))) float;
using f32x8  = __attribute__((ext_vector_type(8))) float;
using u32x4  = __attribute__((ext_vector_type(4))) unsigned;
#define KSWZ(row, colB) ((row) * 256 + ((colB) ^ (((row) & 7) << 4)))
#define SBAR() __builtin_amdgcn_sched_barrier(0)
__device__ __forceinline__ int crow(int r, int hi) { return (r & 3) + 8 * (r >> 2) + 4 * hi; }
__device__ __forceinline__ unsigned cvtpk(float lo, float hi) {
  unsigned r; asm volatile("v_cvt_pk_bf16_f32 %0, %1, %2" : "=v"(r) : "v"(lo), "v"(hi)); return r;
}
__device__ __forceinline__ void partialSM(f32x16& p0, f32x16& p1, float& m_reg, float& mn, float& alpha) {
  constexpr float C = SCALE * 1.4426950408889634f;
  float pmax = p0[0]; for (int r = 1; r < 16; ++r) pmax = fmaxf(pmax, p0[r]); for (int r = 0; r < 16; ++r) pmax = fmaxf(pmax, p1[r]);
  { auto rr = __builtin_amdgcn_permlane32_swap(__float_as_uint(pmax), __float_as_uint(pmax), false, false);
    pmax = fmaxf(__uint_as_float(rr[0]), __uint_as_float(rr[1])); }
  if (__builtin_expect(__all(pmax - m_reg <= THR / SCALE), 1)) { mn = m_reg; alpha = 1.f; }
  else { mn = fmaxf(m_reg, pmax); alpha = __builtin_amdgcn_exp2f((m_reg - mn) * C); m_reg = mn; }
  float mnC = -mn * C;
  for (int r = 0; r < 16; ++r) p0[r] = fmaf(p0[r], C, mnC); for (int r = 0; r < 16; ++r) p1[r] = fmaf(p1[r], C, mnC);
  for (int r = 0; r < 16; ++r) p0[r] = __builtin_amdgcn_exp2f(p0[r]);
}
__device__ __forceinline__ void boundedSM(f32x16& p0, f32x16& p1) {
  for (int r = 0; r < 16; ++r) p0[r] = __builtin_amdgcn_exp2f(p0[r]);
}
__device__ __forceinline__ void finishSM(f32x16& p0, f32x16& p1, float alpha, float& l_reg, bf16x8& pa0, bf16x8& pa1, bf16x8& pa2, bf16x8& pa3) {
  for (int r = 0; r < 16; ++r) p1[r] = __builtin_amdgcn_exp2f(p1[r]);
  float ps = 0; for (int r = 0; r < 16; ++r) ps += p0[r]; for (int r = 0; r < 16; ++r) ps += p1[r];
  { auto rr = __builtin_amdgcn_permlane32_swap(__float_as_uint(ps), __float_as_uint(ps), false, false);
    ps = __uint_as_float(rr[0]) + __uint_as_float(rr[1]); }
  l_reg = l_reg * alpha + ps;
#define PK4(P, BASE, OUT) do { unsigned a0 = cvtpk(P[BASE + 0], P[BASE + 1]), a1 = cvtpk(P[BASE + 2], P[BASE + 3]);   \
    unsigned b0 = cvtpk(P[BASE + 4], P[BASE + 5]), b1 = cvtpk(P[BASE + 6], P[BASE + 7]);                              \
    auto r0 = __builtin_amdgcn_permlane32_swap(a0, b0, false, false); auto r1 = __builtin_amdgcn_permlane32_swap(a1, b1, false, false); \
    u32x4 w = {r0[0], r1[0], r0[1], r1[1]}; OUT = *reinterpret_cast<bf16x8*>(&w); } while (0)
  PK4(p0, 0, pa0); PK4(p0, 8, pa1); PK4(p1, 0, pa2); PK4(p1, 8, pa3);
#undef PK4
}
__device__ __forceinline__ void partialSM1(f32x16& p0, float& m_reg, float& mn, float& alpha) {
  constexpr float C = SCALE * 1.4426950408889634f;
  float pmax = p0[0]; for (int r = 1; r < 16; ++r) pmax = fmaxf(pmax, p0[r]);
  { auto rr = __builtin_amdgcn_permlane32_swap(__float_as_uint(pmax), __float_as_uint(pmax), false, false);
    pmax = fmaxf(__uint_as_float(rr[0]), __uint_as_float(rr[1])); }
  if (__builtin_expect(__all(pmax - m_reg <= THR / SCALE), 1)) { mn = m_reg; alpha = 1.f; }
  else { mn = fmaxf(m_reg, pmax); alpha = __builtin_amdgcn_exp2f((m_reg - mn) * C); m_reg = mn; }
  float mnC = -mn * C;
  for (int r = 0; r < 16; ++r) p0[r] = fmaf(p0[r], C, mnC);
  for (int r = 0; r < 16; ++r) p0[r] = __builtin_amdgcn_exp2f(p0[r]);
}
__device__ __forceinline__ void finishSM1(f32x16& p0, float alpha, float& l_reg, bf16x8& pa0, bf16x8& pa1) {
  float ps = 0; for (int r = 0; r < 16; ++r) ps += p0[r];
  { auto rr = __builtin_amdgcn_permlane32_swap(__float_as_uint(ps), __float_as_uint(ps), false, false);
    ps = __uint_as_float(rr[0]) + __uint_as_float(rr[1]); }
  l_reg = l_reg * alpha + ps;
#define PK4(P, BASE, OUT) do { unsigned a0 = cvtpk(P[BASE + 0], P[BASE + 1]), a1 = cvtpk(P[BASE + 2], P[BASE + 3]);   \
    unsigned b0 = cvtpk(P[BASE + 4], P[BASE + 5]), b1 = cvtpk(P[BASE + 6], P[BASE + 7]);                              \
    auto r0 = __builtin_amdgcn_permlane32_swap(a0, b0, false, false); auto r1 = __builtin_amdgcn_permlane32_swap(a1, b1, false, false); \
    u32x4 w = {r0[0], r1[0], r0[1], r1[1]}; OUT = *reinterpret_cast<bf16x8*>(&w); } while (0)
  PK4(p0, 0, pa0); PK4(p0, 8, pa1);
#undef PK4
}
__device__ __forceinline__ void qkt(f32x16& p0, f32x16& p1, const bf16* Ks, const bf16x8* qr, int r32, int hi, float init = 0.f) {
  for (int r = 0; r < 16; ++r) { p0[r] = init; p1[r] = init; }
  for (int d0 = 0; d0 < 8; ++d0) { int cb = (d0 * 16 + hi * 8) * 2;
    bf16x8 b0 = *reinterpret_cast<const bf16x8*>((const char*)Ks + KSWZ(r32, cb));
    bf16x8 b1 = *reinterpret_cast<const bf16x8*>((const char*)Ks + KSWZ(32 + r32, cb));
    p0 = __builtin_amdgcn_mfma_f32_32x32x16_bf16(b0, qr[d0], p0, 0, 0, 0);
    p1 = __builtin_amdgcn_mfma_f32_32x32x16_bf16(b1, qr[d0], p1, 0, 0, 0); }
}
__device__ __forceinline__ int v_st(int k, int c) { const int kk = (k & ~0xC) | ((k & 4) << 1) | ((k & 8) >> 1); return ((kk >> 3) * 4 + (c >> 5)) * 512 + ((kk & 7) * 32 + (c & 31)) * 2; }
__device__ __forceinline__ int v_rd_base(int lane) { return ((lane & 3) << 3) | (((lane >> 2) & 3) << 6) | (((lane >> 4) & 1) << 5) | (((lane >> 5) & 1) << 8); }
constexpr int v_rd_off(int d0, int ks, int half) { return d0 * 512 + ks * 4096 + half * 2048; }
template <int OFF> __device__ __forceinline__ s16x4 tr_read(int vb) {
  s16x4 r; asm volatile("ds_read_b64_tr_b16 %0, %1 offset:%2" : "=&v"(r) : "v"(vb), "i"(OFF) : "memory"); return r;
}
template <int D0> __device__ __forceinline__ void pv_one(f32x16& od, int vb, bf16x8 pa0, bf16x8 pa1, bf16x8 pa2, bf16x8 pa3) {
  const s16x4 l0 = tr_read<v_rd_off(D0, 0, 0)>(vb), h0 = tr_read<v_rd_off(D0, 0, 1)>(vb), l1 = tr_read<v_rd_off(D0, 1, 0)>(vb), h1 = tr_read<v_rd_off(D0, 1, 1)>(vb);
  const s16x4 l2 = tr_read<v_rd_off(D0, 2, 0)>(vb), h2 = tr_read<v_rd_off(D0, 2, 1)>(vb), l3 = tr_read<v_rd_off(D0, 3, 0)>(vb), h3 = tr_read<v_rd_off(D0, 3, 1)>(vb);
  asm volatile("s_waitcnt lgkmcnt(0)" ::: "memory"); SBAR();
#define PK(L, H) (bf16x8){L[0], L[1], L[2], L[3], H[0], H[1], H[2], H[3]}
  od = __builtin_amdgcn_mfma_f32_32x32x16_bf16(pa0, PK(l0, h0), od, 0, 0, 0);
  od = __builtin_amdgcn_mfma_f32_32x32x16_bf16(pa1, PK(l1, h1), od, 0, 0, 0);
  od = __builtin_amdgcn_mfma_f32_32x32x16_bf16(pa2, PK(l2, h2), od, 0, 0, 0);
  od = __builtin_amdgcn_mfma_f32_32x32x16_bf16(pa3, PK(l3, h3), od, 0, 0, 0);
#undef PK
}
__device__ __forceinline__ void pv_d0(f32x16* o, int vb, bf16x8 pa0, bf16x8 pa1, bf16x8 pa2, bf16x8 pa3) {
  pv_one<0>(o[0], vb, pa0, pa1, pa2, pa3); pv_one<1>(o[1], vb, pa0, pa1, pa2, pa3); pv_one<2>(o[2], vb, pa0, pa1, pa2, pa3); pv_one<3>(o[3], vb, pa0, pa1, pa2, pa3);
}

__device__ __forceinline__ void qkt32(f32x16& p0, const bf16* Ks, const bf16x8* qr, int krow, int hi) {
  for (int r = 0; r < 16; ++r) p0[r] = 0.f;
  for (int d0 = 0; d0 < 8; ++d0) { int cb = (d0 * 16 + hi * 8) * 2;
    bf16x8 b0 = *reinterpret_cast<const bf16x8*>((const char*)Ks + KSWZ(krow, cb));
    p0 = __builtin_amdgcn_mfma_f32_32x32x16_bf16(b0, qr[d0], p0, 0, 0, 0); }
}
template <int D0> __device__ __forceinline__ void pv_one2(f32x16& od, int vb, bf16x8 pa0, bf16x8 pa1) {
  const s16x4 l0 = tr_read<v_rd_off(D0, 0, 0)>(vb), h0 = tr_read<v_rd_off(D0, 0, 1)>(vb), l1 = tr_read<v_rd_off(D0, 1, 0)>(vb), h1 = tr_read<v_rd_off(D0, 1, 1)>(vb);
  asm volatile("s_waitcnt lgkmcnt(0)" ::: "memory"); SBAR();
#define PK(L, H) (bf16x8){L[0], L[1], L[2], L[3], H[0], H[1], H[2], H[3]}
  od = __builtin_amdgcn_mfma_f32_32x32x16_bf16(pa0, PK(l0, h0), od, 0, 0, 0);
  od = __builtin_amdgcn_mfma_f32_32x32x16_bf16(pa1, PK(l1, h1), od, 0, 0, 0);
#undef PK
}
__device__ __forceinline__ void pv_d0h(f32x16* o, int vb, bf16x8 pa0, bf16x8 pa1) {
  pv_one2<0>(o[0], vb, pa0, pa1); pv_one2<1>(o[1], vb, pa0, pa1); pv_one2<2>(o[2], vb, pa0, pa1); pv_one2<3>(o[3], vb, pa0, pa1);
}

constexpr size_t SHM_V = KVBLK * D * 2, SHM_K = KVBLK * D * 2, SHM_ATTN = 2 * SHM_V + 2 * SHM_K + NW * 64 * 4;
constexpr float NEG_INF = -__builtin_inff();
constexpr int OSTAGE_OFF = 73728;

#ifndef MK_PREFETCH_UNIT
#define MK_PREFETCH_UNIT 0
#endif
struct Pre { bf16x8 qr[8]; bf16x8 vs0, vs1, ks0, ks1; };
template <class Cfg, int SD = 2  ,
          bool BOUNDED = false  >
__device__ __forceinline__ void attn_unit(const Cfg& cfg, char* lds, const int wid  , Pre& pre, const bool have_pre  , const Cfg* nxt  ) {
  const int lane = lane_id(), tid = wid * 64 + lane, r32 = lane & 31, hi = lane >> 5;
  bf16* V_lds = (bf16*)lds; bf16* K_lds = (bf16*)(lds + 2 * SHM_V);
  float* ws = (float*)(lds + 2 * SHM_V + 2 * SHM_K) + wid * 64; float* li_l = ws; float* al_l = ws + 32;
  float m_reg = -1e30f, l_reg = 0; f32x16 o[4] = {}; bf16x8 qr[8];
  const bf16* Qw = cfg.proj + cfg.q_off(wid * QBLK + r32) + hi * 8;
  if (have_pre) {
#pragma unroll
    for (int d0 = 0; d0 < 8; ++d0) qr[d0] = pre.qr[d0];
  } else {
#pragma unroll
    for (int d0 = 0; d0 < 8; ++d0) qr[d0] = *reinterpret_cast<const bf16x8*>(Qw + d0 * 16);
  }
  const int sr = tid >> 4, sc = (tid & 15) * 8, vst0 = v_st(sr, sc), vst1 = v_st(32 + sr, sc);
  const int vb0 = (int)(uintptr_t)V_lds + v_rd_base(lane);
  struct { bf16x8 vs0, vs1, ks0, ks1; } sr_[SD];
#define SLOAD(i, t) do { const unsigned o0_ = cfg.kv_off((t), sr) + sc, o1_ = cfg.kv_off((t), 32 + sr) + sc; \
    sr_[i].vs0 = *reinterpret_cast<const bf16x8*>(cfg.proj + cfg.vcol + o0_); sr_[i].vs1 = *reinterpret_cast<const bf16x8*>(cfg.proj + cfg.vcol + o1_); \
    sr_[i].ks0 = *reinterpret_cast<const bf16x8*>(cfg.proj + cfg.kcol + o0_); sr_[i].ks1 = *reinterpret_cast<const bf16x8*>(cfg.proj + cfg.kcol + o1_); } while (0)
#define SWRITE(b, i) do { *(bf16x8*)((char*)V_lds + (b) * SHM_V + vst0) = sr_[i].vs0;          \
    *(bf16x8*)((char*)V_lds + (b) * SHM_V + vst1) = sr_[i].vs1; int kc = sc * 2;               \
    *(bf16x8*)((char*)K_lds + (b) * SHM_K + KSWZ(sr, kc)) = sr_[i].ks0;                       \
    *(bf16x8*)((char*)K_lds + (b) * SHM_K + KSWZ(32 + sr, kc)) = sr_[i].ks1; } while (0)
#define SWAIT() do { if constexpr (SD == 2) asm volatile("s_waitcnt vmcnt(4)" ::: "memory"); else asm volatile("s_waitcnt vmcnt(0)" ::: "memory"); } while (0)
#define RESC(a) do { if (!BOUNDED && __any((a) < 1.f)) { if (hi == 0) al_l[r32] = (a); asm volatile("s_waitcnt lgkmcnt(0)" ::: "memory"); \
    for (int d = 0; d < 4; ++d) for (int r = 0; r < 16; ++r) o[d][r] *= al_l[crow(r, hi)]; } } while (0)
#define QK(P0, P1, KB, T, MN, AL) do { if (cfg.active((T), wid)) { qkt(P0, P1, (KB), qr, r32, hi, BOUNDED ? cfg.negm0C : 0.f); cfg.mask(P0, P1, (T), wid, r32, hi); if constexpr (BOUNDED) { boundedSM(P0, P1); AL = 1.f; } else partialSM(P0, P1, m_reg, MN, AL); } else { AL = 1.f; } } while (0)
#define QK1(P0, P1, KB, T) do { if (cfg.active((T), wid)) { qkt(P0, P1, (KB), qr, r32, hi, BOUNDED ? cfg.negm0C : 0.f); cfg.mask(P0, P1, (T), wid, r32, hi); } } while (0)
#define PSM(P0, P1, T, MN, AL) do { if (cfg.active((T), wid)) { if constexpr (BOUNDED) { boundedSM(P0, P1); AL = 1.f; } else partialSM(P0, P1, m_reg, MN, AL); } else { AL = 1.f; } } while (0)
#define FPV(P0, P1, AL, VB, T) do { if (cfg.active((T), wid)) { finishSM(P0, P1, AL, l_reg, pa0, pa1, pa2, pa3); SBAR(); pv_d0(o, (VB), pa0, pa1, pa2, pa3); } } while (0)
  f32x16 pA0, pA1, pB0, pB1; float mnA, mnB, alA, alB; bf16x8 pa0, pa1, pa2, pa3; const int NT = Cfg::NT;
  constexpr int SE = 0, SO = SD - 1;
  if (have_pre) { sr_[SE].vs0 = pre.vs0; sr_[SE].vs1 = pre.vs1; sr_[SE].ks0 = pre.ks0; sr_[SE].ks1 = pre.ks1; } else SLOAD(SE, 0);
  asm volatile("s_waitcnt vmcnt(0)" ::: "memory"); SWRITE(0, SE); __syncthreads();
  QK(pA0, pA1, K_lds, 0, mnA, alA);
  SLOAD(SO, 1); if constexpr (SD == 2) { if (2 < NT) SLOAD(SE, 2); }
  SWAIT(); SWRITE(1, SO); __syncthreads();
  for (int j = 1; j + 1 < NT; j += 2) {
    SBAR(); QK1(pB0, pB1, (bf16*)((char*)K_lds + SHM_K), j);
    if (cfg.active(j - 1, wid)) { finishSM(pA0, pA1, alA, l_reg, pa0, pa1, pa2, pa3); } SBAR();
    SLOAD(SO, j + SD); SBAR();
    if (cfg.active(j - 1, wid)) { pv_d0(o, vb0, pa0, pa1, pa2, pa3); }
    PSM(pB0, pB1, j, mnB, alB);
    __syncthreads(); SWAIT(); SWRITE(0, SE);
    RESC(alB); __syncthreads();
    SBAR(); QK1(pA0, pA1, K_lds, j + 1);
    if (cfg.active(j, wid)) { finishSM(pB0, pB1, alB, l_reg, pa0, pa1, pa2, pa3); } SBAR();
    if (SD == 1 || j + 3 < NT) SLOAD(SE, j + 1 + SD); SBAR();
    if (cfg.active(j, wid)) { pv_d0(o, vb0 + (int)SHM_V, pa0, pa1, pa2, pa3); }
    PSM(pA0, pA1, j + 1, mnA, alA);
    __syncthreads(); SWAIT(); SWRITE(1, SO);
    RESC(alA); __syncthreads();
  }
  SBAR(); QK1(pB0, pB1, (bf16*)((char*)K_lds + SHM_K), NT - 1);
  if (cfg.active(NT - 2, wid)) { finishSM(pA0, pA1, alA, l_reg, pa0, pa1, pa2, pa3); SBAR(); pv_d0(o, vb0, pa0, pa1, pa2, pa3); }
  PSM(pB0, pB1, NT - 1, mnB, alB);
  __syncthreads(); RESC(alB);
  if (cfg.active(NT - 1, wid)) { finishSM(pB0, pB1, alB, l_reg, pa0, pa1, pa2, pa3); SBAR(); pv_d0(o, vb0 + (int)SHM_V, pa0, pa1, pa2, pa3); }
  if (hi == 0) li_l[r32] = l_reg; asm volatile("s_waitcnt lgkmcnt(0)" ::: "memory");
  if (Cfg::HAS_LSE) { if (hi == 0) cfg.store_lse(wid * QBLK + r32, m_reg * SCALE + __logf(l_reg)); }
  if (MK_PREFETCH_UNIT) {
    const bf16* Qn = nxt->proj + nxt->q_off(wid * QBLK + r32) + hi * 8;
#pragma unroll
    for (int d0 = 0; d0 < 8; ++d0) pre.qr[d0] = *reinterpret_cast<const bf16x8*>(Qn + d0 * 16);
    const unsigned o0_ = nxt->kv_off(0, sr) + sc, o1_ = nxt->kv_off(0, 32 + sr) + sc;
    pre.vs0 = *reinterpret_cast<const bf16x8*>(nxt->proj + nxt->vcol + o0_); pre.vs1 = *reinterpret_cast<const bf16x8*>(nxt->proj + nxt->vcol + o1_);
    pre.ks0 = *reinterpret_cast<const bf16x8*>(nxt->proj + nxt->kcol + o0_); pre.ks1 = *reinterpret_cast<const bf16x8*>(nxt->proj + nxt->kcol + o1_);
    asm volatile("" ::: "memory");
  }
  { bf16* stg = (bf16*)(lds + OSTAGE_OFF) + wid * 2048;
#pragma unroll
    for (int hh = 0; hh < 2; ++hh) {
#pragma unroll
      for (int r8 = 0; r8 < 8; ++r8) { const int r = 8 * hh + r8; const int orow = crow(r, hi); const float rl = __builtin_amdgcn_rcpf(li_l[orow]);
#pragma unroll
        for (int d0 = 0; d0 < 4; ++d0) stg[(orow & 15) * 128 + d0 * 32 + r32] = (bf16)(cvtpk(o[d0][r] * rl, 0.f) & 0xffffu); }
      asm volatile("s_waitcnt lgkmcnt(0)" ::: "memory");
#pragma unroll
      for (int j = 0; j < 4; ++j) { const int row = (lane >> 4) + 4 * j, ch = lane & 15; const u32x4 v = *(const u32x4*)(stg + row * 128 + ch * 8);
        *(u32x4*)(cfg.obuf + cfg.o_off(wid * QBLK + 16 * hh + row) + ch * 8) = v; }
      asm volatile("s_waitcnt lgkmcnt(0)" ::: "memory");
    } }
  __syncthreads();
#undef SLOAD
#undef SWRITE
#undef SWAIT
#undef RESC
#undef QK
#undef QK1
#undef PSM
#undef FPV
}

template <class Cfg, int SD = 2>
__device__ __forceinline__ void attn_unit_h(const Cfg& cfg, char* lds, const int wid  , Pre& pre, const bool have_pre  , const Cfg* nxt  ) {
  const int lane = lane_id(), tid = wid * 64 + lane, r32 = lane & 31, hi = lane >> 5;
  bf16* V_lds = (bf16*)lds; bf16* K_lds = (bf16*)(lds + 2 * SHM_V);
  float* ws = (float*)(lds + 2 * SHM_V + 2 * SHM_K) + wid * 64; float* li_l = ws; float* al_l = ws + 32;
  float m_reg = -1e30f, l_reg = 0; f32x16 o[4] = {}; bf16x8 qr[8];
  const bf16* Qw = cfg.proj + cfg.q_off(wid * QBLK + r32) + hi * 8;
  if (have_pre) {
#pragma unroll
    for (int d0 = 0; d0 < 8; ++d0) qr[d0] = pre.qr[d0];
  } else {
#pragma unroll
    for (int d0 = 0; d0 < 8; ++d0) qr[d0] = *reinterpret_cast<const bf16x8*>(Qw + d0 * 16);
  }
  const int sr = tid >> 4, sc = (tid & 15) * 8, vst0 = v_st(sr, sc), vst1 = v_st(32 + sr, sc);
  const int krow = cfg.kwin(wid) + r32;
  const int Ga = (cfg.kwin(wid) >> 3) + hi;
  const int vb0 = (int)(uintptr_t)V_lds + (v_rd_base(lane) & ~256) + ((Ga >> 1) << 12) + ((Ga & 1) << 8);
  struct { bf16x8 vs0, vs1, ks0, ks1; } sr_[SD];
#define SLOAD(i, t) do { const unsigned o0_ = cfg.kv_off((t), sr) + sc, o1_ = cfg.kv_off((t), 32 + sr) + sc; \
    sr_[i].vs0 = *reinterpret_cast<const bf16x8*>(cfg.proj + cfg.vcol + o0_); sr_[i].vs1 = *reinterpret_cast<const bf16x8*>(cfg.proj + cfg.vcol + o1_); \
    sr_[i].ks0 = *reinterpret_cast<const bf16x8*>(cfg.proj + cfg.kcol + o0_); sr_[i].ks1 = *reinterpret_cast<const bf16x8*>(cfg.proj + cfg.kcol + o1_); } while (0)
#define SWRITE(b, i) do { *(bf16x8*)((char*)V_lds + (b) * SHM_V + vst0) = sr_[i].vs0;          \
    *(bf16x8*)((char*)V_lds + (b) * SHM_V + vst1) = sr_[i].vs1; int kc = sc * 2;               \
    *(bf16x8*)((char*)K_lds + (b) * SHM_K + KSWZ(sr, kc)) = sr_[i].ks0;                       \
    *(bf16x8*)((char*)K_lds + (b) * SHM_K + KSWZ(32 + sr, kc)) = sr_[i].ks1; } while (0)
#define SWAIT() do { if constexpr (SD == 2) asm volatile("s_waitcnt vmcnt(4)" ::: "memory"); else asm volatile("s_waitcnt vmcnt(0)" ::: "memory"); } while (0)
#define RESC(a) do { if (__any((a) < 1.f)) { if (hi == 0) al_l[r32] = (a); asm volatile("s_waitcnt lgkmcnt(0)" ::: "memory"); \
    for (int d = 0; d < 4; ++d) for (int r = 0; r < 16; ++r) o[d][r] *= al_l[crow(r, hi)]; } } while (0)
#define QK(P0, KB, T, MN, AL) do { if (cfg.active((T), wid)) { qkt32(P0, (KB), qr, krow, hi); cfg.mask16(P0, (T), wid, r32, hi); partialSM1(P0, m_reg, MN, AL); } else { AL = 1.f; } } while (0)
#define QK1(P0, KB, T) do { if (cfg.active((T), wid)) { qkt32(P0, (KB), qr, krow, hi); cfg.mask16(P0, (T), wid, r32, hi); } } while (0)
#define PSM(P0, T, MN, AL) do { if (cfg.active((T), wid)) { partialSM1(P0, m_reg, MN, AL); } else { AL = 1.f; } } while (0)
  f32x16 pA0, pB0; float mnA, mnB, alA, alB; bf16x8 pa0, pa1; const int NT = Cfg::NT;
  constexpr int SE = 0, SO = SD - 1;
  if (have_pre) { sr_[SE].vs0 = pre.vs0; sr_[SE].vs1 = pre.vs1; sr_[SE].ks0 = pre.ks0; sr_[SE].ks1 = pre.ks1; } else SLOAD(SE, 0);
  asm volatile("s_waitcnt vmcnt(0)" ::: "memory"); SWRITE(0, SE); __syncthreads();
  QK(pA0, K_lds, 0, mnA, alA);
  SLOAD(SO, 1); if constexpr (SD == 2) { if (2 < NT) SLOAD(SE, 2); }
  SWAIT(); SWRITE(1, SO); __syncthreads();
  for (int j = 1; j + 1 < NT; j += 2) {
    SBAR(); QK1(pB0, (bf16*)((char*)K_lds + SHM_K), j);
    if (cfg.active(j - 1, wid)) { finishSM1(pA0, alA, l_reg, pa0, pa1); } SBAR();
    SLOAD(SO, j + SD); SBAR();
    if (cfg.active(j - 1, wid)) { pv_d0h(o, vb0, pa0, pa1); }
    PSM(pB0, j, mnB, alB);
    __syncthreads(); SWAIT(); SWRITE(0, SE);
    RESC(alB); __syncthreads();
    SBAR(); QK1(pA0, K_lds, j + 1);
    if (cfg.active(j, wid)) { finishSM1(pB0, alB, l_reg, pa0, pa1); } SBAR();
    if (SD == 1 || j + 3 < NT) SLOAD(SE, j + 1 + SD); SBAR();
    if (cfg.active(j, wid)) { pv_d0h(o, vb0 + (int)SHM_V, pa0, pa1); }
    PSM(pA0, j + 1, mnA, alA);
    __syncthreads(); SWAIT(); SWRITE(1, SO);
    RESC(alA); __syncthreads();
  }
  SBAR(); QK1(pB0, (bf16*)((char*)K_lds + SHM_K), NT - 1);
  if (cfg.active(NT - 2, wid)) { finishSM1(pA0, alA, l_reg, pa0, pa1); SBAR(); pv_d0h(o, vb0, pa0, pa1); }
  PSM(pB0, NT - 1, mnB, alB);
  __syncthreads(); RESC(alB);
  if (cfg.active(NT - 1, wid)) { finishSM1(pB0, alB, l_reg, pa0, pa1); SBAR(); pv_d0h(o, vb0 + (int)SHM_V, pa0, pa1); }
  if (hi == 0) li_l[r32] = l_reg; asm volatile("s_waitcnt lgkmcnt(0)" ::: "memory");
  if (Cfg::HAS_LSE) { if (hi == 0) cfg.store_lse(wid * QBLK + r32, m_reg * SCALE + __logf(l_reg)); }
  if (MK_PREFETCH_UNIT) {
    const bf16* Qn = nxt->proj + nxt->q_off(wid * QBLK + r32) + hi * 8;
#pragma unroll
    for (int d0 = 0; d0 < 8; ++d0) pre.qr[d0] = *reinterpret_cast<const bf16x8*>(Qn + d0 * 16);
    const unsigned o0_ = nxt->kv_off(0, sr) + sc, o1_ = nxt->kv_off(0, 32 + sr) + sc;
    pre.vs0 = *reinterpret_cast<const bf16x8*>(nxt->proj + nxt->vcol + o0_); pre.vs1 = *reinterpret_cast<const bf16x8*>(nxt->proj + nxt->vcol + o1_);
    pre.ks0 = *reinterpret_cast<const bf16x8*>(nxt->proj + nxt->kcol + o0_); pre.ks1 = *reinterpret_cast<const bf16x8*>(nxt->proj + nxt->kcol + o1_);
    asm volatile("" ::: "memory");
  }
  { bf16* stg = (bf16*)(lds + OSTAGE_OFF) + wid * 2048;
#pragma unroll
    for (int hh = 0; hh < 2; ++hh) {
#pragma unroll
      for (int r8 = 0; r8 < 8; ++r8) { const int r = 8 * hh + r8; const int orow = crow(r, hi); const float rl = __builtin_amdgcn_rcpf(li_l[orow]);
#pragma unroll
        for (int d0 = 0; d0 < 4; ++d0) stg[(orow & 15) * 128 + d0 * 32 + r32] = (bf16)(cvtpk(o[d0][r] * rl, 0.f) & 0xffffu); }
      asm volatile("s_waitcnt lgkmcnt(0)" ::: "memory");
#pragma unroll
      for (int j = 0; j < 4; ++j) { const int row = (lane >> 4) + 4 * j, ch = lane & 15; const u32x4 v = *(const u32x4*)(stg + row * 128 + ch * 8);
        *(u32x4*)(cfg.obuf + cfg.o_off(wid * QBLK + 16 * hh + row) + ch * 8) = v; }
      asm volatile("s_waitcnt lgkmcnt(0)" ::: "memory");
    } }
  __syncthreads();
#undef SLOAD
#undef SWRITE
#undef SWAIT
#undef RESC
#undef QK
#undef QK1
#undef PSM
}

template <class Cfg>
__device__ __forceinline__ void attn_unit_simple(const Cfg& cfg, char* lds, const int wid  ) {
  const int lane = lane_id(), tid = wid * 64 + lane, r32 = lane & 31, hi = lane >> 5;
  bf16* V_lds = (bf16*)lds; bf16* K_lds = (bf16*)(lds + 2 * SHM_V);
  float* ws = (float*)(lds + 2 * SHM_V + 2 * SHM_K) + wid * 64; float* li_l = ws; float* al_l = ws + 32;
  float m_reg = -1e30f, l_reg = 0; f32x16 o[4] = {}; bf16x8 qr[8];
  const bf16* Qw = cfg.proj + cfg.q_off(wid * QBLK + r32) + hi * 8;
#pragma unroll
  for (int d0 = 0; d0 < 8; ++d0) qr[d0] = *reinterpret_cast<const bf16x8*>(Qw + d0 * 16);
  const int sr = tid >> 4, sc = (tid & 15) * 8, vst0 = v_st(sr, sc), vst1 = v_st(32 + sr, sc);
  const int vb0 = (int)(uintptr_t)V_lds + v_rd_base(lane);
  bf16x8 vs0, vs1, ks0, ks1;
#define SLOAD1(t) do { const unsigned o0_ = cfg.kv_off((t), sr) + sc, o1_ = cfg.kv_off((t), 32 + sr) + sc; \
    vs0 = *reinterpret_cast<const bf16x8*>(cfg.proj + cfg.vcol + o0_); vs1 = *reinterpret_cast<const bf16x8*>(cfg.proj + cfg.vcol + o1_); \
    ks0 = *reinterpret_cast<const bf16x8*>(cfg.proj + cfg.kcol + o0_); ks1 = *reinterpret_cast<const bf16x8*>(cfg.proj + cfg.kcol + o1_); } while (0)
#define SWRITE1(b) do { *(bf16x8*)((char*)V_lds + (b) * SHM_V + vst0) = vs0; *(bf16x8*)((char*)V_lds + (b) * SHM_V + vst1) = vs1; const int kc = sc * 2; \
    *(bf16x8*)((char*)K_lds + (b) * SHM_K + KSWZ(sr, kc)) = ks0; *(bf16x8*)((char*)K_lds + (b) * SHM_K + KSWZ(32 + sr, kc)) = ks1; } while (0)
  const int tb = cfg.t_begin(), te = cfg.t_end();
  SLOAD1(tb); asm volatile("s_waitcnt vmcnt(0)" ::: "memory"); SWRITE1(tb & 1); __syncthreads();
  for (int t = tb; t < te; ++t) {
    const int b = t & 1;
    if (t + 1 < te) SLOAD1(t + 1);
    SBAR();
    if (cfg.active(t, wid)) {
      f32x16 p0, p1; float mn, al; bf16x8 pa0, pa1, pa2, pa3;
      qkt(p0, p1, (bf16*)((char*)K_lds + b * SHM_K), qr, r32, hi);
      cfg.mask(p0, p1, t, wid, r32, hi);
      partialSM(p0, p1, m_reg, mn, al);
      if (__any(al < 1.f)) { if (hi == 0) al_l[r32] = al; asm volatile("s_waitcnt lgkmcnt(0)" ::: "memory");
#pragma unroll
        for (int d = 0; d < 4; ++d)
#pragma unroll
          for (int r = 0; r < 16; ++r) o[d][r] *= al_l[crow(r, hi)]; }
      finishSM(p0, p1, al, l_reg, pa0, pa1, pa2, pa3); SBAR();
      pv_d0(o, vb0 + b * (int)SHM_V, pa0, pa1, pa2, pa3);
    }
    SBAR();
    if (t + 1 < te) { asm volatile("s_waitcnt vmcnt(0)" ::: "memory"); SWRITE1(b ^ 1); }
    __syncthreads();
  }
  if (hi == 0) li_l[r32] = l_reg; asm volatile("s_waitcnt lgkmcnt(0)" ::: "memory");
  if (Cfg::HAS_LSE) { if (hi == 0) cfg.store_lse(wid * QBLK + r32, m_reg * SCALE + __logf(l_reg)); }
  { bf16* stg = (bf16*)(lds + OSTAGE_OFF) + wid * 2048;
#pragma unroll
    for (int hh = 0; hh < 2; ++hh) {
#pragma unroll
      for (int r8 = 0; r8 < 8; ++r8) { const int r = 8 * hh + r8; const int orow = crow(r, hi); const float rl = __builtin_amdgcn_rcpf(li_l[orow]);
#pragma unroll
        for (int d0 = 0; d0 < 4; ++d0) stg[(orow & 15) * 128 + d0 * 32 + r32] = (bf16)(cvtpk(o[d0][r] * rl, 0.f) & 0xffffu); }
      asm volatile("s_waitcnt lgkmcnt(0)" ::: "memory");
#pragma unroll
      for (int j = 0; j < 4; ++j) { const int row = (lane >> 4) + 4 * j, ch = lane & 15; const u32x4 v = *(const u32x4*)(stg + row * 128 + ch * 8);
        *(u32x4*)(cfg.obuf + cfg.o_off(wid * QBLK + 16 * hh + row) + ch * 8) = v; }
      asm volatile("s_waitcnt lgkmcnt(0)" ::: "memory");
    } }
  __syncthreads();
#undef SLOAD1
#undef SWRITE1
}

template <class Cfg>
__device__ __forceinline__ void attn_unit_wave(const Cfg& cfg, char* lds, const int wid  ) {
  const int lane = lane_id(), r32 = lane & 31, hi = lane >> 5;
  char* Vw = lds + wid * 8192;
  float* ws = (float*)(lds + 2 * SHM_V + 2 * SHM_K) + wid * 64; float* li_l = ws; float* al_l = ws + 32;
  float m_reg = -1e30f, l_reg = 0; f32x16 o[4] = {}; bf16x8 qr[8];
  const bf16* Qw = cfg.proj + cfg.q_off(wid * QBLK + r32) + hi * 8;
#pragma unroll
  for (int d0 = 0; d0 < 8; ++d0) qr[d0] = *reinterpret_cast<const bf16x8*>(Qw + d0 * 16);
  const int vkey = lane >> 4, vch = (lane & 15) * 8;
  const int vb0 = (int)(uintptr_t)Vw + v_rd_base(lane);
  const int tb = cfg.t_begin(), te = cfg.t_end();
  for (int t = tb; t < te; ++t) {
    if (!cfg.active(t, wid)) continue;
    bf16x8 kf[16], vf[8];
    { const bf16* k0p = cfg.proj + cfg.kcol + cfg.kv_off(t, r32) + hi * 8; const bf16* k1p = cfg.proj + cfg.kcol + cfg.kv_off(t, 32 + r32) + hi * 8;
#pragma unroll
      for (int d0 = 0; d0 < 8; ++d0) { kf[2 * d0] = *reinterpret_cast<const bf16x8*>(k0p + d0 * 16); kf[2 * d0 + 1] = *reinterpret_cast<const bf16x8*>(k1p + d0 * 16); } }
#pragma unroll
    for (int j = 0; j < 8; ++j) vf[j] = *reinterpret_cast<const bf16x8*>(cfg.proj + cfg.vcol + cfg.kv_off(t, vkey + 4 * j) + vch);
    f32x16 p0 = {}, p1 = {};
#pragma unroll
    for (int d0 = 0; d0 < 8; ++d0) { p0 = __builtin_amdgcn_mfma_f32_32x32x16_bf16(kf[2 * d0], qr[d0], p0, 0, 0, 0); p1 = __builtin_amdgcn_mfma_f32_32x32x16_bf16(kf[2 * d0 + 1], qr[d0], p1, 0, 0, 0); }
    cfg.mask(p0, p1, t, wid, r32, hi);
    float mn, al; bf16x8 pa0, pa1, pa2, pa3;
    partialSM(p0, p1, m_reg, mn, al);
    if (__any(al < 1.f)) { if (hi == 0) al_l[r32] = al; asm volatile("s_waitcnt lgkmcnt(0)" ::: "memory");
#pragma unroll
      for (int d = 0; d < 4; ++d)
#pragma unroll
        for (int r = 0; r < 16; ++r) o[d][r] *= al_l[crow(r, hi)]; }
    finishSM(p0, p1, al, l_reg, pa0, pa1, pa2, pa3);
#pragma unroll
    for (int j = 0; j < 8; ++j) *(bf16x8*)(Vw + v_st(vkey + 4 * j, vch)) = vf[j];
#pragma unroll
    for (int j = 0; j < 8; ++j) vf[j] = *reinterpret_cast<const bf16x8*>(cfg.proj + cfg.vcol + cfg.kv_off(t, 32 + vkey + 4 * j) + vch);
    asm volatile("s_waitcnt lgkmcnt(0)" ::: "memory"); SBAR();
#define PVW(D0, PA, PB) do { const s16x4 l0 = tr_read<v_rd_off(D0, 0, 0)>(vb0), h0 = tr_read<v_rd_off(D0, 0, 1)>(vb0), l1 = tr_read<v_rd_off(D0, 1, 0)>(vb0), h1 = tr_read<v_rd_off(D0, 1, 1)>(vb0); \
      asm volatile("s_waitcnt lgkmcnt(0)" ::: "memory"); SBAR(); \
      o[D0] = __builtin_amdgcn_mfma_f32_32x32x16_bf16(PA, ((bf16x8){l0[0], l0[1], l0[2], l0[3], h0[0], h0[1], h0[2], h0[3]}), o[D0], 0, 0, 0); \
      o[D0] = __builtin_amdgcn_mfma_f32_32x32x16_bf16(PB, ((bf16x8){l1[0], l1[1], l1[2], l1[3], h1[0], h1[1], h1[2], h1[3]}), o[D0], 0, 0, 0); } while (0)
    PVW(0, pa0, pa1); PVW(1, pa0, pa1); PVW(2, pa0, pa1); PVW(3, pa0, pa1);
    SBAR();
#pragma unroll
    for (int j = 0; j < 8; ++j) *(bf16x8*)(Vw + v_st(vkey + 4 * j, vch)) = vf[j];
    asm volatile("s_waitcnt lgkmcnt(0)" ::: "memory"); SBAR();
    PVW(0, pa2, pa3); PVW(1, pa2, pa3); PVW(2, pa2, pa3); PVW(3, pa2, pa3);
    SBAR();
#undef PVW
  }
  if (hi == 0) li_l[r32] = l_reg; asm volatile("s_waitcnt lgkmcnt(0)" ::: "memory");
  if (Cfg::HAS_LSE) { if (hi == 0) cfg.store_lse(wid * QBLK + r32, m_reg * SCALE + __logf(l_reg)); }
  { bf16* stg = (bf16*)(lds + OSTAGE_OFF) + wid * 2048;
#pragma unroll
    for (int hh = 0; hh < 2; ++hh) {
#pragma unroll
      for (int r8 = 0; r8 < 8; ++r8) { const int r = 8 * hh + r8; const int orow = crow(r, hi); const float rl = __builtin_amdgcn_rcpf(li_l[orow]);
#pragma unroll
        for (int d0 = 0; d0 < 4; ++d0) stg[(orow & 15) * 128 + d0 * 32 + r32] = (bf16)(cvtpk(o[d0][r] * rl, 0.f) & 0xffffu); }
      asm volatile("s_waitcnt lgkmcnt(0)" ::: "memory");
#pragma unroll
      for (int j = 0; j < 4; ++j) { const int row = (lane >> 4) + 4 * j, ch = lane & 15; const u32x4 v = *(const u32x4*)(stg + row * 128 + ch * 8);
        *(u32x4*)(cfg.obuf + cfg.o_off(wid * QBLK + 16 * hh + row) + ch * 8) = v; }
      asm volatile("s_waitcnt lgkmcnt(0)" ::: "memory");
    } }
}
#undef KSWZ
#undef SBAR
}

constexpr int NWAVES = 8;
constexpr int NTOK = 49152, SEQ = 4096, NSEQ = 12, NTOK_P = 16384;
constexpr int DM = 2048, INW = 5632, DFF = 8192, NLAYER = 4, HD = 128;
constexpr int COL_AQ = 0, COL_AK = 512, COL_AV = 768, COL_BQ = 1024, COL_BK = 1792, COL_BV = 2560, COL_CQ = 3328, COL_CK = 4096, COL_CV = 4864;
constexpr int OCOL_A = 0, OCOL_B = 512, OCOL_C = 1280;
constexpr float DN_ALPHA = 1.681792830507429f;
constexpr float EPS = 1e-6f;
constexpr float ATT_SCALE = 0.08838834764831845f;
#ifndef MK_BF16_RES
#define MK_BF16_RES 1
#endif
#ifndef MK_FUSE_PREP
#define MK_FUSE_PREP 1
#endif
#ifndef MK_BOUNDED_A
#define MK_BOUNDED_A 1
#endif
#ifndef MK_FIN_PHASES
#define MK_FIN_PHASES 0
#endif
#ifndef MK_TILED_H
#define MK_TILED_H 1
#endif
#ifndef MK_WGM_RES
#define MK_WGM_RES 4
#endif

constexpr size_t MiB = 1u << 20;
constexpr size_t WS_CTL = 0, CTL_ZERO_BYTES = 1 * MiB;
constexpr size_t WS_ROPE_B = 1 * MiB;
constexpr size_t WS_ROPE_A = 3 * MiB;
constexpr size_t WS_LSE    = 4 * MiB;
constexpr size_t WS_WIN    = 6 * MiB;
constexpr size_t WS_WOUT   = 28 * MiB;
constexpr size_t WS_WFF1   = 36 * MiB;
constexpr size_t WS_WFF2   = 68 * MiB;
constexpr size_t WS_XB     = 100 * MiB;
constexpr size_t WS_PROJ   = 292 * MiB;
constexpr size_t WS_O      = 820 * MiB;
constexpr size_t WS_H      = 292 * MiB;
constexpr size_t WS_PART   = 1060 * MiB;
constexpr size_t WS_STAT   = 1072 * MiB;
constexpr size_t WS_VEC    = 1073 * MiB;
constexpr size_t WS_PSB    = 1074 * MiB;
constexpr size_t WS_END    = 1078 * MiB;
static_assert(WS_PROJ + (size_t)NTOK * INW * 2 == WS_O && WS_O + (size_t)NTOK * DM * 2 <= WS_END && WS_H + (size_t)NTOK * DFF * 2 == WS_PART && WS_XB + (size_t)NTOK * DM * 2 == WS_PROJ, "d_ws map");
constexpr int CW_TMO = 0, CW_CODE = 1, CW_BAR = 4096;
constexpr int NCOLP = INW + DFF, VEC_CS_IN = 0, VEC_BW_IN = INW, VEC_CS_FF1 = 2 * INW, VEC_BW_FF1 = 2 * INW + DFF, VEC_ONES = 2 * INW + 2 * DFF, VEC_ZEROS = VEC_ONES + DM, VEC_M0 = VEC_ZEROS + DM;
static_assert((size_t)(VEC_M0 + 16) * 4 <= MiB && (size_t)2 * 32 * NCOLP * 4 <= 4 * MiB && (size_t)NTOK * 8 <= MiB, "small buffers");

constexpr int RING_OFF = 0, RING_BYTES = 131072;
constexpr int LDSCTL_OFF = RING_BYTES, MISC_OFF = LDSCTL_OFF + 320;
constexpr int XCH_OFF = RING_BYTES + 1024;
constexpr int LDS_BYTES = 147456;
static_assert(MISC_OFF + 128 <= XCH_OFF && XCH_OFF + 8192 <= LDS_BYTES, "LDS map");

__host__ __device__ __forceinline__ int pinv_A(int c) { const int half = c >> 6, w = c & 63, hi = w >> 5, i = w & 31; return 8 * (half * 8 + (i >> 2)) + hi * 4 + (i & 3); }
__host__ __device__ __forceinline__ int pinv_B(int c) { const int hi = c >> 6, i = c & 63; return 8 * (i >> 2) + hi * 4 + (i & 3); }
__host__ __device__ __forceinline__ int proj_phys_col(int n) {
#if MK_FUSE_PREP
    if (n < COL_AV) return (n & ~127) + pinv_A(n & 127);
    if (n >= COL_BQ && n < COL_BV) return (n & ~127) + pinv_B(n & 127);
#endif
    return n;
}

struct Frame {
    LAS unsigned char* lds;
    volatile LAS unsigned* MISC;
    gu32* ctl;
    int wave;
    int vcu, G;
    int gw, NGW;
    const float *x_prompt, *x_sample, *w_in, *a_q_gain, *a_k_gain, *c_rel_bias, *mix_gain, *w_out, *ln1_g, *ln1_b, *w_ff1, *w_ff2, *ln2_g, *ln2_b;
    float* X;
    bf16 *Win_t, *Wout_t, *Wff1_t, *Wff2_t;
    bf16 *XB, *PROJ, *O, *H;
    float* LSE; float* ROPE_B; float* ROPE_A;
    pg8::f32x2* PART; pg8::f32x2* STAT; float* VEC; float* PSB;
};

__device__ __forceinline__ float wave_sum(float v) {
#pragma unroll
    for (int o = 1; o < 64; o <<= 1) v += __shfl_xor(v, o);
    return v;
}
__device__ __forceinline__ float wave_max(float v) {
#pragma unroll
    for (int o = 1; o < 64; o <<= 1) v = fmaxf(v, __shfl_xor(v, o));
    return v;
}
__device__ __forceinline__ float bf2f(unsigned short b) { return __builtin_bit_cast(float, (unsigned)b << 16); }
__device__ __forceinline__ float bflo(unsigned w) { return __builtin_bit_cast(float, w << 16); }
__device__ __forceinline__ float bfhi(unsigned w) { return __builtin_bit_cast(float, w & 0xffff0000u); }

struct ConvItem { const float* W; bf16* WT; const float* g; const float* bvec; float* ps; float* pb; int K, N, kb, n0, perm, pad_; };
struct ConvRegs { f32x4 wv[8]; float gk[8], bk[8]; };
__device__ __forceinline__ void conv_load(const ConvItem& it, ConvRegs& r, int lane) {
    const int k0 = 64 * it.kb, c = lane & 7;
#pragma unroll
    for (int i = 0; i < 8; ++i) r.wv[i] = *(const GAS f32x4*)(it.W + (size_t)(k0 + (lane >> 3) + 8 * i) * it.N + it.n0 + 4 * (lane & 7));
#pragma unroll
    for (int i = 0; i < 8; ++i) { r.gk[i] = it.g ? it.g[k0 + 8 * c + i] : 1.f; r.bk[i] = it.bvec ? it.bvec[k0 + 8 * c + i] : 0.f; }
}
__device__ __forceinline__ void conv_finish(const ConvItem& it, const ConvRegs& r, LAS float* scr, int lane) {
    const int k0 = 64 * it.kb, c = lane & 7;
#pragma unroll
    for (int i = 0; i < 8; ++i) { LAS float* d = scr + ((lane >> 3) + 8 * i) * 33 + 4 * (lane & 7); d[0] = r.wv[i].x; d[1] = r.wv[i].y; d[2] = r.wv[i].z; d[3] = r.wv[i].w; }
    LDS_WAIT(); asm volatile("" ::: "memory");
#pragma unroll
    for (int j = 0; j < 4; ++j) { const int n = (lane >> 3) + 8 * j; const LAS float* s = scr + (8 * c) * 33 + n;
        float w[8];
#pragma unroll
        for (int i = 0; i < 8; ++i) w[i] = s[i * 33];
        v4u o; o.x = pk2(w[0] * r.gk[0], w[1] * r.gk[1]); o.y = pk2(w[2] * r.gk[2], w[3] * r.gk[3]); o.z = pk2(w[4] * r.gk[4], w[5] * r.gk[5]); o.w = pk2(w[6] * r.gk[6], w[7] * r.gk[7]);
        const int nd = it.perm ? proj_phys_col(it.n0 + n) : it.n0 + n;
        *(GAS v4u*)(it.WT + (size_t)nd * it.K + k0 + 8 * c) = o;
        if (it.ps) { float sa = ((bflo(o.x) + bfhi(o.x)) + (bflo(o.y) + bfhi(o.y))) + ((bflo(o.z) + bfhi(o.z)) + (bflo(o.w) + bfhi(o.w)));
            float sb = 0.f;
#pragma unroll
            for (int i = 0; i < 8; ++i) sb += w[i] * r.bk[i];
            sa += __shfl_xor(sa, 1); sa += __shfl_xor(sa, 2); sa += __shfl_xor(sa, 4); sb += __shfl_xor(sb, 1); sb += __shfl_xor(sb, 2); sb += __shfl_xor(sb, 4);
            if (c == 0) { it.ps[(size_t)it.kb * NCOLP + nd] = sa; it.pb[(size_t)it.kb * NCOLP + nd] = sb; } } }
    LDS_WAIT(); asm volatile("" ::: "memory");
}
__device__ __forceinline__ void convert_weights(Frame& F, int l, int l_in, int which, int gw, int ngw) {
    const int lane = lane_id();
    LAS float* scr = (LAS float*)(F.lds + RING_OFF + F.wave * 16384);
    constexpr int I_IN = (DM / 64) * (INW / 32), I_OUT = (DM / 64) * (DM / 32), I_F1 = (DM / 64) * (DFF / 32), I_F2 = (DFF / 64) * (DM / 32);
    const int n_in = (which & 1) ? I_IN : 0, n_rest = (which & 2) ? (I_OUT + I_F1 + I_F2) : 0, n_all = n_in + n_rest;
    const float* w_in = F.w_in + (size_t)l_in * DM * INW; const float* w_out = F.w_out + (size_t)l * DM * DM;
    const float* w_ff1 = F.w_ff1 + (size_t)l * DM * DFF; const float* w_ff2 = F.w_ff2 + (size_t)l * DFF * DM;
    const float* gin = (l_in > 0) ? F.ln2_g + (size_t)(l_in - 1) * DM : nullptr; const float* bin = (l_in > 0) ? F.ln2_b + (size_t)(l_in - 1) * DM : nullptr;
    float* ps = F.PSB; float* pb = F.PSB + (size_t)32 * NCOLP;
#define CONV_MAKE(IT, idx) do { int r_ = (idx); \
        if (r_ < n_in) { const int nblk_ = INW / 32; IT.W = w_in; IT.WT = F.Win_t; IT.g = gin; IT.bvec = bin; IT.ps = ps; IT.pb = pb; IT.K = DM; IT.N = INW; IT.kb = r_ / nblk_; IT.n0 = 32 * (r_ % nblk_); IT.perm = 1; } \
        else { r_ -= n_in; \
          if (r_ < I_OUT) { const int nblk_ = DM / 32; IT.W = w_out; IT.WT = F.Wout_t; IT.g = nullptr; IT.bvec = nullptr; IT.ps = nullptr; IT.pb = nullptr; IT.K = DM; IT.N = DM; IT.kb = r_ / nblk_; IT.n0 = 32 * (r_ % nblk_); IT.perm = 0; } \
          else { r_ -= I_OUT; \
            if (r_ < I_F1) { const int nblk_ = DFF / 32; IT.W = w_ff1; IT.WT = F.Wff1_t; IT.g = F.ln1_g + (size_t)l * DM; IT.bvec = F.ln1_b + (size_t)l * DM; IT.ps = ps + INW; IT.pb = pb + INW; IT.K = DM; IT.N = DFF; IT.kb = r_ / nblk_; IT.n0 = 32 * (r_ % nblk_); IT.perm = 0; } \
            else { r_ -= I_F1; const int nblk_ = DM / 32; IT.W = w_ff2; IT.WT = F.Wff2_t; IT.g = nullptr; IT.bvec = nullptr; IT.ps = nullptr; IT.pb = nullptr; IT.K = DFF; IT.N = DM; IT.kb = r_ / nblk_; IT.n0 = 32 * (r_ % nblk_); IT.perm = 0; } } } } while (0)
    if (gw >= n_all) return;
    ConvItem cur; cur.pad_ = 0; ConvRegs rn; CONV_MAKE(cur, gw); conv_load(cur, rn, lane);
    for (int it = gw; it < n_all; it += ngw) {
        ConvRegs rc = rn; ConvItem nxt = cur; const bool has_next = it + ngw < n_all;
        if (has_next) { CONV_MAKE(nxt, it + ngw); conv_load(nxt, rn, lane); }
        asm volatile("" ::: "memory");
        conv_finish(cur, rc, scr, lane);
        cur = nxt;
    }
#undef CONV_MAKE
}
__device__ __forceinline__ void reduce_colsums(Frame& F, int which) {
    const int lane = lane_id();
    const float* ps = F.PSB; const float* pb = F.PSB + (size_t)32 * NCOLP;
    for (int n = F.gw * 64 + lane; n < NCOLP; n += F.NGW * 64) {
        const bool is_in = n < INW; if (is_in ? !(which & 1) : !(which & 2)) continue;
        float a = 0.f, c = 0.f;
#pragma unroll 8
        for (int kb = 0; kb < 32; ++kb) { a += ps[(size_t)kb * NCOLP + n]; c += pb[(size_t)kb * NCOLP + n]; }
        if (is_in) { F.VEC[VEC_CS_IN + n] = a; F.VEC[VEC_BW_IN + n] = c; } else { F.VEC[VEC_CS_FF1 + n - INW] = a; F.VEC[VEC_BW_FF1 + n - INW] = c; }
    }
}
__device__ __forceinline__ void phase_finalize_stats(Frame& F) {
    const int lane = lane_id();
    for (int m = F.gw * 64 + lane; m < NTOK; m += F.NGW * 64) {
        const f32x4* p = (const f32x4*)(F.PART + (size_t)m * 32); float s = 0.f, q = 0.f;
#pragma unroll
        for (int i = 0; i < 16; ++i) { const f32x4 v = p[i]; s += v.x + v.z; q += v.y + v.w; }
        const float mean = s * (1.f / DM); const float var = fmaxf(q * (1.f / DM) - mean * mean, 0.f);
        F.STAT[m] = (pg8::f32x2){mean, 1.f / sqrtf(var + EPS)};
    }
}
__device__ __forceinline__ void stats_panel(Frame& F, int pm) {
    const int tid = F.wave * 64 + lane_id(); const int row = pm * 256 + (tid >> 1), half = tid & 1;
    const f32x4* p = (const f32x4*)(F.PART + (size_t)row * 32 + half * 16); float s = 0.f, q = 0.f;
#pragma unroll
    for (int i = 0; i < 8; ++i) { const f32x4 v = p[i]; s += v.x + v.z; q += v.y + v.w; }
    s += __shfl_xor(s, 1); q += __shfl_xor(q, 1);
    const float mean = s * (1.f / DM); const float var = fmaxf(q * (1.f / DM) - mean * mean, 0.f);
    if (half == 0) F.STAT[row] = (pg8::f32x2){mean, 1.f / sqrtf(var + EPS)};
}
#define STATS_PREAMBLE(S) do { pg8::Unit u_; int last_ = -1; for (int i_ = 0; (S).next(i_, u_); ++i_) if (u_.pm != last_) { last_ = u_.pm; stats_panel(F, u_.pm); } \
        asm volatile("s_waitcnt vmcnt(0)" ::: "memory"); __syncthreads(); } while (0)

__device__ __forceinline__ void sincos_d(double a, float& c, float& s) {
    const double k = __builtin_rint(a * 0.6366197723675814);
    const double r = __builtin_fma(-k, 1.5707963267948966, a) - k * 6.123233995736766e-17;
    const double r2 = r * r;
    double sp = -1.0 / 1307674368000.0;
    sp = sp * r2 + 1.0 / 6227020800.0; sp = sp * r2 - 1.0 / 39916800.0; sp = sp * r2 + 1.0 / 362880.0; sp = sp * r2 - 1.0 / 5040.0; sp = sp * r2 + 1.0 / 120.0; sp = sp * r2 - 1.0 / 6.0; sp = sp * r2 + 1.0;
    sp *= r;
    double cp = 1.0 / 20922789888000.0;
    cp = cp * r2 - 1.0 / 87178291200.0; cp = cp * r2 + 1.0 / 479001600.0; cp = cp * r2 - 1.0 / 3628800.0; cp = cp * r2 + 1.0 / 40320.0; cp = cp * r2 - 1.0 / 720.0; cp = cp * r2 + 1.0 / 24.0; cp = cp * r2 - 0.5; cp = cp * r2 + 1.0;
    const int q = ((int)k) & 3;
    const double ss = (q == 0) ? sp : (q == 1) ? cp : (q == 2) ? -sp : -cp;
    const double cc = (q == 0) ? cp : (q == 1) ? -sp : (q == 2) ? -cp : sp;
    c = (float)cc; s = (float)ss;
}

__device__ __forceinline__ void phase_prologue(Frame& F) {
    const int lane = lane_id();
    const int gt = F.gw * 64 + lane, NGT = F.NGW * 64;
    for (int e = gt; e < SEQ * 64 + 64 * 32; e += NGT) {
        int t, i; double inv = 1.0; float* dst;
        if (e < SEQ * 64) { t = e >> 6; i = e & 63; dst = F.ROPE_B + 2 * (size_t)e; for (int j = 0; j < i; ++j) inv *= 0.8659643233600653; }
        else { const int e2 = e - SEQ * 64; t = e2 >> 5; i = e2 & 31; dst = F.ROPE_A + 2 * (size_t)e2; for (int j = 0; j < 2 * i; ++j) inv *= 0.8659643233600653; }
        float c, s; sincos_d((double)t * inv, c, s);
        dst[0] = c; dst[1] = s;
    }
    { f32x4 xn[8];
#define PRO_LOAD(m_) do { const float* src_ = ((m_) < NTOK_P) ? F.x_prompt + (size_t)(m_) * DM : F.x_sample + (size_t)((m_) - NTOK_P) * DM; \
        _Pragma("unroll") for (int j = 0; j < 8; ++j) xn[j] = __builtin_nontemporal_load((const f32x4*)src_ + lane + 64 * j); } while (0)
      if (F.gw < NTOK) PRO_LOAD(F.gw);
      for (int m = F.gw; m < NTOK; m += F.NGW) {
        f32x4 xc[8];
#pragma unroll
        for (int j = 0; j < 8; ++j) xc[j] = xn[j];
        if (m + F.NGW < NTOK) PRO_LOAD(m + F.NGW);
        asm volatile("" ::: "memory");
        GAS unsigned long long* o8 = (GAS unsigned long long*)(F.XB + (size_t)m * DM) + lane;
#pragma unroll
        for (int j = 0; j < 8; ++j) o8[64 * j] = (unsigned long long)pk2(xc[j].x, xc[j].y) | ((unsigned long long)pk2(xc[j].z, xc[j].w) << 32);
        if (lane == 0) F.STAT[m] = (pg8::f32x2){0.f, 1.f};
      }
#undef PRO_LOAD
    }
    for (int e = gt; e < DM; e += NGT) { F.VEC[VEC_ONES + e] = 1.f; F.VEC[VEC_ZEROS + e] = 0.f; }
    if (F.gw < NLAYER) {
        const float* gq = F.a_q_gain + F.gw * HD; const float* gk = F.a_k_gain + F.gw * HD;
        const float mq = wave_max(fmaxf(fabsf(gq[2 * lane]), fabsf(gq[2 * lane + 1]))), mk = wave_max(fmaxf(fabsf(gk[2 * lane]), fabsf(gk[2 * lane + 1])));
        if (lane == 0) F.VEC[VEC_M0 + F.gw] = 128.f * mq * mk * 1.05f; }
    for (int e = gt; e < 2 * INW; e += NGT) F.VEC[VEC_CS_IN + e] = 0.f;
    convert_weights(F, 0, 0, 1, F.gw, F.NGW);
}

__device__ __forceinline__ void phase_prep(Frame& F, int l) {
    const int lane = lane_id();
    const float* gq = F.a_q_gain + l * HD; const float* gk = F.a_k_gain + l * HD;
    const long NIT = (long)NTOK * 18 * 8;
    for (long ti = (long)F.gw * 64 + lane; ti < NIT; ti += (long)F.NGW * 64) {
        const int c = (int)(ti & 7); const int th = (int)(ti >> 3); const int m = th / 18, hs = th - m * 18; const int t = m & (SEQ - 1);
        int col, lo_off, hi_off; const float* tab; const float* gain = nullptr;
        if (hs < 6) {
            col = (hs < 4) ? COL_AQ + hs * HD : COL_AK + (hs - 4) * HD; gain = (hs < 4) ? gq : gk;
            const int cc = c & 3, half = c >> 2; lo_off = half * 64 + cc * 8; hi_off = lo_off + 32;
            const int pos = half ? (t & 63) : (t >> 6); tab = F.ROPE_A + 2 * (size_t)(pos * 32 + cc * 8);
        } else {
            col = (hs < 12) ? COL_BQ + (hs - 6) * HD : COL_BK + (hs - 12) * HD;
            lo_off = c * 8; hi_off = 64 + c * 8; tab = F.ROPE_B + 2 * (size_t)(t * 64 + c * 8);
        }
        bf16* p = F.PROJ + (size_t)m * INW + col;
        const v4u lo4 = *(const v4u*)(p + lo_off), hi4 = *(const v4u*)(p + hi_off);
        float lo[8], hv[8];
        lo[0] = bflo(lo4.x); lo[1] = bfhi(lo4.x); lo[2] = bflo(lo4.y); lo[3] = bfhi(lo4.y); lo[4] = bflo(lo4.z); lo[5] = bfhi(lo4.z); lo[6] = bflo(lo4.w); lo[7] = bfhi(lo4.w);
        hv[0] = bflo(hi4.x); hv[1] = bfhi(hi4.x); hv[2] = bflo(hi4.y); hv[3] = bfhi(hi4.y); hv[4] = bflo(hi4.z); hv[5] = bfhi(hi4.z); hv[6] = bflo(hi4.w); hv[7] = bfhi(hi4.w);
        float ss = 0.f;
#pragma unroll
        for (int j = 0; j < 8; ++j) ss += lo[j] * lo[j] + hv[j] * hv[j];
        ss += __shfl_xor(ss, 1); ss += __shfl_xor(ss, 2); ss += __shfl_xor(ss, 4);
        if (hs < 6) { const float rs = 1.0f / sqrtf(ss * (1.0f / HD) + EPS);
#pragma unroll
            for (int j = 0; j < 8; ++j) { lo[j] = lo[j] * rs * gain[lo_off + j]; hv[j] = hv[j] * rs * gain[hi_off + j]; } }
        float ol[8], oh[8];
#pragma unroll
        for (int j = 0; j < 8; ++j) { const float cs = tab[2 * j], sn = tab[2 * j + 1]; ol[j] = lo[j] * cs - hv[j] * sn; oh[j] = hv[j] * cs + lo[j] * sn; }
        v4u w; w.x = pk2(ol[0], ol[1]); w.y = pk2(ol[2], ol[3]); w.z = pk2(ol[4], ol[5]); w.w = pk2(ol[6], ol[7]); *(v4u*)(p + lo_off) = w;
        w.x = pk2(oh[0], oh[1]); w.y = pk2(oh[2], oh[3]); w.z = pk2(oh[4], oh[5]); w.w = pk2(oh[6], oh[7]); *(v4u*)(p + hi_off) = w;
    }
}

struct CfgA {
    static constexpr int NT = SEQ / 64; static constexpr bool HAS_LSE = false;
    float negm0C;
    const bf16* proj; bf16* obuf; unsigned qbase, kvbase, obase; int kcol, vcol;
    __device__ __forceinline__ unsigned q_off(int row) const { return qbase + (unsigned)row * INW; }
    __device__ __forceinline__ unsigned kv_off(int t, int row) const { return kvbase + (unsigned)(t * 64 + row) * INW; }
    __device__ __forceinline__ bool active(int, int) const { return true; }
    __device__ __forceinline__ void mask(att::f32x16&, att::f32x16&, int, int, int, int) const {}
    __device__ __forceinline__ unsigned o_off(int row) const { return obase + (unsigned)row * DM; }
    __device__ __forceinline__ void store_lse(int, float) const {}
};
__device__ __forceinline__ CfgA make_cfgA(Frame& F, int u, float negm0C) {
    const int x = F.vcu / (F.G / 8), j = F.vcu % (F.G / 8);
    int combo, hq2, qb;
    if (F.G == 256) { const int i = u / 256; combo = i * 8 + x; hq2 = j >> 4; qb = j & 15; } else { combo = u / 32; hq2 = (u >> 4) & 1; qb = u & 15; }
    const int s = combo >> 1, kvh = combo & 1, hq = kvh * 2 + hq2;
    const unsigned row0 = (unsigned)s * SEQ;
    CfgA cfg; cfg.negm0C = negm0C; cfg.proj = F.PROJ; cfg.obuf = F.O; cfg.qbase = (row0 + (unsigned)qb * 256) * INW + COL_AQ + hq * HD; cfg.kvbase = row0 * INW; cfg.kcol = COL_AK + kvh * HD; cfg.vcol = COL_AV + kvh * HD;
    cfg.obase = (row0 + (unsigned)qb * 256) * DM + OCOL_A + hq * HD;
    return cfg;
}
template <bool BOUNDED> __device__ __forceinline__ void phase_attn_A_(Frame& F, char* lds, float negm0C) {
    att::Pre pre; bool have = false;
    for (int u = F.vcu; u < NSEQ * 4 * 16; u += F.G) {
        const CfgA cfg = make_cfgA(F, u, negm0C); const bool hn = u + F.G < NSEQ * 4 * 16; const CfgA nx = make_cfgA(F, hn ? u + F.G : u, negm0C);
        att::attn_unit<CfgA, 2, BOUNDED>(cfg, lds, F.wave, pre, have, &nx); have = MK_PREFETCH_UNIT != 0;
    }
}
__device__ __forceinline__ void phase_attn_A(Frame& F, int l, char* lds) {
    const float m0 = F.VEC[VEC_M0 + l];
    if (MK_BOUNDED_A && m0 * ATT_SCALE <= 40.f) phase_attn_A_<true>(F, lds, -m0 * ATT_SCALE * 1.4426950408889634f); else phase_attn_A_<false>(F, lds, 0.f);
}

#ifndef MK_WAVE_BC
#define MK_WAVE_BC 0
#endif
#ifndef MK_C16
#define MK_C16 1
#endif
#if MK_C16
#define MK_CFG_C CfgC16
#define MK_UNIT_C att::attn_unit_h<CfgC16, 2>
#else
#define MK_CFG_C CfgC
#define MK_UNIT_C ATT_UNIT_BC(CfgC)
#endif
#ifndef MK_PIPE_BC
#define MK_PIPE_BC 1
#endif
#if MK_WAVE_BC
#define ATT_UNIT_BC(C) att::attn_unit_wave<C>
#elif MK_PIPE_BC
#define ATT_UNIT_BC(C) att::attn_unit<C, 1>
#else
#define ATT_UNIT_BC(C) att::attn_unit_simple<C>
#endif
struct CfgB {
    static constexpr int NT = 6; static constexpr bool HAS_LSE = true;
    static constexpr float negm0C = 0.f;
    const bf16* proj; bf16* obuf; float* lse; unsigned tok0; int sh, s0, L, hb; int kcol, vcol;
    __device__ __forceinline__ unsigned q_off(int row) const { return (tok0 + ((unsigned)(s0 + row) << sh)) * INW + COL_BQ + hb * HD; }
    __device__ __forceinline__ unsigned kv_off(int t, int row) const { int pos = s0 - 64 + 64 * t + row; pos = min(max(pos, 0), L - 1); return (tok0 + ((unsigned)pos << sh)) * INW; }
    __device__ __forceinline__ bool active(int t, int wid) const { return (t >= (wid >> 1)) && (t <= (wid >> 1) + 2) && (t >= t_begin()) && (t < t_end()); }
    __device__ __forceinline__ int t_begin() const { return s0 == 0 ? 1 : 0; }
    __device__ __forceinline__ int t_end() const { return s0 + 256 == L ? 5 : 6; }
    __device__ __forceinline__ void mask(att::f32x16& p0, att::f32x16& p1, int t, int wid, int r32, int hi) const {
        if (t == (wid >> 1) + 1) return;
        const int d0 = 64 * t - 64 - 32 * wid - r32 + 4 * hi;
#pragma unroll
        for (int r = 0; r < 16; ++r) { const int d = d0 + (r & 3) + 8 * (r >> 2);
            if (d < -64 || d > 64) p0[r] = -__builtin_inff();
            if (d + 32 < -64 || d + 32 > 64) p1[r] = -__builtin_inff(); }
    }
    __device__ __forceinline__ unsigned o_off(int row) const { return (tok0 + ((unsigned)(s0 + row) << sh)) * DM + OCOL_B + hb * HD; }
    __device__ __forceinline__ void store_lse(int row, float v) const { lse[(size_t)(tok0 + ((unsigned)(s0 + row) << sh)) * 8 + hb] = v; }
};
struct CfgC {
    static constexpr int NT = 12; static constexpr bool HAS_LSE = false;
    static constexpr float negm0C = 0.f;
    const bf16* proj; bf16* obuf; const float* bias;
    unsigned tokq; unsigned tokk; int R0, kr0, hc; int kcol, vcol;
    __device__ __forceinline__ unsigned q_off(int row) const { return (tokq + (unsigned)row) * INW + COL_CQ + hc * HD; }
    __device__ __forceinline__ unsigned kv_off(int t, int row) const { return (tokk + (unsigned)(t * 64 + row)) * INW; }
    __device__ __forceinline__ bool active(int t, int wid) const { const int r = R0 + (wid >> 1), r0 = min(max(r - 4, 0), 56), kr = kr0 + t; return kr >= r0 && kr < r0 + 8; }
    __device__ __forceinline__ int t_begin() const { return min(max(R0 - 4, 0), 56) - kr0; }
    __device__ __forceinline__ int t_end() const { return min(max(R0 - 1, 0), 56) + 8 - kr0; }
    __device__ __forceinline__ void mask(att::f32x16& p0, att::f32x16& p1, int t, int wid, int r32, int hi) const {
        const int r = R0 + (wid >> 1), kr = kr0 + t, qc = (wid & 1) * 32 + r32, sc = min(max(qc - 8, 0), 48);
        const int w0 = 4 * hi - sc;
        const float* bp = bias + (kr - r + 7) * 31 + (sc - qc + 15) + w0;
#pragma unroll
        for (int rr = 0; rr < 16; ++rr) { const int c = (rr & 3) + 8 * (rr >> 2);
            p0[rr] = ((unsigned)(w0 + c) < 16u) ? p0[rr] + bp[c] : -__builtin_inff();
            p1[rr] = ((unsigned)(w0 + c + 32) < 16u) ? p1[rr] + bp[c + 32] : -__builtin_inff(); }
    }
    __device__ __forceinline__ unsigned o_off(int row) const { return (tokq + (unsigned)row) * DM + OCOL_C + hc * HD; }
    __device__ __forceinline__ void store_lse(int, float) const {}
};
struct CfgC16 {
    static constexpr int NT = 12; static constexpr bool HAS_LSE = false; static constexpr float negm0C = 0.f;
    const bf16* proj; bf16* obuf; const float* bias;
    unsigned tokq; unsigned tokk; int R0, kr0, hc; int kcol, vcol;
    __device__ __forceinline__ int qtok(int idx) const { const int w = idx >> 5, rl = idx & 31; return (2 * (w >> 2) + (rl >> 4)) * 64 + 16 * (w & 3) + (rl & 15); }
    __device__ __forceinline__ unsigned q_off(int idx) const { return (tokq + (unsigned)qtok(idx)) * INW + COL_CQ + hc * HD; }
    __device__ __forceinline__ unsigned kv_off(int t, int row) const { return (tokk + (unsigned)(t * 64 + row)) * INW; }
    __device__ __forceinline__ int kwin(int wid) const { return min(max(16 * (wid & 3) - 8, 0), 32); }
    __device__ __forceinline__ bool active(int t, int wid) const { const int r = R0 + 2 * (wid >> 2), lo = min(max(r - 4, 0), 56), hi_ = min(max(r - 3, 0), 56) + 8, kr = kr0 + t; return kr >= lo && kr < hi_; }
    __device__ __forceinline__ void mask16(att::f32x16& p0, int t, int wid, int r32, int hi) const {
        const int r = R0 + 2 * (wid >> 2) + (r32 >> 4), kr = kr0 + t, qc = 16 * (wid & 3) + (r32 & 15), sc = min(max(qc - 8, 0), 48), r0 = min(max(r - 4, 0), 56);
        const bool rowok = (unsigned)(kr - r0) < 8u;
        const int w0 = kwin(wid) + 4 * hi - sc;
        const float* bp = bias + (kr - r + 7) * 31 + (sc - qc + 15) + w0;
#pragma unroll
        for (int rr = 0; rr < 16; ++rr) { const int cofs = (rr & 3) + 8 * (rr >> 2);
            p0[rr] = (rowok && (unsigned)(w0 + cofs) < 16u) ? p0[rr] + bp[cofs] : -__builtin_inff(); }
    }
    __device__ __forceinline__ unsigned o_off(int idx) const { return (tokq + (unsigned)qtok(idx)) * DM + OCOL_C + hc * HD; }
    __device__ __forceinline__ void store_lse(int, float) const {}
};
constexpr int ATT_BIAS_OFF = 106496;
constexpr int ATT_BIAS_OFF_OLD = 69632;
static_assert(att::OSTAGE_OFF >= (int)att::SHM_ATTN && att::OSTAGE_OFF + 8 * 4096 <= ATT_BIAS_OFF && ATT_BIAS_OFF + 6 * 15 * 31 * 4 + 512 <= RING_BYTES, "O stage / bias table placement");
__device__ __forceinline__ CfgB make_cfgB(Frame& F, int u) {
    const int s = u / 96, rem = u - s * 96, hb = rem >> 4, k = rem & 15;
    const int g = hb >> 1, sh = 2 * g, L = SEQ >> sh, nblk = L >> 8;
    const int r = k / nblk, blk = k - r * nblk;
    CfgB cfg; cfg.proj = F.PROJ; cfg.obuf = F.O; cfg.lse = F.LSE; cfg.tok0 = (unsigned)s * SEQ + r; cfg.sh = sh; cfg.s0 = blk * 256; cfg.L = L; cfg.hb = hb;
    cfg.kcol = COL_BK + hb * HD; cfg.vcol = COL_BV + hb * HD;
    return cfg;
}
__device__ __forceinline__ void phase_attn_B(Frame& F, char* lds) {
    att::Pre pre; bool have = false;
    for (int u = F.vcu; u < 1152; u += F.G) {
        const CfgB cfg = make_cfgB(F, u); const bool hn = u + F.G < 1152; const CfgB nx = make_cfgB(F, hn ? u + F.G : u);
        att::attn_unit<CfgB, 1>(cfg, lds, F.wave, pre, have, &nx); have = MK_PREFETCH_UNIT != 0;
    }
}
__device__ __forceinline__ CfgC16 make_cfgC(Frame& F, int v, const float* bl) {
    const int s = v / 96, rem = v - s * 96, hc = rem >> 4, blk = rem & 15;
    const int R0 = blk * 4, kr0 = min(max(R0 - 4, 0), 52);
    CfgC16 cfg; cfg.proj = F.PROJ; cfg.obuf = F.O; cfg.bias = bl; cfg.tokq = (unsigned)s * SEQ + R0 * 64; cfg.tokk = (unsigned)s * SEQ + kr0 * 64; cfg.R0 = R0; cfg.kr0 = kr0; cfg.hc = hc;
    cfg.kcol = COL_CK + hc * HD; cfg.vcol = COL_CV + hc * HD;
    return cfg;
}
__device__ __forceinline__ void phase_attn_C(Frame& F, int l, char* lds) {
    att::Pre pre; bool have = false; float* bl = (float*)(lds + ATT_BIAS_OFF);
    { const float* rel = F.c_rel_bias + (size_t)l * 6 * (15 * 31);
      for (int e = F.wave * 64 + lane_id(); e < 6 * 15 * 31; e += NWAVES * 64) bl[e] = rel[e] * (1.0f / ATT_SCALE);
      __syncthreads(); }
    for (int v = F.G - 1 - F.vcu; v < 1152; v += F.G) {
        CfgC16 cfg = make_cfgC(F, v, bl); cfg.bias = bl + cfg.hc * (15 * 31); const bool hn = v + F.G < 1152; const CfgC16 nx = make_cfgC(F, hn ? v + F.G : v, bl);
        att::attn_unit_h<CfgC16, 2>(cfg, lds, F.wave, pre, have, &nx); have = MK_PREFETCH_UNIT != 0;
    }
}

__device__ __forceinline__ float dot8(v4u a, v4u b) {
    return bflo(a.x) * bflo(b.x) + bfhi(a.x) * bfhi(b.x) + bflo(a.y) * bflo(b.y) + bfhi(a.y) * bfhi(b.y) + bflo(a.z) * bflo(b.z) + bfhi(a.z) * bfhi(b.z) + bflo(a.w) * bflo(b.w) + bfhi(a.w) * bfhi(b.w);
}
__device__ __forceinline__ void naive_B(Frame& F, int m, int hb) {
    const int lane = lane_id(); const int t = m & (SEQ - 1); const size_t sbase = (size_t)(m - t);
    const int g = hb >> 1, sh = 2 * g, dil = 1 << sh, i = t >> sh, r = t & (dil - 1), L = SEQ >> sh;
    const bf16* qp = F.PROJ + (size_t)m * INW + COL_BQ + hb * HD;
    const bf16* kb = F.PROJ + sbase * INW + COL_BK + hb * HD; const bf16* vb = F.PROJ + sbase * INW + COL_BV + hb * HD;
    float dot[3] = {0.f, 0.f, 0.f}; bool valid[3]; const bf16* kp[3];
#pragma unroll
    for (int j3 = 0; j3 < 3; ++j3) { const int jj = lane + 64 * j3, ik = i - 64 + jj; valid[j3] = (jj <= 128) && (ik >= 0) && (ik < L);
        const int ikc = valid[j3] ? ik : i; kp[j3] = kb + (size_t)(ikc * dil + r) * INW; }
#pragma unroll
    for (int ch = 0; ch < 16; ++ch) { const v4u qv = *(const v4u*)(qp + ch * 8);
#pragma unroll
        for (int j3 = 0; j3 < 3; ++j3) { const v4u kv = *(const v4u*)(kp[j3] + ch * 8); dot[j3] += dot8(qv, kv); } }
    float s[3];
#pragma unroll
    for (int j3 = 0; j3 < 3; ++j3) s[j3] = valid[j3] ? dot[j3] * ATT_SCALE : -__builtin_inff();
    const float mx = wave_max(fmaxf(s[0], fmaxf(s[1], s[2])));
    float p[3];
#pragma unroll
    for (int j3 = 0; j3 < 3; ++j3) p[j3] = valid[j3] ? __expf(s[j3] - mx) : 0.f;
    const float lsum = wave_sum(p[0] + p[1] + p[2]);
    float a0 = 0.f, a1 = 0.f;
#pragma unroll
    for (int j3 = 0; j3 < 3; ++j3) {
        const int nj = (j3 == 2) ? 1 : 64;
        for (int jl = 0; jl < nj; ++jl) { const float pj = __shfl(p[j3], jl); const int ik = i - 64 + jl + 64 * j3;
            if (ik >= 0 && ik < L) { const unsigned w = *(const unsigned*)(vb + (size_t)(ik * dil + r) * INW + 2 * lane); a0 += pj * bflo(w); a1 += pj * bfhi(w); } } }
    const float rl = 1.0f / lsum;
    *(unsigned*)(F.O + (size_t)m * DM + OCOL_B + hb * HD + 2 * lane) = pk2(a0 * rl, a1 * rl);
    if (lane == 0) F.LSE[(size_t)m * 8 + hb] = mx + __logf(lsum);
}
__device__ __forceinline__ void naive_C(Frame& F, int l, int m, int hc) {
    const int lane = lane_id(); const int t = m & (SEQ - 1); const size_t sbase = (size_t)(m - t);
    const int r = t >> 6, c = t & 63; const int r0 = min(max(r - 4, 0), 56), sc = min(max(c - 8, 0), 48);
    const bf16* qp = F.PROJ + (size_t)m * INW + COL_CQ + hc * HD;
    const bf16* kb = F.PROJ + sbase * INW + COL_CK + hc * HD; const bf16* vb = F.PROJ + sbase * INW + COL_CV + hc * HD;
    const float* rel = F.c_rel_bias + ((size_t)l * 6 + hc) * (15 * 31);
    float dot[2] = {0.f, 0.f}; const bf16* kp[2]; float bias[2];
#pragma unroll
    for (int j2 = 0; j2 < 2; ++j2) { const int kk = lane + 64 * j2, jr = kk >> 4, jc = kk & 15; kp[j2] = kb + (size_t)((r0 + jr) * 64 + sc + jc) * INW;
        bias[j2] = rel[(r0 + jr - r + 7) * 31 + (sc + jc - c + 15)]; }
#pragma unroll
    for (int ch = 0; ch < 16; ++ch) { const v4u qv = *(const v4u*)(qp + ch * 8);
#pragma unroll
        for (int j2 = 0; j2 < 2; ++j2) { const v4u kv = *(const v4u*)(kp[j2] + ch * 8); dot[j2] += dot8(qv, kv); } }
    const float s0 = dot[0] * ATT_SCALE + bias[0], s1 = dot[1] * ATT_SCALE + bias[1];
    const float mx = wave_max(fmaxf(s0, s1));
    const float p0 = __expf(s0 - mx), p1 = __expf(s1 - mx);
    const float lsum = wave_sum(p0 + p1);
    float a0 = 0.f, a1 = 0.f;
    for (int kk = 0; kk < 128; ++kk) { const float pj = (kk < 64) ? __shfl(p0, kk) : __shfl(p1, kk - 64); const int jr = kk >> 4, jc = kk & 15;
        const unsigned w = *(const unsigned*)(vb + (size_t)((r0 + jr) * 64 + sc + jc) * INW + 2 * lane); a0 += pj * bflo(w); a1 += pj * bfhi(w); }
    const float rl = 1.0f / lsum;
    *(unsigned*)(F.O + (size_t)m * DM + OCOL_C + hc * HD + 2 * lane) = pk2(a0 * rl, a1 * rl);
}
__device__ __forceinline__ void phase_attn_BC_naive(Frame& F, int l) {
    for (int it = F.gw; it < NTOK * 12; it += F.NGW) { const int m = it / 12, h = it - m * 12;
        if (h < 6) naive_B(F, m, h); else naive_C(F, l, m, h - 6); }
}

__device__ __forceinline__ void phase_mix(Frame& F, int l) {
    const int lane = lane_id();
    const float* gain = F.mix_gain + (size_t)l * DM;
    f32x4 gv[4][2];
#pragma unroll
    for (int j = 0; j < 4; ++j) { gv[j][0] = *(const f32x4*)(gain + 8 * lane + 512 * j); gv[j][1] = *(const f32x4*)(gain + 8 * lane + 512 * j + 4); }
    v4u wn[4]; float ln[6];
#define MIX_LOAD(m_) do { const bf16* row_ = F.O + (size_t)(m_) * DM; const float* lse_ = F.LSE + (size_t)(m_) * 8; \
        _Pragma("unroll") for (int j = 0; j < 4; ++j) wn[j] = *(const v4u*)(row_ + 8 * lane + 512 * j); \
        _Pragma("unroll") for (int h = 0; h < 6; ++h) ln[h] = lse_[h]; } while (0)
    if (F.gw < NTOK) MIX_LOAD(F.gw);
    for (int m = F.gw; m < NTOK; m += F.NGW) {
        bf16* row = F.O + (size_t)m * DM;
        v4u wc[4]; float lc[6];
#pragma unroll
        for (int j = 0; j < 4; ++j) wc[j] = wn[j];
#pragma unroll
        for (int h = 0; h < 6; ++h) lc[h] = ln[h];
        if (m + F.NGW < NTOK) MIX_LOAD(m + F.NGW);
        asm volatile("" ::: "memory");
        float al[6];
#pragma unroll
        for (int h = 0; h < 2; ++h) { const float l0 = lc[h], l1 = lc[2 + h], l2 = lc[4 + h]; const float mx = fmaxf(l0, fmaxf(l1, l2));
            const float e0 = __expf(l0 - mx), e1 = __expf(l1 - mx), e2 = __expf(l2 - mx); const float inv = 1.0f / (e0 + e1 + e2); al[h] = e0 * inv; al[2 + h] = e1 * inv; al[4 + h] = e2 * inv; }
        float v[4][8]; float ssA = 0.f, ssB = 0.f, ssC = 0.f;
#pragma unroll
        for (int j = 0; j < 4; ++j) { const int col = 8 * lane + 512 * j; const v4u w = wc[j];
            v[j][0] = bflo(w.x); v[j][1] = bfhi(w.x); v[j][2] = bflo(w.y); v[j][3] = bfhi(w.y); v[j][4] = bflo(w.z); v[j][5] = bfhi(w.z); v[j][6] = bflo(w.w); v[j][7] = bfhi(w.w);
            float a = 1.f;
            if (col >= OCOL_B && col < OCOL_C) { const int hb = (col - OCOL_B) >> 7; a = (hb == 0) ? al[0] : (hb == 1) ? al[1] : (hb == 2) ? al[2] : (hb == 3) ? al[3] : (hb == 4) ? al[4] : al[5]; }
            float ss = 0.f;
#pragma unroll
            for (int e = 0; e < 8; ++e) { v[j][e] *= a; ss += v[j][e] * v[j][e]; }
            if (col < OCOL_B) ssA += ss; else if (col < OCOL_C) ssB += ss; else ssC += ss; }
        ssA = wave_sum(ssA); ssB = wave_sum(ssB); ssC = wave_sum(ssC);
        const float rA = 1.0f / sqrtf(ssA * (1.0f / 512.f) + EPS), rB = 1.0f / sqrtf(ssB * (1.0f / 768.f) + EPS), rC = 1.0f / sqrtf(ssC * (1.0f / 768.f) + EPS);
#pragma unroll
        for (int j = 0; j < 4; ++j) { const int col = 8 * lane + 512 * j; const float rr = (col < OCOL_B) ? rA : (col < OCOL_C) ? rB : rC;
            const f32x4 g0 = gv[j][0], g1 = gv[j][1];
            v4u w; w.x = pk2(v[j][0] * rr * g0.x, v[j][1] * rr * g0.y); w.y = pk2(v[j][2] * rr * g0.z, v[j][3] * rr * g0.w);
            w.z = pk2(v[j][4] * rr * g1.x, v[j][5] * rr * g1.y); w.w = pk2(v[j][6] * rr * g1.z, v[j][7] * rr * g1.w);
            *(v4u*)(row + col) = w; }
    }
#undef MIX_LOAD
}

__device__ __forceinline__ void phase_final_ln(Frame& F, const float* g, const float* b) {
    static_assert(MK_BF16_RES && !MK_FIN_PHASES, "the final LayerNorm reads the bf16 residual stream and the raw row partials");
    const int lane = lane_id();
    f32x4 gg[8], bb[8];
#pragma unroll
    for (int j = 0; j < 8; ++j) { gg[j] = *((const f32x4*)g + lane + 64 * j); bb[j] = *((const f32x4*)b + lane + 64 * j); }
    unsigned long long zn[8]; pg8::f32x2 pn;
#define FLN_LOAD(m_) do { const GAS unsigned long long* zb_ = (const GAS unsigned long long*)(F.XB + (size_t)(m_) * DM) + lane; \
        _Pragma("unroll") for (int j = 0; j < 8; ++j) zn[j] = zb_[64 * j]; pn = (lane < 32) ? F.PART[(size_t)(m_) * 32 + lane] : (pg8::f32x2){0.f, 0.f}; } while (0)
    if (F.gw < NTOK) FLN_LOAD(F.gw);
    for (int m = F.gw; m < NTOK; m += F.NGW) {
        GAS f32x4* xr = (GAS f32x4*)(F.X + (size_t)m * DM) + lane;
        unsigned long long zc[8]; const pg8::f32x2 pc = pn;
#pragma unroll
        for (int j = 0; j < 8; ++j) zc[j] = zn[j];
        if (m + F.NGW < NTOK) FLN_LOAD(m + F.NGW);
        asm volatile("" ::: "memory");
        const float s = wave_sum(pc.x), q = wave_sum(pc.y);
        const float mean = s * (1.f / DM); const float var = fmaxf(q * (1.f / DM) - mean * mean, 0.f); const float rstd = 1.f / sqrtf(var + EPS);
#pragma unroll
        for (int j = 0; j < 8; ++j) { const unsigned lo = (unsigned)zc[j], hi = (unsigned)(zc[j] >> 32);
            const f32x4 z = {bflo(lo), bfhi(lo), bflo(hi), bfhi(hi)};
            __builtin_nontemporal_store((z - mean) * rstd * gg[j] + bb[j], (f32x4*)(xr + 64 * j)); }
    }
#undef FLN_LOAD
}

__device__ __forceinline__ void phase_prep_copy(Frame& F) {
    const int lane = lane_id();
    const long NIT = (long)NTOK * 18 * 8;
    for (long ti = (long)F.gw * 64 + lane; ti < NIT; ti += (long)F.NGW * 64) {
        const int c = (int)(ti & 7); const int th = (int)(ti >> 3); const int m = th / 18, hs = th - m * 18; const int t = m & (SEQ - 1);
        int col, lo_off, hi_off; const float* tab;
        if (hs < 6) { col = (hs < 4) ? COL_AQ + hs * HD : COL_AK + (hs - 4) * HD; const int cc = c & 3, half = c >> 2; lo_off = half * 64 + cc * 8; hi_off = lo_off + 32; const int pos = half ? (t & 63) : (t >> 6); tab = F.ROPE_A + 2 * (size_t)(pos * 32 + cc * 8); }
        else { col = (hs < 12) ? COL_BQ + (hs - 6) * HD : COL_BK + (hs - 12) * HD; lo_off = c * 8; hi_off = 64 + c * 8; tab = F.ROPE_B + 2 * (size_t)(t * 64 + c * 8); }
        bf16* p = F.PROJ + (size_t)m * INW + col;
        v4u lo4 = *(const v4u*)(p + lo_off), hi4 = *(const v4u*)(p + hi_off);
        const f32x4 t0 = *(const f32x4*)tab, t1 = *(const f32x4*)(tab + 4), t2 = *(const f32x4*)(tab + 8), t3 = *(const f32x4*)(tab + 12);
        if (t0.x + t1.x + t2.x + t3.x > 1e30f) lo4.x ^= 1u;
        *(v4u*)(p + lo_off) = lo4; *(v4u*)(p + hi_off) = hi4;
    }
}
__device__ __forceinline__ void phase_mix_copy(Frame& F) {
    const int lane = lane_id();
    for (int m = F.gw; m < NTOK; m += F.NGW) {
        bf16* row = F.O + (size_t)m * DM; const float* lse = F.LSE + (size_t)m * 8; const float l0 = lse[0] + lse[5];
        v4u w[4];
#pragma unroll
        for (int j = 0; j < 4; ++j) w[j] = *(const v4u*)(row + 8 * lane + 512 * j);
        if (l0 > 1e30f) w[0].x ^= 1u;
#pragma unroll
        for (int j = 0; j < 4; ++j) *(v4u*)(row + 8 * lane + 512 * j) = w[j];
    }
}

#ifndef MK_NAIVE_BC
#define MK_NAIVE_BC 0
#endif
#if MK_NAIVE_BC
#define ATTN_BC(F, l, lds) phase_attn_BC_naive(F, l)
#else
#define ATTN_BC(F, l, lds) do { phase_attn_B(F, lds); phase_attn_C(F, l, lds); } while (0)
#endif
#ifndef MK_DUP_ALL
#define MK_DUP_ALL 0
#endif
#ifndef MK_DUP_GEMM
#define MK_DUP_GEMM 0
#endif
#ifndef MK_STAGGER_OUT
#define MK_STAGGER_OUT 0
#endif
#ifndef MK_STAGGER_IN
#define MK_STAGGER_IN 0
#endif
#ifndef MK_DUP_RES
#define MK_DUP_RES 0
#endif
#ifndef MK_DUP_BAR
#define MK_DUP_BAR 0
#endif
#ifndef MK_XCD_EXTRA
#define MK_XCD_EXTRA -1
#endif
#ifndef MK_DUP_KLOOP
#define MK_DUP_KLOOP 0
#endif
#ifndef MK_DUP_THIN
#define MK_DUP_THIN 0
#endif
#ifndef MK_DUP_ATTN
#define MK_DUP_ATTN 0
#endif
#ifndef MK_PER_PHASE
#define MK_PER_PHASE 0
#endif
constexpr int PH_PER_LAYER = 9, N_PHASES = 2 + PH_PER_LAYER * NLAYER;
struct Args { const float* in[14]; float* out; unsigned char* ws; int ph_lo, ph_hi; };
static_assert(sizeof(Args) == 14 * 8 + 8 + 8 + 8, "Args has no padding");

__global__ void __launch_bounds__(NWAVES * 64, 2) trunk_fwd(Args args) {
    extern __shared__ __attribute__((aligned(16))) unsigned char lds[];
    Frame F;
    F.lds = (LAS unsigned char*)lds;
    F.MISC = (volatile LAS unsigned*)(F.lds + MISC_OFF);
    F.wave = __builtin_amdgcn_readfirstlane((int)threadIdx.x >> 6);
    F.G = gridDim.x; { const int bx = blockIdx.x; F.vcu = (F.G % 8 == 0) ? (bx % 8) * (F.G / 8) + bx / 8 : bx; }
    F.gw = F.vcu * NWAVES + F.wave; F.NGW = F.G * NWAVES;
    unsigned char* ws = args.ws;
    F.ctl = (gu32*)(ws + WS_CTL);
    F.x_prompt = args.in[0]; F.x_sample = args.in[1]; F.w_in = args.in[2]; F.a_q_gain = args.in[3]; F.a_k_gain = args.in[4]; F.c_rel_bias = args.in[5]; F.mix_gain = args.in[6];
    F.w_out = args.in[7]; F.ln1_g = args.in[8]; F.ln1_b = args.in[9]; F.w_ff1 = args.in[10]; F.w_ff2 = args.in[11]; F.ln2_g = args.in[12]; F.ln2_b = args.in[13];
    F.X = args.out;
    F.Win_t = (bf16*)(ws + WS_WIN); F.Wout_t = (bf16*)(ws + WS_WOUT); F.Wff1_t = (bf16*)(ws + WS_WFF1); F.Wff2_t = (bf16*)(ws + WS_WFF2);
    F.XB = (bf16*)(ws + WS_XB); F.PROJ = (bf16*)(ws + WS_PROJ); F.O = (bf16*)(ws + WS_O); F.H = (bf16*)(ws + WS_H);
    F.LSE = (float*)(ws + WS_LSE); F.ROPE_B = (float*)(ws + WS_ROPE_B); F.ROPE_A = (float*)(ws + WS_ROPE_A);
    F.PART = (pg8::f32x2*)(ws + WS_PART); F.STAT = (pg8::f32x2*)(ws + WS_STAT); F.VEC = (float*)(ws + WS_VEC); F.PSB = (float*)(ws + WS_PSB);
    for (int u = F.wave * 64 + lane_id(); u < (LDS_BYTES - LDSCTL_OFF) / 4; u += NWAVES * 64) ((LAS unsigned*)(F.lds + LDSCTL_OFF))[u] = 0u;
    __syncthreads();
    XcdBarrier bar; bar.bar = (unsigned*)(F.ctl + CW_BAR); bar.x = 0; bar.st = nullptr;
    if (!MK_PER_PHASE) bar = xcd_barrier_post((unsigned*)(F.ctl + CW_BAR), F.MISC + 8, F.wave == 0 && lane_id() == 0);
    const int lo = args.ph_lo, hi = args.ph_hi;
#define IN(k) (lo <= (k) && (k) < hi)
#define STAGGER(ticks) do { if ((ticks) > 0) { const unsigned long long t0_ = __builtin_amdgcn_s_memrealtime(); const unsigned long long dl_ = (unsigned long long)((F.vcu & 7) >> 1) * (unsigned long long)(ticks); while (__builtin_amdgcn_s_memrealtime() - t0_ < dl_) __builtin_amdgcn_s_sleep(8); } } while (0)
#define SEAM(k) do { if (IN(k) && IN((k) + 1)) { if (MK_PER_PHASE) { if (F.wave == 0 && lane_id() == 0) __hip_atomic_store(F.ctl + CW_TMO, 0xBADBA0u, RLX_AGENT); } else { xcd_barrier(bar, F.wave == 0 && lane_id() == 0); if (MK_DUP_BAR) xcd_barrier(bar, F.wave == 0 && lane_id() == 0); } } } while (0)

    if (IN(0)) { phase_prologue(F); } SEAM(0);
#if MK_FUSE_PREP
#define INPROJ_EPI(l) pg8::EpiInProj E{F.PROJ, INW, F.STAT, F.VEC + VEC_CS_IN, F.VEC + VEC_BW_IN, F.a_q_gain + l * HD, F.a_k_gain + l * HD, F.ROPE_A, F.ROPE_B, (LAS float*)(F.lds + XCH_OFF), \
                (MK_BOUNDED_A && F.VEC[VEC_M0 + l] * ATT_SCALE <= 40.f) ? ATT_SCALE * 1.4426950408889634f : 1.f}; \
            pg8::gemm_phase<pg8::EpiInProj, pg8::StaticOrder, true, true>(F.lds + RING_OFF, g, S, E, F.wave)
#define PREP_PHASE(l) do {} while (0)
#else
#define INPROJ_EPI(l) pg8::EpiBf16Fold<0> E{F.PROJ, INW, F.STAT, F.VEC + VEC_CS_IN, F.VEC + VEC_BW_IN}; \
            pg8::gemm_phase<pg8::EpiBf16Fold<0>, pg8::StaticOrder, true, true>(F.lds + RING_OFF, g, S, E, F.wave)
#define PREP_PHASE(l) phase_prep(F, l)
#endif
#if MK_BF16_RES
#define RES_EPI_OUT(l) pg8::EpiResLnFoldB E{F.XB, DM, F.STAT, (l == 0) ? F.VEC + VEC_ONES : F.ln2_g + (size_t)(l - 1) * DM, (l == 0) ? F.VEC + VEC_ZEROS : F.ln2_b + (size_t)(l - 1) * DM, F.PART, DN_ALPHA}; \
            pg8::gemm_phase<pg8::EpiResLnFoldB, pg8::StaticOrder, true, true>(F.lds + RING_OFF, g, S, E, F.wave)
#define RES_EPI_FF2(l) pg8::EpiResLnFoldB E{F.XB, DM, F.STAT, F.ln1_g + (size_t)l * DM, F.ln1_b + (size_t)l * DM, F.PART, DN_ALPHA}; \
            pg8::gemm_phase<pg8::EpiResLnFoldB, pg8::StaticOrder, true, true, MK_TILED_H != 0>(F.lds + RING_OFF, g, S, E, F.wave)
#else
#define RES_EPI_OUT(l) pg8::EpiResLnFold E{(l == 0) ? F.x_prompt : F.X, (l == 0) ? F.x_sample : F.X + (size_t)NTOK_P * DM, NTOK_P / 256, F.X, F.XB, DM, F.STAT, \
                                (l == 0) ? F.VEC + VEC_ONES : F.ln2_g + (size_t)(l - 1) * DM, (l == 0) ? F.VEC + VEC_ZEROS : F.ln2_b + (size_t)(l - 1) * DM, F.PART, DN_ALPHA}; \
            pg8::gemm_phase<pg8::EpiResLnFold, pg8::StaticOrder, true, true>(F.lds + RING_OFF, g, S, E, F.wave)
#define RES_EPI_FF2(l) pg8::EpiResLnFold E{F.X, F.X + (size_t)NTOK_P * DM, NTOK_P / 256, F.X, F.XB, DM, F.STAT, F.ln1_g + (size_t)l * DM, F.ln1_b + (size_t)l * DM, F.PART, DN_ALPHA}; \
            pg8::gemm_phase<pg8::EpiResLnFold, pg8::StaticOrder, true, true, MK_TILED_H != 0>(F.lds + RING_OFF, g, S, E, F.wave)
#endif
#define LAYER_BODY(l) do { \
        const int pb = 1 + PH_PER_LAYER * l; \
        if (IN(pb + 0)) { \
            STAGGER(MK_STAGGER_IN); pg8::Gemm g{F.XB, F.Win_t, NTOK, INW, DM}; pg8::StaticOrder S; S.init(NTOK, INW, F.G, (int)blockIdx.x); \
            if (!MK_FIN_PHASES && l > 0) STATS_PREAMBLE(S); \
            { INPROJ_EPI(l); } if (MK_DUP_ALL) { INPROJ_EPI(l); } \
            if (MK_DUP_KLOOP & 1) { pg8::EpiNull EN{F.LSE}; pg8::gemm_phase<pg8::EpiNull, pg8::StaticOrder, true, true>(F.lds + RING_OFF, g, S, EN, F.wave); } \
            for (int rep = 0; rep < 1 + MK_DUP_ALL; ++rep) if (F.G == 256 && blockIdx.x >= 128) convert_weights(F, l, 0, 2, ((int)blockIdx.x - 128) * NWAVES + F.wave, 128 * NWAVES); \
        } SEAM(pb + 0); \
        if (IN(pb + 1)) { PREP_PHASE(l); } if (!MK_FUSE_PREP) SEAM(pb + 1); \
        if (IN(pb + 2)) { phase_attn_A(F, l, (char*)lds + RING_OFF); ATTN_BC(F, l, (char*)lds + RING_OFF); if ((MK_DUP_ATTN & 1) || MK_DUP_ALL) { phase_attn_A(F, l, (char*)lds + RING_OFF); } if ((MK_DUP_ATTN & 2) || MK_DUP_ALL) { ATTN_BC(F, l, (char*)lds + RING_OFF); } \
            for (int rep = 0; rep < 1 + MK_DUP_ALL; ++rep) if (l + 1 < NLAYER && F.G == 256 && F.vcu < 128) convert_weights(F, l, l + 1, 1, F.vcu * NWAVES + F.wave, 128 * NWAVES); } SEAM(pb + 2); \
        if (IN(pb + 3)) { if (MK_DUP_ALL) phase_mix_copy(F); phase_mix(F, l); if (!MK_FIN_PHASES) reduce_colsums(F, (l + 1 < NLAYER) ? 3 : 2); if (F.G != 256) convert_weights(F, l, l + 1, ((l + 1 < NLAYER) ? 1 : 0) | 2, F.gw, F.NGW); } SEAM(pb + 3); \
        if (IN(pb + 4)) { \
            STAGGER(MK_STAGGER_OUT); pg8::Gemm g{F.O, F.Wout_t, NTOK, DM, DM}; pg8::StaticOrder S; S.init(NTOK, DM, F.G, (int)blockIdx.x, MK_WGM_RES); \
            { RES_EPI_OUT(l); } if (MK_DUP_ALL) { pg8::EpiResCopyB EC{F.XB, DM}; pg8::gemm_phase<pg8::EpiResCopyB, pg8::StaticOrder, true, true>(F.lds + RING_OFF, g, S, EC, F.wave); } \
            if (MK_DUP_KLOOP & 2) { pg8::EpiNull EN{F.LSE}; pg8::gemm_phase<pg8::EpiNull, pg8::StaticOrder, true, true>(F.lds + RING_OFF, g, S, EN, F.wave); } \
        } SEAM(pb + 4); \
        if (MK_FIN_PHASES) { if (IN(pb + 5)) { for (int rep = 0; rep < 1 + MK_DUP_ALL; ++rep) { phase_finalize_stats(F); reduce_colsums(F, (l + 1 < NLAYER) ? 3 : 2); } } SEAM(pb + 5); } \
        if (IN(pb + 6)) { \
            STAGGER(MK_STAGGER_IN); pg8::Gemm g{F.XB, F.Wff1_t, NTOK, DFF, DM}; pg8::StaticOrder S; S.init(NTOK, DFF, F.G, (int)blockIdx.x); \
            if (!MK_FIN_PHASES) STATS_PREAMBLE(S); \
            pg8::EpiBf16Fold<3, MK_TILED_H != 0> E{F.H, DFF, F.STAT, F.VEC + VEC_CS_FF1, F.VEC + VEC_BW_FF1}; \
            pg8::gemm_phase<pg8::EpiBf16Fold<3, MK_TILED_H != 0>, pg8::StaticOrder, true, true>(F.lds + RING_OFF, g, S, E, F.wave); \
            if (MK_DUP_ALL) pg8::gemm_phase<pg8::EpiBf16Fold<3, MK_TILED_H != 0>, pg8::StaticOrder, true, true>(F.lds + RING_OFF, g, S, E, F.wave); \
            if (MK_DUP_KLOOP & 4) { pg8::EpiNull EN{F.LSE}; pg8::gemm_phase<pg8::EpiNull, pg8::StaticOrder, true, true>(F.lds + RING_OFF, g, S, EN, F.wave); } \
            if (MK_XCD_EXTRA >= 0 && (int)(blockIdx.x & 7) == MK_XCD_EXTRA) { pg8::StaticOrder S1; S1.init(256, 256, 1, 0); pg8::gemm_phase<pg8::EpiBf16Fold<3, MK_TILED_H != 0>, pg8::StaticOrder, true, true>(F.lds + RING_OFF, g, S1, E, F.wave); } \
        } SEAM(pb + 6); \
        if (IN(pb + 7)) { \
            STAGGER(MK_STAGGER_OUT); pg8::Gemm g{F.H, F.Wff2_t, NTOK, DM, DFF}; pg8::StaticOrder S; S.init(NTOK, DM, F.G, (int)blockIdx.x, MK_WGM_RES); \
            { RES_EPI_FF2(l); } if (MK_DUP_ALL) { pg8::EpiResCopyB EC{F.XB, DM}; pg8::gemm_phase<pg8::EpiResCopyB, pg8::StaticOrder, true, true, MK_TILED_H != 0>(F.lds + RING_OFF, g, S, EC, F.wave); } \
            if (MK_DUP_KLOOP & 8) { pg8::EpiNull EN{F.LSE}; pg8::gemm_phase<pg8::EpiNull, pg8::StaticOrder, true, true, MK_TILED_H != 0>(F.lds + RING_OFF, g, S, EN, F.wave); } \
        } SEAM(pb + 7); \
        if (MK_FIN_PHASES) { if (IN(pb + 8)) { for (int rep = 0; rep < 1 + MK_DUP_ALL; ++rep) phase_finalize_stats(F); } SEAM(pb + 8); } \
    } while (0)
    LAYER_BODY(0); LAYER_BODY(1); LAYER_BODY(2); LAYER_BODY(3);
#undef LAYER_BODY
    if (IN(N_PHASES - 1)) { phase_final_ln(F, F.ln2_g + (size_t)(NLAYER - 1) * DM, F.ln2_b + (size_t)(NLAYER - 1) * DM); }

#undef IN
#undef SEAM
}

extern "C" void kernel_launch(void* const* d_in, const int* in_sizes, int n_in, void* d_out, int out_size, void* d_ws, size_t ws_size, hipStream_t stream) {
    static int grid = 0;
    if (grid == 0) {
        if (n_in != 14 || in_sizes[0] != NTOK_P * DM || out_size != NTOK * DM || ws_size < WS_END) { fprintf(stderr, "kernel_launch: shape/workspace mismatch (n_in %d, out %d, ws %zu < %zu); nothing launched\n", n_in, out_size, ws_size, (size_t)WS_END); grid = -1; return; }
        int dev = 0, cus = 0, per_cu = 0;
        if (hipGetDevice(&dev) != hipSuccess || hipDeviceGetAttribute(&cus, hipDeviceAttributeMultiprocessorCount, dev) != hipSuccess) { grid = -1; return; }
        if (hipFuncSetAttribute((const void*)trunk_fwd, hipFuncAttributeMaxDynamicSharedMemorySize, LDS_BYTES) != hipSuccess) { fprintf(stderr, "kernel_launch: hipFuncSetAttribute failed\n"); grid = -1; return; }
        if (hipOccupancyMaxActiveBlocksPerMultiprocessor(&per_cu, (const void*)trunk_fwd, NWAVES * 64, LDS_BYTES) != hipSuccess || per_cu < 1) { fprintf(stderr, "kernel_launch: occupancy query says %d blocks per CU\n", per_cu); }
        (void)hipGetLastError();
        grid = cus;
    }
    if (grid < 0) return;
    if (hipMemsetAsync((char*)d_ws + WS_CTL, 0, CTL_ZERO_BYTES, stream) != hipSuccess) return;
    Args a{};
    for (int i = 0; i < 14; ++i) a.in[i] = (const float*)d_in[i];
    a.out = (float*)d_out; a.ws = (unsigned char*)d_ws;
#if MK_PER_PHASE
    for (int p = 0; p < N_PHASES; ++p) { a.ph_lo = p; a.ph_hi = p + 1; hipLaunchKernelGGL(trunk_fwd, dim3(grid), dim3(NWAVES * 64), LDS_BYTES, stream, a); }
#else
    a.ph_lo = 0; a.ph_hi = N_PHASES;
    hipLaunchKernelGGL(trunk_fwd, dim3(grid), dim3(NWAVES * 64), LDS_BYTES, stream, a);
#endif
    const hipError_t le = hipPeekAtLastError();
    if (le != hipSuccess) fprintf(stderr, "kernel_launch: launch failed: %s\n", hipGetErrorName(le));
}
```

```cpp
#include <hip/hip_runtime.h>
#include <hip/hip_bf16.h>
#include <cstdio>
#include <cstdint>
#include <cmath>
__device__ __forceinline__ int lane_id() { int l; asm volatile("v_mbcnt_lo_u32_b32 %0, -1, 0\n\tv_mbcnt_hi_u32_b32 %0, -1, %0" : "=v"(l)); return l; }
template <int M> __device__ __forceinline__ float xshfl(float v) { static_assert(M >= 1 && M < 32, "xshfl: xor mask 1..31"); return __builtin_bit_cast(float, __builtin_amdgcn_ds_swizzle(__builtin_bit_cast(int, v), (M << 10) | 0x1f)); }
__device__ __forceinline__ void xswap32(float& a, float& b) { asm volatile("s_nop 1\n\tv_permlane32_swap_b32 %0, %1" : "+v"(a), "+v"(b)); }
__device__ __forceinline__ float xsum32(float v) { float a = v, b = v; xswap32(a, b); return a + b; }
__device__ __forceinline__ float xmax32(float v) { float a = v, b = v; xswap32(a, b); return fmaxf(a, b); }
#ifndef MK_MIXFOLD
#define MK_MIXFOLD 1
#endif
#define MK_SSQ_FROM_O_BYTES ((1012L - 820L) << 20)
#ifndef MK_NT_H
#define MK_NT_H 1
#endif
#ifndef MK_NT_PROJ
#define MK_NT_PROJ 0
#endif
#ifndef MK_NT_HLOAD
#define MK_NT_HLOAD 0
#endif
#ifndef MK_TILED_W
#define MK_TILED_W 0
#endif
namespace pg8 {
#define PG8_LAS __attribute__((address_space(3)))
typedef unsigned short bf16_t;
typedef short bf16x8 __attribute__((ext_vector_type(8)));
typedef float f32x4 __attribute__((ext_vector_type(4)));
typedef unsigned u32x4 __attribute__((ext_vector_type(4)));
constexpr int BM = 256, BK = 64, HALF = 128, HTB = HALF * BK * 2  , STAGE_BYTES = 8 * HTB, NXCD = 8, WGM = 8;

__host__ __device__ __forceinline__ int lds_byte(int r, int c) { const int st = (r >> 4) * 2 + (c >> 5), rr = r & 15, cc = c & 31, ob = rr * 64 + cc * 2; return st * 1024 + (ob ^ (((ob >> 9) & 1) << 5)); }
__host__ __device__ __forceinline__ void stage_rc(int b, int& R, int& C) { const int st = b / 1024, sb = b % 1024, swz = sb ^ (((sb >> 9) & 1) << 5); R = (st >> 1) * 16 + swz / 64; C = (st & 1) * 32 + (swz % 64) / 2; }
__host__ __device__ __forceinline__ int perm32(int rho) { const int n = rho >> 4, i = rho & 15; return 8 * (i >> 2) + 4 * n + (i & 3); }

struct Unit { int pm, pn; };
struct Gemm { const bf16_t* A; const bf16_t* Bt; int M, N, K; const float* rat = nullptr; int ktab_off = 0; };

struct StaticOrder {
    int nM, nN, nwg, G, c, wgm;
    __host__ __device__ __forceinline__ void init(int M, int N, int G_, int c_, int wgm_ = WGM) { nM = M / BM; nN = N / BM; nwg = nM * nN; G = G_; c = c_; wgm = wgm_; }
    __host__ __device__ __forceinline__ bool next(int i, Unit& u) const {
        const long L = (long)i * G + c; if (L >= nwg) return false;
        int wgid = (int)L; { const int q = nwg / NXCD, r = nwg % NXCD, xcd = wgid % NXCD, off = wgid / NXCD; wgid = (xcd < r ? xcd * (q + 1) : r * (q + 1) + (xcd - r) * q) + off; }
        const int nig = wgm * nN, gid = wgid / nig, fm = gid * wgm, gsz = (nM - fm) < wgm ? (nM - fm) : wgm;
        u.pm = fm + ((wgid % nig) % gsz); u.pn = (wgid % nig) / gsz; return true;
    }
    __device__ __forceinline__ void a_ready(const Unit&) const {}
    __device__ __forceinline__ void done(const Unit&) const {}
};

struct HalfOrder {
    StaticOrder s; int pmb;
    __host__ __device__ __forceinline__ void init(int Mh, int N, int G_, int c_, int wgm_, int pmb_) { s.init(Mh, N, G_, c_, wgm_); pmb = pmb_; }
    __host__ __device__ __forceinline__ bool next(int i, Unit& u) const { const bool ok = s.next(i, u); u.pm += pmb; return ok; }
    __device__ __forceinline__ void a_ready(const Unit&) const {}
    __device__ __forceinline__ void done(const Unit&) const {}
};
__device__ __forceinline__ unsigned cvt_pk_bf16(float lo, float hi) { unsigned r; asm volatile("v_cvt_pk_bf16_f32 %0, %1, %2" : "=v"(r) : "v"(lo), "v"(hi)); return r; }
typedef float f32x2 __attribute__((ext_vector_type(2)));
__device__ __forceinline__ f32x2 gelu_pk(f32x2 v) {
    const f32x2 av = __builtin_elementwise_abs(v), d = av * 0.2316418882f + 1.0f;
    f32x2 t; t.x = __builtin_amdgcn_rcpf(d.x); t.y = __builtin_amdgcn_rcpf(d.y);
    f32x2 q = t * 0.5307027145f + (-0.7265760135f); q = q * t + 0.7107068705f; q = q * t + (-0.142248368f); q = q * t + 0.127414796f; q = q * t;
    const f32x2 s = (v * v) * (-0.72134752044f);
    f32x2 e; e.x = __builtin_amdgcn_exp2f(s.x); e.y = __builtin_amdgcn_exp2f(s.y);
    const f32x2 m = v * (q * e), r = v - m;
    f32x2 o; o.x = v.x < 0.f ? m.x : r.x; o.y = v.y < 0.f ? m.y : r.y; return o;
}

template <int ACT  > struct EpiBf16 {
    static constexpr bool PERM = true, AFTER_DRAIN = false; static constexpr int MIN_VMEM = 0;     static_assert(ACT == 0 || ACT == 1, "EpiBf16: ACT is 0 (none) or 1 (gelu_pk)");
    bf16_t* O; int ldc; const float* bias; int split_cols; size_t split_stride; float scale0;
    __device__ __forceinline__ void operator()(const f32x4 (&acc)[2][2][4][2], const Unit& u, int wr, int wc, int fr, int fq) const {
        const int row0 = u.pm * BM + wr * 64 + fr; int colt = u.pn * BM; bf16_t* base = O;
        float sc = 1.f; if (split_cols) { const int t = colt / split_cols; base += (size_t)t * split_stride; colt -= t * split_cols; if (t == 0) sc = scale0; }
        const int col0 = colt + wc * 32 + 8 * fq, bcol0 = u.pn * BM + wc * 32 + 8 * fq;
        f32x4 bv[2][2];
#pragma unroll
        for (int bj = 0; bj < 2; ++bj)
#pragma unroll
            for (int n = 0; n < 2; ++n) bv[bj][n] = bias ? *(const f32x4*)(bias + bcol0 + bj * HALF + 4 * n) : (f32x4){0.f, 0.f, 0.f, 0.f};
#pragma unroll
        for (int ai = 0; ai < 2; ++ai)
#pragma unroll
            for (int m = 0; m < 4; ++m) { bf16_t* rowp = base + (size_t)(row0 + ai * HALF + m * 16) * ldc + col0;
#pragma unroll
                for (int bj = 0; bj < 2; ++bj) { f32x4 v0 = acc[ai][bj][m][0] + bv[bj][0], v1 = acc[ai][bj][m][1] + bv[bj][1];
                    if (ACT == 1) { f32x2 a = gelu_pk((f32x2){v0[0], v0[1]}), b = gelu_pk((f32x2){v0[2], v0[3]}), c = gelu_pk((f32x2){v1[0], v1[1]}), d = gelu_pk((f32x2){v1[2], v1[3]});
                        v0 = (f32x4){a.x, a.y, b.x, b.y}; v1 = (f32x4){c.x, c.y, d.x, d.y}; }
                    v0 = v0 * sc; v1 = v1 * sc; u32x4 w; w.x = cvt_pk_bf16(v0[0], v0[1]); w.y = cvt_pk_bf16(v0[2], v0[3]); w.z = cvt_pk_bf16(v1[0], v1[1]); w.w = cvt_pk_bf16(v1[2], v1[3]);
                    *(u32x4*)(rowp + bj * HALF) = w; } }
    }
};


struct EpiRelu2Bf16 {
    static constexpr bool PERM = true, AFTER_DRAIN = false; static constexpr int MIN_VMEM = 0;
    bf16_t* O; int ldc;
    __device__ __forceinline__ void operator()(const f32x4 (&acc)[2][2][4][2], const Unit& u, int wr, int wc, int fr, int fq) const {
        const int row0 = u.pm * BM + wr * 64 + fr; const int col0 = u.pn * BM + wc * 32 + 8 * fq;
#pragma unroll
        for (int ai = 0; ai < 2; ++ai)
#pragma unroll
            for (int m = 0; m < 4; ++m) { bf16_t* rowp = O + (size_t)(row0 + ai * HALF + m * 16) * ldc + col0;
#pragma unroll
                for (int bj = 0; bj < 2; ++bj) { f32x4 v0 = acc[ai][bj][m][0], v1 = acc[ai][bj][m][1];
#pragma unroll
                    for (int e = 0; e < 4; ++e) { const float a = fmaxf(v0[e], 0.f), b = fmaxf(v1[e], 0.f); v0[e] = a * a; v1[e] = b * b; }
                    u32x4 w; w.x = cvt_pk_bf16(v0[0], v0[1]); w.y = cvt_pk_bf16(v0[2], v0[3]); w.z = cvt_pk_bf16(v1[0], v1[1]); w.w = cvt_pk_bf16(v1[2], v1[3]);
                    *(u32x4*)(rowp + bj * HALF) = w; } }
    }
};
struct EpiResF32 {
    static constexpr bool PERM = false, AFTER_DRAIN = false; static constexpr int MIN_VMEM = 0;
    const float* X; float* Z; int ldc; float alpha;
    __device__ __forceinline__ void operator()(const f32x4 (&acc)[2][2][4][2], const Unit& u, int wr, int wc, int fr, int fq) const {
        const int row0 = u.pm * BM + wr * 64 + fr, col0 = u.pn * BM + wc * 32 + 4 * fq;
#pragma unroll
        for (int ai = 0; ai < 2; ++ai)
#pragma unroll
            for (int m = 0; m < 4; ++m) { const size_t off = (size_t)(row0 + ai * HALF + m * 16) * ldc + col0;
#pragma unroll
                for (int bj = 0; bj < 2; ++bj)
#pragma unroll
                    for (int n = 0; n < 2; ++n) { const f32x4 xv = *(const f32x4*)(X + off + bj * HALF + n * 16);
                        *(f32x4*)(Z + off + bj * HALF + n * 16) = xv * alpha + acc[ai][bj][m][n]; } }
    }
};

template <int ACT, bool TILED = false> struct EpiBf16Fold {
    static constexpr bool PERM = true, AFTER_DRAIN = false; static constexpr int MIN_VMEM = 16;
    bf16_t* O; int ldc; const f32x2* stat; const float* cs; const float* bw;
    __device__ __forceinline__ void operator()(const f32x4 (&acc)[2][2][4][2], const Unit& u, int wr, int wc, int fr, int fq) const {
        const int row0 = u.pm * BM + wr * 64 + fr; const int col0 = u.pn * BM + wc * 32 + 8 * fq;
        f32x4 cv[2][2], bv[2][2]; f32x2 st[2][4];
#pragma unroll
        for (int ai = 0; ai < 2; ++ai)
#pragma unroll
            for (int m = 0; m < 4; ++m) st[ai][m] = stat[row0 + ai * HALF + m * 16];
#pragma unroll
        for (int bj = 0; bj < 2; ++bj)
#pragma unroll
            for (int n = 0; n < 2; ++n) { cv[bj][n] = *(const f32x4*)(cs + col0 + bj * HALF + 4 * n); bv[bj][n] = *(const f32x4*)(bw + col0 + bj * HALF + 4 * n); }
#pragma unroll
        for (int ai = 0; ai < 2; ++ai)
#pragma unroll
            for (int m = 0; m < 4; ++m) { const int row = row0 + ai * HALF + m * 16; const float rs = st[ai][m].y, nm = -st[ai][m].x * st[ai][m].y;
                bf16_t* rowp = TILED ? O + ((size_t)(row >> 8) * (ldc >> 6) + (col0 >> 6)) * 16384 + (row & 255) * 64 + (col0 & 63) : O + (size_t)row * ldc + col0;
#pragma unroll
                for (int bj = 0; bj < 2; ++bj) { f32x4 v0 = acc[ai][bj][m][0] * rs + (cv[bj][0] * nm + bv[bj][0]), v1 = acc[ai][bj][m][1] * rs + (cv[bj][1] * nm + bv[bj][1]);
                    if (ACT == 3) {
#pragma unroll
                        for (int e = 0; e < 4; ++e) { const float a = fmaxf(v0[e], 0.f), b = fmaxf(v1[e], 0.f); v0[e] = a * a; v1[e] = b * b; } }
                    u32x4 w; w.x = cvt_pk_bf16(v0[0], v0[1]); w.y = cvt_pk_bf16(v0[2], v0[3]); w.z = cvt_pk_bf16(v1[0], v1[1]); w.w = cvt_pk_bf16(v1[2], v1[3]);
                    if (TILED && MK_NT_H) __builtin_nontemporal_store(w, (u32x4*)(rowp + bj * 2 * 16384)); else *(u32x4*)(rowp + (TILED ? bj * 2 * 16384 : bj * HALF)) = w; } }
    }
};
struct EpiResLnFold {
    static constexpr bool PERM = false, AFTER_DRAIN = false; static constexpr int MIN_VMEM = 0;
    const float* Xp; const float* Xs; int split_pm;
    float* Z; bf16_t* ZB; int ldc; const f32x2* stat; const float* g; const float* b; f32x2* part; float alpha;
    __device__ __forceinline__ void operator()(const f32x4 (&acc)[2][2][4][2], const Unit& u, int wr, int wc, int fr, int fq) const {
        typedef unsigned u32x2v __attribute__((ext_vector_type(2)));
        const int row0 = u.pm * BM + wr * 64 + fr, col0 = u.pn * BM + wc * 32 + 4 * fq;
        const float* xbase = (u.pm < split_pm) ? Xp : Xs - (size_t)split_pm * BM * ldc;
        f32x4 gv[2][2], bv[2][2]; f32x2 st[2][4];
#pragma unroll
        for (int ai = 0; ai < 2; ++ai)
#pragma unroll
            for (int m = 0; m < 4; ++m) st[ai][m] = stat[row0 + ai * HALF + m * 16];
#pragma unroll
        for (int bj = 0; bj < 2; ++bj)
#pragma unroll
            for (int n = 0; n < 2; ++n) { gv[bj][n] = *(const f32x4*)(g + col0 + bj * HALF + n * 16); bv[bj][n] = *(const f32x4*)(b + col0 + bj * HALF + n * 16); }
        f32x4 xv[2][2][2];
#define RLF_LOAD(buf, rg) do { const size_t off_ = (size_t)(row0 + ((rg) >> 2) * HALF + ((rg) & 3) * 16) * ldc + col0; \
            _Pragma("unroll") for (int bj = 0; bj < 2; ++bj) _Pragma("unroll") for (int n = 0; n < 2; ++n) xv[buf][bj][n] = *(const f32x4*)(xbase + off_ + bj * HALF + n * 16); } while (0)
        RLF_LOAD(0, 0);
#pragma unroll
        for (int rg = 0; rg < 8; ++rg) { const int ai = rg >> 2, m = rg & 3, cur = rg & 1;
            if (rg + 1 < 8) RLF_LOAD(cur ^ 1, rg + 1);
            asm volatile("" ::: "memory");
            const int row = row0 + ai * HALF + m * 16; const size_t off = (size_t)row * ldc + col0; const float mu = st[ai][m].x, rs = st[ai][m].y;
            float s = 0.f, q = 0.f;
#pragma unroll
            for (int bj = 0; bj < 2; ++bj)
#pragma unroll
                for (int n = 0; n < 2; ++n) {
                    const f32x4 xn = (xv[cur][bj][n] - mu) * rs * gv[bj][n] + bv[bj][n]; const f32x4 z = xn * alpha + acc[ai][bj][m][n];
                    *(f32x4*)(Z + off + bj * HALF + n * 16) = z;
                    u32x2v w; w.x = cvt_pk_bf16(z[0], z[1]); w.y = cvt_pk_bf16(z[2], z[3]); *(u32x2v*)(ZB + off + bj * HALF + n * 16) = w;
                    s += (z[0] + z[1]) + (z[2] + z[3]); q += (z[0] * z[0] + z[1] * z[1]) + (z[2] * z[2] + z[3] * z[3]); }
            s += xshfl<16>(s); s = xsum32(s); q += xshfl<16>(q); q = xsum32(q);
            if (fq == 0) part[(size_t)row * 32 + u.pn * 4 + wc] = (f32x2){s, q};
            asm volatile("" ::: "memory");
        }
#undef RLF_LOAD
    }
};

struct EpiInProj {
    static constexpr bool PERM = true, AFTER_DRAIN = false; static constexpr int MIN_VMEM = 16;
    bf16_t* O; int ldc; const f32x2* stat; const float* cs; const float* bw;
    const float* gq; const float* gk; const float* ropeA; const float* ropeB; PG8_LAS float* xch;
    float qscale;
    __device__ __forceinline__ void operator()(const f32x4 (&acc_)[2][2][4][2], const Unit& u, int wr, int wc, int fr, int fq) const {
        f32x4 (&acc)[2][2][4][2] = const_cast<f32x4 (&)[2][2][4][2]>(acc_);
        const int row0 = u.pm * BM + wr * 64 + fr; const int col0 = u.pn * BM + wc * 32 + 8 * fq;
        const int kind = (u.pn < 3) ? 1 : (u.pn >= 4 && u.pn < 10) ? 2 : 0;
        { f32x4 cv[2][2], bv[2][2]; f32x2 st[2][4];
#pragma unroll
          for (int ai = 0; ai < 2; ++ai)
#pragma unroll
            for (int m = 0; m < 4; ++m) st[ai][m] = stat[row0 + ai * HALF + m * 16];
#pragma unroll
          for (int bj = 0; bj < 2; ++bj)
#pragma unroll
            for (int n = 0; n < 2; ++n) { cv[bj][n] = *(const f32x4*)(cs + col0 + bj * HALF + 4 * n); bv[bj][n] = *(const f32x4*)(bw + col0 + bj * HALF + 4 * n); }
#pragma unroll
          for (int ai = 0; ai < 2; ++ai)
#pragma unroll
            for (int m = 0; m < 4; ++m) { const float rs = st[ai][m].y, nm = -st[ai][m].x * st[ai][m].y;
#pragma unroll
                for (int bj = 0; bj < 2; ++bj)
#pragma unroll
                    for (int n = 0; n < 2; ++n) acc[ai][bj][m][n] = acc[ai][bj][m][n] * rs + (cv[bj][n] * nm + bv[bj][n]); } }
        if (kind == 0) {
#pragma unroll
            for (int ai = 0; ai < 2; ++ai)
#pragma unroll
                for (int m = 0; m < 4; ++m) { bf16_t* rowp = O + (size_t)(row0 + ai * HALF + m * 16) * ldc + col0;
#pragma unroll
                    for (int bj = 0; bj < 2; ++bj) { const f32x4 v0 = acc[ai][bj][m][0], v1 = acc[ai][bj][m][1];
                        u32x4 w; w.x = cvt_pk_bf16(v0[0], v0[1]); w.y = cvt_pk_bf16(v0[2], v0[3]); w.z = cvt_pk_bf16(v1[0], v1[1]); w.w = cvt_pk_bf16(v1[2], v1[3]);
                        if (MK_NT_PROJ) __builtin_nontemporal_store(w, (u32x4*)(rowp + bj * HALF)); else *(u32x4*)(rowp + bj * HALF) = w; } }
            return;
        }
        const float qs = (u.pn < 2) ? qscale : 1.f;
        const int half = wc >> 1;
        const int i0 = (kind == 1) ? 4 * (4 * (wc & 1) + fq) : 16 * wc + 4 * fq;
        f32x4 g_lo = {1.f, 1.f, 1.f, 1.f}, g_hi = {1.f, 1.f, 1.f, 1.f};
        if (kind == 1) {
            const float* gain = (u.pn < 2) ? gq : gk; g_lo = *(const f32x4*)(gain + 64 * half + i0); g_hi = *(const f32x4*)(gain + 64 * half + i0 + 32);
#pragma unroll
            for (int ai = 0; ai < 2; ++ai)
#pragma unroll
                for (int m = 0; m < 4; ++m)
#pragma unroll
                    for (int bj = 0; bj < 2; ++bj) { const f32x4 a = acc[ai][bj][m][0], b = acc[ai][bj][m][1];
                        float ss = ((a[0] * a[0] + a[1] * a[1]) + (a[2] * a[2] + a[3] * a[3])) + ((b[0] * b[0] + b[1] * b[1]) + (b[2] * b[2] + b[3] * b[3]));
                        ss += xshfl<16>(ss); ss = xsum32(ss);
                        if (fq == 0) xch[((ai * HALF + wr * 64 + m * 16 + fr) * 2 + bj) * 4 + wc] = ss; }
            asm volatile("s_waitcnt lgkmcnt(0)" ::: "memory"); __builtin_amdgcn_s_barrier(); asm volatile("" ::: "memory");
        }
        f32x4 tb[2][2][2];
#define EIP_LOAD(buf, sg) do { _Pragma("unroll") for (int h = 0; h < 2; ++h) { const int rg_ = 2 * (sg) + h; const int t_ = (row0 + (rg_ >> 2) * HALF + (rg_ & 3) * 16) & 4095; \
            const float* tp_ = (kind == 1) ? ropeA + 2 * ((half ? (t_ & 63) : (t_ >> 6)) * 32 + i0) : ropeB + 2 * (t_ * 64 + i0); \
            tb[buf][h][0] = *(const f32x4*)tp_; tb[buf][h][1] = *(const f32x4*)(tp_ + 4); } } while (0)
        EIP_LOAD(0, 0);
#pragma unroll
        for (int sg = 0; sg < 4; ++sg) { const int cur = sg & 1;
            if (sg + 1 < 4) EIP_LOAD(cur ^ 1, sg + 1);
            asm volatile("" ::: "memory");
#pragma unroll
            for (int h = 0; h < 2; ++h) { const int rg = 2 * sg + h, ai = rg >> 2, m = rg & 3; const int rl = ai * HALF + wr * 64 + m * 16 + fr;
                bf16_t* rowp = O + (size_t)(u.pm * BM + rl) * ldc + col0;
                const f32x4 t0 = tb[cur][h][0], t1 = tb[cur][h][1];
                const f32x4 cs4 = {t0[0], t0[2], t1[0], t1[2]}, sn4 = {t0[1], t0[3], t1[1], t1[3]};
#pragma unroll
                for (int bj = 0; bj < 2; ++bj) { f32x4 lo = acc[ai][bj][m][0], hi = acc[ai][bj][m][1];
                    if (kind == 1) { const f32x4 pq = *(const PG8_LAS f32x4*)(xch + (rl * 2 + bj) * 4); const float rs = 1.0f / sqrtf(((pq[0] + pq[1]) + (pq[2] + pq[3])) * (1.0f / 128.f) + 1e-6f);
                        lo = lo * (rs * qs) * g_lo; hi = hi * (rs * qs) * g_hi; }
                    const f32x4 ol = lo * cs4 - hi * sn4, oh = hi * cs4 + lo * sn4;
                    u32x4 w; w.x = cvt_pk_bf16(ol[0], ol[1]); w.y = cvt_pk_bf16(ol[2], ol[3]); w.z = cvt_pk_bf16(oh[0], oh[1]); w.w = cvt_pk_bf16(oh[2], oh[3]);
                    if (MK_NT_PROJ) __builtin_nontemporal_store(w, (u32x4*)(rowp + bj * HALF)); else *(u32x4*)(rowp + bj * HALF) = w; } }
            asm volatile("" ::: "memory");
        }
#undef EIP_LOAD
        if (kind == 1) { asm volatile("s_waitcnt lgkmcnt(0)" ::: "memory"); __builtin_amdgcn_s_barrier(); asm volatile("" ::: "memory"); }
    }
};

struct EpiResLnFoldB {
    static constexpr bool PERM = false, AFTER_DRAIN = false; static constexpr int MIN_VMEM = 16;
    bf16_t* ZB; int ldc; const f32x2* stat; const float* g; const float* b; f32x2* part; float alpha;
    __device__ __forceinline__ void operator()(const f32x4 (&acc)[2][2][4][2], const Unit& u, int wr, int wc, int fr, int fq) const {
        typedef unsigned u32x2v __attribute__((ext_vector_type(2)));
        const int row0 = u.pm * BM + wr * 64 + fr, col0 = u.pn * BM + wc * 32 + 4 * fq;
        f32x4 gv[2][2], bv[2][2]; f32x2 st[2]; u32x2v xv[2][2][2];
#pragma unroll
        for (int bj = 0; bj < 2; ++bj)
#pragma unroll
            for (int n = 0; n < 2; ++n) { gv[bj][n] = *(const f32x4*)(g + col0 + bj * HALF + n * 16); bv[bj][n] = *(const f32x4*)(b + col0 + bj * HALF + n * 16); }
#define RLB_LOAD(buf, rg) do { const int row_ = row0 + ((rg) >> 2) * HALF + ((rg) & 3) * 16; const size_t off_ = (size_t)row_ * ldc + col0; st[buf] = stat[row_]; \
            _Pragma("unroll") for (int bj = 0; bj < 2; ++bj) _Pragma("unroll") for (int n = 0; n < 2; ++n) xv[buf][bj][n] = *(const u32x2v*)(ZB + off_ + bj * HALF + n * 16); } while (0)
        RLB_LOAD(0, 0);
#pragma unroll
        for (int rg = 0; rg < 8; ++rg) { const int cur = rg & 1, ai = rg >> 2, m = rg & 3;
            if (rg + 1 < 8) RLB_LOAD(cur ^ 1, rg + 1);
            asm volatile("" ::: "memory");
            const int row = row0 + ai * HALF + m * 16; const size_t off = (size_t)row * ldc + col0; const float mu = st[cur].x, rs = st[cur].y;
            float s = 0.f, q = 0.f;
#pragma unroll
            for (int bj = 0; bj < 2; ++bj)
#pragma unroll
                for (int n = 0; n < 2; ++n) { const u32x2v xw = xv[cur][bj][n];
                    const f32x4 xf = {__builtin_bit_cast(float, xw.x << 16), __builtin_bit_cast(float, xw.x & 0xffff0000u), __builtin_bit_cast(float, xw.y << 16), __builtin_bit_cast(float, xw.y & 0xffff0000u)};
                    const f32x4 xn = (xf - mu) * rs * gv[bj][n] + bv[bj][n]; const f32x4 z = xn * alpha + acc[ai][bj][m][n];
                    u32x2v w; w.x = cvt_pk_bf16(z[0], z[1]); w.y = cvt_pk_bf16(z[2], z[3]); *(u32x2v*)(ZB + off + bj * HALF + n * 16) = w;
                    s += (z[0] + z[1]) + (z[2] + z[3]); q += (z[0] * z[0] + z[1] * z[1]) + (z[2] * z[2] + z[3] * z[3]); }
            s += xshfl<16>(s); s = xsum32(s); q += xshfl<16>(q); q = xsum32(q);
            if (fq == 0) part[(size_t)row * 32 + u.pn * 4 + wc] = (f32x2){s, q};
            asm volatile("" ::: "memory");
        }
#undef RLB_LOAD
    }
};

struct EpiNull {
    static constexpr bool PERM = true, AFTER_DRAIN = false; static constexpr int MIN_VMEM = 0;
    float* sink;
    __device__ __forceinline__ void operator()(const f32x4 (&acc)[2][2][4][2], const Unit& u, int wr, int wc, int fr, int fq) const {
        float s = 0.f;
#pragma unroll
        for (int ai = 0; ai < 2; ++ai)
#pragma unroll
            for (int bj = 0; bj < 2; ++bj)
#pragma unroll
                for (int m = 0; m < 4; ++m)
#pragma unroll
                    for (int n = 0; n < 2; ++n) s += (acc[ai][bj][m][n][0] + acc[ai][bj][m][n][1]) + (acc[ai][bj][m][n][2] + acc[ai][bj][m][n][3]);
        if (s == 1.2345678e33f) sink[u.pm * 8 + u.pn + wr + wc + fr + fq] = s;
    }
};

struct EpiResCopy {
    static constexpr bool PERM = false, AFTER_DRAIN = false; static constexpr int MIN_VMEM = 0;
    float* Z; bf16_t* ZB; int ldc;
    __device__ __forceinline__ void operator()(const f32x4 (&acc)[2][2][4][2], const Unit& u, int wr, int wc, int fr, int fq) const {
        typedef unsigned u32x2v __attribute__((ext_vector_type(2)));
        const int row0 = u.pm * BM + wr * 64 + fr, col0 = u.pn * BM + wc * 32 + 4 * fq;
        float s = 0.f;
#pragma unroll
        for (int ai = 0; ai < 2; ++ai)
#pragma unroll
            for (int bj = 0; bj < 2; ++bj)
#pragma unroll
                for (int m = 0; m < 4; ++m)
#pragma unroll
                    for (int n = 0; n < 2; ++n) s += acc[ai][bj][m][n][0] + acc[ai][bj][m][n][3];
        const bool never = (s == 1.2345678e33f);
        f32x4 xv[2][2][2]; u32x2v bvv[2][2][2];
#define RC_LOAD(buf, rg) do { const size_t off_ = (size_t)(row0 + ((rg) >> 2) * HALF + ((rg) & 3) * 16) * ldc + col0; \
            _Pragma("unroll") for (int bj = 0; bj < 2; ++bj) _Pragma("unroll") for (int n = 0; n < 2; ++n) { xv[buf][bj][n] = *(const f32x4*)(Z + off_ + bj * HALF + n * 16); bvv[buf][bj][n] = *(const u32x2v*)(ZB + off_ + bj * HALF + n * 16); } } while (0)
        RC_LOAD(0, 0);
#pragma unroll
        for (int rg = 0; rg < 8; ++rg) { const int ai = rg >> 2, m = rg & 3, cur = rg & 1;
            if (rg + 1 < 8) RC_LOAD(cur ^ 1, rg + 1);
            asm volatile("" ::: "memory");
            const size_t off = (size_t)(row0 + ai * HALF + m * 16) * ldc + col0;
#pragma unroll
            for (int bj = 0; bj < 2; ++bj)
#pragma unroll
                for (int n = 0; n < 2; ++n) { f32x4 z = xv[cur][bj][n]; if (never) z[0] = s; *(f32x4*)(Z + off + bj * HALF + n * 16) = z; *(u32x2v*)(ZB + off + bj * HALF + n * 16) = bvv[cur][bj][n]; }
            asm volatile("" ::: "memory");
        }
#undef RC_LOAD
    }
};

struct EpiResCopyB {
    static constexpr bool PERM = false, AFTER_DRAIN = false; static constexpr int MIN_VMEM = 0;
    bf16_t* ZB; int ldc;
    __device__ __forceinline__ void operator()(const f32x4 (&acc)[2][2][4][2], const Unit& u, int wr, int wc, int fr, int fq) const {
        typedef unsigned u32x2v __attribute__((ext_vector_type(2)));
        const int row0 = u.pm * BM + wr * 64 + fr, col0 = u.pn * BM + wc * 32 + 4 * fq;
        float s = 0.f;
#pragma unroll
        for (int ai = 0; ai < 2; ++ai)
#pragma unroll
            for (int bj = 0; bj < 2; ++bj)
#pragma unroll
                for (int m = 0; m < 4; ++m)
#pragma unroll
                    for (int n = 0; n < 2; ++n) s += acc[ai][bj][m][n][0] + acc[ai][bj][m][n][3];
        const bool never = (s == 1.2345678e33f);
        u32x2v xv[2][2][2];
#define RCB_LOAD(buf, rg) do { const size_t off_ = (size_t)(row0 + ((rg) >> 2) * HALF + ((rg) & 3) * 16) * ldc + col0; \
            _Pragma("unroll") for (int bj = 0; bj < 2; ++bj) _Pragma("unroll") for (int n = 0; n < 2; ++n) xv[buf][bj][n] = *(const u32x2v*)(ZB + off_ + bj * HALF + n * 16); } while (0)
        RCB_LOAD(0, 0);
#pragma unroll
        for (int rg = 0; rg < 8; ++rg) { const int ai = rg >> 2, m = rg & 3, cur = rg & 1;
            if (rg + 1 < 8) RCB_LOAD(cur ^ 1, rg + 1);
            asm volatile("" ::: "memory");
            const size_t off = (size_t)(row0 + ai * HALF + m * 16) * ldc + col0;
#pragma unroll
            for (int bj = 0; bj < 2; ++bj)
#pragma unroll
                for (int n = 0; n < 2; ++n) { u32x2v z = xv[cur][bj][n]; if (never) z.x ^= 1u; *(u32x2v*)(ZB + off + bj * HALF + n * 16) = z; }
            asm volatile("" ::: "memory");
        }
#undef RCB_LOAD
    }
};

template <class Epi, class Sched, bool ALIGN_EPI = false, bool SP2 = false, bool TILED_A = false, bool KSCALE = false>
__device__ __forceinline__ void gemm_phase(PG8_LAS unsigned char* lds, const Gemm g, const Sched& S, const Epi& E, const int wid  ) {
    const int wr = wid >> 2, wc = wid & 3;
    const int K = g.K, nt = K / BK;
    unsigned voffA[2], voffB[2]; int aoff, boff;
#define PG8_LANE_OFFS() do { const int ln_ = lane_id(), td_ = wid * 64 + ln_; \
        _Pragma("unroll") for (int i = 0; i < 2; ++i) { int R, C; stage_rc(td_ * 16 + i * 8192, R, C); const int Rb = Epi::PERM ? ((R & ~31) + perm32(R & 31)) : R; \
            voffA[i] = (unsigned)(R * (TILED_A ? 64 : K) + C) * 2u; voffB[i] = (unsigned)(Rb * (MK_TILED_W ? 64 : K) + C) * 2u; } \
        aoff = lds_byte(wr * 64 + (ln_ & 15), (ln_ >> 4) * 8); boff = lds_byte(wc * 32 + (ln_ & 15), (ln_ >> 4) * 8); } while (0)
    PG8_LANE_OFFS();
    const size_t kstep = (size_t)(BK * 2);
    const size_t hstep = (size_t)HALF * K * 2;
    const size_t tstep = 2 * hstep;
    const size_t kstepA = TILED_A ? (size_t)32768 : kstep, hstepA = TILED_A ? (size_t)HALF * 64 * 2 : hstep;
    const size_t kstepB = MK_TILED_W ? (size_t)32768 : kstep, hstepB = MK_TILED_W ? (size_t)HALF * 64 * 2 : hstep;
    const unsigned ldsw = (unsigned)wid * 1024u;
#define PG8_SA(b, h) (((b) * 2 + (h)) * HTB)
#define PG8_SB(b, h) ((4 + (b) * 2 + (h)) * HTB)
#define PG8_STAGE(bufoff, gbase, voff) do { _Pragma("unroll") for (int _i = 0; _i < 2; ++_i) \
        __builtin_amdgcn_global_load_lds((const unsigned*)((const char*)(gbase) + (voff)[_i]), (PG8_LAS unsigned*)(lds + (bufoff) + ldsw + _i * 8192), 16, 0, 0); } while (0)
#define PG8_STAGE_A(bufoff, gbase, voff) do { _Pragma("unroll") for (int _i = 0; _i < 2; ++_i) { \
        if constexpr (TILED_A && MK_NT_HLOAD) __builtin_amdgcn_global_load_lds((const unsigned*)((const char*)(gbase) + (voff)[_i]), (PG8_LAS unsigned*)(lds + (bufoff) + ldsw + _i * 8192), 16, 0, 2); \
        else __builtin_amdgcn_global_load_lds((const unsigned*)((const char*)(gbase) + (voff)[_i]), (PG8_LAS unsigned*)(lds + (bufoff) + ldsw + _i * 8192), 16, 0, 0); } } while (0)
#define PG8_LDA(dst, b, h) do { _Pragma("unroll") for (int m = 0; m < 4; ++m) _Pragma("unroll") for (int k = 0; k < 2; ++k) dst[m][k] = *(const PG8_LAS bf16x8*)(lds + PG8_SA(b, h) + aoff + m * 2048 + k * 1024); } while (0)
#define PG8_LDB(dst, b, h) do { _Pragma("unroll") for (int n = 0; n < 2; ++n) _Pragma("unroll") for (int k = 0; k < 2; ++k) dst[n][k] = *(const PG8_LAS bf16x8*)(lds + PG8_SB(b, h) + boff + n * 2048 + k * 1024); } while (0)
#define PG8_MMA(ai, bj, At, Bt) do { __builtin_amdgcn_s_setprio(1); _Pragma("unroll") for (int m = 0; m < 4; ++m) _Pragma("unroll") for (int n = 0; n < 2; ++n) _Pragma("unroll") for (int k = 0; k < 2; ++k) \
        acc[ai][bj][m][n] = __builtin_amdgcn_mfma_f32_16x16x32_bf16(Bt[n][k], At[m][k], acc[ai][bj][m][n], 0, 0, 0); __builtin_amdgcn_s_setprio(0); } while (0)
#define PG8_WAIT_V(n) asm volatile("s_waitcnt vmcnt(" #n ")" ::: "memory")
#define PG8_WAIT_L(n) asm volatile("s_waitcnt lgkmcnt(" #n ")" ::: "memory")
#define PG8_BAR __builtin_amdgcn_s_barrier()
#define PG8_SCHED __builtin_amdgcn_sched_barrier(0)
#define PG8_KTAB_DMA(pm_, bsel_) do { const int ln_ = lane_id(); \
        __builtin_amdgcn_global_load_lds((const unsigned*)((const char*)g.rat + (size_t)(pm_) * (256 * 32) + (size_t)((wid * 64 + ln_) * 16)), (PG8_LAS unsigned*)(lds + g.ktab_off + (bsel_) * 8192 + wid * 1024), 16, 0, 0); } while (0)
#define PG8_RESCALE(seg_, bsel_) do { const int ln_ = lane_id(); const PG8_LAS float* tp_ = (const PG8_LAS float*)(lds + g.ktab_off + (bsel_) * 8192 + (wr * 64 + (ln_ & 15)) * 32) + (seg_); \
        _Pragma("unroll") for (int ai = 0; ai < 2; ++ai) _Pragma("unroll") for (int m = 0; m < 4; ++m) { const float r_ = tp_[(ai * 128 + m * 16) * 8]; \
            _Pragma("unroll") for (int bj = 0; bj < 2; ++bj) _Pragma("unroll") for (int n = 0; n < 2; ++n) acc[ai][bj][m][n] *= r_; } } while (0)
    Unit cur, nxt; int ui = 0;
    if (!S.next(0, cur)) return;
    if constexpr (KSCALE) PG8_KTAB_DMA(cur.pm, 0);
    f32x4 acc[2][2][4][2];
#pragma unroll
    for (int a = 0; a < 2; ++a)
#pragma unroll
        for (int b = 0; b < 2; ++b)
#pragma unroll
            for (int m = 0; m < 4; ++m)
#pragma unroll
                for (int n = 0; n < 2; ++n) { acc[a][b][m][n] = (f32x4){0.f, 0.f, 0.f, 0.f}; asm volatile("" : "+v"(acc[a][b][m][n])); }
    bf16x8 At[4][2], B0[2][2], B1[2][2];
    const char* cA = (const char*)g.A + (size_t)cur.pm * tstep; const char* cB = (const char*)g.Bt + (size_t)cur.pn * tstep;
    S.a_ready(cur);
    if constexpr (SP2) {
        PG8_STAGE(PG8_SB(0, 0), cB, voffB); PG8_STAGE(PG8_SB(0, 1), cB + hstepB, voffB); PG8_STAGE_A(PG8_SA(0, 0), cA, voffA); PG8_STAGE_A(PG8_SA(0, 1), cA + hstepA, voffA);
        if (wr == 1) PG8_BAR;
        PG8_WAIT_V(2); PG8_BAR;
        PG8_STAGE(PG8_SB(1, 0), cB + kstepB, voffB); PG8_STAGE_A(PG8_SA(1, 0), cA + kstepA, voffA); PG8_STAGE(PG8_SB(1, 1), cB + hstepB + kstepB, voffB);
        PG8_WAIT_V(6);
        PG8_BAR;
    } else {
        PG8_STAGE(PG8_SB(0, 0), cB, voffB); PG8_STAGE_A(PG8_SA(0, 0), cA, voffA); PG8_STAGE(PG8_SB(0, 1), cB + hstepB, voffB); PG8_STAGE_A(PG8_SA(0, 1), cA + hstepA, voffA);
        if (wr == 1) PG8_BAR;
        PG8_WAIT_V(4); PG8_BAR;
        PG8_STAGE(PG8_SB(1, 0), cB + kstepB, voffB); PG8_STAGE_A(PG8_SA(1, 0), cA + kstepA, voffA); PG8_STAGE(PG8_SB(1, 1), cB + hstepB + kstepB, voffB);
        PG8_WAIT_V(6); PG8_BAR;
    }
    for (;;) {
        const bool has_next = S.next(ui + 1, nxt);
        const char* nA = has_next ? (const char*)g.A + (size_t)nxt.pm * tstep : cA; const char* nB = has_next ? (const char*)g.Bt + (size_t)nxt.pn * tstep : cB;
        static_assert(SP2, "this copy of the body keeps only the two-super-phase K-loop");
#define PG8_TRIP(t, W) do { \
            const bool last = ((t) == nt - 2); \
            const char* a1 = cA + (size_t)((t) + 1) * kstepA; \
            const char* a2 = last ? nA : cA + (size_t)((t) + 2) * kstepA; const char* b2 = last ? nB : cB + (size_t)((t) + 2) * kstepB; \
            const char* a3 = a2 + kstepA; const char* b3 = b2 + kstepB; \
            if (last && has_next) S.a_ready(nxt); \
              \
            PG8_LDB(B0, 0, 0); PG8_LDB(B1, 0, 1); PG8_SCHED; PG8_LDA(At, 0, 0); PG8_STAGE_A(PG8_SA(1, 1), a1 + hstepA, voffA); \
            W; PG8_WAIT_L(0); PG8_BAR; PG8_MMA(0, 0, At, B0); PG8_MMA(0, 1, At, B1); PG8_BAR; PG8_SCHED; \
              \
            PG8_LDA(At, 0, 1); PG8_STAGE(PG8_SB(0, 0), b2, voffB); PG8_STAGE(PG8_SB(0, 1), b2 + hstepB, voffB); PG8_STAGE_A(PG8_SA(0, 0), a2, voffA); \
            W; PG8_WAIT_L(0); PG8_BAR; PG8_MMA(1, 0, At, B0); PG8_MMA(1, 1, At, B1); PG8_BAR; PG8_SCHED; \
              \
            PG8_LDB(B0, 1, 0); PG8_LDB(B1, 1, 1); PG8_SCHED; PG8_LDA(At, 1, 0); PG8_STAGE_A(PG8_SA(0, 1), a2 + hstepA, voffA); \
            PG8_WAIT_V(8); PG8_WAIT_L(0); PG8_BAR; PG8_MMA(0, 0, At, B0); PG8_MMA(0, 1, At, B1); PG8_BAR; PG8_SCHED; \
              \
            PG8_LDA(At, 1, 1); PG8_STAGE(PG8_SB(1, 0), b3, voffB); PG8_STAGE(PG8_SB(1, 1), b3 + hstepB, voffB); PG8_STAGE_A(PG8_SA(1, 0), a3, voffA); \
            PG8_WAIT_V(8); PG8_WAIT_L(0); PG8_BAR; PG8_MMA(1, 0, At, B0); PG8_MMA(1, 1, At, B1); PG8_BAR; PG8_SCHED; } while (0)
#define PG8_WAIT_W(z) asm volatile("s_cmp_eq_u32 %0, 0\n\ts_cbranch_scc1 .Lpg8r%=\n\ts_waitcnt vmcnt(8)\n\ts_branch .Lpg8d%=\n.Lpg8r%=:\n\ts_waitcnt vmcnt(%1)\n.Lpg8d%=:" :: "s"(z), "n"(8 + Epi::MIN_VMEM) : "memory", "scc")
        if constexpr (KSCALE) { int t = 0;
            for (int seg = 0; seg < 8; ++seg) { const int tend = (seg == 0) ? 8 : (seg == 7) ? nt : 8 + 2 * seg;
                for (; t < tend; t += 2) { const int z_ = __builtin_amdgcn_readfirstlane(t + (ui == 0 ? 1 : 0)); PG8_TRIP(t, PG8_WAIT_W(z_)); }
                PG8_RESCALE(seg, ui & 1); } }
        else if constexpr (Epi::MIN_VMEM > 0) { for (int t = 0; t < nt; t += 2) { const int z_ = __builtin_amdgcn_readfirstlane(t + (ui == 0 ? 1 : 0)); PG8_TRIP(t, PG8_WAIT_W(z_)); } }
        else { for (int t = 0; t < nt; t += 2) { PG8_TRIP(t, PG8_WAIT_V(8)); } }
#undef PG8_WAIT_W
#undef PG8_TRIP
        if constexpr (ALIGN_EPI) { if (wr == 0) PG8_BAR; }
        if constexpr (!Epi::AFTER_DRAIN) { const int le_ = lane_id(); E(acc, cur, wr, wc, le_ & 15, le_ >> 4); S.done(cur); }
        if (!has_next) break;
#pragma unroll
        for (int a = 0; a < 2; ++a)
#pragma unroll
            for (int b = 0; b < 2; ++b)
#pragma unroll
                for (int m = 0; m < 4; ++m)
#pragma unroll
                    for (int n = 0; n < 2; ++n) { acc[a][b][m][n] = (f32x4){0.f, 0.f, 0.f, 0.f}; asm volatile("" : "+v"(acc[a][b][m][n])); }
        cur = nxt; cA = nA; cB = nB; ++ui; PG8_LANE_OFFS();
        if constexpr (KSCALE) PG8_KTAB_DMA(cur.pm, ui & 1);
        if constexpr (ALIGN_EPI) { if (wr == 1) PG8_BAR; }
    }
    PG8_WAIT_V(0);
    if constexpr (!ALIGN_EPI) { if (wr == 0) PG8_BAR; }
    PG8_BAR;
    if constexpr (Epi::AFTER_DRAIN) { const int le_ = lane_id(); E.fused(acc, cur, wr, wc, le_ & 15, le_ >> 4, lds, wid, le_); S.done(cur); }
#undef PG8_KTAB_DMA
#undef PG8_RESCALE
#undef PG8_SA
#undef PG8_SB
#undef PG8_STAGE
#undef PG8_LANE_OFFS
#undef PG8_STAGE_A
#undef PG8_LDA
#undef PG8_LDB
#undef PG8_MMA
#undef PG8_WAIT_V
#undef PG8_WAIT_L
#undef PG8_BAR
#undef PG8_SCHED
}
}
#define GAS __attribute__((address_space(1)))
#define LAS __attribute__((address_space(3)))
typedef unsigned short bf16;
typedef unsigned v4u __attribute__((ext_vector_type(4)));
typedef float f32x4 __attribute__((ext_vector_type(4)));
typedef short bf16x8 __attribute__((ext_vector_type(8)));
typedef GAS unsigned gu32;
typedef GAS unsigned long long gu64;
#define RLX_AGENT __ATOMIC_RELAXED, __HIP_MEMORY_SCOPE_AGENT
#define LDS_WAIT() asm volatile("s_waitcnt lgkmcnt(0)" ::: "memory")
#define VM_WAIT() asm volatile("s_waitcnt vmcnt(0)" ::: "memory")
__device__ __forceinline__ unsigned long long rt() { return __builtin_amdgcn_s_memrealtime(); }
__device__ __forceinline__ unsigned f2bf(float f) { unsigned u = __builtin_bit_cast(unsigned, f); return (u + 0x7fffu + ((u >> 16) & 1u)) >> 16; }
__device__ __forceinline__ unsigned pk2(float lo, float hi) { return f2bf(lo) | (f2bf(hi) << 16); }

#define XB_TMO      128
#define XB_XCNT(j)  (256  + 64 * (j))
#define XB_XSUB(j)  (1280 + 64 * (j))
#define XB_XGEN(j)  (2304 + 64 * (j))
#define XB_TOP      3328
#define XB_TOPGEN   3392
#define XCD_BAR_WORDS 3456
#define XB_SPIN_CAP (1u << 18)

__device__ __forceinline__ unsigned xb_ld(unsigned* p)              { return __hip_atomic_load(p, __ATOMIC_RELAXED, __HIP_MEMORY_SCOPE_AGENT); }
__device__ __forceinline__ unsigned xb_add(unsigned* p, unsigned v) { return __hip_atomic_fetch_add(p, v, __ATOMIC_RELAXED, __HIP_MEMORY_SCOPE_AGENT); }
__device__ __forceinline__ unsigned xb_xcc_id() { return (unsigned)__builtin_amdgcn_s_getreg((3 << 11) | 20) & 0xFu; }
#define XB_SPIN(cond, bar) do { unsigned _sp = 0; while (cond) { __builtin_amdgcn_s_sleep(1); \
    if ((++_sp & 255u) == 0u) { if (xb_ld(&(bar)[XB_TMO])) break; if (_sp > XB_SPIN_CAP) { atomicAdd(&(bar)[XB_TMO], 1u); break; } } } } while (0)

struct XcdBarrier {
    unsigned* bar; unsigned x;
    volatile LAS unsigned* st;
};

__device__ __forceinline__ XcdBarrier xcd_barrier_post(unsigned* bar, volatile LAS unsigned* st, const bool t0  ) {
    XcdBarrier b; b.bar = bar; b.x = xb_xcc_id(); b.st = st;
    if (t0) (void)xb_add(&bar[XB_XCNT(b.x)], 1u);
    return b;
}
__device__ __forceinline__ void xcd_barrier_complete(unsigned* bar, unsigned x, unsigned& nloc, unsigned& nx) {
    const unsigned G = gridDim.x * gridDim.y * gridDim.z;
    unsigned sum, cnt, mine, sp = 0u;
    for (;;) {
        sum = 0u; cnt = 0u; mine = 0u;
#pragma unroll
        for (unsigned j = 0; j < 16; ++j) { const unsigned c = xb_ld(&bar[XB_XCNT(j)]); sum += c; cnt += (c > 0u) ? 1u : 0u; mine = (j == x) ? c : mine; }
        if (sum == G) break;
        __builtin_amdgcn_s_sleep(1);
        if ((++sp & 255u) == 0u) { if (xb_ld(&bar[XB_TMO])) break; if (sp > XB_SPIN_CAP) { atomicAdd(&bar[XB_TMO], 1u); break; } }
    }
    nloc = mine > 0u ? mine : 1u; nx = cnt > 0u ? cnt : 1u;
}

__device__ __forceinline__ void xcd_barrier(const XcdBarrier& b, const bool t0  ) {
    asm volatile("s_waitcnt vmcnt(0)" ::: "memory");
    __syncthreads();
    if (t0) {
        unsigned* bar = b.bar;
        __builtin_amdgcn_s_waitcnt(0);
        unsigned nloc = b.st[0], nx = b.st[1];
        if (nloc == 0u) { xcd_barrier_complete(bar, b.x, nloc, nx); b.st[0] = nloc; b.st[1] = nx; }
        const unsigned old = xb_add(&bar[XB_XSUB(b.x)], 1u);
        const unsigned gen = old / nloc;
        if (old + 1u == (gen + 1u) * nloc) {
            __builtin_amdgcn_fence(__ATOMIC_RELEASE, "agent");
            asm volatile("s_waitcnt vmcnt(0)" ::: "memory");
            const unsigned og = xb_add(&bar[XB_TOP], 1u);
            const unsigned tg = og / nx;
            if (og + 1u == (tg + 1u) * nx) xb_add(&bar[XB_TOPGEN], 1u);
            else XB_SPIN(xb_ld(&bar[XB_TOPGEN]) == tg, bar);
            __builtin_amdgcn_fence(__ATOMIC_ACQUIRE, "agent");
            xb_add(&bar[XB_XGEN(b.x)], 1u);
            asm volatile("s_waitcnt vmcnt(0)" ::: "memory");
        } else {
            XB_SPIN(xb_ld(&bar[XB_XGEN(b.x)]) == gen, bar);
            __builtin_amdgcn_fence(__ATOMIC_ACQUIRE, "agent");
            asm volatile("s_waitcnt vmcnt(0)" ::: "memory");
        }
    }
    __syncthreads();
}
namespace att {
typedef unsigned short bf16;
constexpr int NW = 8, QBLK = 32, KVBLK = 64, D = 128;
constexpr float SCALE = 0.088388347648318440f;
constexpr float THR = 8.f;
using bf16x8 = __attribute__((ext_vector_type(8))) short;
using s16x4  = __attribute__((ext_vector_type(4))) short;
using f32x16 = __attribute__((ext_vector_type(16))) float;
using f32x8  = __attribute__((ext_vector_type(8))) float;
using u32x4  = __attribute__((ext_vector_type(4))) unsigned;
#define KSWZ(row, colB) ((row) * 256 + ((colB) ^ (((row) & 7) << 4)))
#define SBAR() __builtin_amdgcn_sched_barrier(0)
__device__ __forceinline__ int crow(int r, int hi) { return (r & 3) + 8 * (r >> 2) + 4 * hi; }
__device__ __forceinline__ unsigned cvtpk(float lo, float hi) {
  unsigned r; asm volatile("v_cvt_pk_bf16_f32 %0, %1, %2" : "=v"(r) : "v"(lo), "v"(hi)); return r;
}
__device__ __forceinline__ float ssq8(const u32x4 v) {
  float q = 0.f;
#pragma unroll
  for (int e = 0; e < 4; ++e) { const float a = __builtin_bit_cast(float, v[e] << 16), b = __builtin_bit_cast(float, v[e] & 0xffff0000u); q += a * a + b * b; }
  return q;
}
__device__ __forceinline__ void partialSM(f32x16& p0, f32x16& p1, float& m_reg, float& mn, float& alpha) {
  constexpr float C = SCALE * 1.4426950408889634f;
  float pmax = p0[0]; for (int r = 1; r < 16; ++r) pmax = fmaxf(pmax, p0[r]); for (int r = 0; r < 16; ++r) pmax = fmaxf(pmax, p1[r]);
  { auto rr = __builtin_amdgcn_permlane32_swap(__float_as_uint(pmax), __float_as_uint(pmax), false, false);
    pmax = fmaxf(__uint_as_float(rr[0]), __uint_as_float(rr[1])); }
  if (__builtin_expect(__all(pmax - m_reg <= THR / SCALE), 1)) { mn = m_reg; alpha = 1.f; }
  else { mn = fmaxf(m_reg, pmax); alpha = __builtin_amdgcn_exp2f((m_reg - mn) * C); m_reg = mn; }
  float mnC = -mn * C;
  for (int r = 0; r < 16; ++r) p0[r] = fmaf(p0[r], C, mnC); for (int r = 0; r < 16; ++r) p1[r] = fmaf(p1[r], C, mnC);
  for (int r = 0; r < 16; ++r) p0[r] = __builtin_amdgcn_exp2f(p0[r]);
}
__device__ __forceinline__ void boundedSM(f32x16& p0, f32x16& p1) {
  for (int r = 0; r < 16; ++r) p0[r] = __builtin_amdgcn_exp2f(p0[r]);
}
__device__ __forceinline__ void finishSM(f32x16& p0, f32x16& p1, float alpha, float& l_reg, bf16x8& pa0, bf16x8& pa1, bf16x8& pa2, bf16x8& pa3) {
  for (int r = 0; r < 16; ++r) p1[r] = __builtin_amdgcn_exp2f(p1[r]);
  float ps = 0; for (int r = 0; r < 16; ++r) ps += p0[r]; for (int r = 0; r < 16; ++r) ps += p1[r];
  { auto rr = __builtin_amdgcn_permlane32_swap(__float_as_uint(ps), __float_as_uint(ps), false, false);
    ps = __uint_as_float(rr[0]) + __uint_as_float(rr[1]); }
  l_reg = l_reg * alpha + ps;
#define PK4(P, BASE, OUT) do { unsigned a0 = cvtpk(P[BASE + 0], P[BASE + 1]), a1 = cvtpk(P[BASE + 2], P[BASE + 3]);   \
    unsigned b0 = cvtpk(P[BASE + 4], P[BASE + 5]), b1 = cvtpk(P[BASE + 6], P[BASE + 7]);                              \
    auto r0 = __builtin_amdgcn_permlane32_swap(a0, b0, false, false); auto r1 = __builtin_amdgcn_permlane32_swap(a1, b1, false, false); \
    u32x4 w = {r0[0], r1[0], r0[1], r1[1]}; OUT = *reinterpret_cast<bf16x8*>(&w); } while (0)
  PK4(p0, 0, pa0); PK4(p0, 8, pa1); PK4(p1, 0, pa2); PK4(p1, 8, pa3);
#undef PK4
}
__device__ __forceinline__ void partialSM1(f32x16& p0, float& m_reg, float& mn, float& alpha) {
  constexpr float C = SCALE * 1.4426950408889634f;
  float pmax = p0[0]; for (int r = 1; r < 16; ++r) pmax = fmaxf(pmax, p0[r]);
  { auto rr = __builtin_amdgcn_permlane32_swap(__float_as_uint(pmax), __float_as_uint(pmax), false, false);
    pmax = fmaxf(__uint_as_float(rr[0]), __uint_as_float(rr[1])); }
  if (__builtin_expect(__all(pmax - m_reg <= THR / SCALE), 1)) { mn = m_reg; alpha = 1.f; }
  else { mn = fmaxf(m_reg, pmax); alpha = __builtin_amdgcn_exp2f((m_reg - mn) * C); m_reg = mn; }
  float mnC = -mn * C;
  for (int r = 0; r < 16; ++r) p0[r] = fmaf(p0[r], C, mnC);
  for (int r = 0; r < 16; ++r) p0[r] = __builtin_amdgcn_exp2f(p0[r]);
}
__device__ __forceinline__ void finishSM1(f32x16& p0, float alpha, float& l_reg, bf16x8& pa0, bf16x8& pa1) {
  float ps = 0; for (int r = 0; r < 16; ++r) ps += p0[r];
  { auto rr = __builtin_amdgcn_permlane32_swap(__float_as_uint(ps), __float_as_uint(ps), false, false);
    ps = __uint_as_float(rr[0]) + __uint_as_float(rr[1]); }
  l_reg = l_reg * alpha + ps;
#define PK4(P, BASE, OUT) do { unsigned a0 = cvtpk(P[BASE + 0], P[BASE + 1]), a1 = cvtpk(P[BASE + 2], P[BASE + 3]);   \
    unsigned b0 = cvtpk(P[BASE + 4], P[BASE + 5]), b1 = cvtpk(P[BASE + 6], P[BASE + 7]);                              \
    auto r0 = __builtin_amdgcn_permlane32_swap(a0, b0, false, false); auto r1 = __builtin_amdgcn_permlane32_swap(a1, b1, false, false); \
    u32x4 w = {r0[0], r1[0], r0[1], r1[1]}; OUT = *reinterpret_cast<bf16x8*>(&w); } while (0)
  PK4(p0, 0, pa0); PK4(p0, 8, pa1);
#undef PK4
}
__device__ __forceinline__ void qkt(f32x16& p0, f32x16& p1, const bf16* Ks, const bf16x8* qr, int r32, int hi, float init = 0.f) {
  for (int r = 0; r < 16; ++r) { p0[r] = init; p1[r] = init; }
  for (int d0 = 0; d0 < 8; ++d0) { int cb = (d0 * 16 + hi * 8) * 2;
    bf16x8 b0 = *reinterpret_cast<const bf16x8*>((const char*)Ks + KSWZ(r32, cb));
    bf16x8 b1 = *reinterpret_cast<const bf16x8*>((const char*)Ks + KSWZ(32 + r32, cb));
    p0 = __builtin_amdgcn_mfma_f32_32x32x16_bf16(b0, qr[d0], p0, 0, 0, 0);
    p1 = __builtin_amdgcn_mfma_f32_32x32x16_bf16(b1, qr[d0], p1, 0, 0, 0); }
}
__device__ __forceinline__ int v_st(int k, int c) { const int kk = (k & ~0xC) | ((k & 4) << 1) | ((k & 8) >> 1); return ((kk >> 3) * 4 + (c >> 5)) * 512 + ((kk & 7) * 32 + (c & 31)) * 2; }
__device__ __forceinline__ int v_rd_base(int lane) { return ((lane & 3) << 3) | (((lane >> 2) & 3) << 6) | (((lane >> 4) & 1) << 5) | (((lane >> 5) & 1) << 8); }
constexpr int v_rd_off(int d0, int ks, int half) { return d0 * 512 + ks * 4096 + half * 2048; }
template <int OFF> __device__ __forceinline__ s16x4 tr_read(int vb) {
  s16x4 r; asm volatile("ds_read_b64_tr_b16 %0, %1 offset:%2" : "=&v"(r) : "v"(vb), "i"(OFF) : "memory"); return r;
}
template <int D0> __device__ __forceinline__ void pv_one(f32x16& od, int vb, bf16x8 pa0, bf16x8 pa1, bf16x8 pa2, bf16x8 pa3) {
  const s16x4 l0 = tr_read<v_rd_off(D0, 0, 0)>(vb), h0 = tr_read<v_rd_off(D0, 0, 1)>(vb), l1 = tr_read<v_rd_off(D0, 1, 0)>(vb), h1 = tr_read<v_rd_off(D0, 1, 1)>(vb);
  const s16x4 l2 = tr_read<v_rd_off(D0, 2, 0)>(vb), h2 = tr_read<v_rd_off(D0, 2, 1)>(vb), l3 = tr_read<v_rd_off(D0, 3, 0)>(vb), h3 = tr_read<v_rd_off(D0, 3, 1)>(vb);
  asm volatile("s_waitcnt lgkmcnt(0)" ::: "memory"); SBAR();
#define PK(L, H) (bf16x8){L[0], L[1], L[2], L[3], H[0], H[1], H[2], H[3]}
  od = __builtin_amdgcn_mfma_f32_32x32x16_bf16(pa0, PK(l0, h0), od, 0, 0, 0);
  od = __builtin_amdgcn_mfma_f32_32x32x16_bf16(pa1, PK(l1, h1), od, 0, 0, 0);
  od = __builtin_amdgcn_mfma_f32_32x32x16_bf16(pa2, PK(l2, h2), od, 0, 0, 0);
  od = __builtin_amdgcn_mfma_f32_32x32x16_bf16(pa3, PK(l3, h3), od, 0, 0, 0);
#undef PK
}
__device__ __forceinline__ void pv_d0(f32x16* o, int vb, bf16x8 pa0, bf16x8 pa1, bf16x8 pa2, bf16x8 pa3) {
  pv_one<0>(o[0], vb, pa0, pa1, pa2, pa3); pv_one<1>(o[1], vb, pa0, pa1, pa2, pa3); pv_one<2>(o[2], vb, pa0, pa1, pa2, pa3); pv_one<3>(o[3], vb, pa0, pa1, pa2, pa3);
}

__device__ __forceinline__ void qkt32(f32x16& p0, const bf16* Ks, const bf16x8* qr, int krow, int hi) {
  for (int r = 0; r < 16; ++r) p0[r] = 0.f;
  for (int d0 = 0; d0 < 8; ++d0) { int cb = (d0 * 16 + hi * 8) * 2;
    bf16x8 b0 = *reinterpret_cast<const bf16x8*>((const char*)Ks + KSWZ(krow, cb));
    p0 = __builtin_amdgcn_mfma_f32_32x32x16_bf16(b0, qr[d0], p0, 0, 0, 0); }
}
template <int D0> __device__ __forceinline__ void pv_one2(f32x16& od, int vb, bf16x8 pa0, bf16x8 pa1) {
  const s16x4 l0 = tr_read<v_rd_off(D0, 0, 0)>(vb), h0 = tr_read<v_rd_off(D0, 0, 1)>(vb), l1 = tr_read<v_rd_off(D0, 1, 0)>(vb), h1 = tr_read<v_rd_off(D0, 1, 1)>(vb);
  asm volatile("s_waitcnt lgkmcnt(0)" ::: "memory"); SBAR();
#define PK(L, H) (bf16x8){L[0], L[1], L[2], L[3], H[0], H[1], H[2], H[3]}
  od = __builtin_amdgcn_mfma_f32_32x32x16_bf16(pa0, PK(l0, h0), od, 0, 0, 0);
  od = __builtin_amdgcn_mfma_f32_32x32x16_bf16(pa1, PK(l1, h1), od, 0, 0, 0);
#undef PK
}
__device__ __forceinline__ void pv_d0h(f32x16* o, int vb, bf16x8 pa0, bf16x8 pa1) {
  pv_one2<0>(o[0], vb, pa0, pa1); pv_one2<1>(o[1], vb, pa0, pa1); pv_one2<2>(o[2], vb, pa0, pa1); pv_one2<3>(o[3], vb, pa0, pa1);
}

constexpr size_t SHM_V = KVBLK * D * 2, SHM_K = KVBLK * D * 2, SHM_ATTN = 2 * SHM_V + 2 * SHM_K + NW * 64 * 4;
constexpr float NEG_INF = -__builtin_inff();
constexpr int OSTAGE_OFF = 73728;

#ifndef MK_PREFETCH_UNIT
#define MK_PREFETCH_UNIT 0
#endif
struct Pre { bf16x8 qr[8]; bf16x8 vs0, vs1, ks0, ks1; };
template <class Cfg, int SD = 2  ,
          bool BOUNDED = false  >
__device__ __forceinline__ void attn_unit(const Cfg& cfg, char* lds, const int wid  , Pre& pre, const bool have_pre  , const Cfg* nxt  ) {
  const int lane = lane_id(), tid = wid * 64 + lane, r32 = lane & 31, hi = lane >> 5;
  bf16* V_lds = (bf16*)lds; bf16* K_lds = (bf16*)(lds + 2 * SHM_V);
  float* ws = (float*)(lds + 2 * SHM_V + 2 * SHM_K) + wid * 64; float* li_l = ws; float* al_l = ws + 32;
  float m_reg = -1e30f, l_reg = 0; f32x16 o[4] = {}; bf16x8 qr[8];
  const bf16* Qw = cfg.proj + cfg.q_off(wid * QBLK + r32) + hi * 8;
  if (have_pre) {
#pragma unroll
    for (int d0 = 0; d0 < 8; ++d0) qr[d0] = pre.qr[d0];
  } else {
#pragma unroll
    for (int d0 = 0; d0 < 8; ++d0) qr[d0] = *reinterpret_cast<const bf16x8*>(Qw + d0 * 16);
  }
  const int sr = tid >> 4, sc = (tid & 15) * 8, vst0 = v_st(sr, sc), vst1 = v_st(32 + sr, sc);
  const int vb0 = (int)(uintptr_t)V_lds + v_rd_base(lane);
  struct { bf16x8 vs0, vs1, ks0, ks1; } sr_[SD];
#define SLOAD(i, t) do { const unsigned o0_ = cfg.kv_off((t), sr) + sc, o1_ = cfg.kv_off((t), 32 + sr) + sc; \
    sr_[i].vs0 = *reinterpret_cast<const bf16x8*>(cfg.proj + cfg.vcol + o0_); sr_[i].vs1 = *reinterpret_cast<const bf16x8*>(cfg.proj + cfg.vcol + o1_); \
    sr_[i].ks0 = *reinterpret_cast<const bf16x8*>(cfg.proj + cfg.kcol + o0_); sr_[i].ks1 = *reinterpret_cast<const bf16x8*>(cfg.proj + cfg.kcol + o1_); } while (0)
#define SWRITE(b, i) do { *(bf16x8*)((char*)V_lds + (b) * SHM_V + vst0) = sr_[i].vs0;          \
    *(bf16x8*)((char*)V_lds + (b) * SHM_V + vst1) = sr_[i].vs1; int kc = sc * 2;               \
    *(bf16x8*)((char*)K_lds + (b) * SHM_K + KSWZ(sr, kc)) = sr_[i].ks0;                       \
    *(bf16x8*)((char*)K_lds + (b) * SHM_K + KSWZ(32 + sr, kc)) = sr_[i].ks1; } while (0)
#define SWAIT() do { if constexpr (SD == 2) asm volatile("s_waitcnt vmcnt(4)" ::: "memory"); else asm volatile("s_waitcnt vmcnt(0)" ::: "memory"); } while (0)
#define RESC(a) do { if (!BOUNDED && __any((a) < 1.f)) { if (hi == 0) al_l[r32] = (a); asm volatile("s_waitcnt lgkmcnt(0)" ::: "memory"); \
    for (int d = 0; d < 4; ++d) for (int r = 0; r < 16; ++r) o[d][r] *= al_l[crow(r, hi)]; } } while (0)
#define QK(P0, P1, KB, T, MN, AL) do { if (cfg.active((T), wid)) { qkt(P0, P1, (KB), qr, r32, hi, BOUNDED ? cfg.negm0C : 0.f); cfg.mask(P0, P1, (T), wid, r32, hi); if constexpr (BOUNDED) { boundedSM(P0, P1); AL = 1.f; } else partialSM(P0, P1, m_reg, MN, AL); } else { AL = 1.f; } } while (0)
#define QK1(P0, P1, KB, T) do { if (cfg.active((T), wid)) { qkt(P0, P1, (KB), qr, r32, hi, BOUNDED ? cfg.negm0C : 0.f); cfg.mask(P0, P1, (T), wid, r32, hi); } } while (0)
#define PSM(P0, P1, T, MN, AL) do { if (cfg.active((T), wid)) { if constexpr (BOUNDED) { boundedSM(P0, P1); AL = 1.f; } else partialSM(P0, P1, m_reg, MN, AL); } else { AL = 1.f; } } while (0)
#define FPV(P0, P1, AL, VB, T) do { if (cfg.active((T), wid)) { finishSM(P0, P1, AL, l_reg, pa0, pa1, pa2, pa3); SBAR(); pv_d0(o, (VB), pa0, pa1, pa2, pa3); } } while (0)
  f32x16 pA0, pA1, pB0, pB1; float mnA, mnB, alA, alB; bf16x8 pa0, pa1, pa2, pa3; const int NT = Cfg::NT;
  constexpr int SE = 0, SO = SD - 1;
  if (have_pre) { sr_[SE].vs0 = pre.vs0; sr_[SE].vs1 = pre.vs1; sr_[SE].ks0 = pre.ks0; sr_[SE].ks1 = pre.ks1; } else SLOAD(SE, 0);
  asm volatile("s_waitcnt vmcnt(0)" ::: "memory"); SWRITE(0, SE); __syncthreads();
  QK(pA0, pA1, K_lds, 0, mnA, alA);
  SLOAD(SO, 1); if constexpr (SD == 2) { if (2 < NT) SLOAD(SE, 2); }
  SWAIT(); SWRITE(1, SO); __syncthreads();
  for (int j = 1; j + 1 < NT; j += 2) {
    SBAR(); QK1(pB0, pB1, (bf16*)((char*)K_lds + SHM_K), j);
    if (cfg.active(j - 1, wid)) { finishSM(pA0, pA1, alA, l_reg, pa0, pa1, pa2, pa3); } SBAR();
    SLOAD(SO, j + SD); SBAR();
    if (cfg.active(j - 1, wid)) { pv_d0(o, vb0, pa0, pa1, pa2, pa3); }
    PSM(pB0, pB1, j, mnB, alB);
    __syncthreads(); SWAIT(); SWRITE(0, SE);
    RESC(alB); __syncthreads();
    SBAR(); QK1(pA0, pA1, K_lds, j + 1);
    if (cfg.active(j, wid)) { finishSM(pB0, pB1, alB, l_reg, pa0, pa1, pa2, pa3); } SBAR();
    if (SD == 1 || j + 3 < NT) SLOAD(SE, j + 1 + SD); SBAR();
    if (cfg.active(j, wid)) { pv_d0(o, vb0 + (int)SHM_V, pa0, pa1, pa2, pa3); }
    PSM(pA0, pA1, j + 1, mnA, alA);
    __syncthreads(); SWAIT(); SWRITE(1, SO);
    RESC(alA); __syncthreads();
  }
  SBAR(); QK1(pB0, pB1, (bf16*)((char*)K_lds + SHM_K), NT - 1);
  if (cfg.active(NT - 2, wid)) { finishSM(pA0, pA1, alA, l_reg, pa0, pa1, pa2, pa3); SBAR(); pv_d0(o, vb0, pa0, pa1, pa2, pa3); }
  PSM(pB0, pB1, NT - 1, mnB, alB);
  __syncthreads(); RESC(alB);
  if (cfg.active(NT - 1, wid)) { finishSM(pB0, pB1, alB, l_reg, pa0, pa1, pa2, pa3); SBAR(); pv_d0(o, vb0 + (int)SHM_V, pa0, pa1, pa2, pa3); }
  if (hi == 0) li_l[r32] = l_reg; asm volatile("s_waitcnt lgkmcnt(0)" ::: "memory");
  if (Cfg::HAS_LSE) { if (hi == 0) cfg.store_lse(wid * QBLK + r32, m_reg * SCALE + __logf(l_reg)); }
  if (MK_PREFETCH_UNIT) {
    const bf16* Qn = nxt->proj + nxt->q_off(wid * QBLK + r32) + hi * 8;
#pragma unroll
    for (int d0 = 0; d0 < 8; ++d0) pre.qr[d0] = *reinterpret_cast<const bf16x8*>(Qn + d0 * 16);
    const unsigned o0_ = nxt->kv_off(0, sr) + sc, o1_ = nxt->kv_off(0, 32 + sr) + sc;
    pre.vs0 = *reinterpret_cast<const bf16x8*>(nxt->proj + nxt->vcol + o0_); pre.vs1 = *reinterpret_cast<const bf16x8*>(nxt->proj + nxt->vcol + o1_);
    pre.ks0 = *reinterpret_cast<const bf16x8*>(nxt->proj + nxt->kcol + o0_); pre.ks1 = *reinterpret_cast<const bf16x8*>(nxt->proj + nxt->kcol + o1_);
    asm volatile("" ::: "memory");
  }
  { bf16* stg = (bf16*)(lds + OSTAGE_OFF) + wid * 2048;
#pragma unroll
    for (int hh = 0; hh < 2; ++hh) {
#pragma unroll
      for (int r8 = 0; r8 < 8; ++r8) { const int r = 8 * hh + r8; const int orow = crow(r, hi); const float rl = __builtin_amdgcn_rcpf(li_l[orow]);
#pragma unroll
        for (int d0 = 0; d0 < 4; ++d0) stg[(orow & 15) * 128 + d0 * 32 + r32] = (bf16)(cvtpk(o[d0][r] * rl, 0.f) & 0xffffu); }
      asm volatile("s_waitcnt lgkmcnt(0)" ::: "memory");
#pragma unroll
      for (int j = 0; j < 4; ++j) { const int row = (lane >> 4) + 4 * j, ch = lane & 15; const u32x4 v = *(const u32x4*)(stg + row * 128 + ch * 8);
        const unsigned oo_ = cfg.o_off(wid * QBLK + 16 * hh + row); *(u32x4*)(cfg.obuf + oo_ + ch * 8) = v;
        if (MK_MIXFOLD) { float q_ = ssq8(v); q_ += xshfl<1>(q_); q_ += xshfl<2>(q_); q_ += xshfl<4>(q_); q_ += xshfl<8>(q_);
          if (ch == 0) ((float*)((char*)cfg.obuf + MK_SSQ_FROM_O_BYTES))[(oo_ >> 11) * 16 + ((oo_ & 2047u) >> 7)] = q_; } }
      asm volatile("s_waitcnt lgkmcnt(0)" ::: "memory");
    } }
  __syncthreads();
#undef SLOAD
#undef SWRITE
#undef SWAIT
#undef RESC
#undef QK
#undef QK1
#undef PSM
#undef FPV
}

template <class Cfg, bool BOUNDED = false>
__device__ __forceinline__ void attn_unit3(const Cfg& cfg, char* lds, const int wid  , Pre& pre, const bool have_pre  , const Cfg* nxt  ) {
  const int lane = lane_id(), tid = wid * 64 + lane, r32 = lane & 31, hi = lane >> 5;
  constexpr int SD = 2;
  bf16* V_lds = (bf16*)lds; bf16* K_lds = (bf16*)(lds + 3 * SHM_V);
  float* ws = (float*)(lds + 3 * SHM_V + 3 * SHM_K) + wid * 64; float* li_l = ws; float* al_l = ws + 32;
  float m_reg = -1e30f, l_reg = 0; f32x16 o[4] = {}; bf16x8 qr[8];
  const bf16* Qw = cfg.proj + cfg.q_off(wid * QBLK + r32) + hi * 8;
  if (have_pre) {
#pragma unroll
    for (int d0 = 0; d0 < 8; ++d0) qr[d0] = pre.qr[d0];
  } else {
#pragma unroll
    for (int d0 = 0; d0 < 8; ++d0) qr[d0] = *reinterpret_cast<const bf16x8*>(Qw + d0 * 16);
  }
  const int sr = tid >> 4, sc = (tid & 15) * 8, vst0 = v_st(sr, sc), vst1 = v_st(32 + sr, sc);
  const int vb0 = (int)(uintptr_t)V_lds + v_rd_base(lane);
  struct { bf16x8 vs0, vs1, ks0, ks1; } sr_[SD];
#define SLOAD(i, t) do { const unsigned o0_ = cfg.kv_off((t), sr) + sc, o1_ = cfg.kv_off((t), 32 + sr) + sc; \
    sr_[i].vs0 = *reinterpret_cast<const bf16x8*>(cfg.proj + cfg.vcol + o0_); sr_[i].vs1 = *reinterpret_cast<const bf16x8*>(cfg.proj + cfg.vcol + o1_); \
    sr_[i].ks0 = *reinterpret_cast<const bf16x8*>(cfg.proj + cfg.kcol + o0_); sr_[i].ks1 = *reinterpret_cast<const bf16x8*>(cfg.proj + cfg.kcol + o1_); } while (0)
#define SWRITE(b, i) do { *(bf16x8*)((char*)V_lds + (b) * SHM_V + vst0) = sr_[i].vs0;          \
    *(bf16x8*)((char*)V_lds + (b) * SHM_V + vst1) = sr_[i].vs1; int kc = sc * 2;               \
    *(bf16x8*)((char*)K_lds + (b) * SHM_K + KSWZ(sr, kc)) = sr_[i].ks0;                       \
    *(bf16x8*)((char*)K_lds + (b) * SHM_K + KSWZ(32 + sr, kc)) = sr_[i].ks1; } while (0)
#define SWAIT() do { if constexpr (SD == 2) asm volatile("s_waitcnt vmcnt(4)" ::: "memory"); else asm volatile("s_waitcnt vmcnt(0)" ::: "memory"); } while (0)
#define RESC(a) do { if (!BOUNDED && __any((a) < 1.f)) { if (hi == 0) al_l[r32] = (a); asm volatile("s_waitcnt lgkmcnt(0)" ::: "memory"); \
    for (int d = 0; d < 4; ++d) for (int r = 0; r < 16; ++r) o[d][r] *= al_l[crow(r, hi)]; } } while (0)
#define QK(P0, P1, KB, T, MN, AL) do { if (cfg.active((T), wid)) { qkt(P0, P1, (KB), qr, r32, hi, BOUNDED ? cfg.negm0C : 0.f); cfg.mask(P0, P1, (T), wid, r32, hi); if constexpr (BOUNDED) { boundedSM(P0, P1); AL = 1.f; } else partialSM(P0, P1, m_reg, MN, AL); } else { AL = 1.f; } } while (0)
#define QK1(P0, P1, KB, T) do { if (cfg.active((T), wid)) { qkt(P0, P1, (KB), qr, r32, hi, BOUNDED ? cfg.negm0C : 0.f); cfg.mask(P0, P1, (T), wid, r32, hi); } } while (0)
#define PSM(P0, P1, T, MN, AL) do { if (cfg.active((T), wid)) { if constexpr (BOUNDED) { boundedSM(P0, P1); AL = 1.f; } else partialSM(P0, P1, m_reg, MN, AL); } else { AL = 1.f; } } while (0)
#define FPV(P0, P1, AL, VB, T) do { if (cfg.active((T), wid)) { finishSM(P0, P1, AL, l_reg, pa0, pa1, pa2, pa3); SBAR(); pv_d0(o, (VB), pa0, pa1, pa2, pa3); } } while (0)
  f32x16 pA0, pA1, pB0, pB1; float mnA, mnB, alA, alB; bf16x8 pa0, pa1, pa2, pa3; const int NT = Cfg::NT;
  constexpr int SE = 0, SO = SD - 1;
  if (have_pre) { sr_[SE].vs0 = pre.vs0; sr_[SE].vs1 = pre.vs1; sr_[SE].ks0 = pre.ks0; sr_[SE].ks1 = pre.ks1; } else SLOAD(SE, 0);
  asm volatile("s_waitcnt vmcnt(0)" ::: "memory"); SWRITE(0, SE); __syncthreads();
  QK(pA0, pA1, K_lds, 0, mnA, alA);
  SLOAD(SO, 1); if constexpr (SD == 2) { if (2 < NT) SLOAD(SE, 2); }
  SWAIT(); SWRITE(1, SO); __syncthreads();
  int bt = 1;
#define KB3(b_) ((bf16*)((char*)K_lds + (b_) * (int)SHM_K))
#define VB3(b_) (vb0 + (b_) * (int)SHM_V)
  for (int j = 1; j + 1 < NT; j += 2) {
    const int bn = (bt == 2) ? 0 : bt + 1, bm = (bt == 0) ? 2 : bt - 1;
    SBAR(); QK1(pB0, pB1, KB3(bt), j);
    if (cfg.active(j - 1, wid)) { finishSM(pA0, pA1, alA, l_reg, pa0, pa1, pa2, pa3); } SBAR();
    SLOAD(SO, j + SD); SBAR();
    if (cfg.active(j - 1, wid)) { pv_d0(o, VB3(bm), pa0, pa1, pa2, pa3); }
    PSM(pB0, pB1, j, mnB, alB);
    SWAIT(); SWRITE(bn, SE);
    RESC(alB); __syncthreads();
    SBAR(); QK1(pA0, pA1, KB3(bn), j + 1);
    if (cfg.active(j, wid)) { finishSM(pB0, pB1, alB, l_reg, pa0, pa1, pa2, pa3); } SBAR();
    if (j + 3 < NT) SLOAD(SE, j + 1 + SD); SBAR();
    if (cfg.active(j, wid)) { pv_d0(o, VB3(bt), pa0, pa1, pa2, pa3); }
    PSM(pA0, pA1, j + 1, mnA, alA);
    SWAIT(); SWRITE(bm, SO);
    RESC(alA); __syncthreads();
    bt = bm;
  }
  { const int bm = (bt == 0) ? 2 : bt - 1;
    SBAR(); QK1(pB0, pB1, KB3(bt), NT - 1);
    if (cfg.active(NT - 2, wid)) { finishSM(pA0, pA1, alA, l_reg, pa0, pa1, pa2, pa3); SBAR(); pv_d0(o, VB3(bm), pa0, pa1, pa2, pa3); }
    PSM(pB0, pB1, NT - 1, mnB, alB);
    RESC(alB);
    if (cfg.active(NT - 1, wid)) { finishSM(pB0, pB1, alB, l_reg, pa0, pa1, pa2, pa3); SBAR(); pv_d0(o, VB3(bt), pa0, pa1, pa2, pa3); } }
#undef KB3
#undef VB3
  if (hi == 0) li_l[r32] = l_reg; asm volatile("s_waitcnt lgkmcnt(0)" ::: "memory");
  if (Cfg::HAS_LSE) { if (hi == 0) cfg.store_lse(wid * QBLK + r32, m_reg * SCALE + __logf(l_reg)); }
  if (MK_PREFETCH_UNIT) {
    const bf16* Qn = nxt->proj + nxt->q_off(wid * QBLK + r32) + hi * 8;
#pragma unroll
    for (int d0 = 0; d0 < 8; ++d0) pre.qr[d0] = *reinterpret_cast<const bf16x8*>(Qn + d0 * 16);
    const unsigned o0_ = nxt->kv_off(0, sr) + sc, o1_ = nxt->kv_off(0, 32 + sr) + sc;
    pre.vs0 = *reinterpret_cast<const bf16x8*>(nxt->proj + nxt->vcol + o0_); pre.vs1 = *reinterpret_cast<const bf16x8*>(nxt->proj + nxt->vcol + o1_);
    pre.ks0 = *reinterpret_cast<const bf16x8*>(nxt->proj + nxt->kcol + o0_); pre.ks1 = *reinterpret_cast<const bf16x8*>(nxt->proj + nxt->kcol + o1_);
    asm volatile("" ::: "memory");
  }
  __syncthreads();
  { bf16* stg = (bf16*)lds + wid * 2048;
#pragma unroll
    for (int hh = 0; hh < 2; ++hh) {
#pragma unroll
      for (int r8 = 0; r8 < 8; ++r8) { const int r = 8 * hh + r8; const int orow = crow(r, hi); const float rl = __builtin_amdgcn_rcpf(li_l[orow]);
#pragma unroll
        for (int d0 = 0; d0 < 4; ++d0) stg[(orow & 15) * 128 + d0 * 32 + r32] = (bf16)(cvtpk(o[d0][r] * rl, 0.f) & 0xffffu); }
      asm volatile("s_waitcnt lgkmcnt(0)" ::: "memory");
#pragma unroll
      for (int j = 0; j < 4; ++j) { const int row = (lane >> 4) + 4 * j, ch = lane & 15; const u32x4 v = *(const u32x4*)(stg + row * 128 + ch * 8);
        const unsigned oo_ = cfg.o_off(wid * QBLK + 16 * hh + row); *(u32x4*)(cfg.obuf + oo_ + ch * 8) = v;
        if (MK_MIXFOLD) { float q_ = ssq8(v); q_ += xshfl<1>(q_); q_ += xshfl<2>(q_); q_ += xshfl<4>(q_); q_ += xshfl<8>(q_);
          if (ch == 0) ((float*)((char*)cfg.obuf + MK_SSQ_FROM_O_BYTES))[(oo_ >> 11) * 16 + ((oo_ & 2047u) >> 7)] = q_; } }
      asm volatile("s_waitcnt lgkmcnt(0)" ::: "memory");
    } }
  __syncthreads();
#undef SLOAD
#undef SWRITE
#undef SWAIT
#undef RESC
#undef QK
#undef QK1
#undef PSM
#undef FPV
}

template <class Cfg, int SD = 2>
__device__ __forceinline__ void attn_unit_h(const Cfg& cfg, char* lds, const int wid  , Pre& pre, const bool have_pre  , const Cfg* nxt  ) {
  const int lane = lane_id(), tid = wid * 64 + lane, r32 = lane & 31, hi = lane >> 5;
  bf16* V_lds = (bf16*)lds; bf16* K_lds = (bf16*)(lds + 2 * SHM_V);
  float* ws = (float*)(lds + 2 * SHM_V + 2 * SHM_K) + wid * 64; float* li_l = ws; float* al_l = ws + 32;
  float m_reg = -1e30f, l_reg = 0; f32x16 o[4] = {}; bf16x8 qr[8];
  const bf16* Qw = cfg.proj + cfg.q_off(wid * QBLK + r32) + hi * 8;
  if (have_pre) {
#pragma unroll
    for (int d0 = 0; d0 < 8; ++d0) qr[d0] = pre.qr[d0];
  } else {
#pragma unroll
    for (int d0 = 0; d0 < 8; ++d0) qr[d0] = *reinterpret_cast<const bf16x8*>(Qw + d0 * 16);
  }
  const int sr = tid >> 4, sc = (tid & 15) * 8, vst0 = v_st(sr, sc), vst1 = v_st(32 + sr, sc);
  const int krow = cfg.kwin(wid) + r32;
  const int Ga = (cfg.kwin(wid) >> 3) + hi;
  const int vb0 = (int)(uintptr_t)V_lds + (v_rd_base(lane) & ~256) + ((Ga >> 1) << 12) + ((Ga & 1) << 8);
  struct { bf16x8 vs0, vs1, ks0, ks1; } sr_[SD];
#define SLOAD(i, t) do { const unsigned o0_ = cfg.kv_off((t), sr) + sc, o1_ = cfg.kv_off((t), 32 + sr) + sc; \
    sr_[i].vs0 = *reinterpret_cast<const bf16x8*>(cfg.proj + cfg.vcol + o0_); sr_[i].vs1 = *reinterpret_cast<const bf16x8*>(cfg.proj + cfg.vcol + o1_); \
    sr_[i].ks0 = *reinterpret_cast<const bf16x8*>(cfg.proj + cfg.kcol + o0_); sr_[i].ks1 = *reinterpret_cast<const bf16x8*>(cfg.proj + cfg.kcol + o1_); } while (0)
#define SWRITE(b, i) do { *(bf16x8*)((char*)V_lds + (b) * SHM_V + vst0) = sr_[i].vs0;          \
    *(bf16x8*)((char*)V_lds + (b) * SHM_V + vst1) = sr_[i].vs1; int kc = sc * 2;               \
    *(bf16x8*)((char*)K_lds + (b) * SHM_K + KSWZ(sr, kc)) = sr_[i].ks0;                       \
    *(bf16x8*)((char*)K_lds + (b) * SHM_K + KSWZ(32 + sr, kc)) = sr_[i].ks1; } while (0)
#define SWAIT() do { if constexpr (SD == 2) asm volatile("s_waitcnt vmcnt(4)" ::: "memory"); else asm volatile("s_waitcnt vmcnt(0)" ::: "memory"); } while (0)
#define RESC(a) do { if (__any((a) < 1.f)) { if (hi == 0) al_l[r32] = (a); asm volatile("s_waitcnt lgkmcnt(0)" ::: "memory"); \
    for (int d = 0; d < 4; ++d) for (int r = 0; r < 16; ++r) o[d][r] *= al_l[crow(r, hi)]; } } while (0)
#define QK(P0, KB, T, MN, AL) do { if (cfg.active((T), wid)) { qkt32(P0, (KB), qr, krow, hi); cfg.mask16(P0, (T), wid, r32, hi); partialSM1(P0, m_reg, MN, AL); } else { AL = 1.f; } } while (0)
#define QK1(P0, KB, T) do { if (cfg.active((T), wid)) { qkt32(P0, (KB), qr, krow, hi); cfg.mask16(P0, (T), wid, r32, hi); } } while (0)
#define PSM(P0, T, MN, AL) do { if (cfg.active((T), wid)) { partialSM1(P0, m_reg, MN, AL); } else { AL = 1.f; } } while (0)
  f32x16 pA0, pB0; float mnA, mnB, alA, alB; bf16x8 pa0, pa1; const int NT = Cfg::NT;
  constexpr int SE = 0, SO = SD - 1;
  if (have_pre) { sr_[SE].vs0 = pre.vs0; sr_[SE].vs1 = pre.vs1; sr_[SE].ks0 = pre.ks0; sr_[SE].ks1 = pre.ks1; } else SLOAD(SE, 0);
  asm volatile("s_waitcnt vmcnt(0)" ::: "memory"); SWRITE(0, SE); __syncthreads();
  QK(pA0, K_lds, 0, mnA, alA);
  SLOAD(SO, 1); if constexpr (SD == 2) { if (2 < NT) SLOAD(SE, 2); }
  SWAIT(); SWRITE(1, SO); __syncthreads();
  for (int j = 1; j + 1 < NT; j += 2) {
    SBAR(); QK1(pB0, (bf16*)((char*)K_lds + SHM_K), j);
    if (cfg.active(j - 1, wid)) { finishSM1(pA0, alA, l_reg, pa0, pa1); } SBAR();
    SLOAD(SO, j + SD); SBAR();
    if (cfg.active(j - 1, wid)) { pv_d0h(o, vb0, pa0, pa1); }
    PSM(pB0, j, mnB, alB);
    __syncthreads(); SWAIT(); SWRITE(0, SE);
    RESC(alB); __syncthreads();
    SBAR(); QK1(pA0, K_lds, j + 1);
    if (cfg.active(j, wid)) { finishSM1(pB0, alB, l_reg, pa0, pa1); } SBAR();
    if (SD == 1 || j + 3 < NT) SLOAD(SE, j + 1 + SD); SBAR();
    if (cfg.active(j, wid)) { pv_d0h(o, vb0 + (int)SHM_V, pa0, pa1); }
    PSM(pA0, j + 1, mnA, alA);
    __syncthreads(); SWAIT(); SWRITE(1, SO);
    RESC(alA); __syncthreads();
  }
  SBAR(); QK1(pB0, (bf16*)((char*)K_lds + SHM_K), NT - 1);
  if (cfg.active(NT - 2, wid)) { finishSM1(pA0, alA, l_reg, pa0, pa1); SBAR(); pv_d0h(o, vb0, pa0, pa1); }
  PSM(pB0, NT - 1, mnB, alB);
  __syncthreads(); RESC(alB);
  if (cfg.active(NT - 1, wid)) { finishSM1(pB0, alB, l_reg, pa0, pa1); SBAR(); pv_d0h(o, vb0 + (int)SHM_V, pa0, pa1); }
  if (hi == 0) li_l[r32] = l_reg; asm volatile("s_waitcnt lgkmcnt(0)" ::: "memory");
  if (Cfg::HAS_LSE) { if (hi == 0) cfg.store_lse(wid * QBLK + r32, m_reg * SCALE + __logf(l_reg)); }
  if (MK_PREFETCH_UNIT) {
    const bf16* Qn = nxt->proj + nxt->q_off(wid * QBLK + r32) + hi * 8;
#pragma unroll
    for (int d0 = 0; d0 < 8; ++d0) pre.qr[d0] = *reinterpret_cast<const bf16x8*>(Qn + d0 * 16);
    const unsigned o0_ = nxt->kv_off(0, sr) + sc, o1_ = nxt->kv_off(0, 32 + sr) + sc;
    pre.vs0 = *reinterpret_cast<const bf16x8*>(nxt->proj + nxt->vcol + o0_); pre.vs1 = *reinterpret_cast<const bf16x8*>(nxt->proj + nxt->vcol + o1_);
    pre.ks0 = *reinterpret_cast<const bf16x8*>(nxt->proj + nxt->kcol + o0_); pre.ks1 = *reinterpret_cast<const bf16x8*>(nxt->proj + nxt->kcol + o1_);
    asm volatile("" ::: "memory");
  }
  { bf16* stg = (bf16*)(lds + OSTAGE_OFF) + wid * 2048;
#pragma unroll
    for (int hh = 0; hh < 2; ++hh) {
#pragma unroll
      for (int r8 = 0; r8 < 8; ++r8) { const int r = 8 * hh + r8; const int orow = crow(r, hi); const float rl = __builtin_amdgcn_rcpf(li_l[orow]);
#pragma unroll
        for (int d0 = 0; d0 < 4; ++d0) stg[(orow & 15) * 128 + d0 * 32 + r32] = (bf16)(cvtpk(o[d0][r] * rl, 0.f) & 0xffffu); }
      asm volatile("s_waitcnt lgkmcnt(0)" ::: "memory");
#pragma unroll
      for (int j = 0; j < 4; ++j) { const int row = (lane >> 4) + 4 * j, ch = lane & 15; const u32x4 v = *(const u32x4*)(stg + row * 128 + ch * 8);
        const unsigned oo_ = cfg.o_off(wid * QBLK + 16 * hh + row); *(u32x4*)(cfg.obuf + oo_ + ch * 8) = v;
        if (MK_MIXFOLD) { float q_ = ssq8(v); q_ += xshfl<1>(q_); q_ += xshfl<2>(q_); q_ += xshfl<4>(q_); q_ += xshfl<8>(q_);
          if (ch == 0) ((float*)((char*)cfg.obuf + MK_SSQ_FROM_O_BYTES))[(oo_ >> 11) * 16 + ((oo_ & 2047u) >> 7)] = q_; } }
      asm volatile("s_waitcnt lgkmcnt(0)" ::: "memory");
    } }
  __syncthreads();
#undef SLOAD
#undef SWRITE
#undef SWAIT
#undef RESC
#undef QK
#undef QK1
#undef PSM
}

template <class Cfg>
__device__ __forceinline__ void attn_unit_simple(const Cfg& cfg, char* lds, const int wid  ) {
  const int lane = lane_id(), tid = wid * 64 + lane, r32 = lane & 31, hi = lane >> 5;
  bf16* V_lds = (bf16*)lds; bf16* K_lds = (bf16*)(lds + 2 * SHM_V);
  float* ws = (float*)(lds + 2 * SHM_V + 2 * SHM_K) + wid * 64; float* li_l = ws; float* al_l = ws + 32;
  float m_reg = -1e30f, l_reg = 0; f32x16 o[4] = {}; bf16x8 qr[8];
  const bf16* Qw = cfg.proj + cfg.q_off(wid * QBLK + r32) + hi * 8;
#pragma unroll
  for (int d0 = 0; d0 < 8; ++d0) qr[d0] = *reinterpret_cast<const bf16x8*>(Qw + d0 * 16);
  const int sr = tid >> 4, sc = (tid & 15) * 8, vst0 = v_st(sr, sc), vst1 = v_st(32 + sr, sc);
  const int vb0 = (int)(uintptr_t)V_lds + v_rd_base(lane);
  bf16x8 vs0, vs1, ks0, ks1;
#define SLOAD1(t) do { const unsigned o0_ = cfg.kv_off((t), sr) + sc, o1_ = cfg.kv_off((t), 32 + sr) + sc; \
    vs0 = *reinterpret_cast<const bf16x8*>(cfg.proj + cfg.vcol + o0_); vs1 = *reinterpret_cast<const bf16x8*>(cfg.proj + cfg.vcol + o1_); \
    ks0 = *reinterpret_cast<const bf16x8*>(cfg.proj + cfg.kcol + o0_); ks1 = *reinterpret_cast<const bf16x8*>(cfg.proj + cfg.kcol + o1_); } while (0)
#define SWRITE1(b) do { *(bf16x8*)((char*)V_lds + (b) * SHM_V + vst0) = vs0; *(bf16x8*)((char*)V_lds + (b) * SHM_V + vst1) = vs1; const int kc = sc * 2; \
    *(bf16x8*)((char*)K_lds + (b) * SHM_K + KSWZ(sr, kc)) = ks0; *(bf16x8*)((char*)K_lds + (b) * SHM_K + KSWZ(32 + sr, kc)) = ks1; } while (0)
  const int tb = cfg.t_begin(), te = cfg.t_end();
  SLOAD1(tb); asm volatile("s_waitcnt vmcnt(0)" ::: "memory"); SWRITE1(tb & 1); __syncthreads();
  for (int t = tb; t < te; ++t) {
    const int b = t & 1;
    if (t + 1 < te) SLOAD1(t + 1);
    SBAR();
    if (cfg.active(t, wid)) {
      f32x16 p0, p1; float mn, al; bf16x8 pa0, pa1, pa2, pa3;
      qkt(p0, p1, (bf16*)((char*)K_lds + b * SHM_K), qr, r32, hi);
      cfg.mask(p0, p1, t, wid, r32, hi);
      partialSM(p0, p1, m_reg, mn, al);
      if (__any(al < 1.f)) { if (hi == 0) al_l[r32] = al; asm volatile("s_waitcnt lgkmcnt(0)" ::: "memory");
#pragma unroll
        for (int d = 0; d < 4; ++d)
#pragma unroll
          for (int r = 0; r < 16; ++r) o[d][r] *= al_l[crow(r, hi)]; }
      finishSM(p0, p1, al, l_reg, pa0, pa1, pa2, pa3); SBAR();
      pv_d0(o, vb0 + b * (int)SHM_V, pa0, pa1, pa2, pa3);
    }
    SBAR();
    if (t + 1 < te) { asm volatile("s_waitcnt vmcnt(0)" ::: "memory"); SWRITE1(b ^ 1); }
    __syncthreads();
  }
  if (hi == 0) li_l[r32] = l_reg; asm volatile("s_waitcnt lgkmcnt(0)" ::: "memory");
  if (Cfg::HAS_LSE) { if (hi == 0) cfg.store_lse(wid * QBLK + r32, m_reg * SCALE + __logf(l_reg)); }
  { bf16* stg = (bf16*)(lds + OSTAGE_OFF) + wid * 2048;
#pragma unroll
    for (int hh = 0; hh < 2; ++hh) {
#pragma unroll
      for (int r8 = 0; r8 < 8; ++r8) { const int r = 8 * hh + r8; const int orow = crow(r, hi); const float rl = __builtin_amdgcn_rcpf(li_l[orow]);
#pragma unroll
        for (int d0 = 0; d0 < 4; ++d0) stg[(orow & 15) * 128 + d0 * 32 + r32] = (bf16)(cvtpk(o[d0][r] * rl, 0.f) & 0xffffu); }
      asm volatile("s_waitcnt lgkmcnt(0)" ::: "memory");
#pragma unroll
      for (int j = 0; j < 4; ++j) { const int row = (lane >> 4) + 4 * j, ch = lane & 15; const u32x4 v = *(const u32x4*)(stg + row * 128 + ch * 8);
        const unsigned oo_ = cfg.o_off(wid * QBLK + 16 * hh + row); *(u32x4*)(cfg.obuf + oo_ + ch * 8) = v;
        if (MK_MIXFOLD) { float q_ = ssq8(v); q_ += xshfl<1>(q_); q_ += xshfl<2>(q_); q_ += xshfl<4>(q_); q_ += xshfl<8>(q_);
          if (ch == 0) ((float*)((char*)cfg.obuf + MK_SSQ_FROM_O_BYTES))[(oo_ >> 11) * 16 + ((oo_ & 2047u) >> 7)] = q_; } }
      asm volatile("s_waitcnt lgkmcnt(0)" ::: "memory");
    } }
  __syncthreads();
#undef SLOAD1
#undef SWRITE1
}

template <class Cfg>
__device__ __forceinline__ void attn_unit_wave(const Cfg& cfg, char* lds, const int wid  ) {
  const int lane = lane_id(), r32 = lane & 31, hi = lane >> 5;
  char* Vw = lds + wid * 8192;
  float* ws = (float*)(lds + 2 * SHM_V + 2 * SHM_K) + wid * 64; float* li_l = ws; float* al_l = ws + 32;
  float m_reg = -1e30f, l_reg = 0; f32x16 o[4] = {}; bf16x8 qr[8];
  const bf16* Qw = cfg.proj + cfg.q_off(wid * QBLK + r32) + hi * 8;
#pragma unroll
  for (int d0 = 0; d0 < 8; ++d0) qr[d0] = *reinterpret_cast<const bf16x8*>(Qw + d0 * 16);
  const int vkey = lane >> 4, vch = (lane & 15) * 8;
  const int vb0 = (int)(uintptr_t)Vw + v_rd_base(lane);
  const int tb = cfg.t_begin(), te = cfg.t_end();
  for (int t = tb; t < te; ++t) {
    if (!cfg.active(t, wid)) continue;
    bf16x8 kf[16], vf[8];
    { const bf16* k0p = cfg.proj + cfg.kcol + cfg.kv_off(t, r32) + hi * 8; const bf16* k1p = cfg.proj + cfg.kcol + cfg.kv_off(t, 32 + r32) + hi * 8;
#pragma unroll
      for (int d0 = 0; d0 < 8; ++d0) { kf[2 * d0] = *reinterpret_cast<const bf16x8*>(k0p + d0 * 16); kf[2 * d0 + 1] = *reinterpret_cast<const bf16x8*>(k1p + d0 * 16); } }
#pragma unroll
    for (int j = 0; j < 8; ++j) vf[j] = *reinterpret_cast<const bf16x8*>(cfg.proj + cfg.vcol + cfg.kv_off(t, vkey + 4 * j) + vch);
    f32x16 p0 = {}, p1 = {};
#pragma unroll
    for (int d0 = 0; d0 < 8; ++d0) { p0 = __builtin_amdgcn_mfma_f32_32x32x16_bf16(kf[2 * d0], qr[d0], p0, 0, 0, 0); p1 = __builtin_amdgcn_mfma_f32_32x32x16_bf16(kf[2 * d0 + 1], qr[d0], p1, 0, 0, 0); }
    cfg.mask(p0, p1, t, wid, r32, hi);
    float mn, al; bf16x8 pa0, pa1, pa2, pa3;
    partialSM(p0, p1, m_reg, mn, al);
    if (__any(al < 1.f)) { if (hi == 0) al_l[r32] = al; asm volatile("s_waitcnt lgkmcnt(0)" ::: "memory");
#pragma unroll
      for (int d = 0; d < 4; ++d)
#pragma unroll
        for (int r = 0; r < 16; ++r) o[d][r] *= al_l[crow(r, hi)]; }
    finishSM(p0, p1, al, l_reg, pa0, pa1, pa2, pa3);
#pragma unroll
    for (int j = 0; j < 8; ++j) *(bf16x8*)(Vw + v_st(vkey + 4 * j, vch)) = vf[j];
#pragma unroll
    for (int j = 0; j < 8; ++j) vf[j] = *reinterpret_cast<const bf16x8*>(cfg.proj + cfg.vcol + cfg.kv_off(t, 32 + vkey + 4 * j) + vch);
    asm volatile("s_waitcnt lgkmcnt(0)" ::: "memory"); SBAR();
#define PVW(D0, PA, PB) do { const s16x4 l0 = tr_read<v_rd_off(D0, 0, 0)>(vb0), h0 = tr_read<v_rd_off(D0, 0, 1)>(vb0), l1 = tr_read<v_rd_off(D0, 1, 0)>(vb0), h1 = tr_read<v_rd_off(D0, 1, 1)>(vb0); \
      asm volatile("s_waitcnt lgkmcnt(0)" ::: "memory"); SBAR(); \
      o[D0] = __builtin_amdgcn_mfma_f32_32x32x16_bf16(PA, ((bf16x8){l0[0], l0[1], l0[2], l0[3], h0[0], h0[1], h0[2], h0[3]}), o[D0], 0, 0, 0); \
      o[D0] = __builtin_amdgcn_mfma_f32_32x32x16_bf16(PB, ((bf16x8){l1[0], l1[1], l1[2], l1[3], h1[0], h1[1], h1[2], h1[3]}), o[D0], 0, 0, 0); } while (0)
    PVW(0, pa0, pa1); PVW(1, pa0, pa1); PVW(2, pa0, pa1); PVW(3, pa0, pa1);
    SBAR();
#pragma unroll
    for (int j = 0; j < 8; ++j) *(bf16x8*)(Vw + v_st(vkey + 4 * j, vch)) = vf[j];
    asm volatile("s_waitcnt lgkmcnt(0)" ::: "memory"); SBAR();
    PVW(0, pa2, pa3); PVW(1, pa2, pa3); PVW(2, pa2, pa3); PVW(3, pa2, pa3);
    SBAR();
#undef PVW
  }
  if (hi == 0) li_l[r32] = l_reg; asm volatile("s_waitcnt lgkmcnt(0)" ::: "memory");
  if (Cfg::HAS_LSE) { if (hi == 0) cfg.store_lse(wid * QBLK + r32, m_reg * SCALE + __logf(l_reg)); }
  { bf16* stg = (bf16*)(lds + OSTAGE_OFF) + wid * 2048;
#pragma unroll
    for (int hh = 0; hh < 2; ++hh) {
#pragma unroll
      for (int r8 = 0; r8 < 8; ++r8) { const int r = 8 * hh + r8; const int orow = crow(r, hi); const float rl = __builtin_amdgcn_rcpf(li_l[orow]);
#pragma unroll
        for (int d0 = 0; d0 < 4; ++d0) stg[(orow & 15) * 128 + d0 * 32 + r32] = (bf16)(cvtpk(o[d0][r] * rl, 0.f) & 0xffffu); }
      asm volatile("s_waitcnt lgkmcnt(0)" ::: "memory");
#pragma unroll
      for (int j = 0; j < 4; ++j) { const int row = (lane >> 4) + 4 * j, ch = lane & 15; const u32x4 v = *(const u32x4*)(stg + row * 128 + ch * 8);
        const unsigned oo_ = cfg.o_off(wid * QBLK + 16 * hh + row); *(u32x4*)(cfg.obuf + oo_ + ch * 8) = v;
        if (MK_MIXFOLD) { float q_ = ssq8(v); q_ += xshfl<1>(q_); q_ += xshfl<2>(q_); q_ += xshfl<4>(q_); q_ += xshfl<8>(q_);
          if (ch == 0) ((float*)((char*)cfg.obuf + MK_SSQ_FROM_O_BYTES))[(oo_ >> 11) * 16 + ((oo_ & 2047u) >> 7)] = q_; } }
      asm volatile("s_waitcnt lgkmcnt(0)" ::: "memory");
    } }
}
#undef KSWZ
#undef SBAR
}

constexpr int NWAVES = 8;
constexpr int NTOK = 49152, SEQ = 4096, NSEQ = 12, NTOK_P = 16384;
constexpr int DM = 2048, INW = 5632, DFF = 8192, NLAYER = 4, HD = 128;
constexpr int COL_AQ = 0, COL_AK = 512, COL_AV = 768, COL_BQ = 1024, COL_BK = 1792, COL_BV = 2560, COL_CQ = 3328, COL_CK = 4096, COL_CV = 4864;
constexpr int OCOL_A = 0, OCOL_B = 512, OCOL_C = 1280;
constexpr float DN_ALPHA = 1.681792830507429f;
constexpr float EPS = 1e-6f;
constexpr float ATT_SCALE = 0.08838834764831845f;
#ifndef MK_BF16_RES
#define MK_BF16_RES 1
#endif
#ifndef MK_FUSE_PREP
#define MK_FUSE_PREP 1
#endif
#ifndef MK_BOUNDED_A
#define MK_BOUNDED_A 1
#endif
#ifndef MK_FIN_PHASES
#define MK_FIN_PHASES 0
#endif
#ifndef MK_TILED_H
#define MK_TILED_H 1
#endif
#ifndef MK_WGM_RES
#define MK_WGM_RES 4
#endif

constexpr size_t MiB = 1u << 20;
constexpr size_t WS_CTL = 0, CTL_ZERO_BYTES = 1 * MiB;
constexpr size_t WS_ROPE_B = 1 * MiB;
constexpr size_t WS_ROPE_A = 3 * MiB;
constexpr size_t WS_LSE    = 4 * MiB;
constexpr size_t WS_WIN    = 6 * MiB;
constexpr size_t WS_WOUT   = 28 * MiB;
constexpr size_t WS_WFF1   = 36 * MiB;
constexpr size_t WS_WFF2   = 68 * MiB;
constexpr size_t WS_XB     = 100 * MiB;
constexpr size_t WS_PROJ   = 292 * MiB;
constexpr size_t WS_O      = 820 * MiB;
constexpr size_t WS_H      = 292 * MiB;
constexpr size_t WS_PART   = 1060 * MiB;
constexpr size_t WS_STAT   = 1072 * MiB;
constexpr size_t WS_VEC    = 1073 * MiB;
constexpr size_t WS_PSB    = 1074 * MiB;
constexpr size_t WS_END    = 1078 * MiB;
constexpr size_t WS_SSQ    = 1012 * MiB;
constexpr size_t WS_RAT    = 1016 * MiB;
static_assert(WS_SSQ == WS_O + (size_t)NTOK * DM * 2 && WS_SSQ - WS_O == (size_t)MK_SSQ_FROM_O_BYTES && WS_SSQ + (size_t)NTOK * 16 * 4 <= WS_RAT && WS_RAT + (size_t)NTOK * 8 * 4 <= WS_PART, "SSQ / RAT placement");
static_assert(WS_PROJ + (size_t)NTOK * INW * 2 == WS_O && WS_O + (size_t)NTOK * DM * 2 <= WS_END && WS_H + (size_t)NTOK * DFF * 2 == WS_PART && WS_XB + (size_t)NTOK * DM * 2 == WS_PROJ, "d_ws map");
constexpr int CW_TMO = 0, CW_CODE = 1, CW_BAR = 4096;
constexpr int CW_ATTQ = 16384;
constexpr int NCOLP = INW + DFF, VEC_CS_IN = 0, VEC_BW_IN = INW, VEC_CS_FF1 = 2 * INW, VEC_BW_FF1 = 2 * INW + DFF, VEC_ONES = 2 * INW + 2 * DFF, VEC_ZEROS = VEC_ONES + DM, VEC_M0 = VEC_ZEROS + DM;
static_assert((size_t)(VEC_M0 + 16) * 4 <= MiB && (size_t)2 * 32 * NCOLP * 4 <= 4 * MiB && (size_t)NTOK * 8 <= MiB, "small buffers");

constexpr int RING_OFF = 0, RING_BYTES = 131072;
constexpr int LDSCTL_OFF = RING_BYTES, MISC_OFF = LDSCTL_OFF + 320;
constexpr int XCH_OFF = RING_BYTES + 1024;
constexpr int KTAB_OFF = XCH_OFF;
constexpr int LDS_BYTES = 148480;
static_assert(MISC_OFF + 128 <= XCH_OFF && XCH_OFF + 8192 <= LDS_BYTES && KTAB_OFF + 16384 <= LDS_BYTES, "LDS map");

__host__ __device__ __forceinline__ int pinv_A(int c) { const int half = c >> 6, w = c & 63, hi = w >> 5, i = w & 31; return 8 * (half * 8 + (i >> 2)) + hi * 4 + (i & 3); }
__host__ __device__ __forceinline__ int pinv_B(int c) { const int hi = c >> 6, i = c & 63; return 8 * (i >> 2) + hi * 4 + (i & 3); }
__host__ __device__ __forceinline__ int proj_phys_col(int n) {
#if MK_FUSE_PREP
    if (n < COL_AV) return (n & ~127) + pinv_A(n & 127);
    if (n >= COL_BQ && n < COL_BV) return (n & ~127) + pinv_B(n & 127);
#endif
    return n;
}

struct Frame {
    LAS unsigned char* lds;
    volatile LAS unsigned* MISC;
    gu32* ctl;
    int wave;
    int vcu, G;
    int gw, NGW;
    const float *x_prompt, *x_sample, *w_in, *a_q_gain, *a_k_gain, *c_rel_bias, *mix_gain, *w_out, *ln1_g, *ln1_b, *w_ff1, *w_ff2, *ln2_g, *ln2_b;
    float* X;
    bf16 *Win_t, *Wout_t, *Wff1_t, *Wff2_t;
    bf16 *XB, *PROJ, *O, *H;
    float* LSE; float* ROPE_B; float* ROPE_A;
    pg8::f32x2* PART; pg8::f32x2* STAT; float* VEC; float* PSB;
    float* SSQ; float* RAT;
};

constexpr int CW_SB = 32768;
__device__ __forceinline__ void sb_arrive(Frame& F, int k) {
    asm volatile("s_waitcnt vmcnt(0)" ::: "memory");
    __syncthreads();
    if (F.wave == 0 && lane_id() == 0) {
        __builtin_amdgcn_fence(__ATOMIC_RELEASE, "agent");
        asm volatile("s_waitcnt vmcnt(0)" ::: "memory");
        (void)__hip_atomic_fetch_add(F.ctl + CW_SB + 64 * k, 1u, RLX_AGENT);
    }
}
__device__ __forceinline__ void sb_wait(Frame& F, int k) {
    if (F.wave == 0 && lane_id() == 0) {
        gu32* w = F.ctl + CW_SB + 64 * k; const unsigned want = (unsigned)F.G; unsigned sp = 0u;
        while (__hip_atomic_load(w, RLX_AGENT) < want) { __builtin_amdgcn_s_sleep(2);
            if ((++sp & 1023u) == 0u) { if (__hip_atomic_load(F.ctl + CW_TMO, RLX_AGENT) != 0u) break; if (sp > (1u << 22)) { __hip_atomic_store(F.ctl + CW_TMO, 1u, RLX_AGENT); break; } } }
        __builtin_amdgcn_fence(__ATOMIC_ACQUIRE, "agent");
        asm volatile("s_waitcnt vmcnt(0)" ::: "memory");
    }
    __syncthreads();
}

__device__ __forceinline__ float wave_sum(float v) {
    v += xshfl<1>(v); v += xshfl<2>(v); v += xshfl<4>(v); v += xshfl<8>(v); v += xshfl<16>(v); v = xsum32(v);
    return v;
}
__device__ __forceinline__ float wave_max(float v) {
    v = fmaxf(v, xshfl<1>(v)); v = fmaxf(v, xshfl<2>(v)); v = fmaxf(v, xshfl<4>(v)); v = fmaxf(v, xshfl<8>(v)); v = fmaxf(v, xshfl<16>(v)); v = xmax32(v);
    return v;
}
__device__ __forceinline__ float bf2f(unsigned short b) { return __builtin_bit_cast(float, (unsigned)b << 16); }
__device__ __forceinline__ float bflo(unsigned w) { return __builtin_bit_cast(float, w << 16); }
__device__ __forceinline__ float bfhi(unsigned w) { return __builtin_bit_cast(float, w & 0xffff0000u); }

struct ConvItem { const float* W; bf16* WT; const float* g; const float* bvec; float* ps; float* pb; int K, N, kb, n0, perm, pad_; };
struct ConvRegs { f32x4 wv[8]; float gk[8], bk[8]; };
__device__ __forceinline__ void conv_load(const ConvItem& it, ConvRegs& r, int lane) {
    const int k0 = 64 * it.kb, c = lane & 7;
#pragma unroll
    for (int i = 0; i < 8; ++i) r.wv[i] = *(const GAS f32x4*)(it.W + (size_t)(k0 + (lane >> 3) + 8 * i) * it.N + it.n0 + 4 * (lane & 7));
#pragma unroll
    for (int i = 0; i < 8; ++i) { r.gk[i] = it.g ? it.g[k0 + 8 * c + i] : 1.f; r.bk[i] = it.bvec ? it.bvec[k0 + 8 * c + i] : 0.f; }
}
__device__ __forceinline__ void conv_finish(const ConvItem& it, const ConvRegs& r, LAS float* scr, int lane) {
    const int k0 = 64 * it.kb, c = lane & 7;
#pragma unroll
    for (int i = 0; i < 8; ++i) { LAS float* d = scr + ((lane >> 3) + 8 * i) * 33 + 4 * (lane & 7); d[0] = r.wv[i].x; d[1] = r.wv[i].y; d[2] = r.wv[i].z; d[3] = r.wv[i].w; }
    LDS_WAIT(); asm volatile("" ::: "memory");
#pragma unroll
    for (int j = 0; j < 4; ++j) { const int n = (lane >> 3) + 8 * j; const LAS float* s = scr + (8 * c) * 33 + n;
        float w[8];
#pragma unroll
        for (int i = 0; i < 8; ++i) w[i] = s[i * 33];
        v4u o; o.x = pk2(w[0] * r.gk[0], w[1] * r.gk[1]); o.y = pk2(w[2] * r.gk[2], w[3] * r.gk[3]); o.z = pk2(w[4] * r.gk[4], w[5] * r.gk[5]); o.w = pk2(w[6] * r.gk[6], w[7] * r.gk[7]);
        const int nd = it.perm ? proj_phys_col(it.n0 + n) : it.n0 + n;
        if (MK_TILED_W) *(GAS v4u*)(it.WT + ((size_t)(nd >> 8) * (it.K >> 6) + (k0 >> 6)) * 16384 + (nd & 255) * 64 + 8 * c) = o;
        else *(GAS v4u*)(it.WT + (size_t)nd * it.K + k0 + 8 * c) = o;
        if (it.ps) { float sa = ((bflo(o.x) + bfhi(o.x)) + (bflo(o.y) + bfhi(o.y))) + ((bflo(o.z) + bfhi(o.z)) + (bflo(o.w) + bfhi(o.w)));
            float sb = 0.f;
#pragma unroll
            for (int i = 0; i < 8; ++i) sb += w[i] * r.bk[i];
            sa += xshfl<1>(sa); sa += xshfl<2>(sa); sa += xshfl<4>(sa); sb += xshfl<1>(sb); sb += xshfl<2>(sb); sb += xshfl<4>(sb);
            if (c == 0) { it.ps[(size_t)it.kb * NCOLP + nd] = sa; it.pb[(size_t)it.kb * NCOLP + nd] = sb; } } }
    LDS_WAIT(); asm volatile("" ::: "memory");
}
__device__ __forceinline__ void convert_weights(Frame& F, int l, int l_in, int which, int gw, int ngw) {
    const int lane = lane_id();
    LAS float* scr = (LAS float*)(F.lds + RING_OFF + F.wave * 16384);
    constexpr int I_IN = (DM / 64) * (INW / 32), I_OUT = (DM / 64) * (DM / 32), I_F1 = (DM / 64) * (DFF / 32), I_F2 = (DFF / 64) * (DM / 32);
    const int n_in = (which & 1) ? I_IN : 0, n_rest = (which & 2) ? (I_OUT + I_F1 + I_F2) : 0, n_all = n_in + n_rest;
    const float* w_in = F.w_in + (size_t)l_in * DM * INW; const float* w_out = F.w_out + (size_t)l * DM * DM;
    const float* w_ff1 = F.w_ff1 + (size_t)l * DM * DFF; const float* w_ff2 = F.w_ff2 + (size_t)l * DFF * DM;
    const float* gin = (l_in > 0) ? F.ln2_g + (size_t)(l_in - 1) * DM : nullptr; const float* bin = (l_in > 0) ? F.ln2_b + (size_t)(l_in - 1) * DM : nullptr;
    float* ps = F.PSB; float* pb = F.PSB + (size_t)32 * NCOLP;
#define CONV_MAKE(IT, idx) do { int r_ = (idx); \
        if (r_ < n_in) { const int nblk_ = INW / 32; IT.W = w_in; IT.WT = F.Win_t; IT.g = gin; IT.bvec = bin; IT.ps = ps; IT.pb = pb; IT.K = DM; IT.N = INW; IT.kb = r_ / nblk_; IT.n0 = 32 * (r_ % nblk_); IT.perm = 1; } \
        else { r_ -= n_in; \
          if (r_ < I_OUT) { const int nblk_ = DM / 32; IT.W = w_out; IT.WT = F.Wout_t; IT.g = MK_MIXFOLD ? F.mix_gain + (size_t)l * DM : nullptr; IT.bvec = nullptr; IT.ps = nullptr; IT.pb = nullptr; IT.K = DM; IT.N = DM; IT.kb = r_ / nblk_; IT.n0 = 32 * (r_ % nblk_); IT.perm = 0; } \
          else { r_ -= I_OUT; \
            if (r_ < I_F1) { const int nblk_ = DFF / 32; IT.W = w_ff1; IT.WT = F.Wff1_t; IT.g = F.ln1_g + (size_t)l * DM; IT.bvec = F.ln1_b + (size_t)l * DM; IT.ps = ps + INW; IT.pb = pb + INW; IT.K = DM; IT.N = DFF; IT.kb = r_ / nblk_; IT.n0 = 32 * (r_ % nblk_); IT.perm = 0; } \
            else { r_ -= I_F1; const int nblk_ = DM / 32; IT.W = w_ff2; IT.WT = F.Wff2_t; IT.g = nullptr; IT.bvec = nullptr; IT.ps = nullptr; IT.pb = nullptr; IT.K = DFF; IT.N = DM; IT.kb = r_ / nblk_; IT.n0 = 32 * (r_ % nblk_); IT.perm = 0; } } } } while (0)
    if (gw >= n_all) return;
    ConvItem cur; cur.pad_ = 0; ConvRegs rn; CONV_MAKE(cur, gw); conv_load(cur, rn, lane);
    for (int it = gw; it < n_all; it += ngw) {
        ConvRegs rc = rn; ConvItem nxt = cur; const bool has_next = it + ngw < n_all;
        if (has_next) { CONV_MAKE(nxt, it + ngw); conv_load(nxt, rn, lane); }
        asm volatile("" ::: "memory");
        conv_finish(cur, rc, scr, lane);
        cur = nxt;
    }
#undef CONV_MAKE
}
__device__ __forceinline__ void reduce_colsums(Frame& F, int which) {
    const int lane = lane_id();
    const float* ps = F.PSB; const float* pb = F.PSB + (size_t)32 * NCOLP;
    for (int n = F.gw * 64 + lane; n < NCOLP; n += F.NGW * 64) {
        const bool is_in = n < INW; if (is_in ? !(which & 1) : !(which & 2)) continue;
        float a = 0.f, c = 0.f;
#pragma unroll 8
        for (int kb = 0; kb < 32; ++kb) { a += ps[(size_t)kb * NCOLP + n]; c += pb[(size_t)kb * NCOLP + n]; }
        if (is_in) { F.VEC[VEC_CS_IN + n] = a; F.VEC[VEC_BW_IN + n] = c; } else { F.VEC[VEC_CS_FF1 + n - INW] = a; F.VEC[VEC_BW_FF1 + n - INW] = c; }
    }
}
__device__ __forceinline__ void phase_finalize_stats(Frame& F) {
    const int lane = lane_id();
    for (int m = F.gw * 64 + lane; m < NTOK; m += F.NGW * 64) {
        const f32x4* p = (const f32x4*)(F.PART + (size_t)m * 32); float s = 0.f, q = 0.f;
#pragma unroll
        for (int i = 0; i < 16; ++i) { const f32x4 v = p[i]; s += v.x + v.z; q += v.y + v.w; }
        const float mean = s * (1.f / DM); const float var = fmaxf(q * (1.f / DM) - mean * mean, 0.f);
        F.STAT[m] = (pg8::f32x2){mean, 1.f / sqrtf(var + EPS)};
    }
}
__device__ __forceinline__ void stats_panel(Frame& F, int pm) {
    const int tid = F.wave * 64 + lane_id(); const int row = pm * 256 + (tid >> 1), half = tid & 1;
    const f32x4* p = (const f32x4*)(F.PART + (size_t)row * 32 + half * 16); float s = 0.f, q = 0.f;
#pragma unroll
    for (int i = 0; i < 8; ++i) { const f32x4 v = p[i]; s += v.x + v.z; q += v.y + v.w; }
    s += xshfl<1>(s); q += xshfl<1>(q);
    const float mean = s * (1.f / DM); const float var = fmaxf(q * (1.f / DM) - mean * mean, 0.f);
    if (half == 0) F.STAT[row] = (pg8::f32x2){mean, 1.f / sqrtf(var + EPS)};
}
#define STATS_PREAMBLE(S) do { pg8::Unit u_; int last_ = -1; for (int i_ = 0; (S).next(i_, u_); ++i_) if (u_.pm != last_) { last_ = u_.pm; stats_panel(F, u_.pm); } \
        asm volatile("s_waitcnt vmcnt(0)" ::: "memory"); __syncthreads(); } while (0)

__device__ __forceinline__ void rat_panel(Frame& F, int pm) {
    const int tid = F.wave * 64 + lane_id(); const int row = pm * 256 + (tid >> 1), half = tid & 1;
    const f32x4* sp = (const f32x4*)(F.SSQ + (size_t)row * 16); const f32x4 s0 = sp[0], s1 = sp[1], s2 = sp[2], s3 = sp[3];
    const f32x4* lp = (const f32x4*)(F.LSE + (size_t)row * 8); const f32x4 l0 = lp[0], l1 = lp[1];
    const float sb[6] = {s1.x, s1.y, s1.z, s1.w, s2.x, s2.y}; const float ls[6] = {l0.x, l0.y, l0.z, l0.w, l1.x, l1.y};
    float al[6];
#pragma unroll
    for (int h = 0; h < 2; ++h) { const float a0 = ls[h], a1 = ls[2 + h], a2 = ls[4 + h]; const float mx = fmaxf(a0, fmaxf(a1, a2));
        const float e0 = __expf(a0 - mx), e1 = __expf(a1 - mx), e2 = __expf(a2 - mx); const float inv = 1.0f / (e0 + e1 + e2); al[h] = e0 * inv; al[2 + h] = e1 * inv; al[4 + h] = e2 * inv; }
    float wB = 0.f;
#pragma unroll
    for (int j = 0; j < 6; ++j) wB += al[j] * al[j] * sb[j];
    const float rA = 1.0f / sqrtf(((s0.x + s0.y) + (s0.z + s0.w)) * (1.0f / 512.f) + EPS), rB = 1.0f / sqrtf(wB * (1.0f / 768.f) + EPS);
    const float rC = 1.0f / sqrtf(((s2.z + s2.w) + (s3.x + s3.y) + (s3.z + s3.w)) * (1.0f / 768.f) + EPS);
    float sg[8]; sg[0] = rA; sg[7] = rC;
#pragma unroll
    for (int j = 0; j < 6; ++j) sg[1 + j] = fmaxf(al[j], 1e-20f) * rB;
    f32x4 o;
    if (half == 0) o = (f32x4){sg[0] / sg[1], sg[1] / sg[2], sg[2] / sg[3], sg[3] / sg[4]}; else o = (f32x4){sg[4] / sg[5], sg[5] / sg[6], sg[6] / sg[7], sg[7]};
    *(f32x4*)(F.RAT + (size_t)row * 8 + half * 4) = o;
}
#define RAT_PREAMBLE(S) do { pg8::Unit u_; int last_ = -1; for (int i_ = 0; (S).next(i_, u_); ++i_) if (u_.pm != last_) { last_ = u_.pm; rat_panel(F, u_.pm); } \
        asm volatile("s_waitcnt vmcnt(0)" ::: "memory"); __syncthreads(); } while (0)

__device__ __forceinline__ void sincos_d(double a, float& c, float& s) {
    const double k = __builtin_rint(a * 0.6366197723675814);
    const double r = __builtin_fma(-k, 1.5707963267948966, a) - k * 6.123233995736766e-17;
    const double r2 = r * r;
    double sp = -1.0 / 1307674368000.0;
    sp = sp * r2 + 1.0 / 6227020800.0; sp = sp * r2 - 1.0 / 39916800.0; sp = sp * r2 + 1.0 / 362880.0; sp = sp * r2 - 1.0 / 5040.0; sp = sp * r2 + 1.0 / 120.0; sp = sp * r2 - 1.0 / 6.0; sp = sp * r2 + 1.0;
    sp *= r;
    double cp = 1.0 / 20922789888000.0;
    cp = cp * r2 - 1.0 / 87178291200.0; cp = cp * r2 + 1.0 / 479001600.0; cp = cp * r2 - 1.0 / 3628800.0; cp = cp * r2 + 1.0 / 40320.0; cp = cp * r2 - 1.0 / 720.0; cp = cp * r2 + 1.0 / 24.0; cp = cp * r2 - 0.5; cp = cp * r2 + 1.0;
    const int q = ((int)k) & 3;
    const double ss = (q == 0) ? sp : (q == 1) ? cp : (q == 2) ? -sp : -cp;
    const double cc = (q == 0) ? cp : (q == 1) ? -sp : (q == 2) ? -cp : sp;
    c = (float)cc; s = (float)ss;
}

__device__ __forceinline__ void phase_prologue(Frame& F) {
    const int lane = lane_id();
    const int gt = F.gw * 64 + lane, NGT = F.NGW * 64;
    for (int e = gt; e < SEQ * 64 + 64 * 32; e += NGT) {
        int t, i; double inv = 1.0; float* dst;
        if (e < SEQ * 64) { t = e >> 6; i = e & 63; dst = F.ROPE_B + 2 * (size_t)e; for (int j = 0; j < i; ++j) inv *= 0.8659643233600653; }
        else { const int e2 = e - SEQ * 64; t = e2 >> 5; i = e2 & 31; dst = F.ROPE_A + 2 * (size_t)e2; for (int j = 0; j < 2 * i; ++j) inv *= 0.8659643233600653; }
        float c, s; sincos_d((double)t * inv, c, s);
        dst[0] = c; dst[1] = s;
    }
    { f32x4 xn[8];
#define PRO_LOAD(m_) do { const float* src_ = ((m_) < NTOK_P) ? F.x_prompt + (size_t)(m_) * DM : F.x_sample + (size_t)((m_) - NTOK_P) * DM; \
        _Pragma("unroll") for (int j = 0; j < 8; ++j) xn[j] = __builtin_nontemporal_load((const f32x4*)src_ + lane + 64 * j); } while (0)
      if (F.gw < NTOK) PRO_LOAD(F.gw);
      for (int m = F.gw; m < NTOK; m += F.NGW) {
        f32x4 xc[8];
#pragma unroll
        for (int j = 0; j < 8; ++j) xc[j] = xn[j];
        if (m + F.NGW < NTOK) PRO_LOAD(m + F.NGW);
        asm volatile("" ::: "memory");
        GAS unsigned long long* o8 = (GAS unsigned long long*)(F.XB + (size_t)m * DM) + lane;
#pragma unroll
        for (int j = 0; j < 8; ++j) o8[64 * j] = (unsigned long long)pk2(xc[j].x, xc[j].y) | ((unsigned long long)pk2(xc[j].z, xc[j].w) << 32);
        if (lane == 0) F.STAT[m] = (pg8::f32x2){0.f, 1.f};
      }
#undef PRO_LOAD
    }
    for (int e = gt; e < DM; e += NGT) { F.VEC[VEC_ONES + e] = 1.f; F.VEC[VEC_ZEROS + e] = 0.f; }
    if (F.gw < NLAYER) {
        const float* gq = F.a_q_gain + F.gw * HD; const float* gk = F.a_k_gain + F.gw * HD;
        const float mq = wave_max(fmaxf(fabsf(gq[2 * lane]), fabsf(gq[2 * lane + 1]))), mk = wave_max(fmaxf(fabsf(gk[2 * lane]), fabsf(gk[2 * lane + 1])));
        if (lane == 0) F.VEC[VEC_M0 + F.gw] = 128.f * mq * mk * 1.05f; }
    for (int e = gt; e < 2 * INW; e += NGT) F.VEC[VEC_CS_IN + e] = 0.f;
    convert_weights(F, 0, 0, 1, F.gw, F.NGW);
}

__device__ __forceinline__ void phase_prep(Frame& F, int l) {
    const int lane = lane_id();
    const float* gq = F.a_q_gain + l * HD; const float* gk = F.a_k_gain + l * HD;
    const long NIT = (long)NTOK * 18 * 8;
    for (long ti = (long)F.gw * 64 + lane; ti < NIT; ti += (long)F.NGW * 64) {
        const int c = (int)(ti & 7); const int th = (int)(ti >> 3); const int m = th / 18, hs = th - m * 18; const int t = m & (SEQ - 1);
        int col, lo_off, hi_off; const float* tab; const float* gain = nullptr;
        if (hs < 6) {
            col = (hs < 4) ? COL_AQ + hs * HD : COL_AK + (hs - 4) * HD; gain = (hs < 4) ? gq : gk;
            const int cc = c & 3, half = c >> 2; lo_off = half * 64 + cc * 8; hi_off = lo_off + 32;
            const int pos = half ? (t & 63) : (t >> 6); tab = F.ROPE_A + 2 * (size_t)(pos * 32 + cc * 8);
        } else {
            col = (hs < 12) ? COL_BQ + (hs - 6) * HD : COL_BK + (hs - 12) * HD;
            lo_off = c * 8; hi_off = 64 + c * 8; tab = F.ROPE_B + 2 * (size_t)(t * 64 + c * 8);
        }
        bf16* p = F.PROJ + (size_t)m * INW + col;
        const v4u lo4 = *(const v4u*)(p + lo_off), hi4 = *(const v4u*)(p + hi_off);
        float lo[8], hv[8];
        lo[0] = bflo(lo4.x); lo[1] = bfhi(lo4.x); lo[2] = bflo(lo4.y); lo[3] = bfhi(lo4.y); lo[4] = bflo(lo4.z); lo[5] = bfhi(lo4.z); lo[6] = bflo(lo4.w); lo[7] = bfhi(lo4.w);
        hv[0] = bflo(hi4.x); hv[1] = bfhi(hi4.x); hv[2] = bflo(hi4.y); hv[3] = bfhi(hi4.y); hv[4] = bflo(hi4.z); hv[5] = bfhi(hi4.z); hv[6] = bflo(hi4.w); hv[7] = bfhi(hi4.w);
        float ss = 0.f;
#pragma unroll
        for (int j = 0; j < 8; ++j) ss += lo[j] * lo[j] + hv[j] * hv[j];
        ss += xshfl<1>(ss); ss += xshfl<2>(ss); ss += xshfl<4>(ss);
        if (hs < 6) { const float rs = 1.0f / sqrtf(ss * (1.0f / HD) + EPS);
#pragma unroll
            for (int j = 0; j < 8; ++j) { lo[j] = lo[j] * rs * gain[lo_off + j]; hv[j] = hv[j] * rs * gain[hi_off + j]; } }
        float ol[8], oh[8];
#pragma unroll
        for (int j = 0; j < 8; ++j) { const float cs = tab[2 * j], sn = tab[2 * j + 1]; ol[j] = lo[j] * cs - hv[j] * sn; oh[j] = hv[j] * cs + lo[j] * sn; }
        v4u w; w.x = pk2(ol[0], ol[1]); w.y = pk2(ol[2], ol[3]); w.z = pk2(ol[4], ol[5]); w.w = pk2(ol[6], ol[7]); *(v4u*)(p + lo_off) = w;
        w.x = pk2(oh[0], oh[1]); w.y = pk2(oh[2], oh[3]); w.z = pk2(oh[4], oh[5]); w.w = pk2(oh[6], oh[7]); *(v4u*)(p + hi_off) = w;
    }
}

#ifndef MK_RING3_A
#define MK_RING3_A 0
#endif
struct CfgA {
    static constexpr int NT = SEQ / 64; static constexpr bool HAS_LSE = false;
    float negm0C;
    const bf16* proj; bf16* obuf; unsigned qbase, kvbase, obase; int kcol, vcol;
    __device__ __forceinline__ unsigned q_off(int row) const { return qbase + (unsigned)row * INW; }
    __device__ __forceinline__ unsigned kv_off(int t, int row) const { return kvbase + (unsigned)(t * 64 + row) * INW; }
    __device__ __forceinline__ bool active(int, int) const { return true; }
    __device__ __forceinline__ void mask(att::f32x16&, att::f32x16&, int, int, int, int) const {}
    __device__ __forceinline__ unsigned o_off(int row) const { return obase + (unsigned)row * DM; }
    __device__ __forceinline__ void store_lse(int, float) const {}
};
__device__ __forceinline__ CfgA make_cfgA(Frame& F, int u, float negm0C) {
    const int x = F.vcu / (F.G / 8), j = F.vcu % (F.G / 8);
    int combo, hq2, qb;
    if (F.G == 256) { const int i = u / 256; combo = i * 8 + x; hq2 = j >> 4; qb = j & 15; } else { combo = u / 32; hq2 = (u >> 4) & 1; qb = u & 15; }
    const int s = combo >> 1, kvh = combo & 1, hq = kvh * 2 + hq2;
    const unsigned row0 = (unsigned)s * SEQ;
    CfgA cfg; cfg.negm0C = negm0C; cfg.proj = F.PROJ; cfg.obuf = F.O; cfg.qbase = (row0 + (unsigned)qb * 256) * INW + COL_AQ + hq * HD; cfg.kvbase = row0 * INW; cfg.kcol = COL_AK + kvh * HD; cfg.vcol = COL_AV + kvh * HD;
    cfg.obase = (row0 + (unsigned)qb * 256) * DM + OCOL_A + hq * HD;
    return cfg;
}
template <bool BOUNDED> __device__ __forceinline__ void phase_attn_A_(Frame& F, char* lds, float negm0C) {
    att::Pre pre; bool have = false;
    for (int u = F.vcu; u < NSEQ * 4 * 16; u += F.G) {
        const CfgA cfg = make_cfgA(F, u, negm0C); const bool hn = u + F.G < NSEQ * 4 * 16; const CfgA nx = make_cfgA(F, hn ? u + F.G : u, negm0C);
        if (MK_RING3_A) att::attn_unit3<CfgA, BOUNDED>(cfg, lds, F.wave, pre, have, &nx); else att::attn_unit<CfgA, 2, BOUNDED>(cfg, lds, F.wave, pre, have, &nx);
        have = MK_PREFETCH_UNIT != 0;
    }
}
__device__ __forceinline__ void phase_attn_A(Frame& F, int l, char* lds) {
    const float m0 = F.VEC[VEC_M0 + l];
    if (MK_BOUNDED_A && m0 * ATT_SCALE <= 40.f) phase_attn_A_<true>(F, lds, -m0 * ATT_SCALE * 1.4426950408889634f); else phase_attn_A_<false>(F, lds, 0.f);
}

#ifndef MK_WAVE_BC
#define MK_WAVE_BC 0
#endif
#ifndef MK_C16
#define MK_C16 1
#endif
#if MK_C16
#define MK_CFG_C CfgC16
#define MK_UNIT_C att::attn_unit_h<CfgC16, 2>
#else
#define MK_CFG_C CfgC
#define MK_UNIT_C ATT_UNIT_BC(CfgC)
#endif
#ifndef MK_PIPE_BC
#define MK_PIPE_BC 1
#endif
#if MK_WAVE_BC
#define ATT_UNIT_BC(C) att::attn_unit_wave<C>
#elif MK_PIPE_BC
#define ATT_UNIT_BC(C) att::attn_unit<C, 1>
#else
#define ATT_UNIT_BC(C) att::attn_unit_simple<C>
#endif
struct CfgB {
    static constexpr int NT = 6; static constexpr bool HAS_LSE = true;
    static constexpr float negm0C = 0.f;
    const bf16* proj; bf16* obuf; float* lse; unsigned tok0; int sh, s0, L, hb; int kcol, vcol;
    __device__ __forceinline__ unsigned q_off(int row) const { return (tok0 + ((unsigned)(s0 + row) << sh)) * INW + COL_BQ + hb * HD; }
    __device__ __forceinline__ unsigned kv_off(int t, int row) const { int pos = s0 - 64 + 64 * t + row; pos = min(max(pos, 0), L - 1); return (tok0 + ((unsigned)pos << sh)) * INW; }
    __device__ __forceinline__ bool active(int t, int wid) const { return (t >= (wid >> 1)) && (t <= (wid >> 1) + 2) && (t >= t_begin()) && (t < t_end()); }
    __device__ __forceinline__ int t_begin() const { return s0 == 0 ? 1 : 0; }
    __device__ __forceinline__ int t_end() const { return s0 + 256 == L ? 5 : 6; }
    __device__ __forceinline__ void mask(att::f32x16& p0, att::f32x16& p1, int t, int wid, int r32, int hi) const {
        if (t == (wid >> 1) + 1) return;
        const int d0 = 64 * t - 64 - 32 * wid - r32 + 4 * hi;
#pragma unroll
        for (int r = 0; r < 16; ++r) { const int d = d0 + (r & 3) + 8 * (r >> 2);
            if (d < -64 || d > 64) p0[r] = -__builtin_inff();
            if (d + 32 < -64 || d + 32 > 64) p1[r] = -__builtin_inff(); }
    }
    __device__ __forceinline__ unsigned o_off(int row) const { return (tok0 + ((unsigned)(s0 + row) << sh)) * DM + OCOL_B + hb * HD; }
    __device__ __forceinline__ void store_lse(int row, float v) const { lse[(size_t)(tok0 + ((unsigned)(s0 + row) << sh)) * 8 + hb] = v; }
};
struct CfgC {
    static constexpr int NT = 12; static constexpr bool HAS_LSE = false;
    static constexpr float negm0C = 0.f;
    const bf16* proj; bf16* obuf; const float* bias;
    unsigned tokq; unsigned tokk; int R0, kr0, hc; int kcol, vcol;
    __device__ __forceinline__ unsigned q_off(int row) const { return (tokq + (unsigned)row) * INW + COL_CQ + hc * HD; }
    __device__ __forceinline__ unsigned kv_off(int t, int row) const { return (tokk + (unsigned)(t * 64 + row)) * INW; }
    __device__ __forceinline__ bool active(int t, int wid) const { const int r = R0 + (wid >> 1), r0 = min(max(r - 4, 0), 56), kr = kr0 + t; return kr >= r0 && kr < r0 + 8; }
    __device__ __forceinline__ int t_begin() const { return min(max(R0 - 4, 0), 56) - kr0; }
    __device__ __forceinline__ int t_end() const { return min(max(R0 - 1, 0), 56) + 8 - kr0; }
    __device__ __forceinline__ void mask(att::f32x16& p0, att::f32x16& p1, int t, int wid, int r32, int hi) const {
        const int r = R0 + (wid >> 1), kr = kr0 + t, qc = (wid & 1) * 32 + r32, sc = min(max(qc - 8, 0), 48);
        const int w0 = 4 * hi - sc;
        const float* bp = bias + (kr - r + 7) * 31 + (sc - qc + 15) + w0;
#pragma unroll
        for (int rr = 0; rr < 16; ++rr) { const int c = (rr & 3) + 8 * (rr >> 2);
            p0[rr] = ((unsigned)(w0 + c) < 16u) ? p0[rr] + bp[c] : -__builtin_inff();
            p1[rr] = ((unsigned)(w0 + c + 32) < 16u) ? p1[rr] + bp[c + 32] : -__builtin_inff(); }
    }
    __device__ __forceinline__ unsigned o_off(int row) const { return (tokq + (unsigned)row) * DM + OCOL_C + hc * HD; }
    __device__ __forceinline__ void store_lse(int, float) const {}
};
struct CfgC16 {
    static constexpr int NT = 12; static constexpr bool HAS_LSE = false; static constexpr float negm0C = 0.f;
    const bf16* proj; bf16* obuf; const float* bias;
    unsigned tokq; unsigned tokk; int R0, kr0, hc; int kcol, vcol;
    __device__ __forceinline__ int qtok(int idx) const { const int w = idx >> 5, rl = idx & 31; return (2 * (w >> 2) + (rl >> 4)) * 64 + 16 * (w & 3) + (rl & 15); }
    __device__ __forceinline__ unsigned q_off(int idx) const { return (tokq + (unsigned)qtok(idx)) * INW + COL_CQ + hc * HD; }
    __device__ __forceinline__ unsigned kv_off(int t, int row) const { return (tokk + (unsigned)(t * 64 + row)) * INW; }
    __device__ __forceinline__ int kwin(int wid) const { return min(max(16 * (wid & 3) - 8, 0), 32); }
    __device__ __forceinline__ bool active(int t, int wid) const { const int r = R0 + 2 * (wid >> 2), lo = min(max(r - 4, 0), 56), hi_ = min(max(r - 3, 0), 56) + 8, kr = kr0 + t; return kr >= lo && kr < hi_; }
    __device__ __forceinline__ void mask16(att::f32x16& p0, int t, int wid, int r32, int hi) const {
        const int r = R0 + 2 * (wid >> 2) + (r32 >> 4), kr = kr0 + t, qc = 16 * (wid & 3) + (r32 & 15), sc = min(max(qc - 8, 0), 48), r0 = min(max(r - 4, 0), 56);
        const bool rowok = (unsigned)(kr - r0) < 8u;
        const int w0 = kwin(wid) + 4 * hi - sc;
        const float* bp = bias + (kr - r + 7) * 31 + (sc - qc + 15) + w0;
#pragma unroll
        for (int rr = 0; rr < 16; ++rr) { const int cofs = (rr & 3) + 8 * (rr >> 2);
            p0[rr] = (rowok && (unsigned)(w0 + cofs) < 16u) ? p0[rr] + bp[cofs] : -__builtin_inff(); }
    }
    __device__ __forceinline__ unsigned o_off(int idx) const { return (tokq + (unsigned)qtok(idx)) * DM + OCOL_C + hc * HD; }
    __device__ __forceinline__ void store_lse(int, float) const {}
};
constexpr int ATT_BIAS_OFF = 106496;
constexpr int ATT_BIAS_OFF_OLD = 69632;
static_assert(att::OSTAGE_OFF >= (int)att::SHM_ATTN && att::OSTAGE_OFF + 8 * 4096 <= ATT_BIAS_OFF && ATT_BIAS_OFF + 6 * 15 * 31 * 4 + 512 <= RING_BYTES, "O stage / bias table placement");
__device__ __forceinline__ CfgB make_cfgB(Frame& F, int u) {
    const int s = u / 96, rem = u - s * 96, hb = rem >> 4, k = rem & 15;
    const int g = hb >> 1, sh = 2 * g, L = SEQ >> sh, nblk = L >> 8;
    const int r = k / nblk, blk = k - r * nblk;
    CfgB cfg; cfg.proj = F.PROJ; cfg.obuf = F.O; cfg.lse = F.LSE; cfg.tok0 = (unsigned)s * SEQ + r; cfg.sh = sh; cfg.s0 = blk * 256; cfg.L = L; cfg.hb = hb;
    cfg.kcol = COL_BK + hb * HD; cfg.vcol = COL_BV + hb * HD;
    return cfg;
}
__device__ __forceinline__ void phase_attn_B(Frame& F, char* lds) {
    att::Pre pre; bool have = false;
    for (int u = F.vcu; u < 1152; u += F.G) {
        const CfgB cfg = make_cfgB(F, u); const bool hn = u + F.G < 1152; const CfgB nx = make_cfgB(F, hn ? u + F.G : u);
        att::attn_unit<CfgB, 1>(cfg, lds, F.wave, pre, have, &nx); have = MK_PREFETCH_UNIT != 0;
    }
}
__device__ __forceinline__ CfgC16 make_cfgC(Frame& F, int v, const float* bl) {
    const int s = v / 96, rem = v - s * 96, hc = rem >> 4, blk = rem & 15;
    const int R0 = blk * 4, kr0 = min(max(R0 - 4, 0), 52);
    CfgC16 cfg; cfg.proj = F.PROJ; cfg.obuf = F.O; cfg.bias = bl; cfg.tokq = (unsigned)s * SEQ + R0 * 64; cfg.tokk = (unsigned)s * SEQ + kr0 * 64; cfg.R0 = R0; cfg.kr0 = kr0; cfg.hc = hc;
    cfg.kcol = COL_CK + hc * HD; cfg.vcol = COL_CV + hc * HD;
    return cfg;
}
__device__ __forceinline__ void phase_attn_C(Frame& F, int l, char* lds) {
    att::Pre pre; bool have = false; float* bl = (float*)(lds + ATT_BIAS_OFF);
    { const float* rel = F.c_rel_bias + (size_t)l * 6 * (15 * 31);
      for (int e = F.wave * 64 + lane_id(); e < 6 * 15 * 31; e += NWAVES * 64) bl[e] = rel[e] * (1.0f / ATT_SCALE);
      __syncthreads(); }
    for (int v = F.G - 1 - F.vcu; v < 1152; v += F.G) {
        CfgC16 cfg = make_cfgC(F, v, bl); cfg.bias = bl + cfg.hc * (15 * 31); const bool hn = v + F.G < 1152; const CfgC16 nx = make_cfgC(F, hn ? v + F.G : v, bl);
        att::attn_unit_h<CfgC16, 2>(cfg, lds, F.wave, pre, have, &nx); have = MK_PREFETCH_UNIT != 0;
    }
}

#ifndef MK_DYN_BC
#define MK_DYN_BC 0
#endif
__device__ __forceinline__ void phase_attn_BC_dyn(Frame& F, int l, char* lds) {
    att::Pre pre; float* bl = (float*)(lds + ATT_BIAS_OFF);
    { const float* rel = F.c_rel_bias + (size_t)l * 6 * (15 * 31);
      for (int e = F.wave * 64 + lane_id(); e < 6 * 15 * 31; e += NWAVES * 64) bl[e] = rel[e] * (1.0f / ATT_SCALE); }
    gu32* head = F.ctl + CW_ATTQ + 64 * l;
    volatile LAS unsigned* slot = F.MISC + 16;
    const bool t0 = (F.wave == 0) && (lane_id() == 0);
    unsigned nq = 0u;
    if (t0) nq = __hip_atomic_fetch_add(head, 1u, RLX_AGENT);
    for (;;) {
        if (t0) *slot = nq;
        __syncthreads();
        const unsigned q = *slot;
        __syncthreads();
        if (q >= 2304u) break;
        if (t0) nq = __hip_atomic_fetch_add(head, 1u, RLX_AGENT);
        if (q < 1152u) {
            CfgC16 cfg = make_cfgC(F, (int)q, bl); cfg.bias = bl + cfg.hc * (15 * 31);
            att::attn_unit_h<CfgC16, 2>(cfg, lds, F.wave, pre, false, &cfg);
        } else {
            const CfgB cfg = make_cfgB(F, (int)q - 1152);
            att::attn_unit<CfgB, 1>(cfg, lds, F.wave, pre, false, &cfg);
        }
    }
}

__device__ __forceinline__ float dot8(v4u a, v4u b) {
    return bflo(a.x) * bflo(b.x) + bfhi(a.x) * bfhi(b.x) + bflo(a.y) * bflo(b.y) + bfhi(a.y) * bfhi(b.y) + bflo(a.z) * bflo(b.z) + bfhi(a.z) * bfhi(b.z) + bflo(a.w) * bflo(b.w) + bfhi(a.w) * bfhi(b.w);
}
__device__ __forceinline__ void naive_B(Frame& F, int m, int hb) {
    const int lane = lane_id(); const int t = m & (SEQ - 1); const size_t sbase = (size_t)(m - t);
    const int g = hb >> 1, sh = 2 * g, dil = 1 << sh, i = t >> sh, r = t & (dil - 1), L = SEQ >> sh;
    const bf16* qp = F.PROJ + (size_t)m * INW + COL_BQ + hb * HD;
    const bf16* kb = F.PROJ + sbase * INW + COL_BK + hb * HD; const bf16* vb = F.PROJ + sbase * INW + COL_BV + hb * HD;
    float dot[3] = {0.f, 0.f, 0.f}; bool valid[3]; const bf16* kp[3];
#pragma unroll
    for (int j3 = 0; j3 < 3; ++j3) { const int jj = lane + 64 * j3, ik = i - 64 + jj; valid[j3] = (jj <= 128) && (ik >= 0) && (ik < L);
        const int ikc = valid[j3] ? ik : i; kp[j3] = kb + (size_t)(ikc * dil + r) * INW; }
#pragma unroll
    for (int ch = 0; ch < 16; ++ch) { const v4u qv = *(const v4u*)(qp + ch * 8);
#pragma unroll
        for (int j3 = 0; j3 < 3; ++j3) { const v4u kv = *(const v4u*)(kp[j3] + ch * 8); dot[j3] += dot8(qv, kv); } }
    float s[3];
#pragma unroll
    for (int j3 = 0; j3 < 3; ++j3) s[j3] = valid[j3] ? dot[j3] * ATT_SCALE : -__builtin_inff();
    const float mx = wave_max(fmaxf(s[0], fmaxf(s[1], s[2])));
    float p[3];
#pragma unroll
    for (int j3 = 0; j3 < 3; ++j3) p[j3] = valid[j3] ? __expf(s[j3] - mx) : 0.f;
    const float lsum = wave_sum(p[0] + p[1] + p[2]);
    float a0 = 0.f, a1 = 0.f;
#pragma unroll
    for (int j3 = 0; j3 < 3; ++j3) {
        const int nj = (j3 == 2) ? 1 : 64;
        for (int jl = 0; jl < nj; ++jl) { const float pj = __shfl(p[j3], jl); const int ik = i - 64 + jl + 64 * j3;
            if (ik >= 0 && ik < L) { const unsigned w = *(const unsigned*)(vb + (size_t)(ik * dil + r) * INW + 2 * lane); a0 += pj * bflo(w); a1 += pj * bfhi(w); } } }
    const float rl = 1.0f / lsum;
    *(unsigned*)(F.O + (size_t)m * DM + OCOL_B + hb * HD + 2 * lane) = pk2(a0 * rl, a1 * rl);
    if (lane == 0) F.LSE[(size_t)m * 8 + hb] = mx + __logf(lsum);
}
__device__ __forceinline__ void naive_C(Frame& F, int l, int m, int hc) {
    const int lane = lane_id(); const int t = m & (SEQ - 1); const size_t sbase = (size_t)(m - t);
    const int r = t >> 6, c = t & 63; const int r0 = min(max(r - 4, 0), 56), sc = min(max(c - 8, 0), 48);
    const bf16* qp = F.PROJ + (size_t)m * INW + COL_CQ + hc * HD;
    const bf16* kb = F.PROJ + sbase * INW + COL_CK + hc * HD; const bf16* vb = F.PROJ + sbase * INW + COL_CV + hc * HD;
    const float* rel = F.c_rel_bias + ((size_t)l * 6 + hc) * (15 * 31);
    float dot[2] = {0.f, 0.f}; const bf16* kp[2]; float bias[2];
#pragma unroll
    for (int j2 = 0; j2 < 2; ++j2) { const int kk = lane + 64 * j2, jr = kk >> 4, jc = kk & 15; kp[j2] = kb + (size_t)((r0 + jr) * 64 + sc + jc) * INW;
        bias[j2] = rel[(r0 + jr - r + 7) * 31 + (sc + jc - c + 15)]; }
#pragma unroll
    for (int ch = 0; ch < 16; ++ch) { const v4u qv = *(const v4u*)(qp + ch * 8);
#pragma unroll
        for (int j2 = 0; j2 < 2; ++j2) { const v4u kv = *(const v4u*)(kp[j2] + ch * 8); dot[j2] += dot8(qv, kv); } }
    const float s0 = dot[0] * ATT_SCALE + bias[0], s1 = dot[1] * ATT_SCALE + bias[1];
    const float mx = wave_max(fmaxf(s0, s1));
    const float p0 = __expf(s0 - mx), p1 = __expf(s1 - mx);
    const float lsum = wave_sum(p0 + p1);
    float a0 = 0.f, a1 = 0.f;
    for (int kk = 0; kk < 128; ++kk) { const float pj = (kk < 64) ? __shfl(p0, kk) : __shfl(p1, kk - 64); const int jr = kk >> 4, jc = kk & 15;
        const unsigned w = *(const unsigned*)(vb + (size_t)((r0 + jr) * 64 + sc + jc) * INW + 2 * lane); a0 += pj * bflo(w); a1 += pj * bfhi(w); }
    const float rl = 1.0f / lsum;
    *(unsigned*)(F.O + (size_t)m * DM + OCOL_C + hc * HD + 2 * lane) = pk2(a0 * rl, a1 * rl);
}
__device__ __forceinline__ void phase_attn_BC_naive(Frame& F, int l) {
    for (int it = F.gw; it < NTOK * 12; it += F.NGW) { const int m = it / 12, h = it - m * 12;
        if (h < 6) naive_B(F, m, h); else naive_C(F, l, m, h - 6); }
}

__device__ __forceinline__ void phase_mix(Frame& F, int l) {
    const int lane = lane_id();
    const float* gain = F.mix_gain + (size_t)l * DM;
    f32x4 gv[4][2];
#pragma unroll
    for (int j = 0; j < 4; ++j) { gv[j][0] = *(const f32x4*)(gain + 8 * lane + 512 * j); gv[j][1] = *(const f32x4*)(gain + 8 * lane + 512 * j + 4); }
    v4u wn[4]; float ln[6];
#define MIX_LOAD(m_) do { const bf16* row_ = F.O + (size_t)(m_) * DM; const float* lse_ = F.LSE + (size_t)(m_) * 8; \
        _Pragma("unroll") for (int j = 0; j < 4; ++j) wn[j] = *(const v4u*)(row_ + 8 * lane + 512 * j); \
        _Pragma("unroll") for (int h = 0; h < 6; ++h) ln[h] = lse_[h]; } while (0)
    if (F.gw < NTOK) MIX_LOAD(F.gw);
    for (int m = F.gw; m < NTOK; m += F.NGW) {
        bf16* row = F.O + (size_t)m * DM;
        v4u wc[4]; float lc[6];
#pragma unroll
        for (int j = 0; j < 4; ++j) wc[j] = wn[j];
#pragma unroll
        for (int h = 0; h < 6; ++h) lc[h] = ln[h];
        if (m + F.NGW < NTOK) MIX_LOAD(m + F.NGW);
        asm volatile("" ::: "memory");
        float al[6];
#pragma unroll
        for (int h = 0; h < 2; ++h) { const float l0 = lc[h], l1 = lc[2 + h], l2 = lc[4 + h]; const float mx = fmaxf(l0, fmaxf(l1, l2));
            const float e0 = __expf(l0 - mx), e1 = __expf(l1 - mx), e2 = __expf(l2 - mx); const float inv = 1.0f / (e0 + e1 + e2); al[h] = e0 * inv; al[2 + h] = e1 * inv; al[4 + h] = e2 * inv; }
        float v[4][8]; float ssA = 0.f, ssB = 0.f, ssC = 0.f;
#pragma unroll
        for (int j = 0; j < 4; ++j) { const int col = 8 * lane + 512 * j; const v4u w = wc[j];
            v[j][0] = bflo(w.x); v[j][1] = bfhi(w.x); v[j][2] = bflo(w.y); v[j][3] = bfhi(w.y); v[j][4] = bflo(w.z); v[j][5] = bfhi(w.z); v[j][6] = bflo(w.w); v[j][7] = bfhi(w.w);
            float a = 1.f;
            if (col >= OCOL_B && col < OCOL_C) { const int hb = (col - OCOL_B) >> 7; a = (hb == 0) ? al[0] : (hb == 1) ? al[1] : (hb == 2) ? al[2] : (hb == 3) ? al[3] : (hb == 4) ? al[4] : al[5]; }
            float ss = 0.f;
#pragma unroll
            for (int e = 0; e < 8; ++e) { v[j][e] *= a; ss += v[j][e] * v[j][e]; }
            if (col < OCOL_B) ssA += ss; else if (col < OCOL_C) ssB += ss; else ssC += ss; }
        ssA = wave_sum(ssA); ssB = wave_sum(ssB); ssC = wave_sum(ssC);
        const float rA = 1.0f / sqrtf(ssA * (1.0f / 512.f) + EPS), rB = 1.0f / sqrtf(ssB * (1.0f / 768.f) + EPS), rC = 1.0f / sqrtf(ssC * (1.0f / 768.f) + EPS);
#pragma unroll
        for (int j = 0; j < 4; ++j) { const int col = 8 * lane + 512 * j; const float rr = (col < OCOL_B) ? rA : (col < OCOL_C) ? rB : rC;
            const f32x4 g0 = gv[j][0], g1 = gv[j][1];
            v4u w; w.x = pk2(v[j][0] * rr * g0.x, v[j][1] * rr * g0.y); w.y = pk2(v[j][2] * rr * g0.z, v[j][3] * rr * g0.w);
            w.z = pk2(v[j][4] * rr * g1.x, v[j][5] * rr * g1.y); w.w = pk2(v[j][6] * rr * g1.z, v[j][7] * rr * g1.w);
            *(v4u*)(row + col) = w; }
    }
#undef MIX_LOAD
}

__device__ __forceinline__ void phase_final_ln(Frame& F, const float* g, const float* b) {
    static_assert(MK_BF16_RES && !MK_FIN_PHASES, "the final LayerNorm reads the bf16 residual stream and the raw row partials");
    const int lane = lane_id();
    f32x4 gg[8], bb[8];
#pragma unroll
    for (int j = 0; j < 8; ++j) { gg[j] = *((const f32x4*)g + lane + 64 * j); bb[j] = *((const f32x4*)b + lane + 64 * j); }
    unsigned long long zn[8]; pg8::f32x2 pn;
#define FLN_LOAD(m_) do { const GAS unsigned long long* zb_ = (const GAS unsigned long long*)(F.XB + (size_t)(m_) * DM) + lane; \
        _Pragma("unroll") for (int j = 0; j < 8; ++j) zn[j] = zb_[64 * j]; pn = (lane < 32) ? F.PART[(size_t)(m_) * 32 + lane] : (pg8::f32x2){0.f, 0.f}; } while (0)
    if (F.gw < NTOK) FLN_LOAD(F.gw);
    for (int m = F.gw; m < NTOK; m += F.NGW) {
        GAS f32x4* xr = (GAS f32x4*)(F.X + (size_t)m * DM) + lane;
        unsigned long long zc[8]; const pg8::f32x2 pc = pn;
#pragma unroll
        for (int j = 0; j < 8; ++j) zc[j] = zn[j];
        if (m + F.NGW < NTOK) FLN_LOAD(m + F.NGW);
        asm volatile("" ::: "memory");
        const float s = wave_sum(pc.x), q = wave_sum(pc.y);
        const float mean = s * (1.f / DM); const float var = fmaxf(q * (1.f / DM) - mean * mean, 0.f); const float rstd = 1.f / sqrtf(var + EPS);
#pragma unroll
        for (int j = 0; j < 8; ++j) { const unsigned lo = (unsigned)zc[j], hi = (unsigned)(zc[j] >> 32);
            const f32x4 z = {bflo(lo), bfhi(lo), bflo(hi), bfhi(hi)};
            __builtin_nontemporal_store((z - mean) * rstd * gg[j] + bb[j], (f32x4*)(xr + 64 * j)); }
    }
#undef FLN_LOAD
}

__device__ __forceinline__ void phase_prep_copy(Frame& F) {
    const int lane = lane_id();
    const long NIT = (long)NTOK * 18 * 8;
    for (long ti = (long)F.gw * 64 + lane; ti < NIT; ti += (long)F.NGW * 64) {
        const int c = (int)(ti & 7); const int th = (int)(ti >> 3); const int m = th / 18, hs = th - m * 18; const int t = m & (SEQ - 1);
        int col, lo_off, hi_off; const float* tab;
        if (hs < 6) { col = (hs < 4) ? COL_AQ + hs * HD : COL_AK + (hs - 4) * HD; const int cc = c & 3, half = c >> 2; lo_off = half * 64 + cc * 8; hi_off = lo_off + 32; const int pos = half ? (t & 63) : (t >> 6); tab = F.ROPE_A + 2 * (size_t)(pos * 32 + cc * 8); }
        else { col = (hs < 12) ? COL_BQ + (hs - 6) * HD : COL_BK + (hs - 12) * HD; lo_off = c * 8; hi_off = 64 + c * 8; tab = F.ROPE_B + 2 * (size_t)(t * 64 + c * 8); }
        bf16* p = F.PROJ + (size_t)m * INW + col;
        v4u lo4 = *(const v4u*)(p + lo_off), hi4 = *(const v4u*)(p + hi_off);
        const f32x4 t0 = *(const f32x4*)tab, t1 = *(const f32x4*)(tab + 4), t2 = *(const f32x4*)(tab + 8), t3 = *(const f32x4*)(tab + 12);
        if (t0.x + t1.x + t2.x + t3.x > 1e30f) lo4.x ^= 1u;
        *(v4u*)(p + lo_off) = lo4; *(v4u*)(p + hi_off) = hi4;
    }
}
__device__ __forceinline__ void phase_mix_copy(Frame& F) {
    const int lane = lane_id();
    for (int m = F.gw; m < NTOK; m += F.NGW) {
        bf16* row = F.O + (size_t)m * DM; const float* lse = F.LSE + (size_t)m * 8; const float l0 = lse[0] + lse[5];
        v4u w[4];
#pragma unroll
        for (int j = 0; j < 4; ++j) w[j] = *(const v4u*)(row + 8 * lane + 512 * j);
        if (l0 > 1e30f) w[0].x ^= 1u;
#pragma unroll
        for (int j = 0; j < 4; ++j) *(v4u*)(row + 8 * lane + 512 * j) = w[j];
    }
}

#ifndef MK_NAIVE_BC
#define MK_NAIVE_BC 0
#endif
#if MK_NAIVE_BC
#define ATTN_BC(F, l, lds) phase_attn_BC_naive(F, l)
#else
#define ATTN_BC(F, l, lds) do { if (MK_DYN_BC) phase_attn_BC_dyn(F, l, lds); else { phase_attn_B(F, lds); phase_attn_C(F, l, lds); } } while (0)
#endif
#ifndef MK_DUP_ENDS
#define MK_DUP_ENDS 0
#endif
#ifndef MK_HALVES
#define MK_HALVES 0
#endif
#ifndef MK_SB_EAGER
#define MK_SB_EAGER 0
#endif
#ifndef MK_DUP_ALL
#define MK_DUP_ALL 0
#endif
#ifndef MK_DUP_GEMM
#define MK_DUP_GEMM 0
#endif
#ifndef MK_STAGGER_OUT
#define MK_STAGGER_OUT 0
#endif
#ifndef MK_STAGGER_IN
#define MK_STAGGER_IN 0
#endif
#ifndef MK_DUP_RES
#define MK_DUP_RES 0
#endif
#ifndef MK_DUP_BAR
#define MK_DUP_BAR 0
#endif
#ifndef MK_XCD_EXTRA
#define MK_XCD_EXTRA -1
#endif
#ifndef MK_DUP_KLOOP
#define MK_DUP_KLOOP 0
#endif
#ifndef MK_DUP_THIN
#define MK_DUP_THIN 0
#endif
#ifndef MK_DUP_ATTN
#define MK_DUP_ATTN 0
#endif
#ifndef MK_PER_PHASE
#define MK_PER_PHASE 0
#endif
constexpr int PH_PER_LAYER = 9, N_PHASES = 2 + PH_PER_LAYER * NLAYER;
struct Args { const float* in[14]; float* out; unsigned char* ws; int ph_lo, ph_hi; };
static_assert(sizeof(Args) == 14 * 8 + 8 + 8 + 8, "Args has no padding");

__global__ void __launch_bounds__(NWAVES * 64, 2) trunk_fwd(Args args) {
    extern __shared__ __attribute__((aligned(16))) unsigned char lds[];
    Frame F;
    F.lds = (LAS unsigned char*)lds;
    F.MISC = (volatile LAS unsigned*)(F.lds + MISC_OFF);
    F.wave = __builtin_amdgcn_readfirstlane((int)threadIdx.x >> 6);
    F.G = gridDim.x; { const int bx = blockIdx.x; F.vcu = (F.G % 8 == 0) ? (bx % 8) * (F.G / 8) + bx / 8 : bx; }
    F.gw = F.vcu * NWAVES + F.wave; F.NGW = F.G * NWAVES;
    unsigned char* ws = args.ws;
    F.ctl = (gu32*)(ws + WS_CTL);
    F.x_prompt = args.in[0]; F.x_sample = args.in[1]; F.w_in = args.in[2]; F.a_q_gain = args.in[3]; F.a_k_gain = args.in[4]; F.c_rel_bias = args.in[5]; F.mix_gain = args.in[6];
    F.w_out = args.in[7]; F.ln1_g = args.in[8]; F.ln1_b = args.in[9]; F.w_ff1 = args.in[10]; F.w_ff2 = args.in[11]; F.ln2_g = args.in[12]; F.ln2_b = args.in[13];
    F.X = args.out;
    F.Win_t = (bf16*)(ws + WS_WIN); F.Wout_t = (bf16*)(ws + WS_WOUT); F.Wff1_t = (bf16*)(ws + WS_WFF1); F.Wff2_t = (bf16*)(ws + WS_WFF2);
    F.XB = (bf16*)(ws + WS_XB); F.PROJ = (bf16*)(ws + WS_PROJ); F.O = (bf16*)(ws + WS_O); F.H = (bf16*)(ws + WS_H);
    F.LSE = (float*)(ws + WS_LSE); F.ROPE_B = (float*)(ws + WS_ROPE_B); F.ROPE_A = (float*)(ws + WS_ROPE_A);
    F.PART = (pg8::f32x2*)(ws + WS_PART); F.STAT = (pg8::f32x2*)(ws + WS_STAT); F.VEC = (float*)(ws + WS_VEC); F.PSB = (float*)(ws + WS_PSB); F.SSQ = (float*)(ws + WS_SSQ); F.RAT = (float*)(ws + WS_RAT);
    for (int u = F.wave * 64 + lane_id(); u < (LDS_BYTES - LDSCTL_OFF) / 4; u += NWAVES * 64) ((LAS unsigned*)(F.lds + LDSCTL_OFF))[u] = 0u;
    __syncthreads();
    XcdBarrier bar; bar.bar = (unsigned*)(F.ctl + CW_BAR); bar.x = 0; bar.st = nullptr;
    if (!MK_PER_PHASE) bar = xcd_barrier_post((unsigned*)(F.ctl + CW_BAR), F.MISC + 8, F.wave == 0 && lane_id() == 0);
    const int lo = args.ph_lo, hi = args.ph_hi;
#define IN(k) (lo <= (k) && (k) < hi)
#define STAGGER(ticks) do { if ((ticks) > 0) { const unsigned long long t0_ = __builtin_amdgcn_s_memrealtime(); const unsigned long long dl_ = (unsigned long long)((F.vcu & 7) >> 1) * (unsigned long long)(ticks); while (__builtin_amdgcn_s_memrealtime() - t0_ < dl_) __builtin_amdgcn_s_sleep(8); } } while (0)
#define SEAM(k) do { if (IN(k) && IN((k) + 1)) { if (MK_PER_PHASE) { if (F.wave == 0 && lane_id() == 0) __hip_atomic_store(F.ctl + CW_TMO, 0xBADBA0u, RLX_AGENT); } else { xcd_barrier(bar, F.wave == 0 && lane_id() == 0); if (MK_DUP_BAR) xcd_barrier(bar, F.wave == 0 && lane_id() == 0); } } } while (0)

    if (IN(0)) { phase_prologue(F); if (MK_DUP_ENDS & 1) phase_prologue(F); } SEAM(0);
#if MK_FUSE_PREP
#define INPROJ_EPI(l) pg8::EpiInProj E{F.PROJ, INW, F.STAT, F.VEC + VEC_CS_IN, F.VEC + VEC_BW_IN, F.a_q_gain + l * HD, F.a_k_gain + l * HD, F.ROPE_A, F.ROPE_B, (LAS float*)(F.lds + XCH_OFF), \
                (MK_BOUNDED_A && F.VEC[VEC_M0 + l] * ATT_SCALE <= 40.f) ? ATT_SCALE * 1.4426950408889634f : 1.f}; \
            pg8::gemm_phase<pg8::EpiInProj, pg8::StaticOrder, true, true>(F.lds + RING_OFF, g, S, E, F.wave)
#define PREP_PHASE(l) do {} while (0)
#else
#define INPROJ_EPI(l) pg8::EpiBf16Fold<0> E{F.PROJ, INW, F.STAT, F.VEC + VEC_CS_IN, F.VEC + VEC_BW_IN}; \
            pg8::gemm_phase<pg8::EpiBf16Fold<0>, pg8::StaticOrder, true, true>(F.lds + RING_OFF, g, S, E, F.wave)
#define PREP_PHASE(l) phase_prep(F, l)
#endif
#if MK_BF16_RES
#define RES_EPI_OUT(l) pg8::EpiResLnFoldB E{F.XB, DM, F.STAT, (l == 0) ? F.VEC + VEC_ONES : F.ln2_g + (size_t)(l - 1) * DM, (l == 0) ? F.VEC + VEC_ZEROS : F.ln2_b + (size_t)(l - 1) * DM, F.PART, DN_ALPHA}; \
            pg8::gemm_phase<pg8::EpiResLnFoldB, pg8::StaticOrder, true, true, false, MK_MIXFOLD != 0>(F.lds + RING_OFF, g, S, E, F.wave)
#define RES_EPI_FF2(l) pg8::EpiResLnFoldB E{F.XB, DM, F.STAT, F.ln1_g + (size_t)l * DM, F.ln1_b + (size_t)l * DM, F.PART, DN_ALPHA}; \
            pg8::gemm_phase<pg8::EpiResLnFoldB, pg8::StaticOrder, true, true, MK_TILED_H != 0>(F.lds + RING_OFF, g, S, E, F.wave)
#else
#define RES_EPI_OUT(l) pg8::EpiResLnFold E{(l == 0) ? F.x_prompt : F.X, (l == 0) ? F.x_sample : F.X + (size_t)NTOK_P * DM, NTOK_P / 256, F.X, F.XB, DM, F.STAT, \
                                (l == 0) ? F.VEC + VEC_ONES : F.ln2_g + (size_t)(l - 1) * DM, (l == 0) ? F.VEC + VEC_ZEROS : F.ln2_b + (size_t)(l - 1) * DM, F.PART, DN_ALPHA}; \
            pg8::gemm_phase<pg8::EpiResLnFold, pg8::StaticOrder, true, true>(F.lds + RING_OFF, g, S, E, F.wave)
#define RES_EPI_FF2(l) pg8::EpiResLnFold E{F.X, F.X + (size_t)NTOK_P * DM, NTOK_P / 256, F.X, F.XB, DM, F.STAT, F.ln1_g + (size_t)l * DM, F.ln1_b + (size_t)l * DM, F.PART, DN_ALPHA}; \
            pg8::gemm_phase<pg8::EpiResLnFold, pg8::StaticOrder, true, true, MK_TILED_H != 0>(F.lds + RING_OFF, g, S, E, F.wave)
#endif
#define LAYER_BODY(l) do { \
        const int pb = 1 + PH_PER_LAYER * l; \
        if (IN(pb + 0)) { \
            STAGGER(MK_STAGGER_IN); pg8::Gemm g{F.XB, F.Win_t, NTOK, INW, DM}; pg8::StaticOrder S; S.init(NTOK, INW, F.G, (int)blockIdx.x); \
            if (!MK_FIN_PHASES && l > 0) STATS_PREAMBLE(S); \
            { INPROJ_EPI(l); } if (MK_DUP_ALL) { INPROJ_EPI(l); } \
            if (MK_DUP_KLOOP & 1) { pg8::EpiNull EN{F.LSE}; pg8::gemm_phase<pg8::EpiNull, pg8::StaticOrder, true, true>(F.lds + RING_OFF, g, S, EN, F.wave); } \
            for (int rep = 0; rep < 1 + MK_DUP_ALL; ++rep) if (F.G == 256 && blockIdx.x >= 128) convert_weights(F, l, 0, 2, ((int)blockIdx.x - 128) * NWAVES + F.wave, 128 * NWAVES); \
        } SEAM(pb + 0); \
        if (IN(pb + 1)) { PREP_PHASE(l); } if (!MK_FUSE_PREP) SEAM(pb + 1); \
        if (IN(pb + 2)) { phase_attn_A(F, l, (char*)lds + RING_OFF); ATTN_BC(F, l, (char*)lds + RING_OFF); if ((MK_DUP_ATTN & 1) || MK_DUP_ALL) { phase_attn_A(F, l, (char*)lds + RING_OFF); } if ((MK_DUP_ATTN & 2) || MK_DUP_ALL) { ATTN_BC(F, l, (char*)lds + RING_OFF); } \
            for (int rep = 0; rep < 1 + MK_DUP_ALL; ++rep) if (l + 1 < NLAYER && F.G == 256 && F.vcu < 128) convert_weights(F, l, l + 1, 1, F.vcu * NWAVES + F.wave, 128 * NWAVES); \
            if (MK_MIXFOLD && F.G != 256) convert_weights(F, l, l + 1, ((l + 1 < NLAYER) ? 1 : 0) | 2, F.gw, F.NGW); } SEAM(pb + 2); \
        if (!MK_MIXFOLD) { if (IN(pb + 3)) { if (MK_DUP_ALL) phase_mix_copy(F); phase_mix(F, l); if (!MK_FIN_PHASES) reduce_colsums(F, (l + 1 < NLAYER) ? 3 : 2); if (F.G != 256) convert_weights(F, l, l + 1, ((l + 1 < NLAYER) ? 1 : 0) | 2, F.gw, F.NGW); } SEAM(pb + 3); } \
        if (IN(pb + 4)) { \
            STAGGER(MK_STAGGER_OUT); pg8::Gemm g{F.O, F.Wout_t, NTOK, DM, DM, F.RAT, KTAB_OFF - RING_OFF}; pg8::StaticOrder S; S.init(NTOK, DM, F.G, (int)blockIdx.x, MK_WGM_RES); \
            if (MK_MIXFOLD) { reduce_colsums(F, (l + 1 < NLAYER) ? 3 : 2); RAT_PREAMBLE(S); } \
            { RES_EPI_OUT(l); } if (MK_DUP_ALL) { pg8::EpiResCopyB EC{F.XB, DM}; pg8::gemm_phase<pg8::EpiResCopyB, pg8::StaticOrder, true, true>(F.lds + RING_OFF, g, S, EC, F.wave); } \
            if (MK_DUP_KLOOP & 2) { pg8::EpiNull EN{F.LSE}; pg8::gemm_phase<pg8::EpiNull, pg8::StaticOrder, true, true>(F.lds + RING_OFF, g, S, EN, F.wave); } \
        } SEAM(pb + 4); \
        if (MK_FIN_PHASES) { if (IN(pb + 5)) { for (int rep = 0; rep < 1 + MK_DUP_ALL; ++rep) { phase_finalize_stats(F); reduce_colsums(F, (l + 1 < NLAYER) ? 3 : 2); } } SEAM(pb + 5); } \
        if (IN(pb + 6)) { \
            STAGGER(MK_STAGGER_IN); pg8::Gemm g{F.XB, F.Wff1_t, NTOK, DFF, DM}; pg8::StaticOrder S; S.init(NTOK, DFF, F.G, (int)blockIdx.x); \
            if (!MK_FIN_PHASES) STATS_PREAMBLE(S); \
            pg8::EpiBf16Fold<3, MK_TILED_H != 0> E{F.H, DFF, F.STAT, F.VEC + VEC_CS_FF1, F.VEC + VEC_BW_FF1}; \
            pg8::gemm_phase<pg8::EpiBf16Fold<3, MK_TILED_H != 0>, pg8::StaticOrder, true, true>(F.lds + RING_OFF, g, S, E, F.wave); \
            if (MK_DUP_ALL) pg8::gemm_phase<pg8::EpiBf16Fold<3, MK_TILED_H != 0>, pg8::StaticOrder, true, true>(F.lds + RING_OFF, g, S, E, F.wave); \
            if (MK_DUP_KLOOP & 4) { pg8::EpiNull EN{F.LSE}; pg8::gemm_phase<pg8::EpiNull, pg8::StaticOrder, true, true>(F.lds + RING_OFF, g, S, EN, F.wave); } \
            if (MK_XCD_EXTRA >= 0 && (int)(blockIdx.x & 7) == MK_XCD_EXTRA) { pg8::StaticOrder S1; S1.init(256, 256, 1, 0); pg8::gemm_phase<pg8::EpiBf16Fold<3, MK_TILED_H != 0>, pg8::StaticOrder, true, true>(F.lds + RING_OFF, g, S1, E, F.wave); } \
        } SEAM(pb + 6); \
        if (IN(pb + 7)) { \
            STAGGER(MK_STAGGER_OUT); pg8::Gemm g{F.H, F.Wff2_t, NTOK, DM, DFF}; pg8::StaticOrder S; S.init(NTOK, DM, F.G, (int)blockIdx.x, MK_WGM_RES); \
            { RES_EPI_FF2(l); } if (MK_DUP_ALL) { pg8::EpiResCopyB EC{F.XB, DM}; pg8::gemm_phase<pg8::EpiResCopyB, pg8::StaticOrder, true, true, MK_TILED_H != 0>(F.lds + RING_OFF, g, S, EC, F.wave); } \
            if (MK_DUP_KLOOP & 8) { pg8::EpiNull EN{F.LSE}; pg8::gemm_phase<pg8::EpiNull, pg8::StaticOrder, true, true, MK_TILED_H != 0>(F.lds + RING_OFF, g, S, EN, F.wave); } \
        } SEAM(pb + 7); \
        if (MK_FIN_PHASES) { if (IN(pb + 8)) { for (int rep = 0; rep < 1 + MK_DUP_ALL; ++rep) phase_finalize_stats(F); } SEAM(pb + 8); } \
    } while (0)
#if !MK_HALVES
    LAYER_BODY(0); LAYER_BODY(1); LAYER_BODY(2); LAYER_BODY(3);
#else
#define SBK(l, i) ((l) * 6 + (i))
#define ROT_C(r) (((F.G & (F.G - 1)) == 0 && F.G >= 256) ? (((int)blockIdx.x + 64 * (r)) & (F.G - 1)) : (int)blockIdx.x)
#define SB_ARRIVE(k) do { sb_arrive(F, (k)); if (MK_SB_EAGER) sb_wait(F, (k)); } while (0)
#define SB_WAIT(k) do { if (!MK_SB_EAGER) sb_wait(F, (k)); } while (0)
#define GEMM_IN_H(l, h) do { pg8::Gemm g{F.XB, F.Win_t, NTOK, INW, DM}; pg8::HalfOrder S; S.init(NTOK / 2, INW, F.G, ROT_C((2 * (l) + (h)) & 3), pg8::WGM, (NTOK / 512) * (h)); \
            if ((l) > 0) STATS_PREAMBLE(S); \
            pg8::EpiInProj E{F.PROJ, INW, F.STAT, F.VEC + VEC_CS_IN, F.VEC + VEC_BW_IN, F.a_q_gain + (l) * HD, F.a_k_gain + (l) * HD, F.ROPE_A, F.ROPE_B, (LAS float*)(F.lds + XCH_OFF), \
                (MK_BOUNDED_A && F.VEC[VEC_M0 + (l)] * ATT_SCALE <= 40.f) ? ATT_SCALE * 1.4426950408889634f : 1.f}; \
            pg8::gemm_phase<pg8::EpiInProj, pg8::HalfOrder, true, true>(F.lds + RING_OFF, g, S, E, F.wave); } while (0)
#define GEMM_OUT_H(l, h) do { pg8::Gemm g{F.O, F.Wout_t, NTOK, DM, DM}; pg8::HalfOrder S; S.init(NTOK / 2, DM, F.G, (int)blockIdx.x, MK_WGM_RES, (NTOK / 512) * (h)); \
            pg8::EpiResLnFoldB E{F.XB, DM, F.STAT, ((l) == 0) ? F.VEC + VEC_ONES : F.ln2_g + (size_t)((l) - 1) * DM, ((l) == 0) ? F.VEC + VEC_ZEROS : F.ln2_b + (size_t)((l) - 1) * DM, F.PART, DN_ALPHA}; \
            pg8::gemm_phase<pg8::EpiResLnFoldB, pg8::HalfOrder, true, true>(F.lds + RING_OFF, g, S, E, F.wave); } while (0)
#define GEMM_FF1_H(l, h) do { pg8::Gemm g{F.XB, F.Wff1_t, NTOK, DFF, DM}; pg8::HalfOrder S; S.init(NTOK / 2, DFF, F.G, (int)blockIdx.x, pg8::WGM, (NTOK / 512) * (h)); \
            STATS_PREAMBLE(S); \
            pg8::EpiBf16Fold<3, MK_TILED_H != 0> E{F.H, DFF, F.STAT, F.VEC + VEC_CS_FF1, F.VEC + VEC_BW_FF1}; \
            pg8::gemm_phase<pg8::EpiBf16Fold<3, MK_TILED_H != 0>, pg8::HalfOrder, true, true>(F.lds + RING_OFF, g, S, E, F.wave); } while (0)
#define GEMM_FF2_H(l, h) do { pg8::Gemm g{F.H, F.Wff2_t, NTOK, DM, DFF}; pg8::HalfOrder S; S.init(NTOK / 2, DM, F.G, (int)blockIdx.x, MK_WGM_RES, (NTOK / 512) * (h)); \
            pg8::EpiResLnFoldB E{F.XB, DM, F.STAT, F.ln1_g + (size_t)(l) * DM, F.ln1_b + (size_t)(l) * DM, F.PART, DN_ALPHA}; \
            pg8::gemm_phase<pg8::EpiResLnFoldB, pg8::HalfOrder, true, true, MK_TILED_H != 0>(F.lds + RING_OFF, g, S, E, F.wave); } while (0)
#define XBAR() xcd_barrier(bar, F.wave == 0 && lane_id() == 0)
#define LAYER_BODY_H(l) do { \
        if ((l) > 0) SB_WAIT(SBK((l) - 1, 4)); GEMM_IN_H(l, 0); \
        if ((l) > 0) SB_WAIT(SBK((l) - 1, 5)); GEMM_IN_H(l, 1); \
        if (F.G == 256 && (((int)blockIdx.x >> 7) ^ ((l) & 1)) == 1) convert_weights(F, l, 0, 2, ((int)blockIdx.x & 127) * NWAVES + F.wave, 128 * NWAVES);     \
        XBAR(); \
        phase_attn_A(F, l, (char*)lds + RING_OFF); phase_attn_B(F, (char*)lds + RING_OFF); phase_attn_C(F, l, (char*)lds + RING_OFF); \
        if ((l) + 1 < NLAYER && F.vcu < F.G / 2) convert_weights(F, l, (l) + 1, 1, F.vcu * NWAVES + F.wave, (F.G / 2) * NWAVES); \
        if (F.G != 256) convert_weights(F, l, 0, 2, F.gw, F.NGW); \
        XBAR(); \
        phase_mix(F, l); reduce_colsums(F, ((l) + 1 < NLAYER) ? 3 : 2); \
        XBAR(); \
        GEMM_OUT_H(l, 0); SB_ARRIVE(SBK(l, 0)); \
        GEMM_OUT_H(l, 1); SB_ARRIVE(SBK(l, 1)); \
        SB_WAIT(SBK(l, 0)); GEMM_FF1_H(l, 0); SB_ARRIVE(SBK(l, 2)); \
        SB_WAIT(SBK(l, 1)); GEMM_FF1_H(l, 1); SB_ARRIVE(SBK(l, 3)); \
        SB_WAIT(SBK(l, 2)); GEMM_FF2_H(l, 0); SB_ARRIVE(SBK(l, 4)); \
        SB_WAIT(SBK(l, 3)); GEMM_FF2_H(l, 1); SB_ARRIVE(SBK(l, 5)); \
    } while (0)
    LAYER_BODY_H(0); LAYER_BODY_H(1); LAYER_BODY_H(2); LAYER_BODY_H(3);
    SB_WAIT(SBK(NLAYER - 1, 4)); SB_WAIT(SBK(NLAYER - 1, 5));
#undef LAYER_BODY_H
#endif
#undef LAYER_BODY
    if (IN(N_PHASES - 1)) { phase_final_ln(F, F.ln2_g + (size_t)(NLAYER - 1) * DM, F.ln2_b + (size_t)(NLAYER - 1) * DM); if (MK_DUP_ENDS & 2) phase_final_ln(F, F.ln2_g + (size_t)(NLAYER - 1) * DM, F.ln2_b + (size_t)(NLAYER - 1) * DM); }

#undef IN
#undef SEAM
}

extern "C" void kernel_launch(void* const* d_in, const int* in_sizes, int n_in, void* d_out, int out_size, void* d_ws, size_t ws_size, hipStream_t stream) {
    static int grid = 0;
    if (grid == 0) {
        if (n_in != 14 || in_sizes[0] != NTOK_P * DM || out_size != NTOK * DM || ws_size < WS_END) { fprintf(stderr, "kernel_launch: shape/workspace mismatch (n_in %d, out %d, ws %zu < %zu); nothing launched\n", n_in, out_size, ws_size, (size_t)WS_END); grid = -1; return; }
        int dev = 0, cus = 0, per_cu = 0;
        if (hipGetDevice(&dev) != hipSuccess || hipDeviceGetAttribute(&cus, hipDeviceAttributeMultiprocessorCount, dev) != hipSuccess) { grid = -1; return; }
        if (hipFuncSetAttribute((const void*)trunk_fwd, hipFuncAttributeMaxDynamicSharedMemorySize, LDS_BYTES) != hipSuccess) { fprintf(stderr, "kernel_launch: hipFuncSetAttribute failed\n"); grid = -1; return; }
        if (hipOccupancyMaxActiveBlocksPerMultiprocessor(&per_cu, (const void*)trunk_fwd, NWAVES * 64, LDS_BYTES) != hipSuccess || per_cu < 1) { fprintf(stderr, "kernel_launch: occupancy query says %d blocks per CU\n", per_cu); }
        (void)hipGetLastError();
        grid = cus;
    }
    if (grid < 0) return;
    if (hipMemsetAsync((char*)d_ws + WS_CTL, 0, CTL_ZERO_BYTES, stream) != hipSuccess) return;
    Args a{};
    for (int i = 0; i < 14; ++i) a.in[i] = (const float*)d_in[i];
    a.out = (float*)d_out; a.ws = (unsigned char*)d_ws;
#if MK_PER_PHASE
    for (int p = 0; p < N_PHASES; ++p) { a.ph_lo = p; a.ph_hi = p + 1; hipLaunchKernelGGL(trunk_fwd, dim3(grid), dim3(NWAVES * 64), LDS_BYTES, stream, a); }
#else
    a.ph_lo = 0; a.ph_hi = N_PHASES;
    hipLaunchKernelGGL(trunk_fwd, dim3(grid), dim3(NWAVES * 64), LDS_BYTES, stream, a);
#endif
    const hipError_t le = hipPeekAtLastError();
    if (le != hipSuccess) fprintf(stderr, "kernel_launch: launch failed: %s\n", hipGetErrorName(le));
}
```

```cpp
#include <hip/hip_runtime.h>
#include <hip/hip_bf16.h>
#include <cstdio>
#include <cstdint>
#include <cmath>
__device__ __forceinline__ int lane_id() { int l; asm volatile("v_mbcnt_lo_u32_b32 %0, -1, 0\n\tv_mbcnt_hi_u32_b32 %0, -1, %0" : "=v"(l)); return l; }
template <int M> __device__ __forceinline__ float xshfl(float v) { static_assert(M >= 1 && M < 32, "xshfl: xor mask 1..31"); return __builtin_bit_cast(float, __builtin_amdgcn_ds_swizzle(__builtin_bit_cast(int, v), (M << 10) | 0x1f)); }
__device__ __forceinline__ float rowsum16(float v) {
    v += __builtin_bit_cast(float, __builtin_amdgcn_update_dpp(0, __builtin_bit_cast(int, v), 0xB1, 0xF, 0xF, true));
    v += __builtin_bit_cast(float, __builtin_amdgcn_update_dpp(0, __builtin_bit_cast(int, v), 0x4E, 0xF, 0xF, true));
    v += __builtin_bit_cast(float, __builtin_amdgcn_update_dpp(0, __builtin_bit_cast(int, v), 0x141, 0xF, 0xF, true));
    v += __builtin_bit_cast(float, __builtin_amdgcn_update_dpp(0, __builtin_bit_cast(int, v), 0x140, 0xF, 0xF, true));
    return v;
}
__device__ __forceinline__ void xswap32(float& a, float& b) { asm volatile("s_nop 1\n\tv_permlane32_swap_b32 %0, %1" : "+v"(a), "+v"(b)); }
__device__ __forceinline__ float xsum32(float v) { float a = v, b = v; xswap32(a, b); return a + b; }
__device__ __forceinline__ float xmax32(float v) { float a = v, b = v; xswap32(a, b); return fmaxf(a, b); }
#ifndef MK_MIXFOLD
#define MK_MIXFOLD 1
#endif
#define MK_SSQ_FROM_O_BYTES ((1012L - 820L) << 20)
#ifndef MK_NT_H
#define MK_NT_H 1
#endif
#ifndef MK_NT_PROJ
#define MK_NT_PROJ 0
#endif
#ifndef MK_NT_HLOAD
#define MK_NT_HLOAD 0
#endif
#ifndef MK_TILED_W
#define MK_TILED_W 0
#endif
namespace pg8 {
#define PG8_LAS __attribute__((address_space(3)))
typedef unsigned short bf16_t;
typedef short bf16x8 __attribute__((ext_vector_type(8)));
typedef float f32x4 __attribute__((ext_vector_type(4)));
typedef unsigned u32x4 __attribute__((ext_vector_type(4)));
constexpr int BM = 256, BK = 64, HALF = 128, HTB = HALF * BK * 2  , STAGE_BYTES = 8 * HTB, NXCD = 8, WGM = 8;

__host__ __device__ __forceinline__ int lds_byte(int r, int c) { const int st = (r >> 4) * 2 + (c >> 5), rr = r & 15, cc = c & 31, ob = rr * 64 + cc * 2; return st * 1024 + (ob ^ (((ob >> 9) & 1) << 5)); }
__host__ __device__ __forceinline__ void stage_rc(int b, int& R, int& C) { const int st = b / 1024, sb = b % 1024, swz = sb ^ (((sb >> 9) & 1) << 5); R = (st >> 1) * 16 + swz / 64; C = (st & 1) * 32 + (swz % 64) / 2; }
__host__ __device__ __forceinline__ int perm32(int rho) { const int n = rho >> 4, i = rho & 15; return 8 * (i >> 2) + 4 * n + (i & 3); }

struct Unit { int pm, pn; };
struct Gemm { const bf16_t* A; const bf16_t* Bt; int M, N, K; const float* rat = nullptr; int ktab_off = 0; };

struct StaticOrder {
    int nM, nN, nwg, G, c, wgm;
    __host__ __device__ __forceinline__ void init(int M, int N, int G_, int c_, int wgm_ = WGM) { nM = M / BM; nN = N / BM; nwg = nM * nN; G = G_; c = c_; wgm = wgm_; }
    __host__ __device__ __forceinline__ bool next(int i, Unit& u) const {
        const long L = (long)i * G + c; if (L >= nwg) return false;
        int wgid = (int)L; { const int q = nwg / NXCD, r = nwg % NXCD, xcd = wgid % NXCD, off = wgid / NXCD; wgid = (xcd < r ? xcd * (q + 1) : r * (q + 1) + (xcd - r) * q) + off; }
        const int nig = wgm * nN, gid = wgid / nig, fm = gid * wgm, gsz = (nM - fm) < wgm ? (nM - fm) : wgm;
        u.pm = fm + ((wgid % nig) % gsz); u.pn = (wgid % nig) / gsz; return true;
    }
    __device__ __forceinline__ void a_ready(const Unit&) const {}
    __device__ __forceinline__ void done(const Unit&) const {}
};

struct HalfOrder {
    StaticOrder s; int pmb;
    __host__ __device__ __forceinline__ void init(int Mh, int N, int G_, int c_, int wgm_, int pmb_) { s.init(Mh, N, G_, c_, wgm_); pmb = pmb_; }
    __host__ __device__ __forceinline__ bool next(int i, Unit& u) const { const bool ok = s.next(i, u); u.pm += pmb; return ok; }
    __device__ __forceinline__ void a_ready(const Unit&) const {}
    __device__ __forceinline__ void done(const Unit&) const {}
};
__device__ __forceinline__ unsigned cvt_pk_bf16(float lo, float hi) { unsigned r; asm volatile("v_cvt_pk_bf16_f32 %0, %1, %2" : "=v"(r) : "v"(lo), "v"(hi)); return r; }
typedef float f32x2 __attribute__((ext_vector_type(2)));
__device__ __forceinline__ f32x2 gelu_pk(f32x2 v) {
    const f32x2 av = __builtin_elementwise_abs(v), d = av * 0.2316418882f + 1.0f;
    f32x2 t; t.x = __builtin_amdgcn_rcpf(d.x); t.y = __builtin_amdgcn_rcpf(d.y);
    f32x2 q = t * 0.5307027145f + (-0.7265760135f); q = q * t + 0.7107068705f; q = q * t + (-0.142248368f); q = q * t + 0.127414796f; q = q * t;
    const f32x2 s = (v * v) * (-0.72134752044f);
    f32x2 e; e.x = __builtin_amdgcn_exp2f(s.x); e.y = __builtin_amdgcn_exp2f(s.y);
    const f32x2 m = v * (q * e), r = v - m;
    f32x2 o; o.x = v.x < 0.f ? m.x : r.x; o.y = v.y < 0.f ? m.y : r.y; return o;
}

template <int ACT  > struct EpiBf16 {
    static constexpr bool PERM = true, AFTER_DRAIN = false; static constexpr int MIN_VMEM = 0;     static_assert(ACT == 0 || ACT == 1, "EpiBf16: ACT is 0 (none) or 1 (gelu_pk)");
    bf16_t* O; int ldc; const float* bias; int split_cols; size_t split_stride; float scale0;
    __device__ __forceinline__ void operator()(const f32x4 (&acc)[2][2][4][2], const Unit& u, int wr, int wc, int fr, int fq) const {
        const int row0 = u.pm * BM + wr * 64 + fr; int colt = u.pn * BM; bf16_t* base = O;
        float sc = 1.f; if (split_cols) { const int t = colt / split_cols; base += (size_t)t * split_stride; colt -= t * split_cols; if (t == 0) sc = scale0; }
        const int col0 = colt + wc * 32 + 8 * fq, bcol0 = u.pn * BM + wc * 32 + 8 * fq;
        f32x4 bv[2][2];
#pragma unroll
        for (int bj = 0; bj < 2; ++bj)
#pragma unroll
            for (int n = 0; n < 2; ++n) bv[bj][n] = bias ? *(const f32x4*)(bias + bcol0 + bj * HALF + 4 * n) : (f32x4){0.f, 0.f, 0.f, 0.f};
#pragma unroll
        for (int ai = 0; ai < 2; ++ai)
#pragma unroll
            for (int m = 0; m < 4; ++m) { bf16_t* rowp = base + (size_t)(row0 + ai * HALF + m * 16) * ldc + col0;
#pragma unroll
                for (int bj = 0; bj < 2; ++bj) { f32x4 v0 = acc[ai][bj][m][0] + bv[bj][0], v1 = acc[ai][bj][m][1] + bv[bj][1];
                    if (ACT == 1) { f32x2 a = gelu_pk((f32x2){v0[0], v0[1]}), b = gelu_pk((f32x2){v0[2], v0[3]}), c = gelu_pk((f32x2){v1[0], v1[1]}), d = gelu_pk((f32x2){v1[2], v1[3]});
                        v0 = (f32x4){a.x, a.y, b.x, b.y}; v1 = (f32x4){c.x, c.y, d.x, d.y}; }
                    v0 = v0 * sc; v1 = v1 * sc; u32x4 w; w.x = cvt_pk_bf16(v0[0], v0[1]); w.y = cvt_pk_bf16(v0[2], v0[3]); w.z = cvt_pk_bf16(v1[0], v1[1]); w.w = cvt_pk_bf16(v1[2], v1[3]);
                    *(u32x4*)(rowp + bj * HALF) = w; } }
    }
};


struct EpiRelu2Bf16 {
    static constexpr bool PERM = true, AFTER_DRAIN = false; static constexpr int MIN_VMEM = 0;
    bf16_t* O; int ldc;
    __device__ __forceinline__ void operator()(const f32x4 (&acc)[2][2][4][2], const Unit& u, int wr, int wc, int fr, int fq) const {
        const int row0 = u.pm * BM + wr * 64 + fr; const int col0 = u.pn * BM + wc * 32 + 8 * fq;
#pragma unroll
        for (int ai = 0; ai < 2; ++ai)
#pragma unroll
            for (int m = 0; m < 4; ++m) { bf16_t* rowp = O + (size_t)(row0 + ai * HALF + m * 16) * ldc + col0;
#pragma unroll
                for (int bj = 0; bj < 2; ++bj) { f32x4 v0 = acc[ai][bj][m][0], v1 = acc[ai][bj][m][1];
#pragma unroll
                    for (int e = 0; e < 4; ++e) { const float a = fmaxf(v0[e], 0.f), b = fmaxf(v1[e], 0.f); v0[e] = a * a; v1[e] = b * b; }
                    u32x4 w; w.x = cvt_pk_bf16(v0[0], v0[1]); w.y = cvt_pk_bf16(v0[2], v0[3]); w.z = cvt_pk_bf16(v1[0], v1[1]); w.w = cvt_pk_bf16(v1[2], v1[3]);
                    *(u32x4*)(rowp + bj * HALF) = w; } }
    }
};
struct EpiResF32 {
    static constexpr bool PERM = false, AFTER_DRAIN = false; static constexpr int MIN_VMEM = 0;
    const float* X; float* Z; int ldc; float alpha;
    __device__ __forceinline__ void operator()(const f32x4 (&acc)[2][2][4][2], const Unit& u, int wr, int wc, int fr, int fq) const {
        const int row0 = u.pm * BM + wr * 64 + fr, col0 = u.pn * BM + wc * 32 + 4 * fq;
#pragma unroll
        for (int ai = 0; ai < 2; ++ai)
#pragma unroll
            for (int m = 0; m < 4; ++m) { const size_t off = (size_t)(row0 + ai * HALF + m * 16) * ldc + col0;
#pragma unroll
                for (int bj = 0; bj < 2; ++bj)
#pragma unroll
                    for (int n = 0; n < 2; ++n) { const f32x4 xv = *(const f32x4*)(X + off + bj * HALF + n * 16);
                        *(f32x4*)(Z + off + bj * HALF + n * 16) = xv * alpha + acc[ai][bj][m][n]; } }
    }
};

template <int ACT, bool TILED = false> struct EpiBf16Fold {
    static constexpr bool PERM = true, AFTER_DRAIN = false; static constexpr int MIN_VMEM = 16;
    bf16_t* O; int ldc; const f32x2* stat; const float* cs; const float* bw;
    __device__ __forceinline__ void operator()(const f32x4 (&acc)[2][2][4][2], const Unit& u, int wr, int wc, int fr, int fq) const {
        const int row0 = u.pm * BM + wr * 64 + fr; const int col0 = u.pn * BM + wc * 32 + 8 * fq;
        f32x4 cv[2][2], bv[2][2]; f32x2 st[2][4];
#pragma unroll
        for (int ai = 0; ai < 2; ++ai)
#pragma unroll
            for (int m = 0; m < 4; ++m) st[ai][m] = stat[row0 + ai * HALF + m * 16];
#pragma unroll
        for (int bj = 0; bj < 2; ++bj)
#pragma unroll
            for (int n = 0; n < 2; ++n) { cv[bj][n] = *(const f32x4*)(cs + col0 + bj * HALF + 4 * n); bv[bj][n] = *(const f32x4*)(bw + col0 + bj * HALF + 4 * n); }
#pragma unroll
        for (int ai = 0; ai < 2; ++ai)
#pragma unroll
            for (int m = 0; m < 4; ++m) { const int row = row0 + ai * HALF + m * 16; const float rs = st[ai][m].y, nm = -st[ai][m].x * st[ai][m].y;
                bf16_t* rowp = TILED ? O + ((size_t)(row >> 8) * (ldc >> 6) + (col0 >> 6)) * 16384 + (row & 255) * 64 + (col0 & 63) : O + (size_t)row * ldc + col0;
#pragma unroll
                for (int bj = 0; bj < 2; ++bj) { f32x4 v0 = acc[ai][bj][m][0] * rs + (cv[bj][0] * nm + bv[bj][0]), v1 = acc[ai][bj][m][1] * rs + (cv[bj][1] * nm + bv[bj][1]);
                    if (ACT == 3) {
#pragma unroll
                        for (int e = 0; e < 4; ++e) { const float a = fmaxf(v0[e], 0.f), b = fmaxf(v1[e], 0.f); v0[e] = a * a; v1[e] = b * b; } }
                    u32x4 w; w.x = cvt_pk_bf16(v0[0], v0[1]); w.y = cvt_pk_bf16(v0[2], v0[3]); w.z = cvt_pk_bf16(v1[0], v1[1]); w.w = cvt_pk_bf16(v1[2], v1[3]);
                    if (TILED && MK_NT_H) __builtin_nontemporal_store(w, (u32x4*)(rowp + bj * 2 * 16384)); else *(u32x4*)(rowp + (TILED ? bj * 2 * 16384 : bj * HALF)) = w; } }
    }
};
struct EpiResLnFold {
    static constexpr bool PERM = false, AFTER_DRAIN = false; static constexpr int MIN_VMEM = 0;
    const float* Xp; const float* Xs; int split_pm;
    float* Z; bf16_t* ZB; int ldc; const f32x2* stat; const float* g; const float* b; f32x2* part; float alpha;
    __device__ __forceinline__ void operator()(const f32x4 (&acc)[2][2][4][2], const Unit& u, int wr, int wc, int fr, int fq) const {
        typedef unsigned u32x2v __attribute__((ext_vector_type(2)));
        const int row0 = u.pm * BM + wr * 64 + fr, col0 = u.pn * BM + wc * 32 + 4 * fq;
        const float* xbase = (u.pm < split_pm) ? Xp : Xs - (size_t)split_pm * BM * ldc;
        f32x4 gv[2][2], bv[2][2]; f32x2 st[2][4];
#pragma unroll
        for (int ai = 0; ai < 2; ++ai)
#pragma unroll
            for (int m = 0; m < 4; ++m) st[ai][m] = stat[row0 + ai * HALF + m * 16];
#pragma unroll
        for (int bj = 0; bj < 2; ++bj)
#pragma unroll
            for (int n = 0; n < 2; ++n) { gv[bj][n] = *(const f32x4*)(g + col0 + bj * HALF + n * 16); bv[bj][n] = *(const f32x4*)(b + col0 + bj * HALF + n * 16); }
        f32x4 xv[2][2][2];
#define RLF_LOAD(buf, rg) do { const size_t off_ = (size_t)(row0 + ((rg) >> 2) * HALF + ((rg) & 3) * 16) * ldc + col0; \
            _Pragma("unroll") for (int bj = 0; bj < 2; ++bj) _Pragma("unroll") for (int n = 0; n < 2; ++n) xv[buf][bj][n] = *(const f32x4*)(xbase + off_ + bj * HALF + n * 16); } while (0)
        RLF_LOAD(0, 0);
#pragma unroll
        for (int rg = 0; rg < 8; ++rg) { const int ai = rg >> 2, m = rg & 3, cur = rg & 1;
            if (rg + 1 < 8) RLF_LOAD(cur ^ 1, rg + 1);
            asm volatile("" ::: "memory");
            const int row = row0 + ai * HALF + m * 16; const size_t off = (size_t)row * ldc + col0; const float mu = st[ai][m].x, rs = st[ai][m].y;
            float s = 0.f, q = 0.f;
#pragma unroll
            for (int bj = 0; bj < 2; ++bj)
#pragma unroll
                for (int n = 0; n < 2; ++n) {
                    const f32x4 xn = (xv[cur][bj][n] - mu) * rs * gv[bj][n] + bv[bj][n]; const f32x4 z = xn * alpha + acc[ai][bj][m][n];
                    *(f32x4*)(Z + off + bj * HALF + n * 16) = z;
                    u32x2v w; w.x = cvt_pk_bf16(z[0], z[1]); w.y = cvt_pk_bf16(z[2], z[3]); *(u32x2v*)(ZB + off + bj * HALF + n * 16) = w;
                    s += (z[0] + z[1]) + (z[2] + z[3]); q += (z[0] * z[0] + z[1] * z[1]) + (z[2] * z[2] + z[3] * z[3]); }
            s += xshfl<16>(s); s = xsum32(s); q += xshfl<16>(q); q = xsum32(q);
            if (fq == 0) part[(size_t)row * 32 + u.pn * 4 + wc] = (f32x2){s, q};
            asm volatile("" ::: "memory");
        }
#undef RLF_LOAD
    }
};

struct EpiInProj {
    static constexpr bool PERM = true, AFTER_DRAIN = false; static constexpr int MIN_VMEM = 16;
    bf16_t* O; int ldc; const f32x2* stat; const float* cs; const float* bw;
    const float* gq; const float* gk; const float* ropeA; const float* ropeB; PG8_LAS float* xch;
    float qscale;
    __device__ __forceinline__ void operator()(const f32x4 (&acc_)[2][2][4][2], const Unit& u, int wr, int wc, int fr, int fq) const {
        f32x4 (&acc)[2][2][4][2] = const_cast<f32x4 (&)[2][2][4][2]>(acc_);
        const int row0 = u.pm * BM + wr * 64 + fr; const int col0 = u.pn * BM + wc * 32 + 8 * fq;
        const int kind = (u.pn < 3) ? 1 : (u.pn >= 4 && u.pn < 10) ? 2 : 0;
        { f32x4 cv[2][2], bv[2][2]; f32x2 st[2][4];
#pragma unroll
          for (int ai = 0; ai < 2; ++ai)
#pragma unroll
            for (int m = 0; m < 4; ++m) st[ai][m] = stat[row0 + ai * HALF + m * 16];
#pragma unroll
          for (int bj = 0; bj < 2; ++bj)
#pragma unroll
            for (int n = 0; n < 2; ++n) { cv[bj][n] = *(const f32x4*)(cs + col0 + bj * HALF + 4 * n); bv[bj][n] = *(const f32x4*)(bw + col0 + bj * HALF + 4 * n); }
#pragma unroll
          for (int ai = 0; ai < 2; ++ai)
#pragma unroll
            for (int m = 0; m < 4; ++m) { const float rs = st[ai][m].y, nm = -st[ai][m].x * st[ai][m].y;
#pragma unroll
                for (int bj = 0; bj < 2; ++bj)
#pragma unroll
                    for (int n = 0; n < 2; ++n) acc[ai][bj][m][n] = acc[ai][bj][m][n] * rs + (cv[bj][n] * nm + bv[bj][n]); } }
        if (kind == 0) {
#pragma unroll
            for (int ai = 0; ai < 2; ++ai)
#pragma unroll
                for (int m = 0; m < 4; ++m) { bf16_t* rowp = O + (size_t)(row0 + ai * HALF + m * 16) * ldc + col0;
#pragma unroll
                    for (int bj = 0; bj < 2; ++bj) { const f32x4 v0 = acc[ai][bj][m][0], v1 = acc[ai][bj][m][1];
                        u32x4 w; w.x = cvt_pk_bf16(v0[0], v0[1]); w.y = cvt_pk_bf16(v0[2], v0[3]); w.z = cvt_pk_bf16(v1[0], v1[1]); w.w = cvt_pk_bf16(v1[2], v1[3]);
                        if (MK_NT_PROJ) __builtin_nontemporal_store(w, (u32x4*)(rowp + bj * HALF)); else *(u32x4*)(rowp + bj * HALF) = w; } }
            return;
        }
        const float qs = (u.pn < 2) ? qscale : 1.f;
        const int half = wc >> 1;
        const int i0 = (kind == 1) ? 4 * (4 * (wc & 1) + fq) : 16 * wc + 4 * fq;
        f32x4 g_lo = {1.f, 1.f, 1.f, 1.f}, g_hi = {1.f, 1.f, 1.f, 1.f};
        if (kind == 1) {
            const float* gain = (u.pn < 2) ? gq : gk; g_lo = *(const f32x4*)(gain + 64 * half + i0); g_hi = *(const f32x4*)(gain + 64 * half + i0 + 32);
#pragma unroll
            for (int ai = 0; ai < 2; ++ai)
#pragma unroll
                for (int m = 0; m < 4; ++m)
#pragma unroll
                    for (int bj = 0; bj < 2; ++bj) { const f32x4 a = acc[ai][bj][m][0], b = acc[ai][bj][m][1];
                        float ss = ((a[0] * a[0] + a[1] * a[1]) + (a[2] * a[2] + a[3] * a[3])) + ((b[0] * b[0] + b[1] * b[1]) + (b[2] * b[2] + b[3] * b[3]));
                        ss += xshfl<16>(ss); ss = xsum32(ss);
                        if (fq == 0) xch[((ai * HALF + wr * 64 + m * 16 + fr) * 2 + bj) * 4 + wc] = ss; }
            asm volatile("s_waitcnt lgkmcnt(0)" ::: "memory"); __builtin_amdgcn_s_barrier(); asm volatile("" ::: "memory");
        }
        f32x4 tb[2][2][2];
#define EIP_LOAD(buf, sg) do { _Pragma("unroll") for (int h = 0; h < 2; ++h) { const int rg_ = 2 * (sg) + h; const int t_ = (row0 + (rg_ >> 2) * HALF + (rg_ & 3) * 16) & 4095; \
            const float* tp_ = (kind == 1) ? ropeA + 2 * ((half ? (t_ & 63) : (t_ >> 6)) * 32 + i0) : ropeB + 2 * (t_ * 64 + i0); \
            tb[buf][h][0] = *(const f32x4*)tp_; tb[buf][h][1] = *(const f32x4*)(tp_ + 4); } } while (0)
        EIP_LOAD(0, 0);
#pragma unroll
        for (int sg = 0; sg < 4; ++sg) { const int cur = sg & 1;
            if (sg + 1 < 4) EIP_LOAD(cur ^ 1, sg + 1);
            asm volatile("" ::: "memory");
#pragma unroll
            for (int h = 0; h < 2; ++h) { const int rg = 2 * sg + h, ai = rg >> 2, m = rg & 3; const int rl = ai * HALF + wr * 64 + m * 16 + fr;
                bf16_t* rowp = O + (size_t)(u.pm * BM + rl) * ldc + col0;
                const f32x4 t0 = tb[cur][h][0], t1 = tb[cur][h][1];
                const f32x4 cs4 = {t0[0], t0[2], t1[0], t1[2]}, sn4 = {t0[1], t0[3], t1[1], t1[3]};
#pragma unroll
                for (int bj = 0; bj < 2; ++bj) { f32x4 lo = acc[ai][bj][m][0], hi = acc[ai][bj][m][1];
                    if (kind == 1) { const f32x4 pq = *(const PG8_LAS f32x4*)(xch + (rl * 2 + bj) * 4); const float rs = 1.0f / sqrtf(((pq[0] + pq[1]) + (pq[2] + pq[3])) * (1.0f / 128.f) + 1e-6f);
                        lo = lo * (rs * qs) * g_lo; hi = hi * (rs * qs) * g_hi; }
                    const f32x4 ol = lo * cs4 - hi * sn4, oh = hi * cs4 + lo * sn4;
                    u32x4 w; w.x = cvt_pk_bf16(ol[0], ol[1]); w.y = cvt_pk_bf16(ol[2], ol[3]); w.z = cvt_pk_bf16(oh[0], oh[1]); w.w = cvt_pk_bf16(oh[2], oh[3]);
                    if (MK_NT_PROJ) __builtin_nontemporal_store(w, (u32x4*)(rowp + bj * HALF)); else *(u32x4*)(rowp + bj * HALF) = w; } }
            asm volatile("" ::: "memory");
        }
#undef EIP_LOAD
        if (kind == 1) { asm volatile("s_waitcnt lgkmcnt(0)" ::: "memory"); __builtin_amdgcn_s_barrier(); asm volatile("" ::: "memory"); }
    }
};

struct EpiResLnFoldB {
    static constexpr bool PERM = false, AFTER_DRAIN = false; static constexpr int MIN_VMEM = 16;
    bf16_t* ZB; int ldc; const f32x2* stat; const float* g; const float* b; f32x2* part; float alpha;
    __device__ __forceinline__ void operator()(const f32x4 (&acc)[2][2][4][2], const Unit& u, int wr, int wc, int fr, int fq) const {
        typedef unsigned u32x2v __attribute__((ext_vector_type(2)));
        const int row0 = u.pm * BM + wr * 64 + fr, col0 = u.pn * BM + wc * 32 + 4 * fq;
        f32x4 gv[2][2], bv[2][2]; f32x2 st[2]; u32x2v xv[2][2][2];
#pragma unroll
        for (int bj = 0; bj < 2; ++bj)
#pragma unroll
            for (int n = 0; n < 2; ++n) { gv[bj][n] = *(const f32x4*)(g + col0 + bj * HALF + n * 16); bv[bj][n] = *(const f32x4*)(b + col0 + bj * HALF + n * 16); }
#define RLB_LOAD(buf, rg) do { const int row_ = row0 + ((rg) >> 2) * HALF + ((rg) & 3) * 16; const size_t off_ = (size_t)row_ * ldc + col0; st[buf] = stat[row_]; \
            _Pragma("unroll") for (int bj = 0; bj < 2; ++bj) _Pragma("unroll") for (int n = 0; n < 2; ++n) xv[buf][bj][n] = *(const u32x2v*)(ZB + off_ + bj * HALF + n * 16); } while (0)
        RLB_LOAD(0, 0);
#pragma unroll
        for (int rg = 0; rg < 8; ++rg) { const int cur = rg & 1, ai = rg >> 2, m = rg & 3;
            if (rg + 1 < 8) RLB_LOAD(cur ^ 1, rg + 1);
            asm volatile("" ::: "memory");
            const int row = row0 + ai * HALF + m * 16; const size_t off = (size_t)row * ldc + col0; const float mu = st[cur].x, rs = st[cur].y;
            float s = 0.f, q = 0.f;
#pragma unroll
            for (int bj = 0; bj < 2; ++bj)
#pragma unroll
                for (int n = 0; n < 2; ++n) { const u32x2v xw = xv[cur][bj][n];
                    const f32x4 xf = {__builtin_bit_cast(float, xw.x << 16), __builtin_bit_cast(float, xw.x & 0xffff0000u), __builtin_bit_cast(float, xw.y << 16), __builtin_bit_cast(float, xw.y & 0xffff0000u)};
                    const f32x4 xn = (xf - mu) * rs * gv[bj][n] + bv[bj][n]; const f32x4 z = xn * alpha + acc[ai][bj][m][n];
                    u32x2v w; w.x = cvt_pk_bf16(z[0], z[1]); w.y = cvt_pk_bf16(z[2], z[3]); *(u32x2v*)(ZB + off + bj * HALF + n * 16) = w;
                    s += (z[0] + z[1]) + (z[2] + z[3]); q += (z[0] * z[0] + z[1] * z[1]) + (z[2] * z[2] + z[3] * z[3]); }
            s += xshfl<16>(s); s = xsum32(s); q += xshfl<16>(q); q = xsum32(q);
            if (fq == 0) part[(size_t)row * 32 + u.pn * 4 + wc] = (f32x2){s, q};
            asm volatile("" ::: "memory");
        }
#undef RLB_LOAD
    }
};

struct EpiNull {
    static constexpr bool PERM = true, AFTER_DRAIN = false; static constexpr int MIN_VMEM = 0;
    float* sink;
    __device__ __forceinline__ void operator()(const f32x4 (&acc)[2][2][4][2], const Unit& u, int wr, int wc, int fr, int fq) const {
        float s = 0.f;
#pragma unroll
        for (int ai = 0; ai < 2; ++ai)
#pragma unroll
            for (int bj = 0; bj < 2; ++bj)
#pragma unroll
                for (int m = 0; m < 4; ++m)
#pragma unroll
                    for (int n = 0; n < 2; ++n) s += (acc[ai][bj][m][n][0] + acc[ai][bj][m][n][1]) + (acc[ai][bj][m][n][2] + acc[ai][bj][m][n][3]);
        if (s == 1.2345678e33f) sink[u.pm * 8 + u.pn + wr + wc + fr + fq] = s;
    }
};

struct EpiResCopy {
    static constexpr bool PERM = false, AFTER_DRAIN = false; static constexpr int MIN_VMEM = 0;
    float* Z; bf16_t* ZB; int ldc;
    __device__ __forceinline__ void operator()(const f32x4 (&acc)[2][2][4][2], const Unit& u, int wr, int wc, int fr, int fq) const {
        typedef unsigned u32x2v __attribute__((ext_vector_type(2)));
        const int row0 = u.pm * BM + wr * 64 + fr, col0 = u.pn * BM + wc * 32 + 4 * fq;
        float s = 0.f;
#pragma unroll
        for (int ai = 0; ai < 2; ++ai)
#pragma unroll
            for (int bj = 0; bj < 2; ++bj)
#pragma unroll
                for (int m = 0; m < 4; ++m)
#pragma unroll
                    for (int n = 0; n < 2; ++n) s += acc[ai][bj][m][n][0] + acc[ai][bj][m][n][3];
        const bool never = (s == 1.2345678e33f);
        f32x4 xv[2][2][2]; u32x2v bvv[2][2][2];
#define RC_LOAD(buf, rg) do { const size_t off_ = (size_t)(row0 + ((rg) >> 2) * HALF + ((rg) & 3) * 16) * ldc + col0; \
            _Pragma("unroll") for (int bj = 0; bj < 2; ++bj) _Pragma("unroll") for (int n = 0; n < 2; ++n) { xv[buf][bj][n] = *(const f32x4*)(Z + off_ + bj * HALF + n * 16); bvv[buf][bj][n] = *(const u32x2v*)(ZB + off_ + bj * HALF + n * 16); } } while (0)
        RC_LOAD(0, 0);
#pragma unroll
        for (int rg = 0; rg < 8; ++rg) { const int ai = rg >> 2, m = rg & 3, cur = rg & 1;
            if (rg + 1 < 8) RC_LOAD(cur ^ 1, rg + 1);
            asm volatile("" ::: "memory");
            const size_t off = (size_t)(row0 + ai * HALF + m * 16) * ldc + col0;
#pragma unroll
            for (int bj = 0; bj < 2; ++bj)
#pragma unroll
                for (int n = 0; n < 2; ++n) { f32x4 z = xv[cur][bj][n]; if (never) z[0] = s; *(f32x4*)(Z + off + bj * HALF + n * 16) = z; *(u32x2v*)(ZB + off + bj * HALF + n * 16) = bvv[cur][bj][n]; }
            asm volatile("" ::: "memory");
        }
#undef RC_LOAD
    }
};

struct EpiResCopyB {
    static constexpr bool PERM = false, AFTER_DRAIN = false; static constexpr int MIN_VMEM = 0;
    bf16_t* ZB; int ldc;
    __device__ __forceinline__ void operator()(const f32x4 (&acc)[2][2][4][2], const Unit& u, int wr, int wc, int fr, int fq) const {
        typedef unsigned u32x2v __attribute__((ext_vector_type(2)));
        const int row0 = u.pm * BM + wr * 64 + fr, col0 = u.pn * BM + wc * 32 + 4 * fq;
        float s = 0.f;
#pragma unroll
        for (int ai = 0; ai < 2; ++ai)
#pragma unroll
            for (int bj = 0; bj < 2; ++bj)
#pragma unroll
                for (int m = 0; m < 4; ++m)
#pragma unroll
                    for (int n = 0; n < 2; ++n) s += acc[ai][bj][m][n][0] + acc[ai][bj][m][n][3];
        const bool never = (s == 1.2345678e33f);
        u32x2v xv[2][2][2];
#define RCB_LOAD(buf, rg) do { const size_t off_ = (size_t)(row0 + ((rg) >> 2) * HALF + ((rg) & 3) * 16) * ldc + col0; \
            _Pragma("unroll") for (int bj = 0; bj < 2; ++bj) _Pragma("unroll") for (int n = 0; n < 2; ++n) xv[buf][bj][n] = *(const u32x2v*)(ZB + off_ + bj * HALF + n * 16); } while (0)
        RCB_LOAD(0, 0);
#pragma unroll
        for (int rg = 0; rg < 8; ++rg) { const int ai = rg >> 2, m = rg & 3, cur = rg & 1;
            if (rg + 1 < 8) RCB_LOAD(cur ^ 1, rg + 1);
            asm volatile("" ::: "memory");
            const size_t off = (size_t)(row0 + ai * HALF + m * 16) * ldc + col0;
#pragma unroll
            for (int bj = 0; bj < 2; ++bj)
#pragma unroll
                for (int n = 0; n < 2; ++n) { u32x2v z = xv[cur][bj][n]; if (never) z.x ^= 1u; *(u32x2v*)(ZB + off + bj * HALF + n * 16) = z; }
            asm volatile("" ::: "memory");
        }
#undef RCB_LOAD
    }
};

template <class Epi, class Sched, bool ALIGN_EPI = false, bool SP2 = false, bool TILED_A = false, bool KSCALE = false>
__device__ __forceinline__ void gemm_phase(PG8_LAS unsigned char* lds, const Gemm g, const Sched& S, const Epi& E, const int wid  ) {
    const int wr = wid >> 2, wc = wid & 3;
    const int K = g.K, nt = K / BK;
    unsigned voffA[2], voffB[2]; int aoff, boff;
#define PG8_LANE_OFFS() do { const int ln_ = lane_id(), td_ = wid * 64 + ln_; \
        _Pragma("unroll") for (int i = 0; i < 2; ++i) { int R, C; stage_rc(td_ * 16 + i * 8192, R, C); const int Rb = Epi::PERM ? ((R & ~31) + perm32(R & 31)) : R; \
            voffA[i] = (unsigned)(R * (TILED_A ? 64 : K) + C) * 2u; voffB[i] = (unsigned)(Rb * (MK_TILED_W ? 64 : K) + C) * 2u; } \
        aoff = lds_byte(wr * 64 + (ln_ & 15), (ln_ >> 4) * 8); boff = lds_byte(wc * 32 + (ln_ & 15), (ln_ >> 4) * 8); } while (0)
    PG8_LANE_OFFS();
    const size_t kstep = (size_t)(BK * 2);
    const size_t hstep = (size_t)HALF * K * 2;
    const size_t tstep = 2 * hstep;
    const size_t kstepA = TILED_A ? (size_t)32768 : kstep, hstepA = TILED_A ? (size_t)HALF * 64 * 2 : hstep;
    const size_t kstepB = MK_TILED_W ? (size_t)32768 : kstep, hstepB = MK_TILED_W ? (size_t)HALF * 64 * 2 : hstep;
    const unsigned ldsw = (unsigned)wid * 1024u;
#define PG8_SA(b, h) (((b) * 2 + (h)) * HTB)
#define PG8_SB(b, h) ((4 + (b) * 2 + (h)) * HTB)
#define PG8_STAGE(bufoff, gbase, voff) do { _Pragma("unroll") for (int _i = 0; _i < 2; ++_i) \
        __builtin_amdgcn_global_load_lds((const unsigned*)((const char*)(gbase) + (voff)[_i]), (PG8_LAS unsigned*)(lds + (bufoff) + ldsw + _i * 8192), 16, 0, 0); } while (0)
#define PG8_STAGE_A(bufoff, gbase, voff) do { _Pragma("unroll") for (int _i = 0; _i < 2; ++_i) { \
        if constexpr (TILED_A && MK_NT_HLOAD) __builtin_amdgcn_global_load_lds((const unsigned*)((const char*)(gbase) + (voff)[_i]), (PG8_LAS unsigned*)(lds + (bufoff) + ldsw + _i * 8192), 16, 0, 2); \
        else __builtin_amdgcn_global_load_lds((const unsigned*)((const char*)(gbase) + (voff)[_i]), (PG8_LAS unsigned*)(lds + (bufoff) + ldsw + _i * 8192), 16, 0, 0); } } while (0)
#define PG8_LDA(dst, b, h) do { _Pragma("unroll") for (int m = 0; m < 4; ++m) _Pragma("unroll") for (int k = 0; k < 2; ++k) dst[m][k] = *(const PG8_LAS bf16x8*)(lds + PG8_SA(b, h) + aoff + m * 2048 + k * 1024); } while (0)
#define PG8_LDB(dst, b, h) do { _Pragma("unroll") for (int n = 0; n < 2; ++n) _Pragma("unroll") for (int k = 0; k < 2; ++k) dst[n][k] = *(const PG8_LAS bf16x8*)(lds + PG8_SB(b, h) + boff + n * 2048 + k * 1024); } while (0)
#define PG8_MMA(ai, bj, At, Bt) do { __builtin_amdgcn_s_setprio(1); _Pragma("unroll") for (int m = 0; m < 4; ++m) _Pragma("unroll") for (int n = 0; n < 2; ++n) _Pragma("unroll") for (int k = 0; k < 2; ++k) \
        acc[ai][bj][m][n] = __builtin_amdgcn_mfma_f32_16x16x32_bf16(Bt[n][k], At[m][k], acc[ai][bj][m][n], 0, 0, 0); __builtin_amdgcn_s_setprio(0); } while (0)
#define PG8_WAIT_V(n) asm volatile("s_waitcnt vmcnt(" #n ")" ::: "memory")
#define PG8_WAIT_L(n) asm volatile("s_waitcnt lgkmcnt(" #n ")" ::: "memory")
#define PG8_BAR __builtin_amdgcn_s_barrier()
#define PG8_SCHED __builtin_amdgcn_sched_barrier(0)
#define PG8_KTAB_DMA(pm_, bsel_) do { const int ln_ = lane_id(); \
        __builtin_amdgcn_global_load_lds((const unsigned*)((const char*)g.rat + (size_t)(pm_) * (256 * 32) + (size_t)((wid * 64 + ln_) * 16)), (PG8_LAS unsigned*)(lds + g.ktab_off + (bsel_) * 8192 + wid * 1024), 16, 0, 0); } while (0)
#define PG8_RESCALE(seg_, bsel_) do { const int ln_ = lane_id(); const PG8_LAS float* tp_ = (const PG8_LAS float*)(lds + g.ktab_off + (bsel_) * 8192 + (wr * 64 + (ln_ & 15)) * 32) + (seg_); \
        _Pragma("unroll") for (int ai = 0; ai < 2; ++ai) _Pragma("unroll") for (int m = 0; m < 4; ++m) { const float r_ = tp_[(ai * 128 + m * 16) * 8]; \
            _Pragma("unroll") for (int bj = 0; bj < 2; ++bj) _Pragma("unroll") for (int n = 0; n < 2; ++n) acc[ai][bj][m][n] *= r_; } } while (0)
    Unit cur, nxt; int ui = 0;
    if (!S.next(0, cur)) return;
    if constexpr (KSCALE) PG8_KTAB_DMA(cur.pm, 0);
    f32x4 acc[2][2][4][2];
#pragma unroll
    for (int a = 0; a < 2; ++a)
#pragma unroll
        for (int b = 0; b < 2; ++b)
#pragma unroll
            for (int m = 0; m < 4; ++m)
#pragma unroll
                for (int n = 0; n < 2; ++n) { acc[a][b][m][n] = (f32x4){0.f, 0.f, 0.f, 0.f}; asm volatile("" : "+v"(acc[a][b][m][n])); }
    bf16x8 At[4][2], B0[2][2], B1[2][2];
    const char* cA = (const char*)g.A + (size_t)cur.pm * tstep; const char* cB = (const char*)g.Bt + (size_t)cur.pn * tstep;
    S.a_ready(cur);
    if constexpr (SP2) {
        PG8_STAGE(PG8_SB(0, 0), cB, voffB); PG8_STAGE(PG8_SB(0, 1), cB + hstepB, voffB); PG8_STAGE_A(PG8_SA(0, 0), cA, voffA); PG8_STAGE_A(PG8_SA(0, 1), cA + hstepA, voffA);
        if (wr == 1) PG8_BAR;
        PG8_WAIT_V(2); PG8_BAR;
        PG8_STAGE(PG8_SB(1, 0), cB + kstepB, voffB); PG8_STAGE_A(PG8_SA(1, 0), cA + kstepA, voffA); PG8_STAGE(PG8_SB(1, 1), cB + hstepB + kstepB, voffB);
        PG8_WAIT_V(6);
        PG8_BAR;
    } else {
        PG8_STAGE(PG8_SB(0, 0), cB, voffB); PG8_STAGE_A(PG8_SA(0, 0), cA, voffA); PG8_STAGE(PG8_SB(0, 1), cB + hstepB, voffB); PG8_STAGE_A(PG8_SA(0, 1), cA + hstepA, voffA);
        if (wr == 1) PG8_BAR;
        PG8_WAIT_V(4); PG8_BAR;
        PG8_STAGE(PG8_SB(1, 0), cB + kstepB, voffB); PG8_STAGE_A(PG8_SA(1, 0), cA + kstepA, voffA); PG8_STAGE(PG8_SB(1, 1), cB + hstepB + kstepB, voffB);
        PG8_WAIT_V(6); PG8_BAR;
    }
    for (;;) {
        const bool has_next = S.next(ui + 1, nxt);
        const char* nA = has_next ? (const char*)g.A + (size_t)nxt.pm * tstep : cA; const char* nB = has_next ? (const char*)g.Bt + (size_t)nxt.pn * tstep : cB;
        static_assert(SP2, "this copy of the body keeps only the two-super-phase K-loop");
#define PG8_TRIP(t, W) do { \
            const bool last = ((t) == nt - 2); \
            const char* a1 = cA + (size_t)((t) + 1) * kstepA; \
            const char* a2 = last ? nA : cA + (size_t)((t) + 2) * kstepA; const char* b2 = last ? nB : cB + (size_t)((t) + 2) * kstepB; \
            const char* a3 = a2 + kstepA; const char* b3 = b2 + kstepB; \
            if (last && has_next) S.a_ready(nxt); \
              \
            PG8_LDB(B0, 0, 0); PG8_LDB(B1, 0, 1); PG8_SCHED; PG8_LDA(At, 0, 0); PG8_STAGE_A(PG8_SA(1, 1), a1 + hstepA, voffA); \
            W; PG8_WAIT_L(0); PG8_BAR; PG8_MMA(0, 0, At, B0); PG8_MMA(0, 1, At, B1); PG8_BAR; PG8_SCHED; \
              \
            PG8_LDA(At, 0, 1); PG8_STAGE(PG8_SB(0, 0), b2, voffB); PG8_STAGE(PG8_SB(0, 1), b2 + hstepB, voffB); PG8_STAGE_A(PG8_SA(0, 0), a2, voffA); \
            W; PG8_WAIT_L(0); PG8_BAR; PG8_MMA(1, 0, At, B0); PG8_MMA(1, 1, At, B1); PG8_BAR; PG8_SCHED; \
              \
            PG8_LDB(B0, 1, 0); PG8_LDB(B1, 1, 1); PG8_SCHED; PG8_LDA(At, 1, 0); PG8_STAGE_A(PG8_SA(0, 1), a2 + hstepA, voffA); \
            PG8_WAIT_V(8); PG8_WAIT_L(0); PG8_BAR; PG8_MMA(0, 0, At, B0); PG8_MMA(0, 1, At, B1); PG8_BAR; PG8_SCHED; \
              \
            PG8_LDA(At, 1, 1); PG8_STAGE(PG8_SB(1, 0), b3, voffB); PG8_STAGE(PG8_SB(1, 1), b3 + hstepB, voffB); PG8_STAGE_A(PG8_SA(1, 0), a3, voffA); \
            PG8_WAIT_V(8); PG8_WAIT_L(0); PG8_BAR; PG8_MMA(1, 0, At, B0); PG8_MMA(1, 1, At, B1); PG8_BAR; PG8_SCHED; } while (0)
#define PG8_WAIT_W(z) asm volatile("s_cmp_eq_u32 %0, 0\n\ts_cbranch_scc1 .Lpg8r%=\n\ts_waitcnt vmcnt(8)\n\ts_branch .Lpg8d%=\n.Lpg8r%=:\n\ts_waitcnt vmcnt(%1)\n.Lpg8d%=:" :: "s"(z), "n"(8 + Epi::MIN_VMEM) : "memory", "scc")
        if constexpr (KSCALE) { int t = 0;
            for (int seg = 0; seg < 8; ++seg) { const int tend = (seg == 0) ? 8 : (seg == 7) ? nt : 8 + 2 * seg;
                for (; t < tend; t += 2) { const int z_ = __builtin_amdgcn_readfirstlane(t + (ui == 0 ? 1 : 0)); PG8_TRIP(t, PG8_WAIT_W(z_)); }
                PG8_RESCALE(seg, ui & 1); } }
        else if constexpr (Epi::MIN_VMEM > 0) { for (int t = 0; t < nt; t += 2) { const int z_ = __builtin_amdgcn_readfirstlane(t + (ui == 0 ? 1 : 0)); PG8_TRIP(t, PG8_WAIT_W(z_)); } }
        else { for (int t = 0; t < nt; t += 2) { PG8_TRIP(t, PG8_WAIT_V(8)); } }
#undef PG8_WAIT_W
#undef PG8_TRIP
        if constexpr (ALIGN_EPI) { if (wr == 0) PG8_BAR; }
        if constexpr (!Epi::AFTER_DRAIN) { const int le_ = lane_id(); E(acc, cur, wr, wc, le_ & 15, le_ >> 4); S.done(cur); }
        if (!has_next) break;
#pragma unroll
        for (int a = 0; a < 2; ++a)
#pragma unroll
            for (int b = 0; b < 2; ++b)
#pragma unroll
                for (int m = 0; m < 4; ++m)
#pragma unroll
                    for (int n = 0; n < 2; ++n) { acc[a][b][m][n] = (f32x4){0.f, 0.f, 0.f, 0.f}; asm volatile("" : "+v"(acc[a][b][m][n])); }
        cur = nxt; cA = nA; cB = nB; ++ui; PG8_LANE_OFFS();
        if constexpr (KSCALE) PG8_KTAB_DMA(cur.pm, ui & 1);
        if constexpr (ALIGN_EPI) { if (wr == 1) PG8_BAR; }
    }
    PG8_WAIT_V(0);
    if constexpr (!ALIGN_EPI) { if (wr == 0) PG8_BAR; }
    PG8_BAR;
    if constexpr (Epi::AFTER_DRAIN) { const int le_ = lane_id(); E.fused(acc, cur, wr, wc, le_ & 15, le_ >> 4, lds, wid, le_); S.done(cur); }
#undef PG8_KTAB_DMA
#undef PG8_RESCALE
#undef PG8_SA
#undef PG8_SB
#undef PG8_STAGE
#undef PG8_LANE_OFFS
#undef PG8_STAGE_A
#undef PG8_LDA
#undef PG8_LDB
#undef PG8_MMA
#undef PG8_WAIT_V
#undef PG8_WAIT_L
#undef PG8_BAR
#undef PG8_SCHED
}
}
#define GAS __attribute__((address_space(1)))
#define LAS __attribute__((address_space(3)))
typedef unsigned short bf16;
typedef unsigned v4u __attribute__((ext_vector_type(4)));
typedef float f32x4 __attribute__((ext_vector_type(4)));
typedef short bf16x8 __attribute__((ext_vector_type(8)));
typedef GAS unsigned gu32;
typedef GAS unsigned long long gu64;
#define RLX_AGENT __ATOMIC_RELAXED, __HIP_MEMORY_SCOPE_AGENT
#define LDS_WAIT() asm volatile("s_waitcnt lgkmcnt(0)" ::: "memory")
#define VM_WAIT() asm volatile("s_waitcnt vmcnt(0)" ::: "memory")
__device__ __forceinline__ unsigned long long rt() { return __builtin_amdgcn_s_memrealtime(); }
__device__ __forceinline__ unsigned f2bf(float f) { unsigned u = __builtin_bit_cast(unsigned, f); return (u + 0x7fffu + ((u >> 16) & 1u)) >> 16; }
__device__ __forceinline__ unsigned pk2(float lo, float hi) { return f2bf(lo) | (f2bf(hi) << 16); }

#define XB_TMO      128
#define XB_XCNT(j)  (256  + 64 * (j))
#define XB_XSUB(j)  (1280 + 64 * (j))
#define XB_XGEN(j)  (2304 + 64 * (j))
#define XB_TOP      3328
#define XB_TOPGEN   3392
#define XCD_BAR_WORDS 3456
#define XB_SPIN_CAP (1u << 18)

__device__ __forceinline__ unsigned xb_ld(unsigned* p)              { return __hip_atomic_load(p, __ATOMIC_RELAXED, __HIP_MEMORY_SCOPE_AGENT); }
__device__ __forceinline__ unsigned xb_add(unsigned* p, unsigned v) { return __hip_atomic_fetch_add(p, v, __ATOMIC_RELAXED, __HIP_MEMORY_SCOPE_AGENT); }
__device__ __forceinline__ unsigned xb_xcc_id() { return (unsigned)__builtin_amdgcn_s_getreg((3 << 11) | 20) & 0xFu; }
#define XB_SPIN(cond, bar) do { unsigned _sp = 0; while (cond) { __builtin_amdgcn_s_sleep(1); \
    if ((++_sp & 255u) == 0u) { if (xb_ld(&(bar)[XB_TMO])) break; if (_sp > XB_SPIN_CAP) { atomicAdd(&(bar)[XB_TMO], 1u); break; } } } } while (0)

struct XcdBarrier {
    unsigned* bar; unsigned x;
    volatile LAS unsigned* st;
};

__device__ __forceinline__ XcdBarrier xcd_barrier_post(unsigned* bar, volatile LAS unsigned* st, const bool t0  ) {
    XcdBarrier b; b.bar = bar; b.x = xb_xcc_id(); b.st = st;
    if (t0) (void)xb_add(&bar[XB_XCNT(b.x)], 1u);
    return b;
}
__device__ __forceinline__ void xcd_barrier_complete(unsigned* bar, unsigned x, unsigned& nloc, unsigned& nx) {
    const unsigned G = gridDim.x * gridDim.y * gridDim.z;
    unsigned sum, cnt, mine, sp = 0u;
    for (;;) {
        sum = 0u; cnt = 0u; mine = 0u;
#pragma unroll
        for (unsigned j = 0; j < 16; ++j) { const unsigned c = xb_ld(&bar[XB_XCNT(j)]); sum += c; cnt += (c > 0u) ? 1u : 0u; mine = (j == x) ? c : mine; }
        if (sum == G) break;
        __builtin_amdgcn_s_sleep(1);
        if ((++sp & 255u) == 0u) { if (xb_ld(&bar[XB_TMO])) break; if (sp > XB_SPIN_CAP) { atomicAdd(&bar[XB_TMO], 1u); break; } }
    }
    nloc = mine > 0u ? mine : 1u; nx = cnt > 0u ? cnt : 1u;
}

__device__ __forceinline__ void xcd_barrier(const XcdBarrier& b, const bool t0  ) {
    asm volatile("s_waitcnt vmcnt(0)" ::: "memory");
    __syncthreads();
    if (t0) {
        unsigned* bar = b.bar;
        __builtin_amdgcn_s_waitcnt(0);
        unsigned nloc = b.st[0], nx = b.st[1];
        if (nloc == 0u) { xcd_barrier_complete(bar, b.x, nloc, nx); b.st[0] = nloc; b.st[1] = nx; }
        const unsigned old = xb_add(&bar[XB_XSUB(b.x)], 1u);
        const unsigned gen = old / nloc;
        if (old + 1u == (gen + 1u) * nloc) {
            __builtin_amdgcn_fence(__ATOMIC_RELEASE, "agent");
            asm volatile("s_waitcnt vmcnt(0)" ::: "memory");
            const unsigned og = xb_add(&bar[XB_TOP], 1u);
            const unsigned tg = og / nx;
            if (og + 1u == (tg + 1u) * nx) xb_add(&bar[XB_TOPGEN], 1u);
            else XB_SPIN(xb_ld(&bar[XB_TOPGEN]) == tg, bar);
            __builtin_amdgcn_fence(__ATOMIC_ACQUIRE, "agent");
            xb_add(&bar[XB_XGEN(b.x)], 1u);
            asm volatile("s_waitcnt vmcnt(0)" ::: "memory");
        } else {
            XB_SPIN(xb_ld(&bar[XB_XGEN(b.x)]) == gen, bar);
            __builtin_amdgcn_fence(__ATOMIC_ACQUIRE, "agent");
            asm volatile("s_waitcnt vmcnt(0)" ::: "memory");
        }
    }
    __syncthreads();
}
namespace att {
typedef unsigned short bf16;
constexpr int NW = 8, QBLK = 32, KVBLK = 64, D = 128;
constexpr float SCALE = 0.088388347648318440f;
constexpr float THR = 8.f;
using bf16x8 = __attribute__((ext_vector_type(8))) short;
using s16x4  = __attribute__((ext_vector_type(4))) short;
using f32x16 = __attribute__((ext_vector_type(16))) float;
using f32x8  = __attribute__((ext_vector_type(8))) float;
using u32x4  = __attribute__((ext_vector_type(4))) unsigned;
#define KSWZ(row, colB) ((row) * 256 + ((colB) ^ (((row) & 7) << 4)))
#define SBAR() __builtin_amdgcn_sched_barrier(0)
__device__ __forceinline__ int crow(int r, int hi) { return (r & 3) + 8 * (r >> 2) + 4 * hi; }
__device__ __forceinline__ unsigned cvtpk(float lo, float hi) {
  unsigned r; asm volatile("v_cvt_pk_bf16_f32 %0, %1, %2" : "=v"(r) : "v"(lo), "v"(hi)); return r;
}
__device__ __forceinline__ float ssq8(const u32x4 v) {
  float q = 0.f;
#pragma unroll
  for (int e = 0; e < 4; ++e) { const float a = __builtin_bit_cast(float, v[e] << 16), b = __builtin_bit_cast(float, v[e] & 0xffff0000u); q += a * a + b * b; }
  return q;
}
__device__ __forceinline__ void partialSM(f32x16& p0, f32x16& p1, float& m_reg, float& mn, float& alpha) {
  constexpr float C = SCALE * 1.4426950408889634f;
  float pmax = p0[0]; for (int r = 1; r < 16; ++r) pmax = fmaxf(pmax, p0[r]); for (int r = 0; r < 16; ++r) pmax = fmaxf(pmax, p1[r]);
  { auto rr = __builtin_amdgcn_permlane32_swap(__float_as_uint(pmax), __float_as_uint(pmax), false, false);
    pmax = fmaxf(__uint_as_float(rr[0]), __uint_as_float(rr[1])); }
  if (__builtin_expect(__all(pmax - m_reg <= THR / SCALE), 1)) { mn = m_reg; alpha = 1.f; }
  else { mn = fmaxf(m_reg, pmax); alpha = __builtin_amdgcn_exp2f((m_reg - mn) * C); m_reg = mn; }
  float mnC = -mn * C;
  for (int r = 0; r < 16; ++r) p0[r] = fmaf(p0[r], C, mnC); for (int r = 0; r < 16; ++r) p1[r] = fmaf(p1[r], C, mnC);
  for (int r = 0; r < 16; ++r) p0[r] = __builtin_amdgcn_exp2f(p0[r]);
}
__device__ __forceinline__ void boundedSM(f32x16& p0, f32x16& p1) {
  for (int r = 0; r < 16; ++r) p0[r] = __builtin_amdgcn_exp2f(p0[r]);
}
__device__ __forceinline__ void finishSM(f32x16& p0, f32x16& p1, float alpha, float& l_reg, bf16x8& pa0, bf16x8& pa1, bf16x8& pa2, bf16x8& pa3) {
  for (int r = 0; r < 16; ++r) p1[r] = __builtin_amdgcn_exp2f(p1[r]);
  float ps = 0; for (int r = 0; r < 16; ++r) ps += p0[r]; for (int r = 0; r < 16; ++r) ps += p1[r];
  { auto rr = __builtin_amdgcn_permlane32_swap(__float_as_uint(ps), __float_as_uint(ps), false, false);
    ps = __uint_as_float(rr[0]) + __uint_as_float(rr[1]); }
  l_reg = l_reg * alpha + ps;
#define PK4(P, BASE, OUT) do { unsigned a0 = cvtpk(P[BASE + 0], P[BASE + 1]), a1 = cvtpk(P[BASE + 2], P[BASE + 3]);   \
    unsigned b0 = cvtpk(P[BASE + 4], P[BASE + 5]), b1 = cvtpk(P[BASE + 6], P[BASE + 7]);                              \
    auto r0 = __builtin_amdgcn_permlane32_swap(a0, b0, false, false); auto r1 = __builtin_amdgcn_permlane32_swap(a1, b1, false, false); \
    u32x4 w = {r0[0], r1[0], r0[1], r1[1]}; OUT = *reinterpret_cast<bf16x8*>(&w); } while (0)
  PK4(p0, 0, pa0); PK4(p0, 8, pa1); PK4(p1, 0, pa2); PK4(p1, 8, pa3);
#undef PK4
}
__device__ __forceinline__ void partialSM1(f32x16& p0, float& m_reg, float& mn, float& alpha) {
  constexpr float C = SCALE * 1.4426950408889634f;
  float pmax = p0[0]; for (int r = 1; r < 16; ++r) pmax = fmaxf(pmax, p0[r]);
  { auto rr = __builtin_amdgcn_permlane32_swap(__float_as_uint(pmax), __float_as_uint(pmax), false, false);
    pmax = fmaxf(__uint_as_float(rr[0]), __uint_as_float(rr[1])); }
  if (__builtin_expect(__all(pmax - m_reg <= THR / SCALE), 1)) { mn = m_reg; alpha = 1.f; }
  else { mn = fmaxf(m_reg, pmax); alpha = __builtin_amdgcn_exp2f((m_reg - mn) * C); m_reg = mn; }
  float mnC = -mn * C;
  for (int r = 0; r < 16; ++r) p0[r] = fmaf(p0[r], C, mnC);
  for (int r = 0; r < 16; ++r) p0[r] = __builtin_amdgcn_exp2f(p0[r]);
}
__device__ __forceinline__ void finishSM1(f32x16& p0, float alpha, float& l_reg, bf16x8& pa0, bf16x8& pa1) {
  float ps = 0; for (int r = 0; r < 16; ++r) ps += p0[r];
  { auto rr = __builtin_amdgcn_permlane32_swap(__float_as_uint(ps), __float_as_uint(ps), false, false);
    ps = __uint_as_float(rr[0]) + __uint_as_float(rr[1]); }
  l_reg = l_reg * alpha + ps;
#define PK4(P, BASE, OUT) do { unsigned a0 = cvtpk(P[BASE + 0], P[BASE + 1]), a1 = cvtpk(P[BASE + 2], P[BASE + 3]);   \
    unsigned b0 = cvtpk(P[BASE + 4], P[BASE + 5]), b1 = cvtpk(P[BASE + 6], P[BASE + 7]);                              \
    auto r0 = __builtin_amdgcn_permlane32_swap(a0, b0, false, false); auto r1 = __builtin_amdgcn_permlane32_swap(a1, b1, false, false); \
    u32x4 w = {r0[0], r1[0], r0[1], r1[1]}; OUT = *reinterpret_cast<bf16x8*>(&w); } while (0)
  PK4(p0, 0, pa0); PK4(p0, 8, pa1);
#undef PK4
}
__device__ __forceinline__ void qkt(f32x16& p0, f32x16& p1, const bf16* Ks, const bf16x8* qr, int r32, int hi, float init = 0.f) {
  for (int r = 0; r < 16; ++r) { p0[r] = init; p1[r] = init; }
  for (int d0 = 0; d0 < 8; ++d0) { int cb = (d0 * 16 + hi * 8) * 2;
    bf16x8 b0 = *reinterpret_cast<const bf16x8*>((const char*)Ks + KSWZ(r32, cb));
    bf16x8 b1 = *reinterpret_cast<const bf16x8*>((const char*)Ks + KSWZ(32 + r32, cb));
    p0 = __builtin_amdgcn_mfma_f32_32x32x16_bf16(b0, qr[d0], p0, 0, 0, 0);
    p1 = __builtin_amdgcn_mfma_f32_32x32x16_bf16(b1, qr[d0], p1, 0, 0, 0); }
}
__device__ __forceinline__ int v_st(int k, int c) { const int kk = (k & ~0xC) | ((k & 4) << 1) | ((k & 8) >> 1); return ((kk >> 3) * 4 + (c >> 5)) * 512 + ((kk & 7) * 32 + (c & 31)) * 2; }
__device__ __forceinline__ int v_rd_base(int lane) { return ((lane & 3) << 3) | (((lane >> 2) & 3) << 6) | (((lane >> 4) & 1) << 5) | (((lane >> 5) & 1) << 8); }
constexpr int v_rd_off(int d0, int ks, int half) { return d0 * 512 + ks * 4096 + half * 2048; }
template <int OFF> __device__ __forceinline__ s16x4 tr_read(int vb) {
  s16x4 r; asm volatile("ds_read_b64_tr_b16 %0, %1 offset:%2" : "=&v"(r) : "v"(vb), "i"(OFF) : "memory"); return r;
}
template <int D0> __device__ __forceinline__ void pv_one(f32x16& od, int vb, bf16x8 pa0, bf16x8 pa1, bf16x8 pa2, bf16x8 pa3) {
  const s16x4 l0 = tr_read<v_rd_off(D0, 0, 0)>(vb), h0 = tr_read<v_rd_off(D0, 0, 1)>(vb), l1 = tr_read<v_rd_off(D0, 1, 0)>(vb), h1 = tr_read<v_rd_off(D0, 1, 1)>(vb);
  const s16x4 l2 = tr_read<v_rd_off(D0, 2, 0)>(vb), h2 = tr_read<v_rd_off(D0, 2, 1)>(vb), l3 = tr_read<v_rd_off(D0, 3, 0)>(vb), h3 = tr_read<v_rd_off(D0, 3, 1)>(vb);
  asm volatile("s_waitcnt lgkmcnt(0)" ::: "memory"); SBAR();
#define PK(L, H) (bf16x8){L[0], L[1], L[2], L[3], H[0], H[1], H[2], H[3]}
  od = __builtin_amdgcn_mfma_f32_32x32x16_bf16(pa0, PK(l0, h0), od, 0, 0, 0);
  od = __builtin_amdgcn_mfma_f32_32x32x16_bf16(pa1, PK(l1, h1), od, 0, 0, 0);
  od = __builtin_amdgcn_mfma_f32_32x32x16_bf16(pa2, PK(l2, h2), od, 0, 0, 0);
  od = __builtin_amdgcn_mfma_f32_32x32x16_bf16(pa3, PK(l3, h3), od, 0, 0, 0);
#undef PK
}
__device__ __forceinline__ void pv_d0(f32x16* o, int vb, bf16x8 pa0, bf16x8 pa1, bf16x8 pa2, bf16x8 pa3) {
  pv_one<0>(o[0], vb, pa0, pa1, pa2, pa3); pv_one<1>(o[1], vb, pa0, pa1, pa2, pa3); pv_one<2>(o[2], vb, pa0, pa1, pa2, pa3); pv_one<3>(o[3], vb, pa0, pa1, pa2, pa3);
}

__device__ __forceinline__ void qkt32(f32x16& p0, const bf16* Ks, const bf16x8* qr, int krow, int hi) {
  for (int r = 0; r < 16; ++r) p0[r] = 0.f;
  for (int d0 = 0; d0 < 8; ++d0) { int cb = (d0 * 16 + hi * 8) * 2;
    bf16x8 b0 = *reinterpret_cast<const bf16x8*>((const char*)Ks + KSWZ(krow, cb));
    p0 = __builtin_amdgcn_mfma_f32_32x32x16_bf16(b0, qr[d0], p0, 0, 0, 0); }
}
template <int D0> __device__ __forceinline__ void pv_one2(f32x16& od, int vb, bf16x8 pa0, bf16x8 pa1) {
  const s16x4 l0 = tr_read<v_rd_off(D0, 0, 0)>(vb), h0 = tr_read<v_rd_off(D0, 0, 1)>(vb), l1 = tr_read<v_rd_off(D0, 1, 0)>(vb), h1 = tr_read<v_rd_off(D0, 1, 1)>(vb);
  asm volatile("s_waitcnt lgkmcnt(0)" ::: "memory"); SBAR();
#define PK(L, H) (bf16x8){L[0], L[1], L[2], L[3], H[0], H[1], H[2], H[3]}
  od = __builtin_amdgcn_mfma_f32_32x32x16_bf16(pa0, PK(l0, h0), od, 0, 0, 0);
  od = __builtin_amdgcn_mfma_f32_32x32x16_bf16(pa1, PK(l1, h1), od, 0, 0, 0);
#undef PK
}
__device__ __forceinline__ void pv_d0h(f32x16* o, int vb, bf16x8 pa0, bf16x8 pa1) {
  pv_one2<0>(o[0], vb, pa0, pa1); pv_one2<1>(o[1], vb, pa0, pa1); pv_one2<2>(o[2], vb, pa0, pa1); pv_one2<3>(o[3], vb, pa0, pa1);
}

constexpr size_t SHM_V = KVBLK * D * 2, SHM_K = KVBLK * D * 2, SHM_ATTN = 2 * SHM_V + 2 * SHM_K + NW * 64 * 4;
constexpr float NEG_INF = -__builtin_inff();
constexpr int OSTAGE_OFF = 73728;

#ifndef MK_PREFETCH_UNIT
#define MK_PREFETCH_UNIT 0
#endif
struct Pre { bf16x8 qr[8]; bf16x8 vs0, vs1, ks0, ks1; };
template <class Cfg, int SD = 2  ,
          bool BOUNDED = false  >
__device__ __forceinline__ void attn_unit(const Cfg& cfg, char* lds, const int wid  , Pre& pre, const bool have_pre  , const Cfg* nxt  ) {
  const int lane = lane_id(), tid = wid * 64 + lane, r32 = lane & 31, hi = lane >> 5;
  bf16* V_lds = (bf16*)lds; bf16* K_lds = (bf16*)(lds + 2 * SHM_V);
  float* ws = (float*)(lds + 2 * SHM_V + 2 * SHM_K) + wid * 64; float* li_l = ws; float* al_l = ws + 32;
  float m_reg = -1e30f, l_reg = 0; f32x16 o[4] = {}; bf16x8 qr[8];
  const bf16* Qw = cfg.proj + cfg.q_off(wid * QBLK + r32) + hi * 8;
  if (have_pre) {
#pragma unroll
    for (int d0 = 0; d0 < 8; ++d0) qr[d0] = pre.qr[d0];
  } else {
#pragma unroll
    for (int d0 = 0; d0 < 8; ++d0) qr[d0] = *reinterpret_cast<const bf16x8*>(Qw + d0 * 16);
  }
  const int sr = tid >> 4, sc = (tid & 15) * 8, vst0 = v_st(sr, sc), vst1 = v_st(32 + sr, sc);
  const int vb0 = (int)(uintptr_t)V_lds + v_rd_base(lane);
  struct { bf16x8 vs0, vs1, ks0, ks1; } sr_[SD];
#define SLOAD(i, t) do { const unsigned o0_ = cfg.kv_off((t), sr) + sc, o1_ = cfg.kv_off((t), 32 + sr) + sc; \
    sr_[i].vs0 = *reinterpret_cast<const bf16x8*>(cfg.proj + cfg.vcol + o0_); sr_[i].vs1 = *reinterpret_cast<const bf16x8*>(cfg.proj + cfg.vcol + o1_); \
    sr_[i].ks0 = *reinterpret_cast<const bf16x8*>(cfg.proj + cfg.kcol + o0_); sr_[i].ks1 = *reinterpret_cast<const bf16x8*>(cfg.proj + cfg.kcol + o1_); } while (0)
#define SWRITE(b, i) do { *(bf16x8*)((char*)V_lds + (b) * SHM_V + vst0) = sr_[i].vs0;          \
    *(bf16x8*)((char*)V_lds + (b) * SHM_V + vst1) = sr_[i].vs1; int kc = sc * 2;               \
    *(bf16x8*)((char*)K_lds + (b) * SHM_K + KSWZ(sr, kc)) = sr_[i].ks0;                       \
    *(bf16x8*)((char*)K_lds + (b) * SHM_K + KSWZ(32 + sr, kc)) = sr_[i].ks1; } while (0)
#define SWAIT() do { if constexpr (SD == 2) asm volatile("s_waitcnt vmcnt(4)" ::: "memory"); else asm volatile("s_waitcnt vmcnt(0)" ::: "memory"); } while (0)
#define RESC(a) do { if (!BOUNDED && __any((a) < 1.f)) { if (hi == 0) al_l[r32] = (a); asm volatile("s_waitcnt lgkmcnt(0)" ::: "memory"); \
    for (int d = 0; d < 4; ++d) for (int r = 0; r < 16; ++r) o[d][r] *= al_l[crow(r, hi)]; } } while (0)
#define QK(P0, P1, KB, T, MN, AL) do { if (cfg.active((T), wid)) { qkt(P0, P1, (KB), qr, r32, hi, BOUNDED ? cfg.negm0C : 0.f); cfg.mask(P0, P1, (T), wid, r32, hi); if constexpr (BOUNDED) { boundedSM(P0, P1); AL = 1.f; } else partialSM(P0, P1, m_reg, MN, AL); } else { AL = 1.f; } } while (0)
#define QK1(P0, P1, KB, T) do { if (cfg.active((T), wid)) { qkt(P0, P1, (KB), qr, r32, hi, BOUNDED ? cfg.negm0C : 0.f); cfg.mask(P0, P1, (T), wid, r32, hi); } } while (0)
#define PSM(P0, P1, T, MN, AL) do { if (cfg.active((T), wid)) { if constexpr (BOUNDED) { boundedSM(P0, P1); AL = 1.f; } else partialSM(P0, P1, m_reg, MN, AL); } else { AL = 1.f; } } while (0)
#define FPV(P0, P1, AL, VB, T) do { if (cfg.active((T), wid)) { finishSM(P0, P1, AL, l_reg, pa0, pa1, pa2, pa3); SBAR(); pv_d0(o, (VB), pa0, pa1, pa2, pa3); } } while (0)
  f32x16 pA0, pA1, pB0, pB1; float mnA, mnB, alA, alB; bf16x8 pa0, pa1, pa2, pa3; const int NT = Cfg::NT;
  constexpr int SE = 0, SO = SD - 1;
  if (have_pre) { sr_[SE].vs0 = pre.vs0; sr_[SE].vs1 = pre.vs1; sr_[SE].ks0 = pre.ks0; sr_[SE].ks1 = pre.ks1; } else SLOAD(SE, 0);
  asm volatile("s_waitcnt vmcnt(0)" ::: "memory"); SWRITE(0, SE); __syncthreads();
  QK(pA0, pA1, K_lds, 0, mnA, alA);
  SLOAD(SO, 1); if constexpr (SD == 2) { if (2 < NT) SLOAD(SE, 2); }
  SWAIT(); SWRITE(1, SO); __syncthreads();
  for (int j = 1; j + 1 < NT; j += 2) {
    SBAR(); QK1(pB0, pB1, (bf16*)((char*)K_lds + SHM_K), j);
    if (cfg.active(j - 1, wid)) { finishSM(pA0, pA1, alA, l_reg, pa0, pa1, pa2, pa3); } SBAR();
    SLOAD(SO, j + SD); SBAR();
    if (cfg.active(j - 1, wid)) { pv_d0(o, vb0, pa0, pa1, pa2, pa3); }
    PSM(pB0, pB1, j, mnB, alB);
    __syncthreads(); SWAIT(); SWRITE(0, SE);
    RESC(alB); __syncthreads();
    SBAR(); QK1(pA0, pA1, K_lds, j + 1);
    if (cfg.active(j, wid)) { finishSM(pB0, pB1, alB, l_reg, pa0, pa1, pa2, pa3); } SBAR();
    if (SD == 1 || j + 3 < NT) SLOAD(SE, j + 1 + SD); SBAR();
    if (cfg.active(j, wid)) { pv_d0(o, vb0 + (int)SHM_V, pa0, pa1, pa2, pa3); }
    PSM(pA0, pA1, j + 1, mnA, alA);
    __syncthreads(); SWAIT(); SWRITE(1, SO);
    RESC(alA); __syncthreads();
  }
  SBAR(); QK1(pB0, pB1, (bf16*)((char*)K_lds + SHM_K), NT - 1);
  if (cfg.active(NT - 2, wid)) { finishSM(pA0, pA1, alA, l_reg, pa0, pa1, pa2, pa3); SBAR(); pv_d0(o, vb0, pa0, pa1, pa2, pa3); }
  PSM(pB0, pB1, NT - 1, mnB, alB);
  __syncthreads(); RESC(alB);
  if (cfg.active(NT - 1, wid)) { finishSM(pB0, pB1, alB, l_reg, pa0, pa1, pa2, pa3); SBAR(); pv_d0(o, vb0 + (int)SHM_V, pa0, pa1, pa2, pa3); }
  if (hi == 0) li_l[r32] = l_reg; asm volatile("s_waitcnt lgkmcnt(0)" ::: "memory");
  if (Cfg::HAS_LSE) { if (hi == 0) cfg.store_lse(wid * QBLK + r32, m_reg * SCALE + __logf(l_reg)); }
  if (MK_PREFETCH_UNIT) {
    const bf16* Qn = nxt->proj + nxt->q_off(wid * QBLK + r32) + hi * 8;
#pragma unroll
    for (int d0 = 0; d0 < 8; ++d0) pre.qr[d0] = *reinterpret_cast<const bf16x8*>(Qn + d0 * 16);
    const unsigned o0_ = nxt->kv_off(0, sr) + sc, o1_ = nxt->kv_off(0, 32 + sr) + sc;
    pre.vs0 = *reinterpret_cast<const bf16x8*>(nxt->proj + nxt->vcol + o0_); pre.vs1 = *reinterpret_cast<const bf16x8*>(nxt->proj + nxt->vcol + o1_);
    pre.ks0 = *reinterpret_cast<const bf16x8*>(nxt->proj + nxt->kcol + o0_); pre.ks1 = *reinterpret_cast<const bf16x8*>(nxt->proj + nxt->kcol + o1_);
    asm volatile("" ::: "memory");
  }
  { bf16* stg = (bf16*)(lds + OSTAGE_OFF) + wid * 2048;
#pragma unroll
    for (int hh = 0; hh < 2; ++hh) {
#pragma unroll
      for (int r8 = 0; r8 < 8; ++r8) { const int r = 8 * hh + r8; const int orow = crow(r, hi); const float rl = __builtin_amdgcn_rcpf(li_l[orow]);
#pragma unroll
        for (int d0 = 0; d0 < 4; ++d0) stg[(orow & 15) * 128 + d0 * 32 + r32] = (bf16)(cvtpk(o[d0][r] * rl, 0.f) & 0xffffu); }
      asm volatile("s_waitcnt lgkmcnt(0)" ::: "memory");
#pragma unroll
      for (int j = 0; j < 4; ++j) { const int row = (lane >> 4) + 4 * j, ch = lane & 15; const u32x4 v = *(const u32x4*)(stg + row * 128 + ch * 8);
        const unsigned oo_ = cfg.o_off(wid * QBLK + 16 * hh + row); *(u32x4*)(cfg.obuf + oo_ + ch * 8) = v;
        if (MK_MIXFOLD) { const float q_ = rowsum16(ssq8(v));
          if (ch == 0) ((float*)((char*)cfg.obuf + MK_SSQ_FROM_O_BYTES))[(oo_ >> 11) * 16 + ((oo_ & 2047u) >> 7)] = q_; } }
      asm volatile("s_waitcnt lgkmcnt(0)" ::: "memory");
    } }
  __syncthreads();
#undef SLOAD
#undef SWRITE
#undef SWAIT
#undef RESC
#undef QK
#undef QK1
#undef PSM
#undef FPV
}

template <class Cfg, bool BOUNDED = false>
__device__ __forceinline__ void attn_unit3(const Cfg& cfg, char* lds, const int wid  , Pre& pre, const bool have_pre  , const Cfg* nxt  ) {
  const int lane = lane_id(), tid = wid * 64 + lane, r32 = lane & 31, hi = lane >> 5;
  constexpr int SD = 2;
  bf16* V_lds = (bf16*)lds; bf16* K_lds = (bf16*)(lds + 3 * SHM_V);
  float* ws = (float*)(lds + 3 * SHM_V + 3 * SHM_K) + wid * 64; float* li_l = ws; float* al_l = ws + 32;
  float m_reg = -1e30f, l_reg = 0; f32x16 o[4] = {}; bf16x8 qr[8];
  const bf16* Qw = cfg.proj + cfg.q_off(wid * QBLK + r32) + hi * 8;
  if (have_pre) {
#pragma unroll
    for (int d0 = 0; d0 < 8; ++d0) qr[d0] = pre.qr[d0];
  } else {
#pragma unroll
    for (int d0 = 0; d0 < 8; ++d0) qr[d0] = *reinterpret_cast<const bf16x8*>(Qw + d0 * 16);
  }
  const int sr = tid >> 4, sc = (tid & 15) * 8, vst0 = v_st(sr, sc), vst1 = v_st(32 + sr, sc);
  const int vb0 = (int)(uintptr_t)V_lds + v_rd_base(lane);
  struct { bf16x8 vs0, vs1, ks0, ks1; } sr_[SD];
#define SLOAD(i, t) do { const unsigned o0_ = cfg.kv_off((t), sr) + sc, o1_ = cfg.kv_off((t), 32 + sr) + sc; \
    sr_[i].vs0 = *reinterpret_cast<const bf16x8*>(cfg.proj + cfg.vcol + o0_); sr_[i].vs1 = *reinterpret_cast<const bf16x8*>(cfg.proj + cfg.vcol + o1_); \
    sr_[i].ks0 = *reinterpret_cast<const bf16x8*>(cfg.proj + cfg.kcol + o0_); sr_[i].ks1 = *reinterpret_cast<const bf16x8*>(cfg.proj + cfg.kcol + o1_); } while (0)
#define SWRITE(b, i) do { *(bf16x8*)((char*)V_lds + (b) * SHM_V + vst0) = sr_[i].vs0;          \
    *(bf16x8*)((char*)V_lds + (b) * SHM_V + vst1) = sr_[i].vs1; int kc = sc * 2;               \
    *(bf16x8*)((char*)K_lds + (b) * SHM_K + KSWZ(sr, kc)) = sr_[i].ks0;                       \
    *(bf16x8*)((char*)K_lds + (b) * SHM_K + KSWZ(32 + sr, kc)) = sr_[i].ks1; } while (0)
#define SWAIT() do { if constexpr (SD == 2) asm volatile("s_waitcnt vmcnt(4)" ::: "memory"); else asm volatile("s_waitcnt vmcnt(0)" ::: "memory"); } while (0)
#define RESC(a) do { if (!BOUNDED && __any((a) < 1.f)) { if (hi == 0) al_l[r32] = (a); asm volatile("s_waitcnt lgkmcnt(0)" ::: "memory"); \
    for (int d = 0; d < 4; ++d) for (int r = 0; r < 16; ++r) o[d][r] *= al_l[crow(r, hi)]; } } while (0)
#define QK(P0, P1, KB, T, MN, AL) do { if (cfg.active((T), wid)) { qkt(P0, P1, (KB), qr, r32, hi, BOUNDED ? cfg.negm0C : 0.f); cfg.mask(P0, P1, (T), wid, r32, hi); if constexpr (BOUNDED) { boundedSM(P0, P1); AL = 1.f; } else partialSM(P0, P1, m_reg, MN, AL); } else { AL = 1.f; } } while (0)
#define QK1(P0, P1, KB, T) do { if (cfg.active((T), wid)) { qkt(P0, P1, (KB), qr, r32, hi, BOUNDED ? cfg.negm0C : 0.f); cfg.mask(P0, P1, (T), wid, r32, hi); } } while (0)
#define PSM(P0, P1, T, MN, AL) do { if (cfg.active((T), wid)) { if constexpr (BOUNDED) { boundedSM(P0, P1); AL = 1.f; } else partialSM(P0, P1, m_reg, MN, AL); } else { AL = 1.f; } } while (0)
#define FPV(P0, P1, AL, VB, T) do { if (cfg.active((T), wid)) { finishSM(P0, P1, AL, l_reg, pa0, pa1, pa2, pa3); SBAR(); pv_d0(o, (VB), pa0, pa1, pa2, pa3); } } while (0)
  f32x16 pA0, pA1, pB0, pB1; float mnA, mnB, alA, alB; bf16x8 pa0, pa1, pa2, pa3; const int NT = Cfg::NT;
  constexpr int SE = 0, SO = SD - 1;
  if (have_pre) { sr_[SE].vs0 = pre.vs0; sr_[SE].vs1 = pre.vs1; sr_[SE].ks0 = pre.ks0; sr_[SE].ks1 = pre.ks1; } else SLOAD(SE, 0);
  asm volatile("s_waitcnt vmcnt(0)" ::: "memory"); SWRITE(0, SE); __syncthreads();
  QK(pA0, pA1, K_lds, 0, mnA, alA);
  SLOAD(SO, 1); if constexpr (SD == 2) { if (2 < NT) SLOAD(SE, 2); }
  SWAIT(); SWRITE(1, SO); __syncthreads();
  int bt = 1;
#define KB3(b_) ((bf16*)((char*)K_lds + (b_) * (int)SHM_K))
#define VB3(b_) (vb0 + (b_) * (int)SHM_V)
  for (int j = 1; j + 1 < NT; j += 2) {
    const int bn = (bt == 2) ? 0 : bt + 1, bm = (bt == 0) ? 2 : bt - 1;
    SBAR(); QK1(pB0, pB1, KB3(bt), j);
    if (cfg.active(j - 1, wid)) { finishSM(pA0, pA1, alA, l_reg, pa0, pa1, pa2, pa3); } SBAR();
    SLOAD(SO, j + SD); SBAR();
    if (cfg.active(j - 1, wid)) { pv_d0(o, VB3(bm), pa0, pa1, pa2, pa3); }
    PSM(pB0, pB1, j, mnB, alB);
    SWAIT(); SWRITE(bn, SE);
    RESC(alB); __syncthreads();
    SBAR(); QK1(pA0, pA1, KB3(bn), j + 1);
    if (cfg.active(j, wid)) { finishSM(pB0, pB1, alB, l_reg, pa0, pa1, pa2, pa3); } SBAR();
    if (j + 3 < NT) SLOAD(SE, j + 1 + SD); SBAR();
    if (cfg.active(j, wid)) { pv_d0(o, VB3(bt), pa0, pa1, pa2, pa3); }
    PSM(pA0, pA1, j + 1, mnA, alA);
    SWAIT(); SWRITE(bm, SO);
    RESC(alA); __syncthreads();
    bt = bm;
  }
  { const int bm = (bt == 0) ? 2 : bt - 1;
    SBAR(); QK1(pB0, pB1, KB3(bt), NT - 1);
    if (cfg.active(NT - 2, wid)) { finishSM(pA0, pA1, alA, l_reg, pa0, pa1, pa2, pa3); SBAR(); pv_d0(o, VB3(bm), pa0, pa1, pa2, pa3); }
    PSM(pB0, pB1, NT - 1, mnB, alB);
    RESC(alB);
    if (cfg.active(NT - 1, wid)) { finishSM(pB0, pB1, alB, l_reg, pa0, pa1, pa2, pa3); SBAR(); pv_d0(o, VB3(bt), pa0, pa1, pa2, pa3); } }
#undef KB3
#undef VB3
  if (hi == 0) li_l[r32] = l_reg; asm volatile("s_waitcnt lgkmcnt(0)" ::: "memory");
  if (Cfg::HAS_LSE) { if (hi == 0) cfg.store_lse(wid * QBLK + r32, m_reg * SCALE + __logf(l_reg)); }
  if (MK_PREFETCH_UNIT) {
    const bf16* Qn = nxt->proj + nxt->q_off(wid * QBLK + r32) + hi * 8;
#pragma unroll
    for (int d0 = 0; d0 < 8; ++d0) pre.qr[d0] = *reinterpret_cast<const bf16x8*>(Qn + d0 * 16);
    const unsigned o0_ = nxt->kv_off(0, sr) + sc, o1_ = nxt->kv_off(0, 32 + sr) + sc;
    pre.vs0 = *reinterpret_cast<const bf16x8*>(nxt->proj + nxt->vcol + o0_); pre.vs1 = *reinterpret_cast<const bf16x8*>(nxt->proj + nxt->vcol + o1_);
    pre.ks0 = *reinterpret_cast<const bf16x8*>(nxt->proj + nxt->kcol + o0_); pre.ks1 = *reinterpret_cast<const bf16x8*>(nxt->proj + nxt->kcol + o1_);
    asm volatile("" ::: "memory");
  }
  __syncthreads();
  { bf16* stg = (bf16*)lds + wid * 2048;
#pragma unroll
    for (int hh = 0; hh < 2; ++hh) {
#pragma unroll
      for (int r8 = 0; r8 < 8; ++r8) { const int r = 8 * hh + r8; const int orow = crow(r, hi); const float rl = __builtin_amdgcn_rcpf(li_l[orow]);
#pragma unroll
        for (int d0 = 0; d0 < 4; ++d0) stg[(orow & 15) * 128 + d0 * 32 + r32] = (bf16)(cvtpk(o[d0][r] * rl, 0.f) & 0xffffu); }
      asm volatile("s_waitcnt lgkmcnt(0)" ::: "memory");
#pragma unroll
      for (int j = 0; j < 4; ++j) { const int row = (lane >> 4) + 4 * j, ch = lane & 15; const u32x4 v = *(const u32x4*)(stg + row * 128 + ch * 8);
        const unsigned oo_ = cfg.o_off(wid * QBLK + 16 * hh + row); *(u32x4*)(cfg.obuf + oo_ + ch * 8) = v;
        if (MK_MIXFOLD) { const float q_ = rowsum16(ssq8(v));
          if (ch == 0) ((float*)((char*)cfg.obuf + MK_SSQ_FROM_O_BYTES))[(oo_ >> 11) * 16 + ((oo_ & 2047u) >> 7)] = q_; } }
      asm volatile("s_waitcnt lgkmcnt(0)" ::: "memory");
    } }
  __syncthreads();
#undef SLOAD
#undef SWRITE
#undef SWAIT
#undef RESC
#undef QK
#undef QK1
#undef PSM
#undef FPV
}

template <class Cfg, int SD = 2>
__device__ __forceinline__ void attn_unit_h(const Cfg& cfg, char* lds, const int wid  , Pre& pre, const bool have_pre  , const Cfg* nxt  ) {
  const int lane = lane_id(), tid = wid * 64 + lane, r32 = lane & 31, hi = lane >> 5;
  bf16* V_lds = (bf16*)lds; bf16* K_lds = (bf16*)(lds + 2 * SHM_V);
  float* ws = (float*)(lds + 2 * SHM_V + 2 * SHM_K) + wid * 64; float* li_l = ws; float* al_l = ws + 32;
  float m_reg = -1e30f, l_reg = 0; f32x16 o[4] = {}; bf16x8 qr[8];
  const bf16* Qw = cfg.proj + cfg.q_off(wid * QBLK + r32) + hi * 8;
  if (have_pre) {
#pragma unroll
    for (int d0 = 0; d0 < 8; ++d0) qr[d0] = pre.qr[d0];
  } else {
#pragma unroll
    for (int d0 = 0; d0 < 8; ++d0) qr[d0] = *reinterpret_cast<const bf16x8*>(Qw + d0 * 16);
  }
  const int sr = tid >> 4, sc = (tid & 15) * 8, vst0 = v_st(sr, sc), vst1 = v_st(32 + sr, sc);
  const int krow = cfg.kwin(wid) + r32;
  const int Ga = (cfg.kwin(wid) >> 3) + hi;
  const int vb0 = (int)(uintptr_t)V_lds + (v_rd_base(lane) & ~256) + ((Ga >> 1) << 12) + ((Ga & 1) << 8);
  struct { bf16x8 vs0, vs1, ks0, ks1; } sr_[SD];
#define SLOAD(i, t) do { const unsigned o0_ = cfg.kv_off((t), sr) + sc, o1_ = cfg.kv_off((t), 32 + sr) + sc; \
    sr_[i].vs0 = *reinterpret_cast<const bf16x8*>(cfg.proj + cfg.vcol + o0_); sr_[i].vs1 = *reinterpret_cast<const bf16x8*>(cfg.proj + cfg.vcol + o1_); \
    sr_[i].ks0 = *reinterpret_cast<const bf16x8*>(cfg.proj + cfg.kcol + o0_); sr_[i].ks1 = *reinterpret_cast<const bf16x8*>(cfg.proj + cfg.kcol + o1_); } while (0)
#define SWRITE(b, i) do { *(bf16x8*)((char*)V_lds + (b) * SHM_V + vst0) = sr_[i].vs0;          \
    *(bf16x8*)((char*)V_lds + (b) * SHM_V + vst1) = sr_[i].vs1; int kc = sc * 2;               \
    *(bf16x8*)((char*)K_lds + (b) * SHM_K + KSWZ(sr, kc)) = sr_[i].ks0;                       \
    *(bf16x8*)((char*)K_lds + (b) * SHM_K + KSWZ(32 + sr, kc)) = sr_[i].ks1; } while (0)
#define SWAIT() do { if constexpr (SD == 2) asm volatile("s_waitcnt vmcnt(4)" ::: "memory"); else asm volatile("s_waitcnt vmcnt(0)" ::: "memory"); } while (0)
#define RESC(a) do { if (__any((a) < 1.f)) { if (hi == 0) al_l[r32] = (a); asm volatile("s_waitcnt lgkmcnt(0)" ::: "memory"); \
    for (int d = 0; d < 4; ++d) for (int r = 0; r < 16; ++r) o[d][r] *= al_l[crow(r, hi)]; } } while (0)
#define QK(P0, KB, T, MN, AL) do { if (cfg.active((T), wid)) { qkt32(P0, (KB), qr, krow, hi); cfg.mask16(P0, (T), wid, r32, hi); partialSM1(P0, m_reg, MN, AL); } else { AL = 1.f; } } while (0)
#define QK1(P0, KB, T) do { if (cfg.active((T), wid)) { qkt32(P0, (KB), qr, krow, hi); cfg.mask16(P0, (T), wid, r32, hi); } } while (0)
#define PSM(P0, T, MN, AL) do { if (cfg.active((T), wid)) { partialSM1(P0, m_reg, MN, AL); } else { AL = 1.f; } } while (0)
  f32x16 pA0, pB0; float mnA, mnB, alA, alB; bf16x8 pa0, pa1; const int NT = Cfg::NT;
  constexpr int SE = 0, SO = SD - 1;
  if (have_pre) { sr_[SE].vs0 = pre.vs0; sr_[SE].vs1 = pre.vs1; sr_[SE].ks0 = pre.ks0; sr_[SE].ks1 = pre.ks1; } else SLOAD(SE, 0);
  asm volatile("s_waitcnt vmcnt(0)" ::: "memory"); SWRITE(0, SE); __syncthreads();
  QK(pA0, K_lds, 0, mnA, alA);
  SLOAD(SO, 1); if constexpr (SD == 2) { if (2 < NT) SLOAD(SE, 2); }
  SWAIT(); SWRITE(1, SO); __syncthreads();
  for (int j = 1; j + 1 < NT; j += 2) {
    SBAR(); QK1(pB0, (bf16*)((char*)K_lds + SHM_K), j);
    if (cfg.active(j - 1, wid)) { finishSM1(pA0, alA, l_reg, pa0, pa1); } SBAR();
    SLOAD(SO, j + SD); SBAR();
    if (cfg.active(j - 1, wid)) { pv_d0h(o, vb0, pa0, pa1); }
    PSM(pB0, j, mnB, alB);
    __syncthreads(); SWAIT(); SWRITE(0, SE);
    RESC(alB); __syncthreads();
    SBAR(); QK1(pA0, K_lds, j + 1);
    if (cfg.active(j, wid)) { finishSM1(pB0, alB, l_reg, pa0, pa1); } SBAR();
    if (SD == 1 || j + 3 < NT) SLOAD(SE, j + 1 + SD); SBAR();
    if (cfg.active(j, wid)) { pv_d0h(o, vb0 + (int)SHM_V, pa0, pa1); }
    PSM(pA0, j + 1, mnA, alA);
    __syncthreads(); SWAIT(); SWRITE(1, SO);
    RESC(alA); __syncthreads();
  }
  SBAR(); QK1(pB0, (bf16*)((char*)K_lds + SHM_K), NT - 1);
  if (cfg.active(NT - 2, wid)) { finishSM1(pA0, alA, l_reg, pa0, pa1); SBAR(); pv_d0h(o, vb0, pa0, pa1); }
  PSM(pB0, NT - 1, mnB, alB);
  __syncthreads(); RESC(alB);
  if (cfg.active(NT - 1, wid)) { finishSM1(pB0, alB, l_reg, pa0, pa1); SBAR(); pv_d0h(o, vb0 + (int)SHM_V, pa0, pa1); }
  if (hi == 0) li_l[r32] = l_reg; asm volatile("s_waitcnt lgkmcnt(0)" ::: "memory");
  if (Cfg::HAS_LSE) { if (hi == 0) cfg.store_lse(wid * QBLK + r32, m_reg * SCALE + __logf(l_reg)); }
  if (MK_PREFETCH_UNIT) {
    const bf16* Qn = nxt->proj + nxt->q_off(wid * QBLK + r32) + hi * 8;
#pragma unroll
    for (int d0 = 0; d0 < 8; ++d0) pre.qr[d0] = *reinterpret_cast<const bf16x8*>(Qn + d0 * 16);
    const unsigned o0_ = nxt->kv_off(0, sr) + sc, o1_ = nxt->kv_off(0, 32 + sr) + sc;
    pre.vs0 = *reinterpret_cast<const bf16x8*>(nxt->proj + nxt->vcol + o0_); pre.vs1 = *reinterpret_cast<const bf16x8*>(nxt->proj + nxt->vcol + o1_);
    pre.ks0 = *reinterpret_cast<const bf16x8*>(nxt->proj + nxt->kcol + o0_); pre.ks1 = *reinterpret_cast<const bf16x8*>(nxt->proj + nxt->kcol + o1_);
    asm volatile("" ::: "memory");
  }
  { bf16* stg = (bf16*)(lds + OSTAGE_OFF) + wid * 2048;
#pragma unroll
    for (int hh = 0; hh < 2; ++hh) {
#pragma unroll
      for (int r8 = 0; r8 < 8; ++r8) { const int r = 8 * hh + r8; const int orow = crow(r, hi); const float rl = __builtin_amdgcn_rcpf(li_l[orow]);
#pragma unroll
        for (int d0 = 0; d0 < 4; ++d0) stg[(orow & 15) * 128 + d0 * 32 + r32] = (bf16)(cvtpk(o[d0][r] * rl, 0.f) & 0xffffu); }
      asm volatile("s_waitcnt lgkmcnt(0)" ::: "memory");
#pragma unroll
      for (int j = 0; j < 4; ++j) { const int row = (lane >> 4) + 4 * j, ch = lane & 15; const u32x4 v = *(const u32x4*)(stg + row * 128 + ch * 8);
        const unsigned oo_ = cfg.o_off(wid * QBLK + 16 * hh + row); *(u32x4*)(cfg.obuf + oo_ + ch * 8) = v;
        if (MK_MIXFOLD) { const float q_ = rowsum16(ssq8(v));
          if (ch == 0) ((float*)((char*)cfg.obuf + MK_SSQ_FROM_O_BYTES))[(oo_ >> 11) * 16 + ((oo_ & 2047u) >> 7)] = q_; } }
      asm volatile("s_waitcnt lgkmcnt(0)" ::: "memory");
    } }
  __syncthreads();
#undef SLOAD
#undef SWRITE
#undef SWAIT
#undef RESC
#undef QK
#undef QK1
#undef PSM
}

template <class Cfg>
__device__ __forceinline__ void attn_unit_simple(const Cfg& cfg, char* lds, const int wid  ) {
  const int lane = lane_id(), tid = wid * 64 + lane, r32 = lane & 31, hi = lane >> 5;
  bf16* V_lds = (bf16*)lds; bf16* K_lds = (bf16*)(lds + 2 * SHM_V);
  float* ws = (float*)(lds + 2 * SHM_V + 2 * SHM_K) + wid * 64; float* li_l = ws; float* al_l = ws + 32;
  float m_reg = -1e30f, l_reg = 0; f32x16 o[4] = {}; bf16x8 qr[8];
  const bf16* Qw = cfg.proj + cfg.q_off(wid * QBLK + r32) + hi * 8;
#pragma unroll
  for (int d0 = 0; d0 < 8; ++d0) qr[d0] = *reinterpret_cast<const bf16x8*>(Qw + d0 * 16);
  const int sr = tid >> 4, sc = (tid & 15) * 8, vst0 = v_st(sr, sc), vst1 = v_st(32 + sr, sc);
  const int vb0 = (int)(uintptr_t)V_lds + v_rd_base(lane);
  bf16x8 vs0, vs1, ks0, ks1;
#define SLOAD1(t) do { const unsigned o0_ = cfg.kv_off((t), sr) + sc, o1_ = cfg.kv_off((t), 32 + sr) + sc; \
    vs0 = *reinterpret_cast<const bf16x8*>(cfg.proj + cfg.vcol + o0_); vs1 = *reinterpret_cast<const bf16x8*>(cfg.proj + cfg.vcol + o1_); \
    ks0 = *reinterpret_cast<const bf16x8*>(cfg.proj + cfg.kcol + o0_); ks1 = *reinterpret_cast<const bf16x8*>(cfg.proj + cfg.kcol + o1_); } while (0)
#define SWRITE1(b) do { *(bf16x8*)((char*)V_lds + (b) * SHM_V + vst0) = vs0; *(bf16x8*)((char*)V_lds + (b) * SHM_V + vst1) = vs1; const int kc = sc * 2; \
    *(bf16x8*)((char*)K_lds + (b) * SHM_K + KSWZ(sr, kc)) = ks0; *(bf16x8*)((char*)K_lds + (b) * SHM_K + KSWZ(32 + sr, kc)) = ks1; } while (0)
  const int tb = cfg.t_begin(), te = cfg.t_end();
  SLOAD1(tb); asm volatile("s_waitcnt vmcnt(0)" ::: "memory"); SWRITE1(tb & 1); __syncthreads();
  for (int t = tb; t < te; ++t) {
    const int b = t & 1;
    if (t + 1 < te) SLOAD1(t + 1);
    SBAR();
    if (cfg.active(t, wid)) {
      f32x16 p0, p1; float mn, al; bf16x8 pa0, pa1, pa2, pa3;
      qkt(p0, p1, (bf16*)((char*)K_lds + b * SHM_K), qr, r32, hi);
      cfg.mask(p0, p1, t, wid, r32, hi);
      partialSM(p0, p1, m_reg, mn, al);
      if (__any(al < 1.f)) { if (hi == 0) al_l[r32] = al; asm volatile("s_waitcnt lgkmcnt(0)" ::: "memory");
#pragma unroll
        for (int d = 0; d < 4; ++d)
#pragma unroll
          for (int r = 0; r < 16; ++r) o[d][r] *= al_l[crow(r, hi)]; }
      finishSM(p0, p1, al, l_reg, pa0, pa1, pa2, pa3); SBAR();
      pv_d0(o, vb0 + b * (int)SHM_V, pa0, pa1, pa2, pa3);
    }
    SBAR();
    if (t + 1 < te) { asm volatile("s_waitcnt vmcnt(0)" ::: "memory"); SWRITE1(b ^ 1); }
    __syncthreads();
  }
  if (hi == 0) li_l[r32] = l_reg; asm volatile("s_waitcnt lgkmcnt(0)" ::: "memory");
  if (Cfg::HAS_LSE) { if (hi == 0) cfg.store_lse(wid * QBLK + r32, m_reg * SCALE + __logf(l_reg)); }
  { bf16* stg = (bf16*)(lds + OSTAGE_OFF) + wid * 2048;
#pragma unroll
    for (int hh = 0; hh < 2; ++hh) {
#pragma unroll
      for (int r8 = 0; r8 < 8; ++r8) { const int r = 8 * hh + r8; const int orow = crow(r, hi); const float rl = __builtin_amdgcn_rcpf(li_l[orow]);
#pragma unroll
        for (int d0 = 0; d0 < 4; ++d0) stg[(orow & 15) * 128 + d0 * 32 + r32] = (bf16)(cvtpk(o[d0][r] * rl, 0.f) & 0xffffu); }
      asm volatile("s_waitcnt lgkmcnt(0)" ::: "memory");
#pragma unroll
      for (int j = 0; j < 4; ++j) { const int row = (lane >> 4) + 4 * j, ch = lane & 15; const u32x4 v = *(const u32x4*)(stg + row * 128 + ch * 8);
        const unsigned oo_ = cfg.o_off(wid * QBLK + 16 * hh + row); *(u32x4*)(cfg.obuf + oo_ + ch * 8) = v;
        if (MK_MIXFOLD) { const float q_ = rowsum16(ssq8(v));
          if (ch == 0) ((float*)((char*)cfg.obuf + MK_SSQ_FROM_O_BYTES))[(oo_ >> 11) * 16 + ((oo_ & 2047u) >> 7)] = q_; } }
      asm volatile("s_waitcnt lgkmcnt(0)" ::: "memory");
    } }
  __syncthreads();
#undef SLOAD1
#undef SWRITE1
}

template <class Cfg>
__device__ __forceinline__ void attn_unit_wave(const Cfg& cfg, char* lds, const int wid  ) {
  const int lane = lane_id(), r32 = lane & 31, hi = lane >> 5;
  char* Vw = lds + wid * 8192;
  float* ws = (float*)(lds + 2 * SHM_V + 2 * SHM_K) + wid * 64; float* li_l = ws; float* al_l = ws + 32;
  float m_reg = -1e30f, l_reg = 0; f32x16 o[4] = {}; bf16x8 qr[8];
  const bf16* Qw = cfg.proj + cfg.q_off(wid * QBLK + r32) + hi * 8;
#pragma unroll
  for (int d0 = 0; d0 < 8; ++d0) qr[d0] = *reinterpret_cast<const bf16x8*>(Qw + d0 * 16);
  const int vkey = lane >> 4, vch = (lane & 15) * 8;
  const int vb0 = (int)(uintptr_t)Vw + v_rd_base(lane);
  const int tb = cfg.t_begin(), te = cfg.t_end();
  for (int t = tb; t < te; ++t) {
    if (!cfg.active(t, wid)) continue;
    bf16x8 kf[16], vf[8];
    { const bf16* k0p = cfg.proj + cfg.kcol + cfg.kv_off(t, r32) + hi * 8; const bf16* k1p = cfg.proj + cfg.kcol + cfg.kv_off(t, 32 + r32) + hi * 8;
#pragma unroll
      for (int d0 = 0; d0 < 8; ++d0) { kf[2 * d0] = *reinterpret_cast<const bf16x8*>(k0p + d0 * 16); kf[2 * d0 + 1] = *reinterpret_cast<const bf16x8*>(k1p + d0 * 16); } }
#pragma unroll
    for (int j = 0; j < 8; ++j) vf[j] = *reinterpret_cast<const bf16x8*>(cfg.proj + cfg.vcol + cfg.kv_off(t, vkey + 4 * j) + vch);
    f32x16 p0 = {}, p1 = {};
#pragma unroll
    for (int d0 = 0; d0 < 8; ++d0) { p0 = __builtin_amdgcn_mfma_f32_32x32x16_bf16(kf[2 * d0], qr[d0], p0, 0, 0, 0); p1 = __builtin_amdgcn_mfma_f32_32x32x16_bf16(kf[2 * d0 + 1], qr[d0], p1, 0, 0, 0); }
    cfg.mask(p0, p1, t, wid, r32, hi);
    float mn, al; bf16x8 pa0, pa1, pa2, pa3;
    partialSM(p0, p1, m_reg, mn, al);
    if (__any(al < 1.f)) { if (hi == 0) al_l[r32] = al; asm volatile("s_waitcnt lgkmcnt(0)" ::: "memory");
#pragma unroll
      for (int d = 0; d < 4; ++d)
#pragma unroll
        for (int r = 0; r < 16; ++r) o[d][r] *= al_l[crow(r, hi)]; }
    finishSM(p0, p1, al, l_reg, pa0, pa1, pa2, pa3);
#pragma unroll
    for (int j = 0; j < 8; ++j) *(bf16x8*)(Vw + v_st(vkey + 4 * j, vch)) = vf[j];
#pragma unroll
    for (int j = 0; j < 8; ++j) vf[j] = *reinterpret_cast<const bf16x8*>(cfg.proj + cfg.vcol + cfg.kv_off(t, 32 + vkey + 4 * j) + vch);
    asm volatile("s_waitcnt lgkmcnt(0)" ::: "memory"); SBAR();
#define PVW(D0, PA, PB) do { const s16x4 l0 = tr_read<v_rd_off(D0, 0, 0)>(vb0), h0 = tr_read<v_rd_off(D0, 0, 1)>(vb0), l1 = tr_read<v_rd_off(D0, 1, 0)>(vb0), h1 = tr_read<v_rd_off(D0, 1, 1)>(vb0); \
      asm volatile("s_waitcnt lgkmcnt(0)" ::: "memory"); SBAR(); \
      o[D0] = __builtin_amdgcn_mfma_f32_32x32x16_bf16(PA, ((bf16x8){l0[0], l0[1], l0[2], l0[3], h0[0], h0[1], h0[2], h0[3]}), o[D0], 0, 0, 0); \
      o[D0] = __builtin_amdgcn_mfma_f32_32x32x16_bf16(PB, ((bf16x8){l1[0], l1[1], l1[2], l1[3], h1[0], h1[1], h1[2], h1[3]}), o[D0], 0, 0, 0); } while (0)
    PVW(0, pa0, pa1); PVW(1, pa0, pa1); PVW(2, pa0, pa1); PVW(3, pa0, pa1);
    SBAR();
#pragma unroll
    for (int j = 0; j < 8; ++j) *(bf16x8*)(Vw + v_st(vkey + 4 * j, vch)) = vf[j];
    asm volatile("s_waitcnt lgkmcnt(0)" ::: "memory"); SBAR();
    PVW(0, pa2, pa3); PVW(1, pa2, pa3); PVW(2, pa2, pa3); PVW(3, pa2, pa3);
    SBAR();
#undef PVW
  }
  if (hi == 0) li_l[r32] = l_reg; asm volatile("s_waitcnt lgkmcnt(0)" ::: "memory");
  if (Cfg::HAS_LSE) { if (hi == 0) cfg.store_lse(wid * QBLK + r32, m_reg * SCALE + __logf(l_reg)); }
  { bf16* stg = (bf16*)(lds + OSTAGE_OFF) + wid * 2048;
#pragma unroll
    for (int hh = 0; hh < 2; ++hh) {
#pragma unroll
      for (int r8 = 0; r8 < 8; ++r8) { const int r = 8 * hh + r8; const int orow = crow(r, hi); const float rl = __builtin_amdgcn_rcpf(li_l[orow]);
#pragma unroll
        for (int d0 = 0; d0 < 4; ++d0) stg[(orow & 15) * 128 + d0 * 32 + r32] = (bf16)(cvtpk(o[d0][r] * rl, 0.f) & 0xffffu); }
      asm volatile("s_waitcnt lgkmcnt(0)" ::: "memory");
#pragma unroll
      for (int j = 0; j < 4; ++j) { const int row = (lane >> 4) + 4 * j, ch = lane & 15; const u32x4 v = *(const u32x4*)(stg + row * 128 + ch * 8);
        const unsigned oo_ = cfg.o_off(wid * QBLK + 16 * hh + row); *(u32x4*)(cfg.obuf + oo_ + ch * 8) = v;
        if (MK_MIXFOLD) { const float q_ = rowsum16(ssq8(v));
          if (ch == 0) ((float*)((char*)cfg.obuf + MK_SSQ_FROM_O_BYTES))[(oo_ >> 11) * 16 + ((oo_ & 2047u) >> 7)] = q_; } }
      asm volatile("s_waitcnt lgkmcnt(0)" ::: "memory");
    } }
}
#undef KSWZ
#undef SBAR
}

constexpr int NWAVES = 8;
constexpr int NTOK = 49152, SEQ = 4096, NSEQ = 12, NTOK_P = 16384;
constexpr int DM = 2048, INW = 5632, DFF = 8192, NLAYER = 4, HD = 128;
constexpr int COL_AQ = 0, COL_AK = 512, COL_AV = 768, COL_BQ = 1024, COL_BK = 1792, COL_BV = 2560, COL_CQ = 3328, COL_CK = 4096, COL_CV = 4864;
constexpr int OCOL_A = 0, OCOL_B = 512, OCOL_C = 1280;
constexpr float DN_ALPHA = 1.681792830507429f;
constexpr float EPS = 1e-6f;
constexpr float ATT_SCALE = 0.08838834764831845f;
#ifndef MK_BF16_RES
#define MK_BF16_RES 1
#endif
#ifndef MK_FUSE_PREP
#define MK_FUSE_PREP 1
#endif
#ifndef MK_BOUNDED_A
#define MK_BOUNDED_A 1
#endif
#ifndef MK_FIN_PHASES
#define MK_FIN_PHASES 0
#endif
#ifndef MK_TILED_H
#define MK_TILED_H 1
#endif
#ifndef MK_WGM_RES
#define MK_WGM_RES 4
#endif

constexpr size_t MiB = 1u << 20;
constexpr size_t WS_CTL = 0, CTL_ZERO_BYTES = 1 * MiB;
constexpr size_t WS_ROPE_B = 1 * MiB;
constexpr size_t WS_ROPE_A = 3 * MiB;
constexpr size_t WS_LSE    = 4 * MiB;
constexpr size_t WS_WIN    = 6 * MiB;
constexpr size_t WS_WOUT   = 28 * MiB;
constexpr size_t WS_WFF1   = 36 * MiB;
constexpr size_t WS_WFF2   = 68 * MiB;
constexpr size_t WS_XB     = 100 * MiB;
constexpr size_t WS_PROJ   = 292 * MiB;
constexpr size_t WS_O      = 820 * MiB;
constexpr size_t WS_H      = 292 * MiB;
constexpr size_t WS_PART   = 1060 * MiB;
constexpr size_t WS_STAT   = 1072 * MiB;
constexpr size_t WS_VEC    = 1073 * MiB;
constexpr size_t WS_PSB    = 1074 * MiB;
constexpr size_t WS_END    = 1078 * MiB;
constexpr size_t WS_SSQ    = 1012 * MiB;
constexpr size_t WS_RAT    = 1016 * MiB;
static_assert(WS_SSQ == WS_O + (size_t)NTOK * DM * 2 && WS_SSQ - WS_O == (size_t)MK_SSQ_FROM_O_BYTES && WS_SSQ + (size_t)NTOK * 16 * 4 <= WS_RAT && WS_RAT + (size_t)NTOK * 8 * 4 <= WS_PART, "SSQ / RAT placement");
static_assert(WS_PROJ + (size_t)NTOK * INW * 2 == WS_O && WS_O + (size_t)NTOK * DM * 2 <= WS_END && WS_H + (size_t)NTOK * DFF * 2 == WS_PART && WS_XB + (size_t)NTOK * DM * 2 == WS_PROJ, "d_ws map");
constexpr int CW_TMO = 0, CW_CODE = 1, CW_BAR = 4096;
constexpr int CW_ATTQ = 16384;
constexpr int NCOLP = INW + DFF, VEC_CS_IN = 0, VEC_BW_IN = INW, VEC_CS_FF1 = 2 * INW, VEC_BW_FF1 = 2 * INW + DFF, VEC_ONES = 2 * INW + 2 * DFF, VEC_ZEROS = VEC_ONES + DM, VEC_M0 = VEC_ZEROS + DM;
static_assert((size_t)(VEC_M0 + 16) * 4 <= MiB && (size_t)2 * 32 * NCOLP * 4 <= 4 * MiB && (size_t)NTOK * 8 <= MiB, "small buffers");

constexpr int RING_OFF = 0, RING_BYTES = 131072;
constexpr int LDSCTL_OFF = RING_BYTES, MISC_OFF = LDSCTL_OFF + 320;
constexpr int XCH_OFF = RING_BYTES + 1024;
constexpr int KTAB_OFF = XCH_OFF;
constexpr int LDS_BYTES = 148480;
static_assert(MISC_OFF + 128 <= XCH_OFF && XCH_OFF + 8192 <= LDS_BYTES && KTAB_OFF + 16384 <= LDS_BYTES, "LDS map");

__host__ __device__ __forceinline__ int pinv_A(int c) { const int half = c >> 6, w = c & 63, hi = w >> 5, i = w & 31; return 8 * (half * 8 + (i >> 2)) + hi * 4 + (i & 3); }
__host__ __device__ __forceinline__ int pinv_B(int c) { const int hi = c >> 6, i = c & 63; return 8 * (i >> 2) + hi * 4 + (i & 3); }
__host__ __device__ __forceinline__ int proj_phys_col(int n) {
#if MK_FUSE_PREP
    if (n < COL_AV) return (n & ~127) + pinv_A(n & 127);
    if (n >= COL_BQ && n < COL_BV) return (n & ~127) + pinv_B(n & 127);
#endif
    return n;
}

struct Frame {
    LAS unsigned char* lds;
    volatile LAS unsigned* MISC;
    gu32* ctl;
    int wave;
    int vcu, G;
    int gw, NGW;
    const float *x_prompt, *x_sample, *w_in, *a_q_gain, *a_k_gain, *c_rel_bias, *mix_gain, *w_out, *ln1_g, *ln1_b, *w_ff1, *w_ff2, *ln2_g, *ln2_b;
    float* X;
    bf16 *Win_t, *Wout_t, *Wff1_t, *Wff2_t;
    bf16 *XB, *PROJ, *O, *H;
    float* LSE; float* ROPE_B; float* ROPE_A;
    pg8::f32x2* PART; pg8::f32x2* STAT; float* VEC; float* PSB;
    float* SSQ; float* RAT;
};

constexpr int CW_SB = 32768;
__device__ __forceinline__ void sb_arrive(Frame& F, int k) {
    asm volatile("s_waitcnt vmcnt(0)" ::: "memory");
    __syncthreads();
    if (F.wave == 0 && lane_id() == 0) {
        __builtin_amdgcn_fence(__ATOMIC_RELEASE, "agent");
        asm volatile("s_waitcnt vmcnt(0)" ::: "memory");
        (void)__hip_atomic_fetch_add(F.ctl + CW_SB + 64 * k, 1u, RLX_AGENT);
    }
}
__device__ __forceinline__ void sb_wait(Frame& F, int k) {
    if (F.wave == 0 && lane_id() == 0) {
        gu32* w = F.ctl + CW_SB + 64 * k; const unsigned want = (unsigned)F.G; unsigned sp = 0u;
        while (__hip_atomic_load(w, RLX_AGENT) < want) { __builtin_amdgcn_s_sleep(2);
            if ((++sp & 1023u) == 0u) { if (__hip_atomic_load(F.ctl + CW_TMO, RLX_AGENT) != 0u) break; if (sp > (1u << 22)) { __hip_atomic_store(F.ctl + CW_TMO, 1u, RLX_AGENT); break; } } }
        __builtin_amdgcn_fence(__ATOMIC_ACQUIRE, "agent");
        asm volatile("s_waitcnt vmcnt(0)" ::: "memory");
    }
    __syncthreads();
}

__device__ __forceinline__ float wave_sum(float v) {
    v += xshfl<1>(v); v += xshfl<2>(v); v += xshfl<4>(v); v += xshfl<8>(v); v += xshfl<16>(v); v = xsum32(v);
    return v;
}
__device__ __forceinline__ float wave_max(float v) {
    v = fmaxf(v, xshfl<1>(v)); v = fmaxf(v, xshfl<2>(v)); v = fmaxf(v, xshfl<4>(v)); v = fmaxf(v, xshfl<8>(v)); v = fmaxf(v, xshfl<16>(v)); v = xmax32(v);
    return v;
}
__device__ __forceinline__ float bf2f(unsigned short b) { return __builtin_bit_cast(float, (unsigned)b << 16); }
__device__ __forceinline__ float bflo(unsigned w) { return __builtin_bit_cast(float, w << 16); }
__device__ __forceinline__ float bfhi(unsigned w) { return __builtin_bit_cast(float, w & 0xffff0000u); }

struct ConvItem { const float* W; bf16* WT; const float* g; const float* bvec; float* ps; float* pb; int K, N, kb, n0, perm, pad_; };
struct ConvRegs { f32x4 wv[8]; float gk[8], bk[8]; };
__device__ __forceinline__ void conv_load(const ConvItem& it, ConvRegs& r, int lane) {
    const int k0 = 64 * it.kb, c = lane & 7;
#pragma unroll
    for (int i = 0; i < 8; ++i) r.wv[i] = *(const GAS f32x4*)(it.W + (size_t)(k0 + (lane >> 3) + 8 * i) * it.N + it.n0 + 4 * (lane & 7));
#pragma unroll
    for (int i = 0; i < 8; ++i) { r.gk[i] = it.g ? it.g[k0 + 8 * c + i] : 1.f; r.bk[i] = it.bvec ? it.bvec[k0 + 8 * c + i] : 0.f; }
}
__device__ __forceinline__ void conv_finish(const ConvItem& it, const ConvRegs& r, LAS float* scr, int lane) {
    const int k0 = 64 * it.kb, c = lane & 7;
#pragma unroll
    for (int i = 0; i < 8; ++i) { LAS float* d = scr + ((lane >> 3) + 8 * i) * 33 + 4 * (lane & 7); d[0] = r.wv[i].x; d[1] = r.wv[i].y; d[2] = r.wv[i].z; d[3] = r.wv[i].w; }
    LDS_WAIT(); asm volatile("" ::: "memory");
#pragma unroll
    for (int j = 0; j < 4; ++j) { const int n = (lane >> 3) + 8 * j; const LAS float* s = scr + (8 * c) * 33 + n;
        float w[8];
#pragma unroll
        for (int i = 0; i < 8; ++i) w[i] = s[i * 33];
        v4u o; o.x = pk2(w[0] * r.gk[0], w[1] * r.gk[1]); o.y = pk2(w[2] * r.gk[2], w[3] * r.gk[3]); o.z = pk2(w[4] * r.gk[4], w[5] * r.gk[5]); o.w = pk2(w[6] * r.gk[6], w[7] * r.gk[7]);
        const int nd = it.perm ? proj_phys_col(it.n0 + n) : it.n0 + n;
        if (MK_TILED_W) *(GAS v4u*)(it.WT + ((size_t)(nd >> 8) * (it.K >> 6) + (k0 >> 6)) * 16384 + (nd & 255) * 64 + 8 * c) = o;
        else *(GAS v4u*)(it.WT + (size_t)nd * it.K + k0 + 8 * c) = o;
        if (it.ps) { float sa = ((bflo(o.x) + bfhi(o.x)) + (bflo(o.y) + bfhi(o.y))) + ((bflo(o.z) + bfhi(o.z)) + (bflo(o.w) + bfhi(o.w)));
            float sb = 0.f;
#pragma unroll
            for (int i = 0; i < 8; ++i) sb += w[i] * r.bk[i];
            sa += xshfl<1>(sa); sa += xshfl<2>(sa); sa += xshfl<4>(sa); sb += xshfl<1>(sb); sb += xshfl<2>(sb); sb += xshfl<4>(sb);
            if (c == 0) { it.ps[(size_t)it.kb * NCOLP + nd] = sa; it.pb[(size_t)it.kb * NCOLP + nd] = sb; } } }
    LDS_WAIT(); asm volatile("" ::: "memory");
}
__device__ __forceinline__ void convert_weights(Frame& F, int l, int l_in, int which, int gw, int ngw) {
    const int lane = lane_id();
    LAS float* scr = (LAS float*)(F.lds + RING_OFF + F.wave * 16384);
    constexpr int I_IN = (DM / 64) * (INW / 32), I_OUT = (DM / 64) * (DM / 32), I_F1 = (DM / 64) * (DFF / 32), I_F2 = (DFF / 64) * (DM / 32);
    const int n_in = (which & 1) ? I_IN : 0, n_rest = (which & 2) ? (I_OUT + I_F1 + I_F2) : 0, n_all = n_in + n_rest;
    const float* w_in = F.w_in + (size_t)l_in * DM * INW; const float* w_out = F.w_out + (size_t)l * DM * DM;
    const float* w_ff1 = F.w_ff1 + (size_t)l * DM * DFF; const float* w_ff2 = F.w_ff2 + (size_t)l * DFF * DM;
    const float* gin = (l_in > 0) ? F.ln2_g + (size_t)(l_in - 1) * DM : nullptr; const float* bin = (l_in > 0) ? F.ln2_b + (size_t)(l_in - 1) * DM : nullptr;
    float* ps = F.PSB; float* pb = F.PSB + (size_t)32 * NCOLP;
#define CONV_MAKE(IT, idx) do { int r_ = (idx); \
        if (r_ < n_in) { const int nblk_ = INW / 32; IT.W = w_in; IT.WT = F.Win_t; IT.g = gin; IT.bvec = bin; IT.ps = ps; IT.pb = pb; IT.K = DM; IT.N = INW; IT.kb = r_ / nblk_; IT.n0 = 32 * (r_ % nblk_); IT.perm = 1; } \
        else { r_ -= n_in; \
          if (r_ < I_OUT) { const int nblk_ = DM / 32; IT.W = w_out; IT.WT = F.Wout_t; IT.g = MK_MIXFOLD ? F.mix_gain + (size_t)l * DM : nullptr; IT.bvec = nullptr; IT.ps = nullptr; IT.pb = nullptr; IT.K = DM; IT.N = DM; IT.kb = r_ / nblk_; IT.n0 = 32 * (r_ % nblk_); IT.perm = 0; } \
          else { r_ -= I_OUT; \
            if (r_ < I_F1) { const int nblk_ = DFF / 32; IT.W = w_ff1; IT.WT = F.Wff1_t; IT.g = F.ln1_g + (size_t)l * DM; IT.bvec = F.ln1_b + (size_t)l * DM; IT.ps = ps + INW; IT.pb = pb + INW; IT.K = DM; IT.N = DFF; IT.kb = r_ / nblk_; IT.n0 = 32 * (r_ % nblk_); IT.perm = 0; } \
            else { r_ -= I_F1; const int nblk_ = DM / 32; IT.W = w_ff2; IT.WT = F.Wff2_t; IT.g = nullptr; IT.bvec = nullptr; IT.ps = nullptr; IT.pb = nullptr; IT.K = DFF; IT.N = DM; IT.kb = r_ / nblk_; IT.n0 = 32 * (r_ % nblk_); IT.perm = 0; } } } } while (0)
    if (gw >= n_all) return;
    ConvItem cur; cur.pad_ = 0; ConvRegs rn; CONV_MAKE(cur, gw); conv_load(cur, rn, lane);
    for (int it = gw; it < n_all; it += ngw) {
        ConvRegs rc = rn; ConvItem nxt = cur; const bool has_next = it + ngw < n_all;
        if (has_next) { CONV_MAKE(nxt, it + ngw); conv_load(nxt, rn, lane); }
        asm volatile("" ::: "memory");
        conv_finish(cur, rc, scr, lane);
        cur = nxt;
    }
#undef CONV_MAKE
}
__device__ __forceinline__ void reduce_colsums(Frame& F, int which) {
    const int lane = lane_id();
    const float* ps = F.PSB; const float* pb = F.PSB + (size_t)32 * NCOLP;
    for (int n = F.gw * 64 + lane; n < NCOLP; n += F.NGW * 64) {
        const bool is_in = n < INW; if (is_in ? !(which & 1) : !(which & 2)) continue;
        float a = 0.f, c = 0.f;
#pragma unroll 8
        for (int kb = 0; kb < 32; ++kb) { a += ps[(size_t)kb * NCOLP + n]; c += pb[(size_t)kb * NCOLP + n]; }
        if (is_in) { F.VEC[VEC_CS_IN + n] = a; F.VEC[VEC_BW_IN + n] = c; } else { F.VEC[VEC_CS_FF1 + n - INW] = a; F.VEC[VEC_BW_FF1 + n - INW] = c; }
    }
}
__device__ __forceinline__ void phase_finalize_stats(Frame& F) {
    const int lane = lane_id();
    for (int m = F.gw * 64 + lane; m < NTOK; m += F.NGW * 64) {
        const f32x4* p = (const f32x4*)(F.PART + (size_t)m * 32); float s = 0.f, q = 0.f;
#pragma unroll
        for (int i = 0; i < 16; ++i) { const f32x4 v = p[i]; s += v.x + v.z; q += v.y + v.w; }
        const float mean = s * (1.f / DM); const float var = fmaxf(q * (1.f / DM) - mean * mean, 0.f);
        F.STAT[m] = (pg8::f32x2){mean, 1.f / sqrtf(var + EPS)};
    }
}
struct StatRegs { f32x4 v[8]; };
__device__ __forceinline__ void stats_load(Frame& F, int pm, StatRegs& r) {
    const int tid = F.wave * 64 + lane_id(); const int row = pm * 256 + (tid >> 1), half = tid & 1;
    const f32x4* p = (const f32x4*)(F.PART + (size_t)row * 32 + half * 16);
#pragma unroll
    for (int i = 0; i < 8; ++i) r.v[i] = p[i];
}
__device__ __forceinline__ void stats_finish(Frame& F, int pm, const StatRegs& r) {
    const int tid = F.wave * 64 + lane_id(); const int row = pm * 256 + (tid >> 1), half = tid & 1;
    float s = 0.f, q = 0.f;
#pragma unroll
    for (int i = 0; i < 8; ++i) { const f32x4 v = r.v[i]; s += v.x + v.z; q += v.y + v.w; }
    s += xshfl<1>(s); q += xshfl<1>(q);
    const float mean = s * (1.f / DM); const float var = fmaxf(q * (1.f / DM) - mean * mean, 0.f);
    if (half == 0) F.STAT[row] = (pg8::f32x2){mean, 1.f / sqrtf(var + EPS)};
}
__device__ __forceinline__ void stats_panel(Frame& F, int pm) { StatRegs r; stats_load(F, pm, r); stats_finish(F, pm, r); }
#define STATS_PREAMBLE(S) do { pg8::Unit u_; int last_ = -1; for (int i_ = 0; (S).next(i_, u_); ++i_) if (u_.pm != last_) { last_ = u_.pm; stats_panel(F, u_.pm); } \
        asm volatile("s_waitcnt vmcnt(0)" ::: "memory"); __syncthreads(); } while (0)

struct RatRegs { f32x4 s0, s1, s2, s3, l0, l1; };
__device__ __forceinline__ void rat_load(Frame& F, int pm, RatRegs& r) {
    const int row = pm * 256 + (F.wave & 3) * 64 + lane_id();
    const f32x4* sp = (const f32x4*)(F.SSQ + (size_t)row * 16); r.s0 = sp[0]; r.s1 = sp[1]; r.s2 = sp[2]; r.s3 = sp[3];
    const f32x4* lp = (const f32x4*)(F.LSE + (size_t)row * 8); r.l0 = lp[0]; r.l1 = lp[1];
}
__device__ __forceinline__ void softmax3(float a0, float a1, float a2, float& p0, float& p1, float& p2) {
    const float mx = fmaxf(a0, fmaxf(a1, a2)); const float e0 = __expf(a0 - mx), e1 = __expf(a1 - mx), e2 = __expf(a2 - mx); const float inv = 1.0f / (e0 + e1 + e2); p0 = e0 * inv; p1 = e1 * inv; p2 = e2 * inv;
}
__device__ __forceinline__ void rat_finish(Frame& F, int pm, const RatRegs& r) {
    const int row = pm * 256 + (F.wave & 3) * 64 + lane_id();
    const f32x4 s0 = r.s0, s1 = r.s1, s2 = r.s2, s3 = r.s3, l0 = r.l0, l1 = r.l1;
    float al0, al1, al2, al3, al4, al5;
    softmax3(l0.x, l0.z, l1.x, al0, al2, al4); softmax3(l0.y, l0.w, l1.y, al1, al3, al5);
    const float wB = ((al0 * al0 * s1.x + al1 * al1 * s1.y) + (al2 * al2 * s1.z + al3 * al3 * s1.w)) + (al4 * al4 * s2.x + al5 * al5 * s2.y);
    const float rA = 1.0f / sqrtf(((s0.x + s0.y) + (s0.z + s0.w)) * (1.0f / 512.f) + EPS), rB = 1.0f / sqrtf(wB * (1.0f / 768.f) + EPS);
    const float rC = 1.0f / sqrtf(((s2.z + s2.w) + (s3.x + s3.y) + (s3.z + s3.w)) * (1.0f / 768.f) + EPS);
    const float g0 = rA, g1 = fmaxf(al0, 1e-20f) * rB, g2 = fmaxf(al1, 1e-20f) * rB, g3 = fmaxf(al2, 1e-20f) * rB, g4 = fmaxf(al3, 1e-20f) * rB, g5 = fmaxf(al4, 1e-20f) * rB, g6 = fmaxf(al5, 1e-20f) * rB, g7 = rC;
    f32x4* op = (f32x4*)(F.RAT + (size_t)row * 8);
    op[0] = (f32x4){g0 / g1, g1 / g2, g2 / g3, g3 / g4}; op[1] = (f32x4){g4 / g5, g5 / g6, g6 / g7, g7};
}
#define RAT_PREAMBLE(S) do { const int h_ = F.wave >> 2; \
        for (int i0_ = 0; ; i0_ += 6) { pg8::Unit u0_, u1_, u2_, ud_; const bool k0_ = (S).next(i0_ + h_, u0_), k1_ = (S).next(i0_ + 2 + h_, u1_), k2_ = (S).next(i0_ + 4 + h_, u2_); \
            if (k0_) { const int q0_ = u0_.pm, q1_ = k1_ ? u1_.pm : q0_, q2_ = k2_ ? u2_.pm : q0_;     \
                RatRegs r0_, r1_, r2_; rat_load(F, q0_, r0_); rat_load(F, q1_, r1_); rat_load(F, q2_, r2_); \
                asm volatile("" ::: "memory"); \
                rat_finish(F, q0_, r0_); rat_finish(F, q1_, r1_); rat_finish(F, q2_, r2_); } \
            if (!(S).next(i0_ + 6, ud_)) break; } \
        asm volatile("s_waitcnt vmcnt(0)" ::: "memory"); __syncthreads(); } while (0)

__device__ __forceinline__ void sincos_d(double a, float& c, float& s) {
    const double k = __builtin_rint(a * 0.6366197723675814);
    const double r = __builtin_fma(-k, 1.5707963267948966, a) - k * 6.123233995736766e-17;
    const double r2 = r * r;
    double sp = -1.0 / 1307674368000.0;
    sp = sp * r2 + 1.0 / 6227020800.0; sp = sp * r2 - 1.0 / 39916800.0; sp = sp * r2 + 1.0 / 362880.0; sp = sp * r2 - 1.0 / 5040.0; sp = sp * r2 + 1.0 / 120.0; sp = sp * r2 - 1.0 / 6.0; sp = sp * r2 + 1.0;
    sp *= r;
    double cp = 1.0 / 20922789888000.0;
    cp = cp * r2 - 1.0 / 87178291200.0; cp = cp * r2 + 1.0 / 479001600.0; cp = cp * r2 - 1.0 / 3628800.0; cp = cp * r2 + 1.0 / 40320.0; cp = cp * r2 - 1.0 / 720.0; cp = cp * r2 + 1.0 / 24.0; cp = cp * r2 - 0.5; cp = cp * r2 + 1.0;
    const int q = ((int)k) & 3;
    const double ss = (q == 0) ? sp : (q == 1) ? cp : (q == 2) ? -sp : -cp;
    const double cc = (q == 0) ? cp : (q == 1) ? -sp : (q == 2) ? -cp : sp;
    c = (float)cc; s = (float)ss;
}

__device__ __forceinline__ void phase_prologue(Frame& F) {
    const int lane = lane_id();
    const int gt = F.gw * 64 + lane, NGT = F.NGW * 64;
    for (int e = gt; e < SEQ * 64 + 64 * 32; e += NGT) {
        int t, i; double inv = 1.0; float* dst;
        if (e < SEQ * 64) { t = e >> 6; i = e & 63; dst = F.ROPE_B + 2 * (size_t)e; for (int j = 0; j < i; ++j) inv *= 0.8659643233600653; }
        else { const int e2 = e - SEQ * 64; t = e2 >> 5; i = e2 & 31; dst = F.ROPE_A + 2 * (size_t)e2; for (int j = 0; j < 2 * i; ++j) inv *= 0.8659643233600653; }
        float c, s; sincos_d((double)t * inv, c, s);
        dst[0] = c; dst[1] = s;
    }
    { f32x4 xn[8];
#define PRO_LOAD(m_) do { const float* src_ = ((m_) < NTOK_P) ? F.x_prompt + (size_t)(m_) * DM : F.x_sample + (size_t)((m_) - NTOK_P) * DM; \
        _Pragma("unroll") for (int j = 0; j < 8; ++j) xn[j] = __builtin_nontemporal_load((const f32x4*)src_ + lane + 64 * j); } while (0)
      if (F.gw < NTOK) PRO_LOAD(F.gw);
      for (int m = F.gw; m < NTOK; m += F.NGW) {
        f32x4 xc[8];
#pragma unroll
        for (int j = 0; j < 8; ++j) xc[j] = xn[j];
        if (m + F.NGW < NTOK) PRO_LOAD(m + F.NGW);
        asm volatile("" ::: "memory");
        GAS unsigned long long* o8 = (GAS unsigned long long*)(F.XB + (size_t)m * DM) + lane;
#pragma unroll
        for (int j = 0; j < 8; ++j) o8[64 * j] = (unsigned long long)pk2(xc[j].x, xc[j].y) | ((unsigned long long)pk2(xc[j].z, xc[j].w) << 32);
        if (lane == 0) F.STAT[m] = (pg8::f32x2){0.f, 1.f};
      }
#undef PRO_LOAD
    }
    for (int e = gt; e < DM; e += NGT) { F.VEC[VEC_ONES + e] = 1.f; F.VEC[VEC_ZEROS + e] = 0.f; }
    if (F.gw < NLAYER) {
        const float* gq = F.a_q_gain + F.gw * HD; const float* gk = F.a_k_gain + F.gw * HD;
        const float mq = wave_max(fmaxf(fabsf(gq[2 * lane]), fabsf(gq[2 * lane + 1]))), mk = wave_max(fmaxf(fabsf(gk[2 * lane]), fabsf(gk[2 * lane + 1])));
        if (lane == 0) F.VEC[VEC_M0 + F.gw] = 128.f * mq * mk * 1.05f; }
    for (int e = gt; e < 2 * INW; e += NGT) F.VEC[VEC_CS_IN + e] = 0.f;
    convert_weights(F, 0, 0, 1, F.gw, F.NGW);
}

__device__ __forceinline__ void phase_prep(Frame& F, int l) {
    const int lane = lane_id();
    const float* gq = F.a_q_gain + l * HD; const float* gk = F.a_k_gain + l * HD;
    const long NIT = (long)NTOK * 18 * 8;
    for (long ti = (long)F.gw * 64 + lane; ti < NIT; ti += (long)F.NGW * 64) {
        const int c = (int)(ti & 7); const int th = (int)(ti >> 3); const int m = th / 18, hs = th - m * 18; const int t = m & (SEQ - 1);
        int col, lo_off, hi_off; const float* tab; const float* gain = nullptr;
        if (hs < 6) {
            col = (hs < 4) ? COL_AQ + hs * HD : COL_AK + (hs - 4) * HD; gain = (hs < 4) ? gq : gk;
            const int cc = c & 3, half = c >> 2; lo_off = half * 64 + cc * 8; hi_off = lo_off + 32;
            const int pos = half ? (t & 63) : (t >> 6); tab = F.ROPE_A + 2 * (size_t)(pos * 32 + cc * 8);
        } else {
            col = (hs < 12) ? COL_BQ + (hs - 6) * HD : COL_BK + (hs - 12) * HD;
            lo_off = c * 8; hi_off = 64 + c * 8; tab = F.ROPE_B + 2 * (size_t)(t * 64 + c * 8);
        }
        bf16* p = F.PROJ + (size_t)m * INW + col;
        const v4u lo4 = *(const v4u*)(p + lo_off), hi4 = *(const v4u*)(p + hi_off);
        float lo[8], hv[8];
        lo[0] = bflo(lo4.x); lo[1] = bfhi(lo4.x); lo[2] = bflo(lo4.y); lo[3] = bfhi(lo4.y); lo[4] = bflo(lo4.z); lo[5] = bfhi(lo4.z); lo[6] = bflo(lo4.w); lo[7] = bfhi(lo4.w);
        hv[0] = bflo(hi4.x); hv[1] = bfhi(hi4.x); hv[2] = bflo(hi4.y); hv[3] = bfhi(hi4.y); hv[4] = bflo(hi4.z); hv[5] = bfhi(hi4.z); hv[6] = bflo(hi4.w); hv[7] = bfhi(hi4.w);
        float ss = 0.f;
#pragma unroll
        for (int j = 0; j < 8; ++j) ss += lo[j] * lo[j] + hv[j] * hv[j];
        ss += xshfl<1>(ss); ss += xshfl<2>(ss); ss += xshfl<4>(ss);
        if (hs < 6) { const float rs = 1.0f / sqrtf(ss * (1.0f / HD) + EPS);
#pragma unroll
            for (int j = 0; j < 8; ++j) { lo[j] = lo[j] * rs * gain[lo_off + j]; hv[j] = hv[j] * rs * gain[hi_off + j]; } }
        float ol[8], oh[8];
#pragma unroll
        for (int j = 0; j < 8; ++j) { const float cs = tab[2 * j], sn = tab[2 * j + 1]; ol[j] = lo[j] * cs - hv[j] * sn; oh[j] = hv[j] * cs + lo[j] * sn; }
        v4u w; w.x = pk2(ol[0], ol[1]); w.y = pk2(ol[2], ol[3]); w.z = pk2(ol[4], ol[5]); w.w = pk2(ol[6], ol[7]); *(v4u*)(p + lo_off) = w;
        w.x = pk2(oh[0], oh[1]); w.y = pk2(oh[2], oh[3]); w.z = pk2(oh[4], oh[5]); w.w = pk2(oh[6], oh[7]); *(v4u*)(p + hi_off) = w;
    }
}

#ifndef MK_RING3_A
#define MK_RING3_A 0
#endif
struct CfgA {
    static constexpr int NT = SEQ / 64; static constexpr bool HAS_LSE = false;
    float negm0C;
    const bf16* proj; bf16* obuf; unsigned qbase, kvbase, obase; int kcol, vcol;
    __device__ __forceinline__ unsigned q_off(int row) const { return qbase + (unsigned)row * INW; }
    __device__ __forceinline__ unsigned kv_off(int t, int row) const { return kvbase + (unsigned)(t * 64 + row) * INW; }
    __device__ __forceinline__ bool active(int, int) const { return true; }
    __device__ __forceinline__ void mask(att::f32x16&, att::f32x16&, int, int, int, int) const {}
    __device__ __forceinline__ unsigned o_off(int row) const { return obase + (unsigned)row * DM; }
    __device__ __forceinline__ void store_lse(int, float) const {}
};
__device__ __forceinline__ CfgA make_cfgA(Frame& F, int u, float negm0C) {
    const int x = F.vcu / (F.G / 8), j = F.vcu % (F.G / 8);
    int combo, hq2, qb;
    if (F.G == 256) { const int i = u / 256; combo = i * 8 + x; hq2 = j >> 4; qb = j & 15; } else { combo = u / 32; hq2 = (u >> 4) & 1; qb = u & 15; }
    const int s = combo >> 1, kvh = combo & 1, hq = kvh * 2 + hq2;
    const unsigned row0 = (unsigned)s * SEQ;
    CfgA cfg; cfg.negm0C = negm0C; cfg.proj = F.PROJ; cfg.obuf = F.O; cfg.qbase = (row0 + (unsigned)qb * 256) * INW + COL_AQ + hq * HD; cfg.kvbase = row0 * INW; cfg.kcol = COL_AK + kvh * HD; cfg.vcol = COL_AV + kvh * HD;
    cfg.obase = (row0 + (unsigned)qb * 256) * DM + OCOL_A + hq * HD;
    return cfg;
}
template <bool BOUNDED> __device__ __forceinline__ void phase_attn_A_(Frame& F, char* lds, float negm0C) {
    att::Pre pre; bool have = false;
    for (int u = F.vcu; u < NSEQ * 4 * 16; u += F.G) {
        const CfgA cfg = make_cfgA(F, u, negm0C); const bool hn = u + F.G < NSEQ * 4 * 16; const CfgA nx = make_cfgA(F, hn ? u + F.G : u, negm0C);
        if (MK_RING3_A) att::attn_unit3<CfgA, BOUNDED>(cfg, lds, F.wave, pre, have, &nx); else att::attn_unit<CfgA, 2, BOUNDED>(cfg, lds, F.wave, pre, have, &nx);
        have = MK_PREFETCH_UNIT != 0;
    }
}
__device__ __forceinline__ void phase_attn_A(Frame& F, int l, char* lds) {
    const float m0 = F.VEC[VEC_M0 + l];
    if (MK_BOUNDED_A && m0 * ATT_SCALE <= 40.f) phase_attn_A_<true>(F, lds, -m0 * ATT_SCALE * 1.4426950408889634f); else phase_attn_A_<false>(F, lds, 0.f);
}

#ifndef MK_WAVE_BC
#define MK_WAVE_BC 0
#endif
#ifndef MK_C16
#define MK_C16 1
#endif
#if MK_C16
#define MK_CFG_C CfgC16
#define MK_UNIT_C att::attn_unit_h<CfgC16, 2>
#else
#define MK_CFG_C CfgC
#define MK_UNIT_C ATT_UNIT_BC(CfgC)
#endif
#ifndef MK_PIPE_BC
#define MK_PIPE_BC 1
#endif
#if MK_WAVE_BC
#define ATT_UNIT_BC(C) att::attn_unit_wave<C>
#elif MK_PIPE_BC
#define ATT_UNIT_BC(C) att::attn_unit<C, 1>
#else
#define ATT_UNIT_BC(C) att::attn_unit_simple<C>
#endif
struct CfgB {
    static constexpr int NT = 6; static constexpr bool HAS_LSE = true;
    static constexpr float negm0C = 0.f;
    const bf16* proj; bf16* obuf; float* lse; unsigned tok0; int sh, s0, L, hb; int kcol, vcol;
    __device__ __forceinline__ unsigned q_off(int row) const { return (tok0 + ((unsigned)(s0 + row) << sh)) * INW + COL_BQ + hb * HD; }
    __device__ __forceinline__ unsigned kv_off(int t, int row) const { int pos = s0 - 64 + 64 * t + row; pos = min(max(pos, 0), L - 1); return (tok0 + ((unsigned)pos << sh)) * INW; }
    __device__ __forceinline__ bool active(int t, int wid) const { return (t >= (wid >> 1)) && (t <= (wid >> 1) + 2) && (t >= t_begin()) && (t < t_end()); }
    __device__ __forceinline__ int t_begin() const { return s0 == 0 ? 1 : 0; }
    __device__ __forceinline__ int t_end() const { return s0 + 256 == L ? 5 : 6; }
    __device__ __forceinline__ void mask(att::f32x16& p0, att::f32x16& p1, int t, int wid, int r32, int hi) const {
        if (t == (wid >> 1) + 1) return;
        const int d0 = 64 * t - 64 - 32 * wid - r32 + 4 * hi;
#pragma unroll
        for (int r = 0; r < 16; ++r) { const int d = d0 + (r & 3) + 8 * (r >> 2);
            if (d < -64 || d > 64) p0[r] = -__builtin_inff();
            if (d + 32 < -64 || d + 32 > 64) p1[r] = -__builtin_inff(); }
    }
    __device__ __forceinline__ unsigned o_off(int row) const { return (tok0 + ((unsigned)(s0 + row) << sh)) * DM + OCOL_B + hb * HD; }
    __device__ __forceinline__ void store_lse(int row, float v) const { lse[(size_t)(tok0 + ((unsigned)(s0 + row) << sh)) * 8 + hb] = v; }
};
struct CfgC {
    static constexpr int NT = 12; static constexpr bool HAS_LSE = false;
    static constexpr float negm0C = 0.f;
    const bf16* proj; bf16* obuf; const float* bias;
    unsigned tokq; unsigned tokk; int R0, kr0, hc; int kcol, vcol;
    __device__ __forceinline__ unsigned q_off(int row) const { return (tokq + (unsigned)row) * INW + COL_CQ + hc * HD; }
    __device__ __forceinline__ unsigned kv_off(int t, int row) const { return (tokk + (unsigned)(t * 64 + row)) * INW; }
    __device__ __forceinline__ bool active(int t, int wid) const { const int r = R0 + (wid >> 1), r0 = min(max(r - 4, 0), 56), kr = kr0 + t; return kr >= r0 && kr < r0 + 8; }
    __device__ __forceinline__ int t_begin() const { return min(max(R0 - 4, 0), 56) - kr0; }
    __device__ __forceinline__ int t_end() const { return min(max(R0 - 1, 0), 56) + 8 - kr0; }
    __device__ __forceinline__ void mask(att::f32x16& p0, att::f32x16& p1, int t, int wid, int r32, int hi) const {
        const int r = R0 + (wid >> 1), kr = kr0 + t, qc = (wid & 1) * 32 + r32, sc = min(max(qc - 8, 0), 48);
        const int w0 = 4 * hi - sc;
        const float* bp = bias + (kr - r + 7) * 31 + (sc - qc + 15) + w0;
#pragma unroll
        for (int rr = 0; rr < 16; ++rr) { const int c = (rr & 3) + 8 * (rr >> 2);
            p0[rr] = ((unsigned)(w0 + c) < 16u) ? p0[rr] + bp[c] : -__builtin_inff();
            p1[rr] = ((unsigned)(w0 + c + 32) < 16u) ? p1[rr] + bp[c + 32] : -__builtin_inff(); }
    }
    __device__ __forceinline__ unsigned o_off(int row) const { return (tokq + (unsigned)row) * DM + OCOL_C + hc * HD; }
    __device__ __forceinline__ void store_lse(int, float) const {}
};
struct CfgC16 {
    static constexpr int NT = 12; static constexpr bool HAS_LSE = false; static constexpr float negm0C = 0.f;
    const bf16* proj; bf16* obuf; const float* bias;
    unsigned tokq; unsigned tokk; int R0, kr0, hc; int kcol, vcol;
    __device__ __forceinline__ int qtok(int idx) const { const int w = idx >> 5, rl = idx & 31; return (2 * (w >> 2) + (rl >> 4)) * 64 + 16 * (w & 3) + (rl & 15); }
    __device__ __forceinline__ unsigned q_off(int idx) const { return (tokq + (unsigned)qtok(idx)) * INW + COL_CQ + hc * HD; }
    __device__ __forceinline__ unsigned kv_off(int t, int row) const { return (tokk + (unsigned)(t * 64 + row)) * INW; }
    __device__ __forceinline__ int kwin(int wid) const { return min(max(16 * (wid & 3) - 8, 0), 32); }
    __device__ __forceinline__ bool active(int t, int wid) const { const int r = R0 + 2 * (wid >> 2), lo = min(max(r - 4, 0), 56), hi_ = min(max(r - 3, 0), 56) + 8, kr = kr0 + t; return kr >= lo && kr < hi_; }
    __device__ __forceinline__ void mask16(att::f32x16& p0, int t, int wid, int r32, int hi) const {
        const int r = R0 + 2 * (wid >> 2) + (r32 >> 4), kr = kr0 + t, qc = 16 * (wid & 3) + (r32 & 15), sc = min(max(qc - 8, 0), 48), r0 = min(max(r - 4, 0), 56);
        const bool rowok = (unsigned)(kr - r0) < 8u;
        const int w0 = kwin(wid) + 4 * hi - sc;
        const float* bp = bias + (kr - r + 7) * 31 + (sc - qc + 15) + w0;
#pragma unroll
        for (int rr = 0; rr < 16; ++rr) { const int cofs = (rr & 3) + 8 * (rr >> 2);
            p0[rr] = (rowok && (unsigned)(w0 + cofs) < 16u) ? p0[rr] + bp[cofs] : -__builtin_inff(); }
    }
    __device__ __forceinline__ unsigned o_off(int idx) const { return (tokq + (unsigned)qtok(idx)) * DM + OCOL_C + hc * HD; }
    __device__ __forceinline__ void store_lse(int, float) const {}
};
constexpr int ATT_BIAS_OFF = 106496;
constexpr int ATT_BIAS_OFF_OLD = 69632;
static_assert(att::OSTAGE_OFF >= (int)att::SHM_ATTN && att::OSTAGE_OFF + 8 * 4096 <= ATT_BIAS_OFF && ATT_BIAS_OFF + 6 * 15 * 31 * 4 + 512 <= RING_BYTES, "O stage / bias table placement");
__device__ __forceinline__ CfgB make_cfgB(Frame& F, int u) {
    const int s = u / 96, rem = u - s * 96, hb = rem >> 4, k = rem & 15;
    const int g = hb >> 1, sh = 2 * g, L = SEQ >> sh, nblk = L >> 8;
    const int r = k / nblk, blk = k - r * nblk;
    CfgB cfg; cfg.proj = F.PROJ; cfg.obuf = F.O; cfg.lse = F.LSE; cfg.tok0 = (unsigned)s * SEQ + r; cfg.sh = sh; cfg.s0 = blk * 256; cfg.L = L; cfg.hb = hb;
    cfg.kcol = COL_BK + hb * HD; cfg.vcol = COL_BV + hb * HD;
    return cfg;
}
__device__ __forceinline__ void phase_attn_B(Frame& F, char* lds) {
    att::Pre pre; bool have = false;
    for (int u = F.vcu; u < 1152; u += F.G) {
        const CfgB cfg = make_cfgB(F, u); const bool hn = u + F.G < 1152; const CfgB nx = make_cfgB(F, hn ? u + F.G : u);
        att::attn_unit<CfgB, 1>(cfg, lds, F.wave, pre, have, &nx); have = MK_PREFETCH_UNIT != 0;
    }
}
__device__ __forceinline__ CfgC16 make_cfgC(Frame& F, int v, const float* bl) {
    const int s = v / 96, rem = v - s * 96, hc = rem >> 4, blk = rem & 15;
    const int R0 = blk * 4, kr0 = min(max(R0 - 4, 0), 52);
    CfgC16 cfg; cfg.proj = F.PROJ; cfg.obuf = F.O; cfg.bias = bl; cfg.tokq = (unsigned)s * SEQ + R0 * 64; cfg.tokk = (unsigned)s * SEQ + kr0 * 64; cfg.R0 = R0; cfg.kr0 = kr0; cfg.hc = hc;
    cfg.kcol = COL_CK + hc * HD; cfg.vcol = COL_CV + hc * HD;
    return cfg;
}
__device__ __forceinline__ void phase_attn_C(Frame& F, int l, char* lds) {
    att::Pre pre; bool have = false; float* bl = (float*)(lds + ATT_BIAS_OFF);
    { const float* rel = F.c_rel_bias + (size_t)l * 6 * (15 * 31);
      for (int e = F.wave * 64 + lane_id(); e < 6 * 15 * 31; e += NWAVES * 64) bl[e] = rel[e] * (1.0f / ATT_SCALE);
      __syncthreads(); }
    for (int v = F.G - 1 - F.vcu; v < 1152; v += F.G) {
        CfgC16 cfg = make_cfgC(F, v, bl); cfg.bias = bl + cfg.hc * (15 * 31); const bool hn = v + F.G < 1152; const CfgC16 nx = make_cfgC(F, hn ? v + F.G : v, bl);
        att::attn_unit_h<CfgC16, 2>(cfg, lds, F.wave, pre, have, &nx); have = MK_PREFETCH_UNIT != 0;
    }
}

#ifndef MK_DYN_BC
#define MK_DYN_BC 0
#endif
__device__ __forceinline__ void phase_attn_BC_dyn(Frame& F, int l, char* lds) {
    att::Pre pre; float* bl = (float*)(lds + ATT_BIAS_OFF);
    { const float* rel = F.c_rel_bias + (size_t)l * 6 * (15 * 31);
      for (int e = F.wave * 64 + lane_id(); e < 6 * 15 * 31; e += NWAVES * 64) bl[e] = rel[e] * (1.0f / ATT_SCALE); }
    gu32* head = F.ctl + CW_ATTQ + 64 * l;
    volatile LAS unsigned* slot = F.MISC + 16;
    const bool t0 = (F.wave == 0) && (lane_id() == 0);
    unsigned nq = 0u;
    if (t0) nq = __hip_atomic_fetch_add(head, 1u, RLX_AGENT);
    for (;;) {
        if (t0) *slot = nq;
        __syncthreads();
        const unsigned q = *slot;
        __syncthreads();
        if (q >= 2304u) break;
        if (t0) nq = __hip_atomic_fetch_add(head, 1u, RLX_AGENT);
        if (q < 1152u) {
            CfgC16 cfg = make_cfgC(F, (int)q, bl); cfg.bias = bl + cfg.hc * (15 * 31);
            att::attn_unit_h<CfgC16, 2>(cfg, lds, F.wave, pre, false, &cfg);
        } else {
            const CfgB cfg = make_cfgB(F, (int)q - 1152);
            att::attn_unit<CfgB, 1>(cfg, lds, F.wave, pre, false, &cfg);
        }
    }
}

__device__ __forceinline__ float dot8(v4u a, v4u b) {
    return bflo(a.x) * bflo(b.x) + bfhi(a.x) * bfhi(b.x) + bflo(a.y) * bflo(b.y) + bfhi(a.y) * bfhi(b.y) + bflo(a.z) * bflo(b.z) + bfhi(a.z) * bfhi(b.z) + bflo(a.w) * bflo(b.w) + bfhi(a.w) * bfhi(b.w);
}
__device__ __forceinline__ void naive_B(Frame& F, int m, int hb) {
    const int lane = lane_id(); const int t = m & (SEQ - 1); const size_t sbase = (size_t)(m - t);
    const int g = hb >> 1, sh = 2 * g, dil = 1 << sh, i = t >> sh, r = t & (dil - 1), L = SEQ >> sh;
    const bf16* qp = F.PROJ + (size_t)m * INW + COL_BQ + hb * HD;
    const bf16* kb = F.PROJ + sbase * INW + COL_BK + hb * HD; const bf16* vb = F.PROJ + sbase * INW + COL_BV + hb * HD;
    float dot[3] = {0.f, 0.f, 0.f}; bool valid[3]; const bf16* kp[3];
#pragma unroll
    for (int j3 = 0; j3 < 3; ++j3) { const int jj = lane + 64 * j3, ik = i - 64 + jj; valid[j3] = (jj <= 128) && (ik >= 0) && (ik < L);
        const int ikc = valid[j3] ? ik : i; kp[j3] = kb + (size_t)(ikc * dil + r) * INW; }
#pragma unroll
    for (int ch = 0; ch < 16; ++ch) { const v4u qv = *(const v4u*)(qp + ch * 8);
#pragma unroll
        for (int j3 = 0; j3 < 3; ++j3) { const v4u kv = *(const v4u*)(kp[j3] + ch * 8); dot[j3] += dot8(qv, kv); } }
    float s[3];
#pragma unroll
    for (int j3 = 0; j3 < 3; ++j3) s[j3] = valid[j3] ? dot[j3] * ATT_SCALE : -__builtin_inff();
    const float mx = wave_max(fmaxf(s[0], fmaxf(s[1], s[2])));
    float p[3];
#pragma unroll
    for (int j3 = 0; j3 < 3; ++j3) p[j3] = valid[j3] ? __expf(s[j3] - mx) : 0.f;
    const float lsum = wave_sum(p[0] + p[1] + p[2]);
    float a0 = 0.f, a1 = 0.f;
#pragma unroll
    for (int j3 = 0; j3 < 3; ++j3) {
        const int nj = (j3 == 2) ? 1 : 64;
        for (int jl = 0; jl < nj; ++jl) { const float pj = __shfl(p[j3], jl); const int ik = i - 64 + jl + 64 * j3;
            if (ik >= 0 && ik < L) { const unsigned w = *(const unsigned*)(vb + (size_t)(ik * dil + r) * INW + 2 * lane); a0 += pj * bflo(w); a1 += pj * bfhi(w); } } }
    const float rl = 1.0f / lsum;
    *(unsigned*)(F.O + (size_t)m * DM + OCOL_B + hb * HD + 2 * lane) = pk2(a0 * rl, a1 * rl);
    if (lane == 0) F.LSE[(size_t)m * 8 + hb] = mx + __logf(lsum);
}
__device__ __forceinline__ void naive_C(Frame& F, int l, int m, int hc) {
    const int lane = lane_id(); const int t = m & (SEQ - 1); const size_t sbase = (size_t)(m - t);
    const int r = t >> 6, c = t & 63; const int r0 = min(max(r - 4, 0), 56), sc = min(max(c - 8, 0), 48);
    const bf16* qp = F.PROJ + (size_t)m * INW + COL_CQ + hc * HD;
    const bf16* kb = F.PROJ + sbase * INW + COL_CK + hc * HD; const bf16* vb = F.PROJ + sbase * INW + COL_CV + hc * HD;
    const float* rel = F.c_rel_bias + ((size_t)l * 6 + hc) * (15 * 31);
    float dot[2] = {0.f, 0.f}; const bf16* kp[2]; float bias[2];
#pragma unroll
    for (int j2 = 0; j2 < 2; ++j2) { const int kk = lane + 64 * j2, jr = kk >> 4, jc = kk & 15; kp[j2] = kb + (size_t)((r0 + jr) * 64 + sc + jc) * INW;
        bias[j2] = rel[(r0 + jr - r + 7) * 31 + (sc + jc - c + 15)]; }
#pragma unroll
    for (int ch = 0; ch < 16; ++ch) { const v4u qv = *(const v4u*)(qp + ch * 8);
#pragma unroll
        for (int j2 = 0; j2 < 2; ++j2) { const v4u kv = *(const v4u*)(kp[j2] + ch * 8); dot[j2] += dot8(qv, kv); } }
    const float s0 = dot[0] * ATT_SCALE + bias[0], s1 = dot[1] * ATT_SCALE + bias[1];
    const float mx = wave_max(fmaxf(s0, s1));
    const float p0 = __expf(s0 - mx), p1 = __expf(s1 - mx);
    const float lsum = wave_sum(p0 + p1);
    float a0 = 0.f, a1 = 0.f;
    for (int kk = 0; kk < 128; ++kk) { const float pj = (kk < 64) ? __shfl(p0, kk) : __shfl(p1, kk - 64); const int jr = kk >> 4, jc = kk & 15;
        const unsigned w = *(const unsigned*)(vb + (size_t)((r0 + jr) * 64 + sc + jc) * INW + 2 * lane); a0 += pj * bflo(w); a1 += pj * bfhi(w); }
    const float rl = 1.0f / lsum;
    *(unsigned*)(F.O + (size_t)m * DM + OCOL_C + hc * HD + 2 * lane) = pk2(a0 * rl, a1 * rl);
}
__device__ __forceinline__ void phase_attn_BC_naive(Frame& F, int l) {
    for (int it = F.gw; it < NTOK * 12; it += F.NGW) { const int m = it / 12, h = it - m * 12;
        if (h < 6) naive_B(F, m, h); else naive_C(F, l, m, h - 6); }
}

__device__ __forceinline__ void phase_mix(Frame& F, int l) {
    const int lane = lane_id();
    const float* gain = F.mix_gain + (size_t)l * DM;
    f32x4 gv[4][2];
#pragma unroll
    for (int j = 0; j < 4; ++j) { gv[j][0] = *(const f32x4*)(gain + 8 * lane + 512 * j); gv[j][1] = *(const f32x4*)(gain + 8 * lane + 512 * j + 4); }
    v4u wn[4]; float ln[6];
#define MIX_LOAD(m_) do { const bf16* row_ = F.O + (size_t)(m_) * DM; const float* lse_ = F.LSE + (size_t)(m_) * 8; \
        _Pragma("unroll") for (int j = 0; j < 4; ++j) wn[j] = *(const v4u*)(row_ + 8 * lane + 512 * j); \
        _Pragma("unroll") for (int h = 0; h < 6; ++h) ln[h] = lse_[h]; } while (0)
    if (F.gw < NTOK) MIX_LOAD(F.gw);
    for (int m = F.gw; m < NTOK; m += F.NGW) {
        bf16* row = F.O + (size_t)m * DM;
        v4u wc[4]; float lc[6];
#pragma unroll
        for (int j = 0; j < 4; ++j) wc[j] = wn[j];
#pragma unroll
        for (int h = 0; h < 6; ++h) lc[h] = ln[h];
        if (m + F.NGW < NTOK) MIX_LOAD(m + F.NGW);
        asm volatile("" ::: "memory");
        float al[6];
#pragma unroll
        for (int h = 0; h < 2; ++h) { const float l0 = lc[h], l1 = lc[2 + h], l2 = lc[4 + h]; const float mx = fmaxf(l0, fmaxf(l1, l2));
            const float e0 = __expf(l0 - mx), e1 = __expf(l1 - mx), e2 = __expf(l2 - mx); const float inv = 1.0f / (e0 + e1 + e2); al[h] = e0 * inv; al[2 + h] = e1 * inv; al[4 + h] = e2 * inv; }
        float v[4][8]; float ssA = 0.f, ssB = 0.f, ssC = 0.f;
#pragma unroll
        for (int j = 0; j < 4; ++j) { const int col = 8 * lane + 512 * j; const v4u w = wc[j];
            v[j][0] = bflo(w.x); v[j][1] = bfhi(w.x); v[j][2] = bflo(w.y); v[j][3] = bfhi(w.y); v[j][4] = bflo(w.z); v[j][5] = bfhi(w.z); v[j][6] = bflo(w.w); v[j][7] = bfhi(w.w);
            float a = 1.f;
            if (col >= OCOL_B && col < OCOL_C) { const int hb = (col - OCOL_B) >> 7; a = (hb == 0) ? al[0] : (hb == 1) ? al[1] : (hb == 2) ? al[2] : (hb == 3) ? al[3] : (hb == 4) ? al[4] : al[5]; }
            float ss = 0.f;
#pragma unroll
            for (int e = 0; e < 8; ++e) { v[j][e] *= a; ss += v[j][e] * v[j][e]; }
            if (col < OCOL_B) ssA += ss; else if (col < OCOL_C) ssB += ss; else ssC += ss; }
        ssA = wave_sum(ssA); ssB = wave_sum(ssB); ssC = wave_sum(ssC);
        const float rA = 1.0f / sqrtf(ssA * (1.0f / 512.f) + EPS), rB = 1.0f / sqrtf(ssB * (1.0f / 768.f) + EPS), rC = 1.0f / sqrtf(ssC * (1.0f / 768.f) + EPS);
#pragma unroll
        for (int j = 0; j < 4; ++j) { const int col = 8 * lane + 512 * j; const float rr = (col < OCOL_B) ? rA : (col < OCOL_C) ? rB : rC;
            const f32x4 g0 = gv[j][0], g1 = gv[j][1];
            v4u w; w.x = pk2(v[j][0] * rr * g0.x, v[j][1] * rr * g0.y); w.y = pk2(v[j][2] * rr * g0.z, v[j][3] * rr * g0.w);
            w.z = pk2(v[j][4] * rr * g1.x, v[j][5] * rr * g1.y); w.w = pk2(v[j][6] * rr * g1.z, v[j][7] * rr * g1.w);
            *(v4u*)(row + col) = w; }
    }
#undef MIX_LOAD
}

__device__ __forceinline__ void fin_rows(const bf16* XB, const pg8::f32x2* PART, float* X, const float* g, const float* b, int m0, int mstride, int mend) {
    static_assert(MK_BF16_RES && !MK_FIN_PHASES, "the final LayerNorm reads the bf16 residual stream and the raw row partials");
    const int lane = lane_id();
    f32x4 gg[8], bb[8];
#pragma unroll
    for (int j = 0; j < 8; ++j) { gg[j] = *((const f32x4*)g + lane + 64 * j); bb[j] = *((const f32x4*)b + lane + 64 * j); }
    unsigned long long zA[8], zB[8]; pg8::f32x2 pA, pB;
#define FLN_LOAD(Z, P, m_) do { const GAS unsigned long long* zb_ = (const GAS unsigned long long*)(XB + (size_t)(m_) * DM) + lane; \
        _Pragma("unroll") for (int j = 0; j < 8; ++j) Z[j] = zb_[64 * j]; P = (lane < 32) ? PART[(size_t)(m_) * 32 + lane] : (pg8::f32x2){0.f, 0.f}; } while (0)
#define FLN_ROW(ZC, PC, m_) do { GAS f32x4* xr = (GAS f32x4*)(X + (size_t)(m_) * DM) + lane; \
        const float s = wave_sum(PC.x), q = wave_sum(PC.y); \
        const float mean = s * (1.f / DM); const float var = fmaxf(q * (1.f / DM) - mean * mean, 0.f); const float rstd = 1.f / sqrtf(var + EPS); \
        _Pragma("unroll") for (int j = 0; j < 8; ++j) { const unsigned lo = (unsigned)ZC[j], hi = (unsigned)(ZC[j] >> 32); \
            const f32x4 z = {bflo(lo), bfhi(lo), bflo(hi), bfhi(hi)}; \
            __builtin_nontemporal_store((z - mean) * rstd * gg[j] + bb[j], (f32x4*)(xr + 64 * j)); } } while (0)
    if (m0 < mend) FLN_LOAD(zA, pA, m0);
    if (m0 + mstride < mend) FLN_LOAD(zB, pB, m0 + mstride);
    for (int m = m0; m < mend; m += 2 * mstride) {
        unsigned long long zc[8]; pg8::f32x2 pc = pA;
#pragma unroll
        for (int j = 0; j < 8; ++j) zc[j] = zA[j];
        if (m + 2 * mstride < mend) FLN_LOAD(zA, pA, m + 2 * mstride);
        asm volatile("" ::: "memory");
        FLN_ROW(zc, pc, m);
        if (m + mstride < mend) {
            pc = pB;
#pragma unroll
            for (int j = 0; j < 8; ++j) zc[j] = zB[j];
            if (m + 3 * mstride < mend) FLN_LOAD(zB, pB, m + 3 * mstride);
            asm volatile("" ::: "memory");
            FLN_ROW(zc, pc, m + mstride);
        }
    }
#undef FLN_LOAD
#undef FLN_ROW
}
__device__ __forceinline__ void phase_final_ln(Frame& F, const float* g, const float* b) { fin_rows(F.XB, F.PART, F.X, g, b, F.gw, F.NGW, NTOK); }

struct FinalOrder {
    pg8::StaticOrder s; const bf16* XB; const pg8::f32x2* PART; float* X; const float* g; const float* b; gu32* cnt; int wave;
    __device__ __forceinline__ bool next(int i, pg8::Unit& u) const { return s.next(i, u); }
    __device__ __forceinline__ void a_ready(const pg8::Unit&) const {}
    __device__ __forceinline__ void done(const pg8::Unit& u) const {
        asm volatile("s_waitcnt vmcnt(0)" ::: "memory"); __syncthreads();
        if (wave == 0 && lane_id() == 0) {
            __builtin_amdgcn_fence(__ATOMIC_RELEASE, "agent"); asm volatile("s_waitcnt vmcnt(0)" ::: "memory");
            gu32* w = cnt + 64 * u.pm; (void)__hip_atomic_fetch_add(w, 1u, RLX_AGENT);
            unsigned sp = 0u; while (__hip_atomic_load(w, RLX_AGENT) < (unsigned)(DM / 256)) { __builtin_amdgcn_s_sleep(1); if (++sp > (1u << 22)) break; }
            __builtin_amdgcn_fence(__ATOMIC_ACQUIRE, "agent"); asm volatile("s_waitcnt vmcnt(0)" ::: "memory");
        }
        __syncthreads();
        const int base = u.pm * 256 + u.pn * 32;
        fin_rows(XB, PART, X, g, b, base + wave, 8, base + 32);
    }
};
#ifndef MK_FUSE_FINAL
#define MK_FUSE_FINAL 0
#endif
constexpr int CW_FIN = 65536;

__device__ __forceinline__ void phase_prep_copy(Frame& F) {
    const int lane = lane_id();
    const long NIT = (long)NTOK * 18 * 8;
    for (long ti = (long)F.gw * 64 + lane; ti < NIT; ti += (long)F.NGW * 64) {
        const int c = (int)(ti & 7); const int th = (int)(ti >> 3); const int m = th / 18, hs = th - m * 18; const int t = m & (SEQ - 1);
        int col, lo_off, hi_off; const float* tab;
        if (hs < 6) { col = (hs < 4) ? COL_AQ + hs * HD : COL_AK + (hs - 4) * HD; const int cc = c & 3, half = c >> 2; lo_off = half * 64 + cc * 8; hi_off = lo_off + 32; const int pos = half ? (t & 63) : (t >> 6); tab = F.ROPE_A + 2 * (size_t)(pos * 32 + cc * 8); }
        else { col = (hs < 12) ? COL_BQ + (hs - 6) * HD : COL_BK + (hs - 12) * HD; lo_off = c * 8; hi_off = 64 + c * 8; tab = F.ROPE_B + 2 * (size_t)(t * 64 + c * 8); }
        bf16* p = F.PROJ + (size_t)m * INW + col;
        v4u lo4 = *(const v4u*)(p + lo_off), hi4 = *(const v4u*)(p + hi_off);
        const f32x4 t0 = *(const f32x4*)tab, t1 = *(const f32x4*)(tab + 4), t2 = *(const f32x4*)(tab + 8), t3 = *(const f32x4*)(tab + 12);
        if (t0.x + t1.x + t2.x + t3.x > 1e30f) lo4.x ^= 1u;
        *(v4u*)(p + lo_off) = lo4; *(v4u*)(p + hi_off) = hi4;
    }
}
__device__ __forceinline__ void phase_mix_copy(Frame& F) {
    const int lane = lane_id();
    for (int m = F.gw; m < NTOK; m += F.NGW) {
        bf16* row = F.O + (size_t)m * DM; const float* lse = F.LSE + (size_t)m * 8; const float l0 = lse[0] + lse[5];
        v4u w[4];
#pragma unroll
        for (int j = 0; j < 4; ++j) w[j] = *(const v4u*)(row + 8 * lane + 512 * j);
        if (l0 > 1e30f) w[0].x ^= 1u;
#pragma unroll
        for (int j = 0; j < 4; ++j) *(v4u*)(row + 8 * lane + 512 * j) = w[j];
    }
}

#ifndef MK_NAIVE_BC
#define MK_NAIVE_BC 0
#endif
#if MK_NAIVE_BC
#define ATTN_BC(F, l, lds) phase_attn_BC_naive(F, l)
#else
#define ATTN_BC(F, l, lds) do { if (MK_DYN_BC) phase_attn_BC_dyn(F, l, lds); else { phase_attn_B(F, lds); phase_attn_C(F, l, lds); } } while (0)
#endif
#ifndef MK_DUP_ENDS
#define MK_DUP_ENDS 0
#endif
#ifndef MK_HALVES
#define MK_HALVES 0
#endif
#ifndef MK_SB_EAGER
#define MK_SB_EAGER 0
#endif
#ifndef MK_DUP_ALL
#define MK_DUP_ALL 0
#endif
#ifndef MK_DUP_GEMM
#define MK_DUP_GEMM 0
#endif
#ifndef MK_STAGGER_OUT
#define MK_STAGGER_OUT 0
#endif
#ifndef MK_STAGGER_IN
#define MK_STAGGER_IN 0
#endif
#ifndef MK_DUP_RES
#define MK_DUP_RES 0
#endif
#ifndef MK_DUP_BAR
#define MK_DUP_BAR 0
#endif
#ifndef MK_XCD_EXTRA
#define MK_XCD_EXTRA -1
#endif
#ifndef MK_DUP_KLOOP
#define MK_DUP_KLOOP 0
#endif
#ifndef MK_DUP_THIN
#define MK_DUP_THIN 0
#endif
#ifndef MK_DUP_ATTN
#define MK_DUP_ATTN 0
#endif
#ifndef MK_PER_PHASE
#define MK_PER_PHASE 0
#endif
constexpr int PH_PER_LAYER = 9, N_PHASES = 2 + PH_PER_LAYER * NLAYER;
struct Args { const float* in[14]; float* out; unsigned char* ws; int ph_lo, ph_hi; };
static_assert(sizeof(Args) == 14 * 8 + 8 + 8 + 8, "Args has no padding");

__global__ void __launch_bounds__(NWAVES * 64, 2) trunk_fwd(Args args) {
    extern __shared__ __attribute__((aligned(16))) unsigned char lds[];
    Frame F;
    F.lds = (LAS unsigned char*)lds;
    F.MISC = (volatile LAS unsigned*)(F.lds + MISC_OFF);
    F.wave = __builtin_amdgcn_readfirstlane((int)threadIdx.x >> 6);
    F.G = gridDim.x; { const int bx = blockIdx.x; F.vcu = (F.G % 8 == 0) ? (bx % 8) * (F.G / 8) + bx / 8 : bx; }
    F.gw = F.vcu * NWAVES + F.wave; F.NGW = F.G * NWAVES;
    unsigned char* ws = args.ws;
    F.ctl = (gu32*)(ws + WS_CTL);
    F.x_prompt = args.in[0]; F.x_sample = args.in[1]; F.w_in = args.in[2]; F.a_q_gain = args.in[3]; F.a_k_gain = args.in[4]; F.c_rel_bias = args.in[5]; F.mix_gain = args.in[6];
    F.w_out = args.in[7]; F.ln1_g = args.in[8]; F.ln1_b = args.in[9]; F.w_ff1 = args.in[10]; F.w_ff2 = args.in[11]; F.ln2_g = args.in[12]; F.ln2_b = args.in[13];
    F.X = args.out;
    F.Win_t = (bf16*)(ws + WS_WIN); F.Wout_t = (bf16*)(ws + WS_WOUT); F.Wff1_t = (bf16*)(ws + WS_WFF1); F.Wff2_t = (bf16*)(ws + WS_WFF2);
    F.XB = (bf16*)(ws + WS_XB); F.PROJ = (bf16*)(ws + WS_PROJ); F.O = (bf16*)(ws + WS_O); F.H = (bf16*)(ws + WS_H);
    F.LSE = (float*)(ws + WS_LSE); F.ROPE_B = (float*)(ws + WS_ROPE_B); F.ROPE_A = (float*)(ws + WS_ROPE_A);
    F.PART = (pg8::f32x2*)(ws + WS_PART); F.STAT = (pg8::f32x2*)(ws + WS_STAT); F.VEC = (float*)(ws + WS_VEC); F.PSB = (float*)(ws + WS_PSB); F.SSQ = (float*)(ws + WS_SSQ); F.RAT = (float*)(ws + WS_RAT);
    for (int u = F.wave * 64 + lane_id(); u < (LDS_BYTES - LDSCTL_OFF) / 4; u += NWAVES * 64) ((LAS unsigned*)(F.lds + LDSCTL_OFF))[u] = 0u;
    __syncthreads();
    XcdBarrier bar; bar.bar = (unsigned*)(F.ctl + CW_BAR); bar.x = 0; bar.st = nullptr;
    if (!MK_PER_PHASE) bar = xcd_barrier_post((unsigned*)(F.ctl + CW_BAR), F.MISC + 8, F.wave == 0 && lane_id() == 0);
    const int lo = args.ph_lo, hi = args.ph_hi;
#define IN(k) (lo <= (k) && (k) < hi)
#define STAGGER(ticks) do { if ((ticks) > 0) { const unsigned long long t0_ = __builtin_amdgcn_s_memrealtime(); const unsigned long long dl_ = (unsigned long long)((F.vcu & 7) >> 1) * (unsigned long long)(ticks); while (__builtin_amdgcn_s_memrealtime() - t0_ < dl_) __builtin_amdgcn_s_sleep(8); } } while (0)
#define SEAM(k) do { if (IN(k) && IN((k) + 1)) { if (MK_PER_PHASE) { if (F.wave == 0 && lane_id() == 0) __hip_atomic_store(F.ctl + CW_TMO, 0xBADBA0u, RLX_AGENT); } else { xcd_barrier(bar, F.wave == 0 && lane_id() == 0); if (MK_DUP_BAR) xcd_barrier(bar, F.wave == 0 && lane_id() == 0); } } } while (0)

    if (IN(0)) { phase_prologue(F); if (MK_DUP_ENDS & 1) phase_prologue(F); } SEAM(0);
#if MK_FUSE_PREP
#define INPROJ_EPI(l) pg8::EpiInProj E{F.PROJ, INW, F.STAT, F.VEC + VEC_CS_IN, F.VEC + VEC_BW_IN, F.a_q_gain + l * HD, F.a_k_gain + l * HD, F.ROPE_A, F.ROPE_B, (LAS float*)(F.lds + XCH_OFF), \
                (MK_BOUNDED_A && F.VEC[VEC_M0 + l] * ATT_SCALE <= 40.f) ? ATT_SCALE * 1.4426950408889634f : 1.f}; \
            pg8::gemm_phase<pg8::EpiInProj, pg8::StaticOrder, true, true>(F.lds + RING_OFF, g, S, E, F.wave)
#define PREP_PHASE(l) do {} while (0)
#else
#define INPROJ_EPI(l) pg8::EpiBf16Fold<0> E{F.PROJ, INW, F.STAT, F.VEC + VEC_CS_IN, F.VEC + VEC_BW_IN}; \
            pg8::gemm_phase<pg8::EpiBf16Fold<0>, pg8::StaticOrder, true, true>(F.lds + RING_OFF, g, S, E, F.wave)
#define PREP_PHASE(l) phase_prep(F, l)
#endif
#if MK_BF16_RES
#define RES_EPI_OUT(l) pg8::EpiResLnFoldB E{F.XB, DM, F.STAT, (l == 0) ? F.VEC + VEC_ONES : F.ln2_g + (size_t)(l - 1) * DM, (l == 0) ? F.VEC + VEC_ZEROS : F.ln2_b + (size_t)(l - 1) * DM, F.PART, DN_ALPHA}; \
            pg8::gemm_phase<pg8::EpiResLnFoldB, pg8::StaticOrder, true, true, false, MK_MIXFOLD != 0>(F.lds + RING_OFF, g, S, E, F.wave)
#define RES_EPI_FF2(l) pg8::EpiResLnFoldB E{F.XB, DM, F.STAT, F.ln1_g + (size_t)l * DM, F.ln1_b + (size_t)l * DM, F.PART, DN_ALPHA}; \
            pg8::gemm_phase<pg8::EpiResLnFoldB, pg8::StaticOrder, true, true, MK_TILED_H != 0>(F.lds + RING_OFF, g, S, E, F.wave)
#else
#define RES_EPI_OUT(l) pg8::EpiResLnFold E{(l == 0) ? F.x_prompt : F.X, (l == 0) ? F.x_sample : F.X + (size_t)NTOK_P * DM, NTOK_P / 256, F.X, F.XB, DM, F.STAT, \
                                (l == 0) ? F.VEC + VEC_ONES : F.ln2_g + (size_t)(l - 1) * DM, (l == 0) ? F.VEC + VEC_ZEROS : F.ln2_b + (size_t)(l - 1) * DM, F.PART, DN_ALPHA}; \
            pg8::gemm_phase<pg8::EpiResLnFold, pg8::StaticOrder, true, true>(F.lds + RING_OFF, g, S, E, F.wave)
#define RES_EPI_FF2(l) pg8::EpiResLnFold E{F.X, F.X + (size_t)NTOK_P * DM, NTOK_P / 256, F.X, F.XB, DM, F.STAT, F.ln1_g + (size_t)l * DM, F.ln1_b + (size_t)l * DM, F.PART, DN_ALPHA}; \
            pg8::gemm_phase<pg8::EpiResLnFold, pg8::StaticOrder, true, true, MK_TILED_H != 0>(F.lds + RING_OFF, g, S, E, F.wave)
#endif
#define LAYER_BODY(l) do { \
        const int pb = 1 + PH_PER_LAYER * l; \
        if (IN(pb + 0)) { \
            STAGGER(MK_STAGGER_IN); pg8::Gemm g{F.XB, F.Win_t, NTOK, INW, DM}; pg8::StaticOrder S; S.init(NTOK, INW, F.G, (int)blockIdx.x); \
            if (!MK_FIN_PHASES && l > 0) STATS_PREAMBLE(S); \
            { INPROJ_EPI(l); } if (MK_DUP_ALL) { INPROJ_EPI(l); } \
            if (MK_DUP_KLOOP & 1) { pg8::EpiNull EN{F.LSE}; pg8::gemm_phase<pg8::EpiNull, pg8::StaticOrder, true, true>(F.lds + RING_OFF, g, S, EN, F.wave); } \
            for (int rep = 0; rep < 1 + MK_DUP_ALL; ++rep) if (F.G == 256 && blockIdx.x >= 128) convert_weights(F, l, 0, 2, ((int)blockIdx.x - 128) * NWAVES + F.wave, 128 * NWAVES); \
        } SEAM(pb + 0); \
        if (IN(pb + 1)) { PREP_PHASE(l); } if (!MK_FUSE_PREP) SEAM(pb + 1); \
        if (IN(pb + 2)) { phase_attn_A(F, l, (char*)lds + RING_OFF); ATTN_BC(F, l, (char*)lds + RING_OFF); if ((MK_DUP_ATTN & 1) || MK_DUP_ALL) { phase_attn_A(F, l, (char*)lds + RING_OFF); } if ((MK_DUP_ATTN & 2) || MK_DUP_ALL) { ATTN_BC(F, l, (char*)lds + RING_OFF); } \
            for (int rep = 0; rep < 1 + MK_DUP_ALL; ++rep) if (l + 1 < NLAYER && F.G == 256 && F.vcu < 128) convert_weights(F, l, l + 1, 1, F.vcu * NWAVES + F.wave, 128 * NWAVES); \
            if (MK_MIXFOLD && F.G != 256) convert_weights(F, l, l + 1, ((l + 1 < NLAYER) ? 1 : 0) | 2, F.gw, F.NGW); } SEAM(pb + 2); \
        if (!MK_MIXFOLD) { if (IN(pb + 3)) { if (MK_DUP_ALL) phase_mix_copy(F); phase_mix(F, l); if (!MK_FIN_PHASES) reduce_colsums(F, (l + 1 < NLAYER) ? 3 : 2); if (F.G != 256) convert_weights(F, l, l + 1, ((l + 1 < NLAYER) ? 1 : 0) | 2, F.gw, F.NGW); } SEAM(pb + 3); } \
        if (IN(pb + 4)) { \
            STAGGER(MK_STAGGER_OUT); pg8::Gemm g{F.O, F.Wout_t, NTOK, DM, DM, F.RAT, KTAB_OFF - RING_OFF}; pg8::StaticOrder S; S.init(NTOK, DM, F.G, (int)blockIdx.x, MK_WGM_RES); \
            if (MK_MIXFOLD) { reduce_colsums(F, (l + 1 < NLAYER) ? 3 : 2); RAT_PREAMBLE(S); } \
            { RES_EPI_OUT(l); } if (MK_DUP_ALL) { pg8::EpiResCopyB EC{F.XB, DM}; pg8::gemm_phase<pg8::EpiResCopyB, pg8::StaticOrder, true, true>(F.lds + RING_OFF, g, S, EC, F.wave); } \
            if (MK_DUP_KLOOP & 2) { pg8::EpiNull EN{F.LSE}; pg8::gemm_phase<pg8::EpiNull, pg8::StaticOrder, true, true>(F.lds + RING_OFF, g, S, EN, F.wave); } \
        } SEAM(pb + 4); \
        if (MK_FIN_PHASES) { if (IN(pb + 5)) { for (int rep = 0; rep < 1 + MK_DUP_ALL; ++rep) { phase_finalize_stats(F); reduce_colsums(F, (l + 1 < NLAYER) ? 3 : 2); } } SEAM(pb + 5); } \
        if (IN(pb + 6)) { \
            STAGGER(MK_STAGGER_IN); pg8::Gemm g{F.XB, F.Wff1_t, NTOK, DFF, DM}; pg8::StaticOrder S; S.init(NTOK, DFF, F.G, (int)blockIdx.x); \
            if (!MK_FIN_PHASES) STATS_PREAMBLE(S); \
            pg8::EpiBf16Fold<3, MK_TILED_H != 0> E{F.H, DFF, F.STAT, F.VEC + VEC_CS_FF1, F.VEC + VEC_BW_FF1}; \
            pg8::gemm_phase<pg8::EpiBf16Fold<3, MK_TILED_H != 0>, pg8::StaticOrder, true, true>(F.lds + RING_OFF, g, S, E, F.wave); \
            if (MK_DUP_ALL) pg8::gemm_phase<pg8::EpiBf16Fold<3, MK_TILED_H != 0>, pg8::StaticOrder, true, true>(F.lds + RING_OFF, g, S, E, F.wave); \
            if (MK_DUP_KLOOP & 4) { pg8::EpiNull EN{F.LSE}; pg8::gemm_phase<pg8::EpiNull, pg8::StaticOrder, true, true>(F.lds + RING_OFF, g, S, EN, F.wave); } \
            if (MK_XCD_EXTRA >= 0 && (int)(blockIdx.x & 7) == MK_XCD_EXTRA) { pg8::StaticOrder S1; S1.init(256, 256, 1, 0); pg8::gemm_phase<pg8::EpiBf16Fold<3, MK_TILED_H != 0>, pg8::StaticOrder, true, true>(F.lds + RING_OFF, g, S1, E, F.wave); } \
        } SEAM(pb + 6); \
        if (IN(pb + 7)) { \
            STAGGER(MK_STAGGER_OUT); pg8::Gemm g{F.H, F.Wff2_t, NTOK, DM, DFF}; pg8::StaticOrder S; S.init(NTOK, DM, F.G, (int)blockIdx.x, MK_WGM_RES); \
            if (MK_FUSE_FINAL && l == NLAYER - 1 && F.G == 256) { FinalOrder SF; SF.s = S; SF.XB = F.XB; SF.PART = F.PART; SF.X = F.X; SF.g = F.ln2_g + (size_t)(NLAYER - 1) * DM; SF.b = F.ln2_b + (size_t)(NLAYER - 1) * DM; SF.cnt = F.ctl + CW_FIN; SF.wave = F.wave; \
                pg8::EpiResLnFoldB E{F.XB, DM, F.STAT, F.ln1_g + (size_t)l * DM, F.ln1_b + (size_t)l * DM, F.PART, DN_ALPHA}; \
                pg8::gemm_phase<pg8::EpiResLnFoldB, FinalOrder, true, true, MK_TILED_H != 0>(F.lds + RING_OFF, g, SF, E, F.wave); } \
            else { RES_EPI_FF2(l); } if (MK_DUP_ALL) { pg8::EpiResCopyB EC{F.XB, DM}; pg8::gemm_phase<pg8::EpiResCopyB, pg8::StaticOrder, true, true, MK_TILED_H != 0>(F.lds + RING_OFF, g, S, EC, F.wave); } \
            if (MK_DUP_KLOOP & 8) { pg8::EpiNull EN{F.LSE}; pg8::gemm_phase<pg8::EpiNull, pg8::StaticOrder, true, true, MK_TILED_H != 0>(F.lds + RING_OFF, g, S, EN, F.wave); } \
        } if (!(MK_FUSE_FINAL && l == NLAYER - 1 && F.G == 256)) SEAM(pb + 7); \
        if (MK_FIN_PHASES) { if (IN(pb + 8)) { for (int rep = 0; rep < 1 + MK_DUP_ALL; ++rep) phase_finalize_stats(F); } SEAM(pb + 8); } \
    } while (0)
#if !MK_HALVES
    LAYER_BODY(0); LAYER_BODY(1); LAYER_BODY(2); LAYER_BODY(3);
#else
#define SBK(l, i) ((l) * 6 + (i))
#define ROT_C(r) (((F.G & (F.G - 1)) == 0 && F.G >= 256) ? (((int)blockIdx.x + 64 * (r)) & (F.G - 1)) : (int)blockIdx.x)
#define SB_ARRIVE(k) do { sb_arrive(F, (k)); if (MK_SB_EAGER) sb_wait(F, (k)); } while (0)
#define SB_WAIT(k) do { if (!MK_SB_EAGER) sb_wait(F, (k)); } while (0)
#define GEMM_IN_H(l, h) do { pg8::Gemm g{F.XB, F.Win_t, NTOK, INW, DM}; pg8::HalfOrder S; S.init(NTOK / 2, INW, F.G, ROT_C((2 * (l) + (h)) & 3), pg8::WGM, (NTOK / 512) * (h)); \
            if ((l) > 0) STATS_PREAMBLE(S); \
            pg8::EpiInProj E{F.PROJ, INW, F.STAT, F.VEC + VEC_CS_IN, F.VEC + VEC_BW_IN, F.a_q_gain + (l) * HD, F.a_k_gain + (l) * HD, F.ROPE_A, F.ROPE_B, (LAS float*)(F.lds + XCH_OFF), \
                (MK_BOUNDED_A && F.VEC[VEC_M0 + (l)] * ATT_SCALE <= 40.f) ? ATT_SCALE * 1.4426950408889634f : 1.f}; \
            pg8::gemm_phase<pg8::EpiInProj, pg8::HalfOrder, true, true>(F.lds + RING_OFF, g, S, E, F.wave); } while (0)
#define GEMM_OUT_H(l, h) do { pg8::Gemm g{F.O, F.Wout_t, NTOK, DM, DM}; pg8::HalfOrder S; S.init(NTOK / 2, DM, F.G, (int)blockIdx.x, MK_WGM_RES, (NTOK / 512) * (h)); \
            pg8::EpiResLnFoldB E{F.XB, DM, F.STAT, ((l) == 0) ? F.VEC + VEC_ONES : F.ln2_g + (size_t)((l) - 1) * DM, ((l) == 0) ? F.VEC + VEC_ZEROS : F.ln2_b + (size_t)((l) - 1) * DM, F.PART, DN_ALPHA}; \
            pg8::gemm_phase<pg8::EpiResLnFoldB, pg8::HalfOrder, true, true>(F.lds + RING_OFF, g, S, E, F.wave); } while (0)
#define GEMM_FF1_H(l, h) do { pg8::Gemm g{F.XB, F.Wff1_t, NTOK, DFF, DM}; pg8::HalfOrder S; S.init(NTOK / 2, DFF, F.G, (int)blockIdx.x, pg8::WGM, (NTOK / 512) * (h)); \
            STATS_PREAMBLE(S); \
            pg8::EpiBf16Fold<3, MK_TILED_H != 0> E{F.H, DFF, F.STAT, F.VEC + VEC_CS_FF1, F.VEC + VEC_BW_FF1}; \
            pg8::gemm_phase<pg8::EpiBf16Fold<3, MK_TILED_H != 0>, pg8::HalfOrder, true, true>(F.lds + RING_OFF, g, S, E, F.wave); } while (0)
#define GEMM_FF2_H(l, h) do { pg8::Gemm g{F.H, F.Wff2_t, NTOK, DM, DFF}; pg8::HalfOrder S; S.init(NTOK / 2, DM, F.G, (int)blockIdx.x, MK_WGM_RES, (NTOK / 512) * (h)); \
            pg8::EpiResLnFoldB E{F.XB, DM, F.STAT, F.ln1_g + (size_t)(l) * DM, F.ln1_b + (size_t)(l) * DM, F.PART, DN_ALPHA}; \
            pg8::gemm_phase<pg8::EpiResLnFoldB, pg8::HalfOrder, true, true, MK_TILED_H != 0>(F.lds + RING_OFF, g, S, E, F.wave); } while (0)
#define XBAR() xcd_barrier(bar, F.wave == 0 && lane_id() == 0)
#define LAYER_BODY_H(l) do { \
        if ((l) > 0) SB_WAIT(SBK((l) - 1, 4)); GEMM_IN_H(l, 0); \
        if ((l) > 0) SB_WAIT(SBK((l) - 1, 5)); GEMM_IN_H(l, 1); \
        if (F.G == 256 && (((int)blockIdx.x >> 7) ^ ((l) & 1)) == 1) convert_weights(F, l, 0, 2, ((int)blockIdx.x & 127) * NWAVES + F.wave, 128 * NWAVES);     \
        XBAR(); \
        phase_attn_A(F, l, (char*)lds + RING_OFF); phase_attn_B(F, (char*)lds + RING_OFF); phase_attn_C(F, l, (char*)lds + RING_OFF); \
        if ((l) + 1 < NLAYER && F.vcu < F.G / 2) convert_weights(F, l, (l) + 1, 1, F.vcu * NWAVES + F.wave, (F.G / 2) * NWAVES); \
        if (F.G != 256) convert_weights(F, l, 0, 2, F.gw, F.NGW); \
        XBAR(); \
        phase_mix(F, l); reduce_colsums(F, ((l) + 1 < NLAYER) ? 3 : 2); \
        XBAR(); \
        GEMM_OUT_H(l, 0); SB_ARRIVE(SBK(l, 0)); \
        GEMM_OUT_H(l, 1); SB_ARRIVE(SBK(l, 1)); \
        SB_WAIT(SBK(l, 0)); GEMM_FF1_H(l, 0); SB_ARRIVE(SBK(l, 2)); \
        SB_WAIT(SBK(l, 1)); GEMM_FF1_H(l, 1); SB_ARRIVE(SBK(l, 3)); \
        SB_WAIT(SBK(l, 2)); GEMM_FF2_H(l, 0); SB_ARRIVE(SBK(l, 4)); \
        SB_WAIT(SBK(l, 3)); GEMM_FF2_H(l, 1); SB_ARRIVE(SBK(l, 5)); \
    } while (0)
    LAYER_BODY_H(0); LAYER_BODY_H(1); LAYER_BODY_H(2); LAYER_BODY_H(3);
    SB_WAIT(SBK(NLAYER - 1, 4)); SB_WAIT(SBK(NLAYER - 1, 5));
#undef LAYER_BODY_H
#endif
#undef LAYER_BODY
    if (IN(N_PHASES - 1) && !(MK_FUSE_FINAL && F.G == 256)) { phase_final_ln(F, F.ln2_g + (size_t)(NLAYER - 1) * DM, F.ln2_b + (size_t)(NLAYER - 1) * DM); if (MK_DUP_ENDS & 2) phase_final_ln(F, F.ln2_g + (size_t)(NLAYER - 1) * DM, F.ln2_b + (size_t)(NLAYER - 1) * DM); }

#undef IN
#undef SEAM
}

extern "C" void kernel_launch(void* const* d_in, const int* in_sizes, int n_in, void* d_out, int out_size, void* d_ws, size_t ws_size, hipStream_t stream) {
    static int grid = 0;
    if (grid == 0) {
        if (n_in != 14 || in_sizes[0] != NTOK_P * DM || out_size != NTOK * DM || ws_size < WS_END) { fprintf(stderr, "kernel_launch: shape/workspace mismatch (n_in %d, out %d, ws %zu < %zu); nothing launched\n", n_in, out_size, ws_size, (size_t)WS_END); grid = -1; return; }
        int dev = 0, cus = 0, per_cu = 0;
        if (hipGetDevice(&dev) != hipSuccess || hipDeviceGetAttribute(&cus, hipDeviceAttributeMultiprocessorCount, dev) != hipSuccess) { grid = -1; return; }
        if (hipFuncSetAttribute((const void*)trunk_fwd, hipFuncAttributeMaxDynamicSharedMemorySize, LDS_BYTES) != hipSuccess) { fprintf(stderr, "kernel_launch: hipFuncSetAttribute failed\n"); grid = -1; return; }
        if (hipOccupancyMaxActiveBlocksPerMultiprocessor(&per_cu, (const void*)trunk_fwd, NWAVES * 64, LDS_BYTES) != hipSuccess || per_cu < 1) { fprintf(stderr, "kernel_launch: occupancy query says %d blocks per CU\n", per_cu); }
        (void)hipGetLastError();
        grid = cus;
    }
    if (grid < 0) return;
    if (hipMemsetAsync((char*)d_ws + WS_CTL, 0, CTL_ZERO_BYTES, stream) != hipSuccess) return;
    Args a{};
    for (int i = 0; i < 14; ++i) a.in[i] = (const float*)d_in[i];
    a.out = (float*)d_out; a.ws = (unsigned char*)d_ws;
#if MK_PER_PHASE
    for (int p = 0; p < N_PHASES; ++p) { a.ph_lo = p; a.ph_hi = p + 1; hipLaunchKernelGGL(trunk_fwd, dim3(grid), dim3(NWAVES * 64), LDS_BYTES, stream, a); }
#else
    a.ph_lo = 0; a.ph_hi = N_PHASES;
    hipLaunchKernelGGL(trunk_fwd, dim3(grid), dim3(NWAVES * 64), LDS_BYTES, stream, a);
#endif
    const hipError_t le = hipPeekAtLastError();
    if (le != hipSuccess) fprintf(stderr, "kernel_launch: launch failed: %s\n", hipGetErrorName(le));
}
```

```cpp
#include <hip/hip_runtime.h>
#include <hip/hip_bf16.h>
#include <cstdio>
#include <cstdint>
#include <cmath>
__device__ __forceinline__ int lane_id() { int l; asm volatile("v_mbcnt_lo_u32_b32 %0, -1, 0\n\tv_mbcnt_hi_u32_b32 %0, -1, %0" : "=v"(l)); return l; }
template <int M> __device__ __forceinline__ float xshfl(float v) { static_assert(M >= 1 && M < 32, "xshfl: xor mask 1..31"); return __builtin_bit_cast(float, __builtin_amdgcn_ds_swizzle(__builtin_bit_cast(int, v), (M << 10) | 0x1f)); }
__device__ __forceinline__ float rowsum16(float v) {
    v += __builtin_bit_cast(float, __builtin_amdgcn_update_dpp(0, __builtin_bit_cast(int, v), 0xB1, 0xF, 0xF, true));
    v += __builtin_bit_cast(float, __builtin_amdgcn_update_dpp(0, __builtin_bit_cast(int, v), 0x4E, 0xF, 0xF, true));
    v += __builtin_bit_cast(float, __builtin_amdgcn_update_dpp(0, __builtin_bit_cast(int, v), 0x141, 0xF, 0xF, true));
    v += __builtin_bit_cast(float, __builtin_amdgcn_update_dpp(0, __builtin_bit_cast(int, v), 0x140, 0xF, 0xF, true));
    return v;
}
__device__ __forceinline__ void xswap32(float& a, float& b) { asm volatile("s_nop 1\n\tv_permlane32_swap_b32 %0, %1" : "+v"(a), "+v"(b)); }
__device__ __forceinline__ float xsum32(float v) { float a = v, b = v; xswap32(a, b); return a + b; }
__device__ __forceinline__ float xmax32(float v) { float a = v, b = v; xswap32(a, b); return fmaxf(a, b); }
#ifndef MK_MIXFOLD
#define MK_MIXFOLD 1
#endif
#define MK_SSQ_FROM_O_BYTES ((1012L - 820L) << 20)
#ifndef MK_EPI_STAGE
#define MK_EPI_STAGE 1
#endif
#ifndef MK_NT_H
#define MK_NT_H 1
#endif
#ifndef MK_NT_PROJ
#define MK_NT_PROJ 0
#endif
#ifndef MK_NT_HLOAD
#define MK_NT_HLOAD 0
#endif
#ifndef MK_TILED_W
#define MK_TILED_W 0
#endif
namespace pg8 {
#define PG8_LAS __attribute__((address_space(3)))
typedef unsigned short bf16_t;
typedef short bf16x8 __attribute__((ext_vector_type(8)));
typedef float f32x4 __attribute__((ext_vector_type(4)));
typedef unsigned u32x4 __attribute__((ext_vector_type(4)));
constexpr int BM = 256, BK = 64, HALF = 128, HTB = HALF * BK * 2  , STAGE_BYTES = 8 * HTB, NXCD = 8, WGM = 8;

__host__ __device__ __forceinline__ int lds_byte(int r, int c) { const int st = (r >> 4) * 2 + (c >> 5), rr = r & 15, cc = c & 31, ob = rr * 64 + cc * 2; return st * 1024 + (ob ^ (((ob >> 9) & 1) << 5)); }
__host__ __device__ __forceinline__ void stage_rc(int b, int& R, int& C) { const int st = b / 1024, sb = b % 1024, swz = sb ^ (((sb >> 9) & 1) << 5); R = (st >> 1) * 16 + swz / 64; C = (st & 1) * 32 + (swz % 64) / 2; }
__host__ __device__ __forceinline__ int perm32(int rho) { const int n = rho >> 4, i = rho & 15; return 8 * (i >> 2) + 4 * n + (i & 3); }

struct Unit { int pm, pn; };
struct Gemm { const bf16_t* A; const bf16_t* Bt; int M, N, K; const float* rat = nullptr; int ktab_off = 0; int stg_off = 0; };

struct StaticOrder {
    int nM, nN, nwg, G, c, wgm;
    __host__ __device__ __forceinline__ void init(int M, int N, int G_, int c_, int wgm_ = WGM) { nM = M / BM; nN = N / BM; nwg = nM * nN; G = G_; c = c_; wgm = wgm_; }
    __host__ __device__ __forceinline__ bool next(int i, Unit& u) const {
        const long L = (long)i * G + c; if (L >= nwg) return false;
        int wgid = (int)L; { const int q = nwg / NXCD, r = nwg % NXCD, xcd = wgid % NXCD, off = wgid / NXCD; wgid = (xcd < r ? xcd * (q + 1) : r * (q + 1) + (xcd - r) * q) + off; }
        const int nig = wgm * nN, gid = wgid / nig, fm = gid * wgm, gsz = (nM - fm) < wgm ? (nM - fm) : wgm;
        u.pm = fm + ((wgid % nig) % gsz); u.pn = (wgid % nig) / gsz; return true;
    }
    __device__ __forceinline__ void a_ready(const Unit&) const {}
    __device__ __forceinline__ void done(const Unit&) const {}
};

struct HalfOrder {
    StaticOrder s; int pmb;
    __host__ __device__ __forceinline__ void init(int Mh, int N, int G_, int c_, int wgm_, int pmb_) { s.init(Mh, N, G_, c_, wgm_); pmb = pmb_; }
    __host__ __device__ __forceinline__ bool next(int i, Unit& u) const { const bool ok = s.next(i, u); u.pm += pmb; return ok; }
    __device__ __forceinline__ void a_ready(const Unit&) const {}
    __device__ __forceinline__ void done(const Unit&) const {}
};
__device__ __forceinline__ unsigned cvt_pk_bf16(float lo, float hi) { unsigned r; asm volatile("v_cvt_pk_bf16_f32 %0, %1, %2" : "=v"(r) : "v"(lo), "v"(hi)); return r; }
typedef float f32x2 __attribute__((ext_vector_type(2)));
__device__ __forceinline__ f32x2 gelu_pk(f32x2 v) {
    const f32x2 av = __builtin_elementwise_abs(v), d = av * 0.2316418882f + 1.0f;
    f32x2 t; t.x = __builtin_amdgcn_rcpf(d.x); t.y = __builtin_amdgcn_rcpf(d.y);
    f32x2 q = t * 0.5307027145f + (-0.7265760135f); q = q * t + 0.7107068705f; q = q * t + (-0.142248368f); q = q * t + 0.127414796f; q = q * t;
    const f32x2 s = (v * v) * (-0.72134752044f);
    f32x2 e; e.x = __builtin_amdgcn_exp2f(s.x); e.y = __builtin_amdgcn_exp2f(s.y);
    const f32x2 m = v * (q * e), r = v - m;
    f32x2 o; o.x = v.x < 0.f ? m.x : r.x; o.y = v.y < 0.f ? m.y : r.y; return o;
}

template <int ACT  > struct EpiBf16 {
    static constexpr bool PERM = true, AFTER_DRAIN = false, LDS_STAGE = false; static constexpr int MIN_VMEM = 0;     static_assert(ACT == 0 || ACT == 1, "EpiBf16: ACT is 0 (none) or 1 (gelu_pk)");
    bf16_t* O; int ldc; const float* bias; int split_cols; size_t split_stride; float scale0;
    __device__ __forceinline__ void operator()(const f32x4 (&acc)[2][2][4][2], const Unit& u, int wr, int wc, int fr, int fq) const {
        const int row0 = u.pm * BM + wr * 64 + fr; int colt = u.pn * BM; bf16_t* base = O;
        float sc = 1.f; if (split_cols) { const int t = colt / split_cols; base += (size_t)t * split_stride; colt -= t * split_cols; if (t == 0) sc = scale0; }
        const int col0 = colt + wc * 32 + 8 * fq, bcol0 = u.pn * BM + wc * 32 + 8 * fq;
        f32x4 bv[2][2];
#pragma unroll
        for (int bj = 0; bj < 2; ++bj)
#pragma unroll
            for (int n = 0; n < 2; ++n) bv[bj][n] = bias ? *(const f32x4*)(bias + bcol0 + bj * HALF + 4 * n) : (f32x4){0.f, 0.f, 0.f, 0.f};
#pragma unroll
        for (int ai = 0; ai < 2; ++ai)
#pragma unroll
            for (int m = 0; m < 4; ++m) { bf16_t* rowp = base + (size_t)(row0 + ai * HALF + m * 16) * ldc + col0;
#pragma unroll
                for (int bj = 0; bj < 2; ++bj) { f32x4 v0 = acc[ai][bj][m][0] + bv[bj][0], v1 = acc[ai][bj][m][1] + bv[bj][1];
                    if (ACT == 1) { f32x2 a = gelu_pk((f32x2){v0[0], v0[1]}), b = gelu_pk((f32x2){v0[2], v0[3]}), c = gelu_pk((f32x2){v1[0], v1[1]}), d = gelu_pk((f32x2){v1[2], v1[3]});
                        v0 = (f32x4){a.x, a.y, b.x, b.y}; v1 = (f32x4){c.x, c.y, d.x, d.y}; }
                    v0 = v0 * sc; v1 = v1 * sc; u32x4 w; w.x = cvt_pk_bf16(v0[0], v0[1]); w.y = cvt_pk_bf16(v0[2], v0[3]); w.z = cvt_pk_bf16(v1[0], v1[1]); w.w = cvt_pk_bf16(v1[2], v1[3]);
                    *(u32x4*)(rowp + bj * HALF) = w; } }
    }
};


struct EpiRelu2Bf16 {
    static constexpr bool PERM = true, AFTER_DRAIN = false, LDS_STAGE = false; static constexpr int MIN_VMEM = 0;
    bf16_t* O; int ldc;
    __device__ __forceinline__ void operator()(const f32x4 (&acc)[2][2][4][2], const Unit& u, int wr, int wc, int fr, int fq) const {
        const int row0 = u.pm * BM + wr * 64 + fr; const int col0 = u.pn * BM + wc * 32 + 8 * fq;
#pragma unroll
        for (int ai = 0; ai < 2; ++ai)
#pragma unroll
            for (int m = 0; m < 4; ++m) { bf16_t* rowp = O + (size_t)(row0 + ai * HALF + m * 16) * ldc + col0;
#pragma unroll
                for (int bj = 0; bj < 2; ++bj) { f32x4 v0 = acc[ai][bj][m][0], v1 = acc[ai][bj][m][1];
#pragma unroll
                    for (int e = 0; e < 4; ++e) { const float a = fmaxf(v0[e], 0.f), b = fmaxf(v1[e], 0.f); v0[e] = a * a; v1[e] = b * b; }
                    u32x4 w; w.x = cvt_pk_bf16(v0[0], v0[1]); w.y = cvt_pk_bf16(v0[2], v0[3]); w.z = cvt_pk_bf16(v1[0], v1[1]); w.w = cvt_pk_bf16(v1[2], v1[3]);
                    *(u32x4*)(rowp + bj * HALF) = w; } }
    }
};
struct EpiResF32 {
    static constexpr bool PERM = false, AFTER_DRAIN = false, LDS_STAGE = false; static constexpr int MIN_VMEM = 0;
    const float* X; float* Z; int ldc; float alpha;
    __device__ __forceinline__ void operator()(const f32x4 (&acc)[2][2][4][2], const Unit& u, int wr, int wc, int fr, int fq) const {
        const int row0 = u.pm * BM + wr * 64 + fr, col0 = u.pn * BM + wc * 32 + 4 * fq;
#pragma unroll
        for (int ai = 0; ai < 2; ++ai)
#pragma unroll
            for (int m = 0; m < 4; ++m) { const size_t off = (size_t)(row0 + ai * HALF + m * 16) * ldc + col0;
#pragma unroll
                for (int bj = 0; bj < 2; ++bj)
#pragma unroll
                    for (int n = 0; n < 2; ++n) { const f32x4 xv = *(const f32x4*)(X + off + bj * HALF + n * 16);
                        *(f32x4*)(Z + off + bj * HALF + n * 16) = xv * alpha + acc[ai][bj][m][n]; } }
    }
};

template <int ACT, bool TILED = false> struct EpiBf16Fold {
    static constexpr bool PERM = true, AFTER_DRAIN = false, LDS_STAGE = (MK_EPI_STAGE != 0); static constexpr int MIN_VMEM = 16;
    bf16_t* O; int ldc; const f32x2* stat; const float* cs; const float* bw;
    __device__ __forceinline__ void stage(const Unit& u, PG8_LAS unsigned char* buf, int wid) const {
        if (wid < 4) { const int ln = lane_id();
            const char* src = (wid < 2) ? (const char*)(stat + (size_t)u.pm * BM) + (wid * 64 + ln) * 16 : (wid == 2) ? (const char*)(cs + u.pn * BM) + ln * 16 : (const char*)(bw + u.pn * BM) + ln * 16;
            __builtin_amdgcn_global_load_lds((const unsigned*)src, (PG8_LAS unsigned*)(buf + wid * 1024), 16, 0, 0); }
    }
    __device__ __forceinline__ void operator()(const f32x4 (&acc)[2][2][4][2], const Unit& u, int wr, int wc, int fr, int fq, const PG8_LAS unsigned char* sbuf = nullptr) const {
        const int row0 = u.pm * BM + wr * 64 + fr; const int col0 = u.pn * BM + wc * 32 + 8 * fq;
        f32x4 cv[2][2], bv[2][2]; f32x2 st[2][4];
#pragma unroll
        for (int ai = 0; ai < 2; ++ai)
#pragma unroll
            for (int m = 0; m < 4; ++m) st[ai][m] = LDS_STAGE ? ((const PG8_LAS f32x2*)sbuf)[ai * HALF + wr * 64 + m * 16 + fr] : stat[row0 + ai * HALF + m * 16];
#pragma unroll
        for (int bj = 0; bj < 2; ++bj)
#pragma unroll
            for (int n = 0; n < 2; ++n) { const int lc_ = bj * HALF + wc * 32 + 8 * fq + 4 * n;
                cv[bj][n] = LDS_STAGE ? *(const PG8_LAS f32x4*)(sbuf + 2048 + lc_ * 4) : *(const f32x4*)(cs + col0 + bj * HALF + 4 * n); bv[bj][n] = LDS_STAGE ? *(const PG8_LAS f32x4*)(sbuf + 3072 + lc_ * 4) : *(const f32x4*)(bw + col0 + bj * HALF + 4 * n); }
#pragma unroll
        for (int ai = 0; ai < 2; ++ai)
#pragma unroll
            for (int m = 0; m < 4; ++m) { const int row = row0 + ai * HALF + m * 16; const float rs = st[ai][m].y, nm = -st[ai][m].x * st[ai][m].y;
                bf16_t* rowp = TILED ? O + ((size_t)(row >> 8) * (ldc >> 6) + (col0 >> 6)) * 16384 + (row & 255) * 64 + (col0 & 63) : O + (size_t)row * ldc + col0;
#pragma unroll
                for (int bj = 0; bj < 2; ++bj) { f32x4 v0 = acc[ai][bj][m][0] * rs + (cv[bj][0] * nm + bv[bj][0]), v1 = acc[ai][bj][m][1] * rs + (cv[bj][1] * nm + bv[bj][1]);
                    if (ACT == 3) {
#pragma unroll
                        for (int e = 0; e < 4; ++e) { const float a = fmaxf(v0[e], 0.f), b = fmaxf(v1[e], 0.f); v0[e] = a * a; v1[e] = b * b; } }
                    u32x4 w; w.x = cvt_pk_bf16(v0[0], v0[1]); w.y = cvt_pk_bf16(v0[2], v0[3]); w.z = cvt_pk_bf16(v1[0], v1[1]); w.w = cvt_pk_bf16(v1[2], v1[3]);
                    if (TILED && MK_NT_H) __builtin_nontemporal_store(w, (u32x4*)(rowp + bj * 2 * 16384)); else *(u32x4*)(rowp + (TILED ? bj * 2 * 16384 : bj * HALF)) = w; } }
    }
};
struct EpiResLnFold {
    static constexpr bool PERM = false, AFTER_DRAIN = false, LDS_STAGE = false; static constexpr int MIN_VMEM = 0;
    const float* Xp; const float* Xs; int split_pm;
    float* Z; bf16_t* ZB; int ldc; const f32x2* stat; const float* g; const float* b; f32x2* part; float alpha;
    __device__ __forceinline__ void operator()(const f32x4 (&acc)[2][2][4][2], const Unit& u, int wr, int wc, int fr, int fq) const {
        typedef unsigned u32x2v __attribute__((ext_vector_type(2)));
        const int row0 = u.pm * BM + wr * 64 + fr, col0 = u.pn * BM + wc * 32 + 4 * fq;
        const float* xbase = (u.pm < split_pm) ? Xp : Xs - (size_t)split_pm * BM * ldc;
        f32x4 gv[2][2], bv[2][2]; f32x2 st[2][4];
#pragma unroll
        for (int ai = 0; ai < 2; ++ai)
#pragma unroll
            for (int m = 0; m < 4; ++m) st[ai][m] = stat[row0 + ai * HALF + m * 16];
#pragma unroll
        for (int bj = 0; bj < 2; ++bj)
#pragma unroll
            for (int n = 0; n < 2; ++n) { gv[bj][n] = *(const f32x4*)(g + col0 + bj * HALF + n * 16); bv[bj][n] = *(const f32x4*)(b + col0 + bj * HALF + n * 16); }
        f32x4 xv[2][2][2];
#define RLF_LOAD(buf, rg) do { const size_t off_ = (size_t)(row0 + ((rg) >> 2) * HALF + ((rg) & 3) * 16) * ldc + col0; \
            _Pragma("unroll") for (int bj = 0; bj < 2; ++bj) _Pragma("unroll") for (int n = 0; n < 2; ++n) xv[buf][bj][n] = *(const f32x4*)(xbase + off_ + bj * HALF + n * 16); } while (0)
        RLF_LOAD(0, 0);
#pragma unroll
        for (int rg = 0; rg < 8; ++rg) { const int ai = rg >> 2, m = rg & 3, cur = rg & 1;
            if (rg + 1 < 8) RLF_LOAD(cur ^ 1, rg + 1);
            asm volatile("" ::: "memory");
            const int row = row0 + ai * HALF + m * 16; const size_t off = (size_t)row * ldc + col0; const float mu = st[ai][m].x, rs = st[ai][m].y;
            float s = 0.f, q = 0.f;
#pragma unroll
            for (int bj = 0; bj < 2; ++bj)
#pragma unroll
                for (int n = 0; n < 2; ++n) {
                    const f32x4 xn = (xv[cur][bj][n] - mu) * rs * gv[bj][n] + bv[bj][n]; const f32x4 z = xn * alpha + acc[ai][bj][m][n];
                    *(f32x4*)(Z + off + bj * HALF + n * 16) = z;
                    u32x2v w; w.x = cvt_pk_bf16(z[0], z[1]); w.y = cvt_pk_bf16(z[2], z[3]); *(u32x2v*)(ZB + off + bj * HALF + n * 16) = w;
                    s += (z[0] + z[1]) + (z[2] + z[3]); q += (z[0] * z[0] + z[1] * z[1]) + (z[2] * z[2] + z[3] * z[3]); }
            s += xshfl<16>(s); s = xsum32(s); q += xshfl<16>(q); q = xsum32(q);
            if (fq == 0) part[(size_t)row * 32 + u.pn * 4 + wc] = (f32x2){s, q};
            asm volatile("" ::: "memory");
        }
#undef RLF_LOAD
    }
};

struct EpiInProj {
    static constexpr bool PERM = true, AFTER_DRAIN = false, LDS_STAGE = (MK_EPI_STAGE != 0); static constexpr int MIN_VMEM = 16;
    bf16_t* O; int ldc; const f32x2* stat; const float* cs; const float* bw;
    const float* gq; const float* gk; const float* ropeA; const float* ropeB; PG8_LAS float* xch;
    float qscale;
    __device__ __forceinline__ void stage(const Unit& u, PG8_LAS unsigned char* buf, int wid) const {
        if (wid < 4) { const int ln = lane_id();
            const char* src = (wid < 2) ? (const char*)(stat + (size_t)u.pm * BM) + (wid * 64 + ln) * 16 : (wid == 2) ? (const char*)(cs + u.pn * BM) + ln * 16 : (const char*)(bw + u.pn * BM) + ln * 16;
            __builtin_amdgcn_global_load_lds((const unsigned*)src, (PG8_LAS unsigned*)(buf + wid * 1024), 16, 0, 0); }
    }
    __device__ __forceinline__ void operator()(const f32x4 (&acc_)[2][2][4][2], const Unit& u, int wr, int wc, int fr, int fq, const PG8_LAS unsigned char* sbuf = nullptr) const {
        f32x4 (&acc)[2][2][4][2] = const_cast<f32x4 (&)[2][2][4][2]>(acc_);
        const int row0 = u.pm * BM + wr * 64 + fr; const int col0 = u.pn * BM + wc * 32 + 8 * fq;
        const int kind = (u.pn < 3) ? 1 : (u.pn >= 4 && u.pn < 10) ? 2 : 0;
        { f32x4 cv[2][2], bv[2][2]; f32x2 st[2][4];
#pragma unroll
          for (int ai = 0; ai < 2; ++ai)
#pragma unroll
            for (int m = 0; m < 4; ++m) st[ai][m] = LDS_STAGE ? ((const PG8_LAS f32x2*)sbuf)[ai * HALF + wr * 64 + m * 16 + fr] : stat[row0 + ai * HALF + m * 16];
#pragma unroll
          for (int bj = 0; bj < 2; ++bj)
#pragma unroll
            for (int n = 0; n < 2; ++n) { const int lc_ = bj * HALF + wc * 32 + 8 * fq + 4 * n;
                cv[bj][n] = LDS_STAGE ? *(const PG8_LAS f32x4*)(sbuf + 2048 + lc_ * 4) : *(const f32x4*)(cs + col0 + bj * HALF + 4 * n); bv[bj][n] = LDS_STAGE ? *(const PG8_LAS f32x4*)(sbuf + 3072 + lc_ * 4) : *(const f32x4*)(bw + col0 + bj * HALF + 4 * n); }
#pragma unroll
          for (int ai = 0; ai < 2; ++ai)
#pragma unroll
            for (int m = 0; m < 4; ++m) { const float rs = st[ai][m].y, nm = -st[ai][m].x * st[ai][m].y;
#pragma unroll
                for (int bj = 0; bj < 2; ++bj)
#pragma unroll
                    for (int n = 0; n < 2; ++n) acc[ai][bj][m][n] = acc[ai][bj][m][n] * rs + (cv[bj][n] * nm + bv[bj][n]); } }
        if (kind == 0) {
#pragma unroll
            for (int ai = 0; ai < 2; ++ai)
#pragma unroll
                for (int m = 0; m < 4; ++m) { bf16_t* rowp = O + (size_t)(row0 + ai * HALF + m * 16) * ldc + col0;
#pragma unroll
                    for (int bj = 0; bj < 2; ++bj) { const f32x4 v0 = acc[ai][bj][m][0], v1 = acc[ai][bj][m][1];
                        u32x4 w; w.x = cvt_pk_bf16(v0[0], v0[1]); w.y = cvt_pk_bf16(v0[2], v0[3]); w.z = cvt_pk_bf16(v1[0], v1[1]); w.w = cvt_pk_bf16(v1[2], v1[3]);
                        if (MK_NT_PROJ) __builtin_nontemporal_store(w, (u32x4*)(rowp + bj * HALF)); else *(u32x4*)(rowp + bj * HALF) = w; } }
            return;
        }
        const float qs = (u.pn < 2) ? qscale : 1.f;
        const int half = wc >> 1;
        const int i0 = (kind == 1) ? 4 * (4 * (wc & 1) + fq) : 16 * wc + 4 * fq;
        f32x4 g_lo = {1.f, 1.f, 1.f, 1.f}, g_hi = {1.f, 1.f, 1.f, 1.f};
        if (kind == 1) {
            const float* gain = (u.pn < 2) ? gq : gk; g_lo = *(const f32x4*)(gain + 64 * half + i0); g_hi = *(const f32x4*)(gain + 64 * half + i0 + 32);
#pragma unroll
            for (int ai = 0; ai < 2; ++ai)
#pragma unroll
                for (int m = 0; m < 4; ++m)
#pragma unroll
                    for (int bj = 0; bj < 2; ++bj) { const f32x4 a = acc[ai][bj][m][0], b = acc[ai][bj][m][1];
                        float ss = ((a[0] * a[0] + a[1] * a[1]) + (a[2] * a[2] + a[3] * a[3])) + ((b[0] * b[0] + b[1] * b[1]) + (b[2] * b[2] + b[3] * b[3]));
                        ss += xshfl<16>(ss); ss = xsum32(ss);
                        if (fq == 0) xch[((ai * HALF + wr * 64 + m * 16 + fr) * 2 + bj) * 4 + wc] = ss; }
            asm volatile("s_waitcnt lgkmcnt(0)" ::: "memory"); __builtin_amdgcn_s_barrier(); asm volatile("" ::: "memory");
        }
        f32x4 tb[2][2][2];
#define EIP_LOAD(buf, sg) do { _Pragma("unroll") for (int h = 0; h < 2; ++h) { const int rg_ = 2 * (sg) + h; const int t_ = (row0 + (rg_ >> 2) * HALF + (rg_ & 3) * 16) & 4095; \
            const float* tp_ = (kind == 1) ? ropeA + 2 * ((half ? (t_ & 63) : (t_ >> 6)) * 32 + i0) : ropeB + 2 * (t_ * 64 + i0); \
            tb[buf][h][0] = *(const f32x4*)tp_; tb[buf][h][1] = *(const f32x4*)(tp_ + 4); } } while (0)
        EIP_LOAD(0, 0);
#pragma unroll
        for (int sg = 0; sg < 4; ++sg) { const int cur = sg & 1;
            if (sg + 1 < 4) EIP_LOAD(cur ^ 1, sg + 1);
            asm volatile("" ::: "memory");
#pragma unroll
            for (int h = 0; h < 2; ++h) { const int rg = 2 * sg + h, ai = rg >> 2, m = rg & 3; const int rl = ai * HALF + wr * 64 + m * 16 + fr;
                bf16_t* rowp = O + (size_t)(u.pm * BM + rl) * ldc + col0;
                const f32x4 t0 = tb[cur][h][0], t1 = tb[cur][h][1];
                const f32x4 cs4 = {t0[0], t0[2], t1[0], t1[2]}, sn4 = {t0[1], t0[3], t1[1], t1[3]};
#pragma unroll
                for (int bj = 0; bj < 2; ++bj) { f32x4 lo = acc[ai][bj][m][0], hi = acc[ai][bj][m][1];
                    if (kind == 1) { const f32x4 pq = *(const PG8_LAS f32x4*)(xch + (rl * 2 + bj) * 4); const float rs = 1.0f / sqrtf(((pq[0] + pq[1]) + (pq[2] + pq[3])) * (1.0f / 128.f) + 1e-6f);
                        lo = lo * (rs * qs) * g_lo; hi = hi * (rs * qs) * g_hi; }
                    const f32x4 ol = lo * cs4 - hi * sn4, oh = hi * cs4 + lo * sn4;
                    u32x4 w; w.x = cvt_pk_bf16(ol[0], ol[1]); w.y = cvt_pk_bf16(ol[2], ol[3]); w.z = cvt_pk_bf16(oh[0], oh[1]); w.w = cvt_pk_bf16(oh[2], oh[3]);
                    if (MK_NT_PROJ) __builtin_nontemporal_store(w, (u32x4*)(rowp + bj * HALF)); else *(u32x4*)(rowp + bj * HALF) = w; } }
            asm volatile("" ::: "memory");
        }
#undef EIP_LOAD
        if (kind == 1) { asm volatile("s_waitcnt lgkmcnt(0)" ::: "memory"); __builtin_amdgcn_s_barrier(); asm volatile("" ::: "memory"); }
    }
};

struct EpiResLnFoldB {
    static constexpr bool PERM = false, AFTER_DRAIN = false, LDS_STAGE = false; static constexpr int MIN_VMEM = 16;
    bf16_t* ZB; int ldc; const f32x2* stat; const float* g; const float* b; f32x2* part; float alpha;
    __device__ __forceinline__ void operator()(const f32x4 (&acc)[2][2][4][2], const Unit& u, int wr, int wc, int fr, int fq) const {
        typedef unsigned u32x2v __attribute__((ext_vector_type(2)));
        const int row0 = u.pm * BM + wr * 64 + fr, col0 = u.pn * BM + wc * 32 + 4 * fq;
        f32x4 gv[2][2], bv[2][2]; f32x2 st[3]; u32x2v xv[3][2][2];
#pragma unroll
        for (int bj = 0; bj < 2; ++bj)
#pragma unroll
            for (int n = 0; n < 2; ++n) { gv[bj][n] = *(const f32x4*)(g + col0 + bj * HALF + n * 16); bv[bj][n] = *(const f32x4*)(b + col0 + bj * HALF + n * 16); }
#define RLB_LOAD(buf, rg) do { const int row_ = row0 + ((rg) >> 2) * HALF + ((rg) & 3) * 16; const size_t off_ = (size_t)row_ * ldc + col0; st[buf] = stat[row_]; \
            _Pragma("unroll") for (int bj = 0; bj < 2; ++bj) _Pragma("unroll") for (int n = 0; n < 2; ++n) xv[buf][bj][n] = *(const u32x2v*)(ZB + off_ + bj * HALF + n * 16); } while (0)
        RLB_LOAD(0, 0); RLB_LOAD(1, 1);
#pragma unroll
        for (int rg = 0; rg < 8; ++rg) { const int cur = rg % 3, ai = rg >> 2, m = rg & 3;
            if (rg + 2 < 8) RLB_LOAD((rg + 2) % 3, rg + 2);
            asm volatile("" ::: "memory");
            const int row = row0 + ai * HALF + m * 16; const size_t off = (size_t)row * ldc + col0; const float mu = st[cur].x, rs = st[cur].y;
            float s = 0.f, q = 0.f;
#pragma unroll
            for (int bj = 0; bj < 2; ++bj)
#pragma unroll
                for (int n = 0; n < 2; ++n) { const u32x2v xw = xv[cur][bj][n];
                    const f32x4 xf = {__builtin_bit_cast(float, xw.x << 16), __builtin_bit_cast(float, xw.x & 0xffff0000u), __builtin_bit_cast(float, xw.y << 16), __builtin_bit_cast(float, xw.y & 0xffff0000u)};
                    const f32x4 xn = (xf - mu) * rs * gv[bj][n] + bv[bj][n]; const f32x4 z = xn * alpha + acc[ai][bj][m][n];
                    u32x2v w; w.x = cvt_pk_bf16(z[0], z[1]); w.y = cvt_pk_bf16(z[2], z[3]); *(u32x2v*)(ZB + off + bj * HALF + n * 16) = w;
                    s += (z[0] + z[1]) + (z[2] + z[3]); q += (z[0] * z[0] + z[1] * z[1]) + (z[2] * z[2] + z[3] * z[3]); }
            s += xshfl<16>(s); s = xsum32(s); q += xshfl<16>(q); q = xsum32(q);
            if (fq == 0) part[(size_t)row * 32 + u.pn * 4 + wc] = (f32x2){s, q};
            asm volatile("" ::: "memory");
        }
#undef RLB_LOAD
    }
};

struct EpiNull {
    static constexpr bool PERM = true, AFTER_DRAIN = false, LDS_STAGE = false; static constexpr int MIN_VMEM = 0;
    float* sink;
    __device__ __forceinline__ void operator()(const f32x4 (&acc)[2][2][4][2], const Unit& u, int wr, int wc, int fr, int fq) const {
        float s = 0.f;
#pragma unroll
        for (int ai = 0; ai < 2; ++ai)
#pragma unroll
            for (int bj = 0; bj < 2; ++bj)
#pragma unroll
                for (int m = 0; m < 4; ++m)
#pragma unroll
                    for (int n = 0; n < 2; ++n) s += (acc[ai][bj][m][n][0] + acc[ai][bj][m][n][1]) + (acc[ai][bj][m][n][2] + acc[ai][bj][m][n][3]);
        if (s == 1.2345678e33f) sink[u.pm * 8 + u.pn + wr + wc + fr + fq] = s;
    }
};

struct EpiResCopy {
    static constexpr bool PERM = false, AFTER_DRAIN = false, LDS_STAGE = false; static constexpr int MIN_VMEM = 0;
    float* Z; bf16_t* ZB; int ldc;
    __device__ __forceinline__ void operator()(const f32x4 (&acc)[2][2][4][2], const Unit& u, int wr, int wc, int fr, int fq) const {
        typedef unsigned u32x2v __attribute__((ext_vector_type(2)));
        const int row0 = u.pm * BM + wr * 64 + fr, col0 = u.pn * BM + wc * 32 + 4 * fq;
        float s = 0.f;
#pragma unroll
        for (int ai = 0; ai < 2; ++ai)
#pragma unroll
            for (int bj = 0; bj < 2; ++bj)
#pragma unroll
                for (int m = 0; m < 4; ++m)
#pragma unroll
                    for (int n = 0; n < 2; ++n) s += acc[ai][bj][m][n][0] + acc[ai][bj][m][n][3];
        const bool never = (s == 1.2345678e33f);
        f32x4 xv[2][2][2]; u32x2v bvv[2][2][2];
#define RC_LOAD(buf, rg) do { const size_t off_ = (size_t)(row0 + ((rg) >> 2) * HALF + ((rg) & 3) * 16) * ldc + col0; \
            _Pragma("unroll") for (int bj = 0; bj < 2; ++bj) _Pragma("unroll") for (int n = 0; n < 2; ++n) { xv[buf][bj][n] = *(const f32x4*)(Z + off_ + bj * HALF + n * 16); bvv[buf][bj][n] = *(const u32x2v*)(ZB + off_ + bj * HALF + n * 16); } } while (0)
        RC_LOAD(0, 0);
#pragma unroll
        for (int rg = 0; rg < 8; ++rg) { const int ai = rg >> 2, m = rg & 3, cur = rg & 1;
            if (rg + 1 < 8) RC_LOAD(cur ^ 1, rg + 1);
            asm volatile("" ::: "memory");
            const size_t off = (size_t)(row0 + ai * HALF + m * 16) * ldc + col0;
#pragma unroll
            for (int bj = 0; bj < 2; ++bj)
#pragma unroll
                for (int n = 0; n < 2; ++n) { f32x4 z = xv[cur][bj][n]; if (never) z[0] = s; *(f32x4*)(Z + off + bj * HALF + n * 16) = z; *(u32x2v*)(ZB + off + bj * HALF + n * 16) = bvv[cur][bj][n]; }
            asm volatile("" ::: "memory");
        }
#undef RC_LOAD
    }
};

struct EpiResCopyB {
    static constexpr bool PERM = false, AFTER_DRAIN = false, LDS_STAGE = false; static constexpr int MIN_VMEM = 0;
    bf16_t* ZB; int ldc;
    __device__ __forceinline__ void operator()(const f32x4 (&acc)[2][2][4][2], const Unit& u, int wr, int wc, int fr, int fq) const {
        typedef unsigned u32x2v __attribute__((ext_vector_type(2)));
        const int row0 = u.pm * BM + wr * 64 + fr, col0 = u.pn * BM + wc * 32 + 4 * fq;
        float s = 0.f;
#pragma unroll
        for (int ai = 0; ai < 2; ++ai)
#pragma unroll
            for (int bj = 0; bj < 2; ++bj)
#pragma unroll
                for (int m = 0; m < 4; ++m)
#pragma unroll
                    for (int n = 0; n < 2; ++n) s += acc[ai][bj][m][n][0] + acc[ai][bj][m][n][3];
        const bool never = (s == 1.2345678e33f);
        u32x2v xv[2][2][2];
#define RCB_LOAD(buf, rg) do { const size_t off_ = (size_t)(row0 + ((rg) >> 2) * HALF + ((rg) & 3) * 16) * ldc + col0; \
            _Pragma("unroll") for (int bj = 0; bj < 2; ++bj) _Pragma("unroll") for (int n = 0; n < 2; ++n) xv[buf][bj][n] = *(const u32x2v*)(ZB + off_ + bj * HALF + n * 16); } while (0)
        RCB_LOAD(0, 0);
#pragma unroll
        for (int rg = 0; rg < 8; ++rg) { const int ai = rg >> 2, m = rg & 3, cur = rg & 1;
            if (rg + 1 < 8) RCB_LOAD(cur ^ 1, rg + 1);
            asm volatile("" ::: "memory");
            const size_t off = (size_t)(row0 + ai * HALF + m * 16) * ldc + col0;
#pragma unroll
            for (int bj = 0; bj < 2; ++bj)
#pragma unroll
                for (int n = 0; n < 2; ++n) { u32x2v z = xv[cur][bj][n]; if (never) z.x ^= 1u; *(u32x2v*)(ZB + off + bj * HALF + n * 16) = z; }
            asm volatile("" ::: "memory");
        }
#undef RCB_LOAD
    }
};

template <class Epi, class Sched, bool ALIGN_EPI = false, bool SP2 = false, bool TILED_A = false, bool KSCALE = false>
__device__ __forceinline__ void gemm_phase(PG8_LAS unsigned char* lds, const Gemm g, const Sched& S, const Epi& E, const int wid  ) {
    const int wr = wid >> 2, wc = wid & 3;
    const int K = g.K, nt = K / BK;
    unsigned voffA[2], voffB[2]; int aoff, boff;
#define PG8_LANE_OFFS() do { const int ln_ = lane_id(), td_ = wid * 64 + ln_; \
        _Pragma("unroll") for (int i = 0; i < 2; ++i) { int R, C; stage_rc(td_ * 16 + i * 8192, R, C); const int Rb = Epi::PERM ? ((R & ~31) + perm32(R & 31)) : R; \
            voffA[i] = (unsigned)(R * (TILED_A ? 64 : K) + C) * 2u; voffB[i] = (unsigned)(Rb * (MK_TILED_W ? 64 : K) + C) * 2u; } \
        aoff = lds_byte(wr * 64 + (ln_ & 15), (ln_ >> 4) * 8); boff = lds_byte(wc * 32 + (ln_ & 15), (ln_ >> 4) * 8); } while (0)
    PG8_LANE_OFFS();
    const size_t kstep = (size_t)(BK * 2);
    const size_t hstep = (size_t)HALF * K * 2;
    const size_t tstep = 2 * hstep;
    const size_t kstepA = TILED_A ? (size_t)32768 : kstep, hstepA = TILED_A ? (size_t)HALF * 64 * 2 : hstep;
    const size_t kstepB = MK_TILED_W ? (size_t)32768 : kstep, hstepB = MK_TILED_W ? (size_t)HALF * 64 * 2 : hstep;
    const unsigned ldsw = (unsigned)wid * 1024u;
#define PG8_SA(b, h) (((b) * 2 + (h)) * HTB)
#define PG8_SB(b, h) ((4 + (b) * 2 + (h)) * HTB)
#define PG8_STAGE(bufoff, gbase, voff) do { _Pragma("unroll") for (int _i = 0; _i < 2; ++_i) \
        __builtin_amdgcn_global_load_lds((const unsigned*)((const char*)(gbase) + (voff)[_i]), (PG8_LAS unsigned*)(lds + (bufoff) + ldsw + _i * 8192), 16, 0, 0); } while (0)
#define PG8_STAGE_A(bufoff, gbase, voff) do { _Pragma("unroll") for (int _i = 0; _i < 2; ++_i) { \
        if constexpr (TILED_A && MK_NT_HLOAD) __builtin_amdgcn_global_load_lds((const unsigned*)((const char*)(gbase) + (voff)[_i]), (PG8_LAS unsigned*)(lds + (bufoff) + ldsw + _i * 8192), 16, 0, 2); \
        else __builtin_amdgcn_global_load_lds((const unsigned*)((const char*)(gbase) + (voff)[_i]), (PG8_LAS unsigned*)(lds + (bufoff) + ldsw + _i * 8192), 16, 0, 0); } } while (0)
#define PG8_LDA(dst, b, h) do { _Pragma("unroll") for (int m = 0; m < 4; ++m) _Pragma("unroll") for (int k = 0; k < 2; ++k) dst[m][k] = *(const PG8_LAS bf16x8*)(lds + PG8_SA(b, h) + aoff + m * 2048 + k * 1024); } while (0)
#define PG8_LDB(dst, b, h) do { _Pragma("unroll") for (int n = 0; n < 2; ++n) _Pragma("unroll") for (int k = 0; k < 2; ++k) dst[n][k] = *(const PG8_LAS bf16x8*)(lds + PG8_SB(b, h) + boff + n * 2048 + k * 1024); } while (0)
#define PG8_MMA(ai, bj, At, Bt) do { __builtin_amdgcn_s_setprio(1); _Pragma("unroll") for (int m = 0; m < 4; ++m) _Pragma("unroll") for (int n = 0; n < 2; ++n) _Pragma("unroll") for (int k = 0; k < 2; ++k) \
        acc[ai][bj][m][n] = __builtin_amdgcn_mfma_f32_16x16x32_bf16(Bt[n][k], At[m][k], acc[ai][bj][m][n], 0, 0, 0); __builtin_amdgcn_s_setprio(0); } while (0)
#define PG8_WAIT_V(n) asm volatile("s_waitcnt vmcnt(" #n ")" ::: "memory")
#define PG8_WAIT_L(n) asm volatile("s_waitcnt lgkmcnt(" #n ")" ::: "memory")
#define PG8_BAR __builtin_amdgcn_s_barrier()
#define PG8_SCHED __builtin_amdgcn_sched_barrier(0)
#define PG8_KTAB_DMA(pm_, bsel_) do { const int ln_ = lane_id(); \
        __builtin_amdgcn_global_load_lds((const unsigned*)((const char*)g.rat + (size_t)(pm_) * (256 * 32) + (size_t)((wid * 64 + ln_) * 16)), (PG8_LAS unsigned*)(lds + g.ktab_off + (bsel_) * 8192 + wid * 1024), 16, 0, 0); } while (0)
#define PG8_RESCALE(seg_, bsel_) do { const int ln_ = lane_id(); const PG8_LAS float* tp_ = (const PG8_LAS float*)(lds + g.ktab_off + (bsel_) * 8192 + (wr * 64 + (ln_ & 15)) * 32) + (seg_); \
        _Pragma("unroll") for (int ai = 0; ai < 2; ++ai) _Pragma("unroll") for (int m = 0; m < 4; ++m) { const float r_ = tp_[(ai * 128 + m * 16) * 8]; \
            _Pragma("unroll") for (int bj = 0; bj < 2; ++bj) _Pragma("unroll") for (int n = 0; n < 2; ++n) acc[ai][bj][m][n] *= r_; } } while (0)
    Unit cur, nxt; int ui = 0;
    if (!S.next(0, cur)) return;
    if constexpr (KSCALE) PG8_KTAB_DMA(cur.pm, 0);
    if constexpr (Epi::LDS_STAGE) E.stage(cur, lds + g.stg_off, wid);
    f32x4 acc[2][2][4][2];
#pragma unroll
    for (int a = 0; a < 2; ++a)
#pragma unroll
        for (int b = 0; b < 2; ++b)
#pragma unroll
            for (int m = 0; m < 4; ++m)
#pragma unroll
                for (int n = 0; n < 2; ++n) { acc[a][b][m][n] = (f32x4){0.f, 0.f, 0.f, 0.f}; asm volatile("" : "+v"(acc[a][b][m][n])); }
    bf16x8 At[4][2], B0[2][2], B1[2][2];
    const char* cA = (const char*)g.A + (size_t)cur.pm * tstep; const char* cB = (const char*)g.Bt + (size_t)cur.pn * tstep;
    S.a_ready(cur);
    if constexpr (SP2) {
        PG8_STAGE(PG8_SB(0, 0), cB, voffB); PG8_STAGE(PG8_SB(0, 1), cB + hstepB, voffB); PG8_STAGE_A(PG8_SA(0, 0), cA, voffA); PG8_STAGE_A(PG8_SA(0, 1), cA + hstepA, voffA);
        if (wr == 1) PG8_BAR;
        PG8_WAIT_V(2); PG8_BAR;
        PG8_STAGE(PG8_SB(1, 0), cB + kstepB, voffB); PG8_STAGE_A(PG8_SA(1, 0), cA + kstepA, voffA); PG8_STAGE(PG8_SB(1, 1), cB + hstepB + kstepB, voffB);
        PG8_WAIT_V(6);
        PG8_BAR;
    } else {
        PG8_STAGE(PG8_SB(0, 0), cB, voffB); PG8_STAGE_A(PG8_SA(0, 0), cA, voffA); PG8_STAGE(PG8_SB(0, 1), cB + hstepB, voffB); PG8_STAGE_A(PG8_SA(0, 1), cA + hstepA, voffA);
        if (wr == 1) PG8_BAR;
        PG8_WAIT_V(4); PG8_BAR;
        PG8_STAGE(PG8_SB(1, 0), cB + kstepB, voffB); PG8_STAGE_A(PG8_SA(1, 0), cA + kstepA, voffA); PG8_STAGE(PG8_SB(1, 1), cB + hstepB + kstepB, voffB);
        PG8_WAIT_V(6); PG8_BAR;
    }
    for (;;) {
        const bool has_next = S.next(ui + 1, nxt);
        const char* nA = has_next ? (const char*)g.A + (size_t)nxt.pm * tstep : cA; const char* nB = has_next ? (const char*)g.Bt + (size_t)nxt.pn * tstep : cB;
        static_assert(SP2, "this copy of the body keeps only the two-super-phase K-loop");
#define PG8_TRIP(t, W) do { \
            const bool last = ((t) == nt - 2); \
            const char* a1 = cA + (size_t)((t) + 1) * kstepA; \
            const char* a2 = last ? nA : cA + (size_t)((t) + 2) * kstepA; const char* b2 = last ? nB : cB + (size_t)((t) + 2) * kstepB; \
            const char* a3 = a2 + kstepA; const char* b3 = b2 + kstepB; \
            if (last && has_next) S.a_ready(nxt); \
              \
            PG8_LDB(B0, 0, 0); PG8_LDB(B1, 0, 1); PG8_SCHED; PG8_LDA(At, 0, 0); PG8_STAGE_A(PG8_SA(1, 1), a1 + hstepA, voffA); \
            W; PG8_WAIT_L(0); PG8_BAR; PG8_MMA(0, 0, At, B0); PG8_MMA(0, 1, At, B1); PG8_BAR; PG8_SCHED; \
              \
            PG8_LDA(At, 0, 1); PG8_STAGE(PG8_SB(0, 0), b2, voffB); PG8_STAGE(PG8_SB(0, 1), b2 + hstepB, voffB); PG8_STAGE_A(PG8_SA(0, 0), a2, voffA); \
            W; PG8_WAIT_L(0); PG8_BAR; PG8_MMA(1, 0, At, B0); PG8_MMA(1, 1, At, B1); PG8_BAR; PG8_SCHED; \
              \
            PG8_LDB(B0, 1, 0); PG8_LDB(B1, 1, 1); PG8_SCHED; PG8_LDA(At, 1, 0); PG8_STAGE_A(PG8_SA(0, 1), a2 + hstepA, voffA); \
            PG8_WAIT_V(8); PG8_WAIT_L(0); PG8_BAR; PG8_MMA(0, 0, At, B0); PG8_MMA(0, 1, At, B1); PG8_BAR; PG8_SCHED; \
              \
            PG8_LDA(At, 1, 1); PG8_STAGE(PG8_SB(1, 0), b3, voffB); PG8_STAGE(PG8_SB(1, 1), b3 + hstepB, voffB); PG8_STAGE_A(PG8_SA(1, 0), a3, voffA); \
            PG8_WAIT_V(8); PG8_WAIT_L(0); PG8_BAR; PG8_MMA(1, 0, At, B0); PG8_MMA(1, 1, At, B1); PG8_BAR; PG8_SCHED; } while (0)
#define PG8_WAIT_W(z) asm volatile("s_cmp_eq_u32 %0, 0\n\ts_cbranch_scc1 .Lpg8r%=\n\ts_waitcnt vmcnt(8)\n\ts_branch .Lpg8d%=\n.Lpg8r%=:\n\ts_waitcnt vmcnt(%1)\n.Lpg8d%=:" :: "s"(z), "n"(8 + Epi::MIN_VMEM) : "memory", "scc")
        if constexpr (KSCALE) { int t = 0;
            for (int seg = 0; seg < 8; ++seg) { const int tend = (seg == 0) ? 8 : (seg == 7) ? nt : 8 + 2 * seg;
                for (; t < tend; t += 2) { const int z_ = __builtin_amdgcn_readfirstlane(t + (ui == 0 ? 1 : 0)); PG8_TRIP(t, PG8_WAIT_W(z_)); }
                PG8_RESCALE(seg, ui & 1); } }
        else if constexpr (Epi::MIN_VMEM > 0) { for (int t = 0; t < nt; t += 2) { const int z_ = __builtin_amdgcn_readfirstlane(t + (ui == 0 ? 1 : 0)); PG8_TRIP(t, PG8_WAIT_W(z_)); } }
        else { for (int t = 0; t < nt; t += 2) { PG8_TRIP(t, PG8_WAIT_V(8)); } }
#undef PG8_WAIT_W
#undef PG8_TRIP
        if constexpr (ALIGN_EPI) { if (wr == 0) PG8_BAR; }
        if constexpr (!Epi::AFTER_DRAIN) { const int le_ = lane_id(); if constexpr (Epi::LDS_STAGE) E(acc, cur, wr, wc, le_ & 15, le_ >> 4, lds + g.stg_off + (ui & 1) * 4096); else E(acc, cur, wr, wc, le_ & 15, le_ >> 4); S.done(cur); }
        if (!has_next) break;
#pragma unroll
        for (int a = 0; a < 2; ++a)
#pragma unroll
            for (int b = 0; b < 2; ++b)
#pragma unroll
                for (int m = 0; m < 4; ++m)
#pragma unroll
                    for (int n = 0; n < 2; ++n) { acc[a][b][m][n] = (f32x4){0.f, 0.f, 0.f, 0.f}; asm volatile("" : "+v"(acc[a][b][m][n])); }
        cur = nxt; cA = nA; cB = nB; ++ui; PG8_LANE_OFFS();
        if constexpr (KSCALE) PG8_KTAB_DMA(cur.pm, ui & 1);
        if constexpr (Epi::LDS_STAGE) E.stage(cur, lds + g.stg_off + (ui & 1) * 4096, wid);
        if constexpr (ALIGN_EPI) { if (wr == 1) PG8_BAR; }
    }
    PG8_WAIT_V(0);
    if constexpr (!ALIGN_EPI) { if (wr == 0) PG8_BAR; }
    PG8_BAR;
    if constexpr (Epi::AFTER_DRAIN) { const int le_ = lane_id(); E.fused(acc, cur, wr, wc, le_ & 15, le_ >> 4, lds, wid, le_); S.done(cur); }
#undef PG8_KTAB_DMA
#undef PG8_RESCALE
#undef PG8_SA
#undef PG8_SB
#undef PG8_STAGE
#undef PG8_LANE_OFFS
#undef PG8_STAGE_A
#undef PG8_LDA
#undef PG8_LDB
#undef PG8_MMA
#undef PG8_WAIT_V
#undef PG8_WAIT_L
#undef PG8_BAR
#undef PG8_SCHED
}
}
#define GAS __attribute__((address_space(1)))
#define LAS __attribute__((address_space(3)))
typedef unsigned short bf16;
typedef unsigned v4u __attribute__((ext_vector_type(4)));
typedef float f32x4 __attribute__((ext_vector_type(4)));
typedef short bf16x8 __attribute__((ext_vector_type(8)));
typedef GAS unsigned gu32;
typedef GAS unsigned long long gu64;
#define RLX_AGENT __ATOMIC_RELAXED, __HIP_MEMORY_SCOPE_AGENT
#define LDS_WAIT() asm volatile("s_waitcnt lgkmcnt(0)" ::: "memory")
#define VM_WAIT() asm volatile("s_waitcnt vmcnt(0)" ::: "memory")
__device__ __forceinline__ unsigned long long rt() { return __builtin_amdgcn_s_memrealtime(); }
__device__ __forceinline__ unsigned f2bf(float f) { unsigned u = __builtin_bit_cast(unsigned, f); return (u + 0x7fffu + ((u >> 16) & 1u)) >> 16; }
__device__ __forceinline__ unsigned pk2(float lo, float hi) { return f2bf(lo) | (f2bf(hi) << 16); }

#define XB_TMO      128
#define XB_XCNT(j)  (256  + 64 * (j))
#define XB_XSUB(j)  (1280 + 64 * (j))
#define XB_XGEN(j)  (2304 + 64 * (j))
#define XB_TOP      3328
#define XB_TOPGEN   3392
#define XCD_BAR_WORDS 3456
#define XB_SPIN_CAP (1u << 18)

__device__ __forceinline__ unsigned xb_ld(unsigned* p)              { return __hip_atomic_load(p, __ATOMIC_RELAXED, __HIP_MEMORY_SCOPE_AGENT); }
__device__ __forceinline__ unsigned xb_add(unsigned* p, unsigned v) { return __hip_atomic_fetch_add(p, v, __ATOMIC_RELAXED, __HIP_MEMORY_SCOPE_AGENT); }
__device__ __forceinline__ unsigned xb_xcc_id() { return (unsigned)__builtin_amdgcn_s_getreg((3 << 11) | 20) & 0xFu; }
#define XB_SPIN(cond, bar) do { unsigned _sp = 0; while (cond) { __builtin_amdgcn_s_sleep(1); \
    if ((++_sp & 255u) == 0u) { if (xb_ld(&(bar)[XB_TMO])) break; if (_sp > XB_SPIN_CAP) { atomicAdd(&(bar)[XB_TMO], 1u); break; } } } } while (0)

struct XcdBarrier {
    unsigned* bar; unsigned x;
    volatile LAS unsigned* st;
};

__device__ __forceinline__ XcdBarrier xcd_barrier_post(unsigned* bar, volatile LAS unsigned* st, const bool t0  ) {
    XcdBarrier b; b.bar = bar; b.x = xb_xcc_id(); b.st = st;
    if (t0) (void)xb_add(&bar[XB_XCNT(b.x)], 1u);
    return b;
}
__device__ __forceinline__ void xcd_barrier_complete(unsigned* bar, unsigned x, unsigned& nloc, unsigned& nx) {
    const unsigned G = gridDim.x * gridDim.y * gridDim.z;
    unsigned sum, cnt, mine, sp = 0u;
    for (;;) {
        sum = 0u; cnt = 0u; mine = 0u;
#pragma unroll
        for (unsigned j = 0; j < 16; ++j) { const unsigned c = xb_ld(&bar[XB_XCNT(j)]); sum += c; cnt += (c > 0u) ? 1u : 0u; mine = (j == x) ? c : mine; }
        if (sum == G) break;
        __builtin_amdgcn_s_sleep(1);
        if ((++sp & 255u) == 0u) { if (xb_ld(&bar[XB_TMO])) break; if (sp > XB_SPIN_CAP) { atomicAdd(&bar[XB_TMO], 1u); break; } }
    }
    nloc = mine > 0u ? mine : 1u; nx = cnt > 0u ? cnt : 1u;
}

__device__ __forceinline__ void xcd_barrier(const XcdBarrier& b, const bool t0  ) {
    asm volatile("s_waitcnt vmcnt(0)" ::: "memory");
    __syncthreads();
    if (t0) {
        unsigned* bar = b.bar;
        __builtin_amdgcn_s_waitcnt(0);
        unsigned nloc = b.st[0], nx = b.st[1];
        if (nloc == 0u) { xcd_barrier_complete(bar, b.x, nloc, nx); b.st[0] = nloc; b.st[1] = nx; }
        const unsigned old = xb_add(&bar[XB_XSUB(b.x)], 1u);
        const unsigned gen = old / nloc;
        if (old + 1u == (gen + 1u) * nloc) {
            __builtin_amdgcn_fence(__ATOMIC_RELEASE, "agent");
            asm volatile("s_waitcnt vmcnt(0)" ::: "memory");
            const unsigned og = xb_add(&bar[XB_TOP], 1u);
            const unsigned tg = og / nx;
            if (og + 1u == (tg + 1u) * nx) xb_add(&bar[XB_TOPGEN], 1u);
            else XB_SPIN(xb_ld(&bar[XB_TOPGEN]) == tg, bar);
            __builtin_amdgcn_fence(__ATOMIC_ACQUIRE, "agent");
            xb_add(&bar[XB_XGEN(b.x)], 1u);
            asm volatile("s_waitcnt vmcnt(0)" ::: "memory");
        } else {
            XB_SPIN(xb_ld(&bar[XB_XGEN(b.x)]) == gen, bar);
            __builtin_amdgcn_fence(__ATOMIC_ACQUIRE, "agent");
            asm volatile("s_waitcnt vmcnt(0)" ::: "memory");
        }
    }
    __syncthreads();
}
namespace att {
typedef unsigned short bf16;
constexpr int NW = 8, QBLK = 32, KVBLK = 64, D = 128;
constexpr float SCALE = 0.088388347648318440f;
constexpr float THR = 8.f;
using bf16x8 = __attribute__((ext_vector_type(8))) short;
using s16x4  = __attribute__((ext_vector_type(4))) short;
using f32x16 = __attribute__((ext_vector_type(16))) float;
using f32x8  = __attribute__((ext_vector_type(8))) float;
using u32x4  = __attribute__((ext_vector_type(4))) unsigned;
#define KSWZ(row, colB) ((row) * 256 + ((colB) ^ (((row) & 7) << 4)))
#define SBAR() __builtin_amdgcn_sched_barrier(0)
__device__ __forceinline__ int crow(int r, int hi) { return (r & 3) + 8 * (r >> 2) + 4 * hi; }
__device__ __forceinline__ unsigned cvtpk(float lo, float hi) {
  unsigned r; asm volatile("v_cvt_pk_bf16_f32 %0, %1, %2" : "=v"(r) : "v"(lo), "v"(hi)); return r;
}
__device__ __forceinline__ float ssq8(const u32x4 v) {
  float q = 0.f;
#pragma unroll
  for (int e = 0; e < 4; ++e) { const float a = __builtin_bit_cast(float, v[e] << 16), b = __builtin_bit_cast(float, v[e] & 0xffff0000u); q += a * a + b * b; }
  return q;
}
__device__ __forceinline__ void partialSM(f32x16& p0, f32x16& p1, float& m_reg, float& mn, float& alpha) {
  constexpr float C = SCALE * 1.4426950408889634f;
  float pmax = p0[0]; for (int r = 1; r < 16; ++r) pmax = fmaxf(pmax, p0[r]); for (int r = 0; r < 16; ++r) pmax = fmaxf(pmax, p1[r]);
  { auto rr = __builtin_amdgcn_permlane32_swap(__float_as_uint(pmax), __float_as_uint(pmax), false, false);
    pmax = fmaxf(__uint_as_float(rr[0]), __uint_as_float(rr[1])); }
  if (__builtin_expect(__all(pmax - m_reg <= THR / SCALE), 1)) { mn = m_reg; alpha = 1.f; }
  else { mn = fmaxf(m_reg, pmax); alpha = __builtin_amdgcn_exp2f((m_reg - mn) * C); m_reg = mn; }
  float mnC = -mn * C;
  for (int r = 0; r < 16; ++r) p0[r] = fmaf(p0[r], C, mnC); for (int r = 0; r < 16; ++r) p1[r] = fmaf(p1[r], C, mnC);
  for (int r = 0; r < 16; ++r) p0[r] = __builtin_amdgcn_exp2f(p0[r]);
}
__device__ __forceinline__ void boundedSM(f32x16& p0, f32x16& p1) {
  for (int r = 0; r < 16; ++r) p0[r] = __builtin_amdgcn_exp2f(p0[r]);
}
__device__ __forceinline__ void finishSM(f32x16& p0, f32x16& p1, float alpha, float& l_reg, bf16x8& pa0, bf16x8& pa1, bf16x8& pa2, bf16x8& pa3) {
  for (int r = 0; r < 16; ++r) p1[r] = __builtin_amdgcn_exp2f(p1[r]);
  float ps = 0; for (int r = 0; r < 16; ++r) ps += p0[r]; for (int r = 0; r < 16; ++r) ps += p1[r];
  { auto rr = __builtin_amdgcn_permlane32_swap(__float_as_uint(ps), __float_as_uint(ps), false, false);
    ps = __uint_as_float(rr[0]) + __uint_as_float(rr[1]); }
  l_reg = l_reg * alpha + ps;
#define PK4(P, BASE, OUT) do { unsigned a0 = cvtpk(P[BASE + 0], P[BASE + 1]), a1 = cvtpk(P[BASE + 2], P[BASE + 3]);   \
    unsigned b0 = cvtpk(P[BASE + 4], P[BASE + 5]), b1 = cvtpk(P[BASE + 6], P[BASE + 7]);                              \
    auto r0 = __builtin_amdgcn_permlane32_swap(a0, b0, false, false); auto r1 = __builtin_amdgcn_permlane32_swap(a1, b1, false, false); \
    u32x4 w = {r0[0], r1[0], r0[1], r1[1]}; OUT = *reinterpret_cast<bf16x8*>(&w); } while (0)
  PK4(p0, 0, pa0); PK4(p0, 8, pa1); PK4(p1, 0, pa2); PK4(p1, 8, pa3);
#undef PK4
}
__device__ __forceinline__ void partialSM1(f32x16& p0, float& m_reg, float& mn, float& alpha) {
  constexpr float C = SCALE * 1.4426950408889634f;
  float pmax = p0[0]; for (int r = 1; r < 16; ++r) pmax = fmaxf(pmax, p0[r]);
  { auto rr = __builtin_amdgcn_permlane32_swap(__float_as_uint(pmax), __float_as_uint(pmax), false, false);
    pmax = fmaxf(__uint_as_float(rr[0]), __uint_as_float(rr[1])); }
  if (__builtin_expect(__all(pmax - m_reg <= THR / SCALE), 1)) { mn = m_reg; alpha = 1.f; }
  else { mn = fmaxf(m_reg, pmax); alpha = __builtin_amdgcn_exp2f((m_reg - mn) * C); m_reg = mn; }
  float mnC = -mn * C;
  for (int r = 0; r < 16; ++r) p0[r] = fmaf(p0[r], C, mnC);
  for (int r = 0; r < 16; ++r) p0[r] = __builtin_amdgcn_exp2f(p0[r]);
}
__device__ __forceinline__ void finishSM1(f32x16& p0, float alpha, float& l_reg, bf16x8& pa0, bf16x8& pa1) {
  float ps = 0; for (int r = 0; r < 16; ++r) ps += p0[r];
  { auto rr = __builtin_amdgcn_permlane32_swap(__float_as_uint(ps), __float_as_uint(ps), false, false);
    ps = __uint_as_float(rr[0]) + __uint_as_float(rr[1]); }
  l_reg = l_reg * alpha + ps;
#define PK4(P, BASE, OUT) do { unsigned a0 = cvtpk(P[BASE + 0], P[BASE + 1]), a1 = cvtpk(P[BASE + 2], P[BASE + 3]);   \
    unsigned b0 = cvtpk(P[BASE + 4], P[BASE + 5]), b1 = cvtpk(P[BASE + 6], P[BASE + 7]);                              \
    auto r0 = __builtin_amdgcn_permlane32_swap(a0, b0, false, false); auto r1 = __builtin_amdgcn_permlane32_swap(a1, b1, false, false); \
    u32x4 w = {r0[0], r1[0], r0[1], r1[1]}; OUT = *reinterpret_cast<bf16x8*>(&w); } while (0)
  PK4(p0, 0, pa0); PK4(p0, 8, pa1);
#undef PK4
}
__device__ __forceinline__ void qkt(f32x16& p0, f32x16& p1, const bf16* Ks, const bf16x8* qr, int r32, int hi, float init = 0.f) {
  for (int r = 0; r < 16; ++r) { p0[r] = init; p1[r] = init; }
  for (int d0 = 0; d0 < 8; ++d0) { int cb = (d0 * 16 + hi * 8) * 2;
    bf16x8 b0 = *reinterpret_cast<const bf16x8*>((const char*)Ks + KSWZ(r32, cb));
    bf16x8 b1 = *reinterpret_cast<const bf16x8*>((const char*)Ks + KSWZ(32 + r32, cb));
    p0 = __builtin_amdgcn_mfma_f32_32x32x16_bf16(b0, qr[d0], p0, 0, 0, 0);
    p1 = __builtin_amdgcn_mfma_f32_32x32x16_bf16(b1, qr[d0], p1, 0, 0, 0); }
}
__device__ __forceinline__ int v_st(int k, int c) { const int kk = (k & ~0xC) | ((k & 4) << 1) | ((k & 8) >> 1); return ((kk >> 3) * 4 + (c >> 5)) * 512 + ((kk & 7) * 32 + (c & 31)) * 2; }
__device__ __forceinline__ int v_rd_base(int lane) { return ((lane & 3) << 3) | (((lane >> 2) & 3) << 6) | (((lane >> 4) & 1) << 5) | (((lane >> 5) & 1) << 8); }
constexpr int v_rd_off(int d0, int ks, int half) { return d0 * 512 + ks * 4096 + half * 2048; }
template <int OFF> __device__ __forceinline__ s16x4 tr_read(int vb) {
  s16x4 r; asm volatile("ds_read_b64_tr_b16 %0, %1 offset:%2" : "=&v"(r) : "v"(vb), "i"(OFF) : "memory"); return r;
}
template <int D0> __device__ __forceinline__ void pv_one(f32x16& od, int vb, bf16x8 pa0, bf16x8 pa1, bf16x8 pa2, bf16x8 pa3) {
  const s16x4 l0 = tr_read<v_rd_off(D0, 0, 0)>(vb), h0 = tr_read<v_rd_off(D0, 0, 1)>(vb), l1 = tr_read<v_rd_off(D0, 1, 0)>(vb), h1 = tr_read<v_rd_off(D0, 1, 1)>(vb);
  const s16x4 l2 = tr_read<v_rd_off(D0, 2, 0)>(vb), h2 = tr_read<v_rd_off(D0, 2, 1)>(vb), l3 = tr_read<v_rd_off(D0, 3, 0)>(vb), h3 = tr_read<v_rd_off(D0, 3, 1)>(vb);
  asm volatile("s_waitcnt lgkmcnt(0)" ::: "memory"); SBAR();
#define PK(L, H) (bf16x8){L[0], L[1], L[2], L[3], H[0], H[1], H[2], H[3]}
  od = __builtin_amdgcn_mfma_f32_32x32x16_bf16(pa0, PK(l0, h0), od, 0, 0, 0);
  od = __builtin_amdgcn_mfma_f32_32x32x16_bf16(pa1, PK(l1, h1), od, 0, 0, 0);
  od = __builtin_amdgcn_mfma_f32_32x32x16_bf16(pa2, PK(l2, h2), od, 0, 0, 0);
  od = __builtin_amdgcn_mfma_f32_32x32x16_bf16(pa3, PK(l3, h3), od, 0, 0, 0);
#undef PK
}
__device__ __forceinline__ void pv_d0(f32x16* o, int vb, bf16x8 pa0, bf16x8 pa1, bf16x8 pa2, bf16x8 pa3) {
  pv_one<0>(o[0], vb, pa0, pa1, pa2, pa3); pv_one<1>(o[1], vb, pa0, pa1, pa2, pa3); pv_one<2>(o[2], vb, pa0, pa1, pa2, pa3); pv_one<3>(o[3], vb, pa0, pa1, pa2, pa3);
}

__device__ __forceinline__ void qkt32(f32x16& p0, const bf16* Ks, const bf16x8* qr, int krow, int hi) {
  for (int r = 0; r < 16; ++r) p0[r] = 0.f;
  for (int d0 = 0; d0 < 8; ++d0) { int cb = (d0 * 16 + hi * 8) * 2;
    bf16x8 b0 = *reinterpret_cast<const bf16x8*>((const char*)Ks + KSWZ(krow, cb));
    p0 = __builtin_amdgcn_mfma_f32_32x32x16_bf16(b0, qr[d0], p0, 0, 0, 0); }
}
template <int D0> __device__ __forceinline__ void pv_one2(f32x16& od, int vb, bf16x8 pa0, bf16x8 pa1) {
  const s16x4 l0 = tr_read<v_rd_off(D0, 0, 0)>(vb), h0 = tr_read<v_rd_off(D0, 0, 1)>(vb), l1 = tr_read<v_rd_off(D0, 1, 0)>(vb), h1 = tr_read<v_rd_off(D0, 1, 1)>(vb);
  asm volatile("s_waitcnt lgkmcnt(0)" ::: "memory"); SBAR();
#define PK(L, H) (bf16x8){L[0], L[1], L[2], L[3], H[0], H[1], H[2], H[3]}
  od = __builtin_amdgcn_mfma_f32_32x32x16_bf16(pa0, PK(l0, h0), od, 0, 0, 0);
  od = __builtin_amdgcn_mfma_f32_32x32x16_bf16(pa1, PK(l1, h1), od, 0, 0, 0);
#undef PK
}
__device__ __forceinline__ void pv_d0h(f32x16* o, int vb, bf16x8 pa0, bf16x8 pa1) {
  pv_one2<0>(o[0], vb, pa0, pa1); pv_one2<1>(o[1], vb, pa0, pa1); pv_one2<2>(o[2], vb, pa0, pa1); pv_one2<3>(o[3], vb, pa0, pa1);
}

constexpr size_t SHM_V = KVBLK * D * 2, SHM_K = KVBLK * D * 2, SHM_ATTN = 2 * SHM_V + 2 * SHM_K + NW * 64 * 4;
constexpr float NEG_INF = -__builtin_inff();
constexpr int OSTAGE_OFF = 73728;

#ifndef MK_PREFETCH_UNIT
#define MK_PREFETCH_UNIT 0
#endif
struct Pre { bf16x8 qr[8]; bf16x8 vs0, vs1, ks0, ks1; };
template <class Cfg, int SD = 2  ,
          bool BOUNDED = false  >
__device__ __forceinline__ void attn_unit(const Cfg& cfg, char* lds, const int wid  , Pre& pre, const bool have_pre  , const Cfg* nxt  ) {
  const int lane = lane_id(), tid = wid * 64 + lane, r32 = lane & 31, hi = lane >> 5;
  bf16* V_lds = (bf16*)lds; bf16* K_lds = (bf16*)(lds + 2 * SHM_V);
  float* ws = (float*)(lds + 2 * SHM_V + 2 * SHM_K) + wid * 64; float* li_l = ws; float* al_l = ws + 32;
  float m_reg = -1e30f, l_reg = 0; f32x16 o[4] = {}; bf16x8 qr[8];
  const bf16* Qw = cfg.proj + cfg.q_off(wid * QBLK + r32) + hi * 8;
  if (have_pre) {
#pragma unroll
    for (int d0 = 0; d0 < 8; ++d0) qr[d0] = pre.qr[d0];
  } else {
#pragma unroll
    for (int d0 = 0; d0 < 8; ++d0) qr[d0] = *reinterpret_cast<const bf16x8*>(Qw + d0 * 16);
  }
  const int sr = tid >> 4, sc = (tid & 15) * 8, vst0 = v_st(sr, sc), vst1 = v_st(32 + sr, sc);
  const int vb0 = (int)(uintptr_t)V_lds + v_rd_base(lane);
  struct { bf16x8 vs0, vs1, ks0, ks1; } sr_[SD];
#define SLOAD(i, t) do { const unsigned o0_ = cfg.kv_off((t), sr) + sc, o1_ = cfg.kv_off((t), 32 + sr) + sc; \
    sr_[i].vs0 = *reinterpret_cast<const bf16x8*>(cfg.proj + cfg.vcol + o0_); sr_[i].vs1 = *reinterpret_cast<const bf16x8*>(cfg.proj + cfg.vcol + o1_); \
    sr_[i].ks0 = *reinterpret_cast<const bf16x8*>(cfg.proj + cfg.kcol + o0_); sr_[i].ks1 = *reinterpret_cast<const bf16x8*>(cfg.proj + cfg.kcol + o1_); } while (0)
#define SWRITE(b, i) do { *(bf16x8*)((char*)V_lds + (b) * SHM_V + vst0) = sr_[i].vs0;          \
    *(bf16x8*)((char*)V_lds + (b) * SHM_V + vst1) = sr_[i].vs1; int kc = sc * 2;               \
    *(bf16x8*)((char*)K_lds + (b) * SHM_K + KSWZ(sr, kc)) = sr_[i].ks0;                       \
    *(bf16x8*)((char*)K_lds + (b) * SHM_K + KSWZ(32 + sr, kc)) = sr_[i].ks1; } while (0)
#define SWAIT() do { if constexpr (SD == 2) asm volatile("s_waitcnt vmcnt(4)" ::: "memory"); else asm volatile("s_waitcnt vmcnt(0)" ::: "memory"); } while (0)
#define RESC(a) do { if (!BOUNDED && __any((a) < 1.f)) { if (hi == 0) al_l[r32] = (a); asm volatile("s_waitcnt lgkmcnt(0)" ::: "memory"); \
    for (int d = 0; d < 4; ++d) for (int r = 0; r < 16; ++r) o[d][r] *= al_l[crow(r, hi)]; } } while (0)
#define QK(P0, P1, KB, T, MN, AL) do { if (cfg.active((T), wid)) { qkt(P0, P1, (KB), qr, r32, hi, BOUNDED ? cfg.negm0C : 0.f); cfg.mask(P0, P1, (T), wid, r32, hi); if constexpr (BOUNDED) { boundedSM(P0, P1); AL = 1.f; } else partialSM(P0, P1, m_reg, MN, AL); } else { AL = 1.f; } } while (0)
#define QK1(P0, P1, KB, T) do { if (cfg.active((T), wid)) { qkt(P0, P1, (KB), qr, r32, hi, BOUNDED ? cfg.negm0C : 0.f); cfg.mask(P0, P1, (T), wid, r32, hi); } } while (0)
#define PSM(P0, P1, T, MN, AL) do { if (cfg.active((T), wid)) { if constexpr (BOUNDED) { boundedSM(P0, P1); AL = 1.f; } else partialSM(P0, P1, m_reg, MN, AL); } else { AL = 1.f; } } while (0)
#define FPV(P0, P1, AL, VB, T) do { if (cfg.active((T), wid)) { finishSM(P0, P1, AL, l_reg, pa0, pa1, pa2, pa3); SBAR(); pv_d0(o, (VB), pa0, pa1, pa2, pa3); } } while (0)
  f32x16 pA0, pA1, pB0, pB1; float mnA, mnB, alA, alB; bf16x8 pa0, pa1, pa2, pa3; const int NT = Cfg::NT;
  constexpr int SE = 0, SO = SD - 1;
  if (have_pre) { sr_[SE].vs0 = pre.vs0; sr_[SE].vs1 = pre.vs1; sr_[SE].ks0 = pre.ks0; sr_[SE].ks1 = pre.ks1; } else SLOAD(SE, 0);
  asm volatile("s_waitcnt vmcnt(0)" ::: "memory"); SWRITE(0, SE); __syncthreads();
  QK(pA0, pA1, K_lds, 0, mnA, alA);
  SLOAD(SO, 1); if constexpr (SD == 2) { if (2 < NT) SLOAD(SE, 2); }
  SWAIT(); SWRITE(1, SO); __syncthreads();
  for (int j = 1; j + 1 < NT; j += 2) {
    SBAR(); QK1(pB0, pB1, (bf16*)((char*)K_lds + SHM_K), j);
    if (cfg.active(j - 1, wid)) { finishSM(pA0, pA1, alA, l_reg, pa0, pa1, pa2, pa3); } SBAR();
    SLOAD(SO, j + SD); SBAR();
    if (cfg.active(j - 1, wid)) { pv_d0(o, vb0, pa0, pa1, pa2, pa3); }
    PSM(pB0, pB1, j, mnB, alB);
    __syncthreads(); SWAIT(); SWRITE(0, SE);
    RESC(alB); __syncthreads();
    SBAR(); QK1(pA0, pA1, K_lds, j + 1);
    if (cfg.active(j, wid)) { finishSM(pB0, pB1, alB, l_reg, pa0, pa1, pa2, pa3); } SBAR();
    if (SD == 1 || j + 3 < NT) SLOAD(SE, j + 1 + SD); SBAR();
    if (cfg.active(j, wid)) { pv_d0(o, vb0 + (int)SHM_V, pa0, pa1, pa2, pa3); }
    PSM(pA0, pA1, j + 1, mnA, alA);
    __syncthreads(); SWAIT(); SWRITE(1, SO);
    RESC(alA); __syncthreads();
  }
  SBAR(); QK1(pB0, pB1, (bf16*)((char*)K_lds + SHM_K), NT - 1);
  if (cfg.active(NT - 2, wid)) { finishSM(pA0, pA1, alA, l_reg, pa0, pa1, pa2, pa3); SBAR(); pv_d0(o, vb0, pa0, pa1, pa2, pa3); }
  PSM(pB0, pB1, NT - 1, mnB, alB);
  __syncthreads(); RESC(alB);
  if (cfg.active(NT - 1, wid)) { finishSM(pB0, pB1, alB, l_reg, pa0, pa1, pa2, pa3); SBAR(); pv_d0(o, vb0 + (int)SHM_V, pa0, pa1, pa2, pa3); }
  if (hi == 0) li_l[r32] = l_reg; asm volatile("s_waitcnt lgkmcnt(0)" ::: "memory");
  if (Cfg::HAS_LSE) { if (hi == 0) cfg.store_lse(wid * QBLK + r32, m_reg * SCALE + __logf(l_reg)); }
  if (MK_PREFETCH_UNIT) {
    const bf16* Qn = nxt->proj + nxt->q_off(wid * QBLK + r32) + hi * 8;
#pragma unroll
    for (int d0 = 0; d0 < 8; ++d0) pre.qr[d0] = *reinterpret_cast<const bf16x8*>(Qn + d0 * 16);
    const unsigned o0_ = nxt->kv_off(0, sr) + sc, o1_ = nxt->kv_off(0, 32 + sr) + sc;
    pre.vs0 = *reinterpret_cast<const bf16x8*>(nxt->proj + nxt->vcol + o0_); pre.vs1 = *reinterpret_cast<const bf16x8*>(nxt->proj + nxt->vcol + o1_);
    pre.ks0 = *reinterpret_cast<const bf16x8*>(nxt->proj + nxt->kcol + o0_); pre.ks1 = *reinterpret_cast<const bf16x8*>(nxt->proj + nxt->kcol + o1_);
    asm volatile("" ::: "memory");
  }
  { bf16* stg = (bf16*)(lds + OSTAGE_OFF) + wid * 2048;
#pragma unroll
    for (int hh = 0; hh < 2; ++hh) {
#pragma unroll
      for (int r8 = 0; r8 < 8; ++r8) { const int r = 8 * hh + r8; const int orow = crow(r, hi); const float rl = __builtin_amdgcn_rcpf(li_l[orow]);
#pragma unroll
        for (int d0 = 0; d0 < 4; ++d0) stg[(orow & 15) * 128 + d0 * 32 + r32] = (bf16)(cvtpk(o[d0][r] * rl, 0.f) & 0xffffu); }
      asm volatile("s_waitcnt lgkmcnt(0)" ::: "memory");
#pragma unroll
      for (int j = 0; j < 4; ++j) { const int row = (lane >> 4) + 4 * j, ch = lane & 15; const u32x4 v = *(const u32x4*)(stg + row * 128 + ch * 8);
        const unsigned oo_ = cfg.o_off(wid * QBLK + 16 * hh + row); *(u32x4*)(cfg.obuf + oo_ + ch * 8) = v;
        if (MK_MIXFOLD) { const float q_ = rowsum16(ssq8(v));
          if (ch == 0) ((float*)((char*)cfg.obuf + MK_SSQ_FROM_O_BYTES))[(oo_ >> 11) * 16 + ((oo_ & 2047u) >> 7)] = q_; } }
      asm volatile("s_waitcnt lgkmcnt(0)" ::: "memory");
    } }
  __syncthreads();
#undef SLOAD
#undef SWRITE
#undef SWAIT
#undef RESC
#undef QK
#undef QK1
#undef PSM
#undef FPV
}

template <class Cfg, bool BOUNDED = false>
__device__ __forceinline__ void attn_unit3(const Cfg& cfg, char* lds, const int wid  , Pre& pre, const bool have_pre  , const Cfg* nxt  ) {
  const int lane = lane_id(), tid = wid * 64 + lane, r32 = lane & 31, hi = lane >> 5;
  constexpr int SD = 2;
  bf16* V_lds = (bf16*)lds; bf16* K_lds = (bf16*)(lds + 3 * SHM_V);
  float* ws = (float*)(lds + 3 * SHM_V + 3 * SHM_K) + wid * 64; float* li_l = ws; float* al_l = ws + 32;
  float m_reg = -1e30f, l_reg = 0; f32x16 o[4] = {}; bf16x8 qr[8];
  const bf16* Qw = cfg.proj + cfg.q_off(wid * QBLK + r32) + hi * 8;
  if (have_pre) {
#pragma unroll
    for (int d0 = 0; d0 < 8; ++d0) qr[d0] = pre.qr[d0];
  } else {
#pragma unroll
    for (int d0 = 0; d0 < 8; ++d0) qr[d0] = *reinterpret_cast<const bf16x8*>(Qw + d0 * 16);
  }
  const int sr = tid >> 4, sc = (tid & 15) * 8, vst0 = v_st(sr, sc), vst1 = v_st(32 + sr, sc);
  const int vb0 = (int)(uintptr_t)V_lds + v_rd_base(lane);
  struct { bf16x8 vs0, vs1, ks0, ks1; } sr_[SD];
#define SLOAD(i, t) do { const unsigned o0_ = cfg.kv_off((t), sr) + sc, o1_ = cfg.kv_off((t), 32 + sr) + sc; \
    sr_[i].vs0 = *reinterpret_cast<const bf16x8*>(cfg.proj + cfg.vcol + o0_); sr_[i].vs1 = *reinterpret_cast<const bf16x8*>(cfg.proj + cfg.vcol + o1_); \
    sr_[i].ks0 = *reinterpret_cast<const bf16x8*>(cfg.proj + cfg.kcol + o0_); sr_[i].ks1 = *reinterpret_cast<const bf16x8*>(cfg.proj + cfg.kcol + o1_); } while (0)
#define SWRITE(b, i) do { *(bf16x8*)((char*)V_lds + (b) * SHM_V + vst0) = sr_[i].vs0;          \
    *(bf16x8*)((char*)V_lds + (b) * SHM_V + vst1) = sr_[i].vs1; int kc = sc * 2;               \
    *(bf16x8*)((char*)K_lds + (b) * SHM_K + KSWZ(sr, kc)) = sr_[i].ks0;                       \
    *(bf16x8*)((char*)K_lds + (b) * SHM_K + KSWZ(32 + sr, kc)) = sr_[i].ks1; } while (0)
#define SWAIT() do { if constexpr (SD == 2) asm volatile("s_waitcnt vmcnt(4)" ::: "memory"); else asm volatile("s_waitcnt vmcnt(0)" ::: "memory"); } while (0)
#define RESC(a) do { if (!BOUNDED && __any((a) < 1.f)) { if (hi == 0) al_l[r32] = (a); asm volatile("s_waitcnt lgkmcnt(0)" ::: "memory"); \
    for (int d = 0; d < 4; ++d) for (int r = 0; r < 16; ++r) o[d][r] *= al_l[crow(r, hi)]; } } while (0)
#define QK(P0, P1, KB, T, MN, AL) do { if (cfg.active((T), wid)) { qkt(P0, P1, (KB), qr, r32, hi, BOUNDED ? cfg.negm0C : 0.f); cfg.mask(P0, P1, (T), wid, r32, hi); if constexpr (BOUNDED) { boundedSM(P0, P1); AL = 1.f; } else partialSM(P0, P1, m_reg, MN, AL); } else { AL = 1.f; } } while (0)
#define QK1(P0, P1, KB, T) do { if (cfg.active((T), wid)) { qkt(P0, P1, (KB), qr, r32, hi, BOUNDED ? cfg.negm0C : 0.f); cfg.mask(P0, P1, (T), wid, r32, hi); } } while (0)
#define PSM(P0, P1, T, MN, AL) do { if (cfg.active((T), wid)) { if constexpr (BOUNDED) { boundedSM(P0, P1); AL = 1.f; } else partialSM(P0, P1, m_reg, MN, AL); } else { AL = 1.f; } } while (0)
#define FPV(P0, P1, AL, VB, T) do { if (cfg.active((T), wid)) { finishSM(P0, P1, AL, l_reg, pa0, pa1, pa2, pa3); SBAR(); pv_d0(o, (VB), pa0, pa1, pa2, pa3); } } while (0)
  f32x16 pA0, pA1, pB0, pB1; float mnA, mnB, alA, alB; bf16x8 pa0, pa1, pa2, pa3; const int NT = Cfg::NT;
  constexpr int SE = 0, SO = SD - 1;
  if (have_pre) { sr_[SE].vs0 = pre.vs0; sr_[SE].vs1 = pre.vs1; sr_[SE].ks0 = pre.ks0; sr_[SE].ks1 = pre.ks1; } else SLOAD(SE, 0);
  asm volatile("s_waitcnt vmcnt(0)" ::: "memory"); SWRITE(0, SE); __syncthreads();
  QK(pA0, pA1, K_lds, 0, mnA, alA);
  SLOAD(SO, 1); if constexpr (SD == 2) { if (2 < NT) SLOAD(SE, 2); }
  SWAIT(); SWRITE(1, SO); __syncthreads();
  int bt = 1;
#define KB3(b_) ((bf16*)((char*)K_lds + (b_) * (int)SHM_K))
#define VB3(b_) (vb0 + (b_) * (int)SHM_V)
  for (int j = 1; j + 1 < NT; j += 2) {
    const int bn = (bt == 2) ? 0 : bt + 1, bm = (bt == 0) ? 2 : bt - 1;
    SBAR(); QK1(pB0, pB1, KB3(bt), j);
    if (cfg.active(j - 1, wid)) { finishSM(pA0, pA1, alA, l_reg, pa0, pa1, pa2, pa3); } SBAR();
    SLOAD(SO, j + SD); SBAR();
    if (cfg.active(j - 1, wid)) { pv_d0(o, VB3(bm), pa0, pa1, pa2, pa3); }
    PSM(pB0, pB1, j, mnB, alB);
    SWAIT(); SWRITE(bn, SE);
    RESC(alB); __syncthreads();
    SBAR(); QK1(pA0, pA1, KB3(bn), j + 1);
    if (cfg.active(j, wid)) { finishSM(pB0, pB1, alB, l_reg, pa0, pa1, pa2, pa3); } SBAR();
    if (j + 3 < NT) SLOAD(SE, j + 1 + SD); SBAR();
    if (cfg.active(j, wid)) { pv_d0(o, VB3(bt), pa0, pa1, pa2, pa3); }
    PSM(pA0, pA1, j + 1, mnA, alA);
    SWAIT(); SWRITE(bm, SO);
    RESC(alA); __syncthreads();
    bt = bm;
  }
  { const int bm = (bt == 0) ? 2 : bt - 1;
    SBAR(); QK1(pB0, pB1, KB3(bt), NT - 1);
    if (cfg.active(NT - 2, wid)) { finishSM(pA0, pA1, alA, l_reg, pa0, pa1, pa2, pa3); SBAR(); pv_d0(o, VB3(bm), pa0, pa1, pa2, pa3); }
    PSM(pB0, pB1, NT - 1, mnB, alB);
    RESC(alB);
    if (cfg.active(NT - 1, wid)) { finishSM(pB0, pB1, alB, l_reg, pa0, pa1, pa2, pa3); SBAR(); pv_d0(o, VB3(bt), pa0, pa1, pa2, pa3); } }
#undef KB3
#undef VB3
  if (hi == 0) li_l[r32] = l_reg; asm volatile("s_waitcnt lgkmcnt(0)" ::: "memory");
  if (Cfg::HAS_LSE) { if (hi == 0) cfg.store_lse(wid * QBLK + r32, m_reg * SCALE + __logf(l_reg)); }
  if (MK_PREFETCH_UNIT) {
    const bf16* Qn = nxt->proj + nxt->q_off(wid * QBLK + r32) + hi * 8;
#pragma unroll
    for (int d0 = 0; d0 < 8; ++d0) pre.qr[d0] = *reinterpret_cast<const bf16x8*>(Qn + d0 * 16);
    const unsigned o0_ = nxt->kv_off(0, sr) + sc, o1_ = nxt->kv_off(0, 32 + sr) + sc;
    pre.vs0 = *reinterpret_cast<const bf16x8*>(nxt->proj + nxt->vcol + o0_); pre.vs1 = *reinterpret_cast<const bf16x8*>(nxt->proj + nxt->vcol + o1_);
    pre.ks0 = *reinterpret_cast<const bf16x8*>(nxt->proj + nxt->kcol + o0_); pre.ks1 = *reinterpret_cast<const bf16x8*>(nxt->proj + nxt->kcol + o1_);
    asm volatile("" ::: "memory");
  }
  __syncthreads();
  { bf16* stg = (bf16*)lds + wid * 2048;
#pragma unroll
    for (int hh = 0; hh < 2; ++hh) {
#pragma unroll
      for (int r8 = 0; r8 < 8; ++r8) { const int r = 8 * hh + r8; const int orow = crow(r, hi); const float rl = __builtin_amdgcn_rcpf(li_l[orow]);
#pragma unroll
        for (int d0 = 0; d0 < 4; ++d0) stg[(orow & 15) * 128 + d0 * 32 + r32] = (bf16)(cvtpk(o[d0][r] * rl, 0.f) & 0xffffu); }
      asm volatile("s_waitcnt lgkmcnt(0)" ::: "memory");
#pragma unroll
      for (int j = 0; j < 4; ++j) { const int row = (lane >> 4) + 4 * j, ch = lane & 15; const u32x4 v = *(const u32x4*)(stg + row * 128 + ch * 8);
        const unsigned oo_ = cfg.o_off(wid * QBLK + 16 * hh + row); *(u32x4*)(cfg.obuf + oo_ + ch * 8) = v;
        if (MK_MIXFOLD) { const float q_ = rowsum16(ssq8(v));
          if (ch == 0) ((float*)((char*)cfg.obuf + MK_SSQ_FROM_O_BYTES))[(oo_ >> 11) * 16 + ((oo_ & 2047u) >> 7)] = q_; } }
      asm volatile("s_waitcnt lgkmcnt(0)" ::: "memory");
    } }
  __syncthreads();
#undef SLOAD
#undef SWRITE
#undef SWAIT
#undef RESC
#undef QK
#undef QK1
#undef PSM
#undef FPV
}

template <class Cfg, int SD = 2>
__device__ __forceinline__ void attn_unit_h(const Cfg& cfg, char* lds, const int wid  , Pre& pre, const bool have_pre  , const Cfg* nxt  ) {
  const int lane = lane_id(), tid = wid * 64 + lane, r32 = lane & 31, hi = lane >> 5;
  bf16* V_lds = (bf16*)lds; bf16* K_lds = (bf16*)(lds + 2 * SHM_V);
  float* ws = (float*)(lds + 2 * SHM_V + 2 * SHM_K) + wid * 64; float* li_l = ws; float* al_l = ws + 32;
  float m_reg = -1e30f, l_reg = 0; f32x16 o[4] = {}; bf16x8 qr[8];
  const bf16* Qw = cfg.proj + cfg.q_off(wid * QBLK + r32) + hi * 8;
  if (have_pre) {
#pragma unroll
    for (int d0 = 0; d0 < 8; ++d0) qr[d0] = pre.qr[d0];
  } else {
#pragma unroll
    for (int d0 = 0; d0 < 8; ++d0) qr[d0] = *reinterpret_cast<const bf16x8*>(Qw + d0 * 16);
  }
  const int sr = tid >> 4, sc = (tid & 15) * 8, vst0 = v_st(sr, sc), vst1 = v_st(32 + sr, sc);
  const int krow = cfg.kwin(wid) + r32;
  const int Ga = (cfg.kwin(wid) >> 3) + hi;
  const int vb0 = (int)(uintptr_t)V_lds + (v_rd_base(lane) & ~256) + ((Ga >> 1) << 12) + ((Ga & 1) << 8);
  struct { bf16x8 vs0, vs1, ks0, ks1; } sr_[SD];
#define SLOAD(i, t) do { const unsigned o0_ = cfg.kv_off((t), sr) + sc, o1_ = cfg.kv_off((t), 32 + sr) + sc; \
    sr_[i].vs0 = *reinterpret_cast<const bf16x8*>(cfg.proj + cfg.vcol + o0_); sr_[i].vs1 = *reinterpret_cast<const bf16x8*>(cfg.proj + cfg.vcol + o1_); \
    sr_[i].ks0 = *reinterpret_cast<const bf16x8*>(cfg.proj + cfg.kcol + o0_); sr_[i].ks1 = *reinterpret_cast<const bf16x8*>(cfg.proj + cfg.kcol + o1_); } while (0)
#define SWRITE(b, i) do { *(bf16x8*)((char*)V_lds + (b) * SHM_V + vst0) = sr_[i].vs0;          \
    *(bf16x8*)((char*)V_lds + (b) * SHM_V + vst1) = sr_[i].vs1; int kc = sc * 2;               \
    *(bf16x8*)((char*)K_lds + (b) * SHM_K + KSWZ(sr, kc)) = sr_[i].ks0;                       \
    *(bf16x8*)((char*)K_lds + (b) * SHM_K + KSWZ(32 + sr, kc)) = sr_[i].ks1; } while (0)
#define SWAIT() do { if constexpr (SD == 2) asm volatile("s_waitcnt vmcnt(4)" ::: "memory"); else asm volatile("s_waitcnt vmcnt(0)" ::: "memory"); } while (0)
#define RESC(a) do { if (__any((a) < 1.f)) { if (hi == 0) al_l[r32] = (a); asm volatile("s_waitcnt lgkmcnt(0)" ::: "memory"); \
    for (int d = 0; d < 4; ++d) for (int r = 0; r < 16; ++r) o[d][r] *= al_l[crow(r, hi)]; } } while (0)
#define QK(P0, KB, T, MN, AL) do { if (cfg.active((T), wid)) { qkt32(P0, (KB), qr, krow, hi); cfg.mask16(P0, (T), wid, r32, hi); partialSM1(P0, m_reg, MN, AL); } else { AL = 1.f; } } while (0)
#define QK1(P0, KB, T) do { if (cfg.active((T), wid)) { qkt32(P0, (KB), qr, krow, hi); cfg.mask16(P0, (T), wid, r32, hi); } } while (0)
#define PSM(P0, T, MN, AL) do { if (cfg.active((T), wid)) { partialSM1(P0, m_reg, MN, AL); } else { AL = 1.f; } } while (0)
  f32x16 pA0, pB0; float mnA, mnB, alA, alB; bf16x8 pa0, pa1; const int NT = Cfg::NT;
  constexpr int SE = 0, SO = SD - 1;
  if (have_pre) { sr_[SE].vs0 = pre.vs0; sr_[SE].vs1 = pre.vs1; sr_[SE].ks0 = pre.ks0; sr_[SE].ks1 = pre.ks1; } else SLOAD(SE, 0);
  asm volatile("s_waitcnt vmcnt(0)" ::: "memory"); SWRITE(0, SE); __syncthreads();
  QK(pA0, K_lds, 0, mnA, alA);
  SLOAD(SO, 1); if constexpr (SD == 2) { if (2 < NT) SLOAD(SE, 2); }
  SWAIT(); SWRITE(1, SO); __syncthreads();
  for (int j = 1; j + 1 < NT; j += 2) {
    SBAR(); QK1(pB0, (bf16*)((char*)K_lds + SHM_K), j);
    if (cfg.active(j - 1, wid)) { finishSM1(pA0, alA, l_reg, pa0, pa1); } SBAR();
    SLOAD(SO, j + SD); SBAR();
    if (cfg.active(j - 1, wid)) { pv_d0h(o, vb0, pa0, pa1); }
    PSM(pB0, j, mnB, alB);
    __syncthreads(); SWAIT(); SWRITE(0, SE);
    RESC(alB); __syncthreads();
    SBAR(); QK1(pA0, K_lds, j + 1);
    if (cfg.active(j, wid)) { finishSM1(pB0, alB, l_reg, pa0, pa1); } SBAR();
    if (SD == 1 || j + 3 < NT) SLOAD(SE, j + 1 + SD); SBAR();
    if (cfg.active(j, wid)) { pv_d0h(o, vb0 + (int)SHM_V, pa0, pa1); }
    PSM(pA0, j + 1, mnA, alA);
    __syncthreads(); SWAIT(); SWRITE(1, SO);
    RESC(alA); __syncthreads();
  }
  SBAR(); QK1(pB0, (bf16*)((char*)K_lds + SHM_K), NT - 1);
  if (cfg.active(NT - 2, wid)) { finishSM1(pA0, alA, l_reg, pa0, pa1); SBAR(); pv_d0h(o, vb0, pa0, pa1); }
  PSM(pB0, NT - 1, mnB, alB);
  __syncthreads(); RESC(alB);
  if (cfg.active(NT - 1, wid)) { finishSM1(pB0, alB, l_reg, pa0, pa1); SBAR(); pv_d0h(o, vb0 + (int)SHM_V, pa0, pa1); }
  if (hi == 0) li_l[r32] = l_reg; asm volatile("s_waitcnt lgkmcnt(0)" ::: "memory");
  if (Cfg::HAS_LSE) { if (hi == 0) cfg.store_lse(wid * QBLK + r32, m_reg * SCALE + __logf(l_reg)); }
  if (MK_PREFETCH_UNIT) {
    const bf16* Qn = nxt->proj + nxt->q_off(wid * QBLK + r32) + hi * 8;
#pragma unroll
    for (int d0 = 0; d0 < 8; ++d0) pre.qr[d0] = *reinterpret_cast<const bf16x8*>(Qn + d0 * 16);
    const unsigned o0_ = nxt->kv_off(0, sr) + sc, o1_ = nxt->kv_off(0, 32 + sr) + sc;
    pre.vs0 = *reinterpret_cast<const bf16x8*>(nxt->proj + nxt->vcol + o0_); pre.vs1 = *reinterpret_cast<const bf16x8*>(nxt->proj + nxt->vcol + o1_);
    pre.ks0 = *reinterpret_cast<const bf16x8*>(nxt->proj + nxt->kcol + o0_); pre.ks1 = *reinterpret_cast<const bf16x8*>(nxt->proj + nxt->kcol + o1_);
    asm volatile("" ::: "memory");
  }
  { bf16* stg = (bf16*)(lds + OSTAGE_OFF) + wid * 2048;
#pragma unroll
    for (int hh = 0; hh < 2; ++hh) {
#pragma unroll
      for (int r8 = 0; r8 < 8; ++r8) { const int r = 8 * hh + r8; const int orow = crow(r, hi); const float rl = __builtin_amdgcn_rcpf(li_l[orow]);
#pragma unroll
        for (int d0 = 0; d0 < 4; ++d0) stg[(orow & 15) * 128 + d0 * 32 + r32] = (bf16)(cvtpk(o[d0][r] * rl, 0.f) & 0xffffu); }
      asm volatile("s_waitcnt lgkmcnt(0)" ::: "memory");
#pragma unroll
      for (int j = 0; j < 4; ++j) { const int row = (lane >> 4) + 4 * j, ch = lane & 15; const u32x4 v = *(const u32x4*)(stg + row * 128 + ch * 8);
        const unsigned oo_ = cfg.o_off(wid * QBLK + 16 * hh + row); *(u32x4*)(cfg.obuf + oo_ + ch * 8) = v;
        if (MK_MIXFOLD) { const float q_ = rowsum16(ssq8(v));
          if (ch == 0) ((float*)((char*)cfg.obuf + MK_SSQ_FROM_O_BYTES))[(oo_ >> 11) * 16 + ((oo_ & 2047u) >> 7)] = q_; } }
      asm volatile("s_waitcnt lgkmcnt(0)" ::: "memory");
    } }
  __syncthreads();
#undef SLOAD
#undef SWRITE
#undef SWAIT
#undef RESC
#undef QK
#undef QK1
#undef PSM
}

template <class Cfg>
__device__ __forceinline__ void attn_unit_simple(const Cfg& cfg, char* lds, const int wid  ) {
  const int lane = lane_id(), tid = wid * 64 + lane, r32 = lane & 31, hi = lane >> 5;
  bf16* V_lds = (bf16*)lds; bf16* K_lds = (bf16*)(lds + 2 * SHM_V);
  float* ws = (float*)(lds + 2 * SHM_V + 2 * SHM_K) + wid * 64; float* li_l = ws; float* al_l = ws + 32;
  float m_reg = -1e30f, l_reg = 0; f32x16 o[4] = {}; bf16x8 qr[8];
  const bf16* Qw = cfg.proj + cfg.q_off(wid * QBLK + r32) + hi * 8;
#pragma unroll
  for (int d0 = 0; d0 < 8; ++d0) qr[d0] = *reinterpret_cast<const bf16x8*>(Qw + d0 * 16);
  const int sr = tid >> 4, sc = (tid & 15) * 8, vst0 = v_st(sr, sc), vst1 = v_st(32 + sr, sc);
  const int vb0 = (int)(uintptr_t)V_lds + v_rd_base(lane);
  bf16x8 vs0, vs1, ks0, ks1;
#define SLOAD1(t) do { const unsigned o0_ = cfg.kv_off((t), sr) + sc, o1_ = cfg.kv_off((t), 32 + sr) + sc; \
    vs0 = *reinterpret_cast<const bf16x8*>(cfg.proj + cfg.vcol + o0_); vs1 = *reinterpret_cast<const bf16x8*>(cfg.proj + cfg.vcol + o1_); \
    ks0 = *reinterpret_cast<const bf16x8*>(cfg.proj + cfg.kcol + o0_); ks1 = *reinterpret_cast<const bf16x8*>(cfg.proj + cfg.kcol + o1_); } while (0)
#define SWRITE1(b) do { *(bf16x8*)((char*)V_lds + (b) * SHM_V + vst0) = vs0; *(bf16x8*)((char*)V_lds + (b) * SHM_V + vst1) = vs1; const int kc = sc * 2; \
    *(bf16x8*)((char*)K_lds + (b) * SHM_K + KSWZ(sr, kc)) = ks0; *(bf16x8*)((char*)K_lds + (b) * SHM_K + KSWZ(32 + sr, kc)) = ks1; } while (0)
  const int tb = cfg.t_begin(), te = cfg.t_end();
  SLOAD1(tb); asm volatile("s_waitcnt vmcnt(0)" ::: "memory"); SWRITE1(tb & 1); __syncthreads();
  for (int t = tb; t < te; ++t) {
    const int b = t & 1;
    if (t + 1 < te) SLOAD1(t + 1);
    SBAR();
    if (cfg.active(t, wid)) {
      f32x16 p0, p1; float mn, al; bf16x8 pa0, pa1, pa2, pa3;
      qkt(p0, p1, (bf16*)((char*)K_lds + b * SHM_K), qr, r32, hi);
      cfg.mask(p0, p1, t, wid, r32, hi);
      partialSM(p0, p1, m_reg, mn, al);
      if (__any(al < 1.f)) { if (hi == 0) al_l[r32] = al; asm volatile("s_waitcnt lgkmcnt(0)" ::: "memory");
#pragma unroll
        for (int d = 0; d < 4; ++d)
#pragma unroll
          for (int r = 0; r < 16; ++r) o[d][r] *= al_l[crow(r, hi)]; }
      finishSM(p0, p1, al, l_reg, pa0, pa1, pa2, pa3); SBAR();
      pv_d0(o, vb0 + b * (int)SHM_V, pa0, pa1, pa2, pa3);
    }
    SBAR();
    if (t + 1 < te) { asm volatile("s_waitcnt vmcnt(0)" ::: "memory"); SWRITE1(b ^ 1); }
    __syncthreads();
  }
  if (hi == 0) li_l[r32] = l_reg; asm volatile("s_waitcnt lgkmcnt(0)" ::: "memory");
  if (Cfg::HAS_LSE) { if (hi == 0) cfg.store_lse(wid * QBLK + r32, m_reg * SCALE + __logf(l_reg)); }
  { bf16* stg = (bf16*)(lds + OSTAGE_OFF) + wid * 2048;
#pragma unroll
    for (int hh = 0; hh < 2; ++hh) {
#pragma unroll
      for (int r8 = 0; r8 < 8; ++r8) { const int r = 8 * hh + r8; const int orow = crow(r, hi); const float rl = __builtin_amdgcn_rcpf(li_l[orow]);
#pragma unroll
        for (int d0 = 0; d0 < 4; ++d0) stg[(orow & 15) * 128 + d0 * 32 + r32] = (bf16)(cvtpk(o[d0][r] * rl, 0.f) & 0xffffu); }
      asm volatile("s_waitcnt lgkmcnt(0)" ::: "memory");
#pragma unroll
      for (int j = 0; j < 4; ++j) { const int row = (lane >> 4) + 4 * j, ch = lane & 15; const u32x4 v = *(const u32x4*)(stg + row * 128 + ch * 8);
        const unsigned oo_ = cfg.o_off(wid * QBLK + 16 * hh + row); *(u32x4*)(cfg.obuf + oo_ + ch * 8) = v;
        if (MK_MIXFOLD) { const float q_ = rowsum16(ssq8(v));
          if (ch == 0) ((float*)((char*)cfg.obuf + MK_SSQ_FROM_O_BYTES))[(oo_ >> 11) * 16 + ((oo_ & 2047u) >> 7)] = q_; } }
      asm volatile("s_waitcnt lgkmcnt(0)" ::: "memory");
    } }
  __syncthreads();
#undef SLOAD1
#undef SWRITE1
}

template <class Cfg>
__device__ __forceinline__ void attn_unit_wave(const Cfg& cfg, char* lds, const int wid  ) {
  const int lane = lane_id(), r32 = lane & 31, hi = lane >> 5;
  char* Vw = lds + wid * 8192;
  float* ws = (float*)(lds + 2 * SHM_V + 2 * SHM_K) + wid * 64; float* li_l = ws; float* al_l = ws + 32;
  float m_reg = -1e30f, l_reg = 0; f32x16 o[4] = {}; bf16x8 qr[8];
  const bf16* Qw = cfg.proj + cfg.q_off(wid * QBLK + r32) + hi * 8;
#pragma unroll
  for (int d0 = 0; d0 < 8; ++d0) qr[d0] = *reinterpret_cast<const bf16x8*>(Qw + d0 * 16);
  const int vkey = lane >> 4, vch = (lane & 15) * 8;
  const int vb0 = (int)(uintptr_t)Vw + v_rd_base(lane);
  const int tb = cfg.t_begin(), te = cfg.t_end();
  for (int t = tb; t < te; ++t) {
    if (!cfg.active(t, wid)) continue;
    bf16x8 kf[16], vf[8];
    { const bf16* k0p = cfg.proj + cfg.kcol + cfg.kv_off(t, r32) + hi * 8; const bf16* k1p = cfg.proj + cfg.kcol + cfg.kv_off(t, 32 + r32) + hi * 8;
#pragma unroll
      for (int d0 = 0; d0 < 8; ++d0) { kf[2 * d0] = *reinterpret_cast<const bf16x8*>(k0p + d0 * 16); kf[2 * d0 + 1] = *reinterpret_cast<const bf16x8*>(k1p + d0 * 16); } }
#pragma unroll
    for (int j = 0; j < 8; ++j) vf[j] = *reinterpret_cast<const bf16x8*>(cfg.proj + cfg.vcol + cfg.kv_off(t, vkey + 4 * j) + vch);
    f32x16 p0 = {}, p1 = {};
#pragma unroll
    for (int d0 = 0; d0 < 8; ++d0) { p0 = __builtin_amdgcn_mfma_f32_32x32x16_bf16(kf[2 * d0], qr[d0], p0, 0, 0, 0); p1 = __builtin_amdgcn_mfma_f32_32x32x16_bf16(kf[2 * d0 + 1], qr[d0], p1, 0, 0, 0); }
    cfg.mask(p0, p1, t, wid, r32, hi);
    float mn, al; bf16x8 pa0, pa1, pa2, pa3;
    partialSM(p0, p1, m_reg, mn, al);
    if (__any(al < 1.f)) { if (hi == 0) al_l[r32] = al; asm volatile("s_waitcnt lgkmcnt(0)" ::: "memory");
#pragma unroll
      for (int d = 0; d < 4; ++d)
#pragma unroll
        for (int r = 0; r < 16; ++r) o[d][r] *= al_l[crow(r, hi)]; }
    finishSM(p0, p1, al, l_reg, pa0, pa1, pa2, pa3);
#pragma unroll
    for (int j = 0; j < 8; ++j) *(bf16x8*)(Vw + v_st(vkey + 4 * j, vch)) = vf[j];
#pragma unroll
    for (int j = 0; j < 8; ++j) vf[j] = *reinterpret_cast<const bf16x8*>(cfg.proj + cfg.vcol + cfg.kv_off(t, 32 + vkey + 4 * j) + vch);
    asm volatile("s_waitcnt lgkmcnt(0)" ::: "memory"); SBAR();
#define PVW(D0, PA, PB) do { const s16x4 l0 = tr_read<v_rd_off(D0, 0, 0)>(vb0), h0 = tr_read<v_rd_off(D0, 0, 1)>(vb0), l1 = tr_read<v_rd_off(D0, 1, 0)>(vb0), h1 = tr_read<v_rd_off(D0, 1, 1)>(vb0); \
      asm volatile("s_waitcnt lgkmcnt(0)" ::: "memory"); SBAR(); \
      o[D0] = __builtin_amdgcn_mfma_f32_32x32x16_bf16(PA, ((bf16x8){l0[0], l0[1], l0[2], l0[3], h0[0], h0[1], h0[2], h0[3]}), o[D0], 0, 0, 0); \
      o[D0] = __builtin_amdgcn_mfma_f32_32x32x16_bf16(PB, ((bf16x8){l1[0], l1[1], l1[2], l1[3], h1[0], h1[1], h1[2], h1[3]}), o[D0], 0, 0, 0); } while (0)
    PVW(0, pa0, pa1); PVW(1, pa0, pa1); PVW(2, pa0, pa1); PVW(3, pa0, pa1);
    SBAR();
#pragma unroll
    for (int j = 0; j < 8; ++j) *(bf16x8*)(Vw + v_st(vkey + 4 * j, vch)) = vf[j];
    asm volatile("s_waitcnt lgkmcnt(0)" ::: "memory"); SBAR();
    PVW(0, pa2, pa3); PVW(1, pa2, pa3); PVW(2, pa2, pa3); PVW(3, pa2, pa3);
    SBAR();
#undef PVW
  }
  if (hi == 0) li_l[r32] = l_reg; asm volatile("s_waitcnt lgkmcnt(0)" ::: "memory");
  if (Cfg::HAS_LSE) { if (hi == 0) cfg.store_lse(wid * QBLK + r32, m_reg * SCALE + __logf(l_reg)); }
  { bf16* stg = (bf16*)(lds + OSTAGE_OFF) + wid * 2048;
#pragma unroll
    for (int hh = 0; hh < 2; ++hh) {
#pragma unroll
      for (int r8 = 0; r8 < 8; ++r8) { const int r = 8 * hh + r8; const int orow = crow(r, hi); const float rl = __builtin_amdgcn_rcpf(li_l[orow]);
#pragma unroll
        for (int d0 = 0; d0 < 4; ++d0) stg[(orow & 15) * 128 + d0 * 32 + r32] = (bf16)(cvtpk(o[d0][r] * rl, 0.f) & 0xffffu); }
      asm volatile("s_waitcnt lgkmcnt(0)" ::: "memory");
#pragma unroll
      for (int j = 0; j < 4; ++j) { const int row = (lane >> 4) + 4 * j, ch = lane & 15; const u32x4 v = *(const u32x4*)(stg + row * 128 + ch * 8);
        const unsigned oo_ = cfg.o_off(wid * QBLK + 16 * hh + row); *(u32x4*)(cfg.obuf + oo_ + ch * 8) = v;
        if (MK_MIXFOLD) { const float q_ = rowsum16(ssq8(v));
          if (ch == 0) ((float*)((char*)cfg.obuf + MK_SSQ_FROM_O_BYTES))[(oo_ >> 11) * 16 + ((oo_ & 2047u) >> 7)] = q_; } }
      asm volatile("s_waitcnt lgkmcnt(0)" ::: "memory");
    } }
}
#undef KSWZ
#undef SBAR
}

constexpr int NWAVES = 8;
constexpr int NTOK = 49152, SEQ = 4096, NSEQ = 12, NTOK_P = 16384;
constexpr int DM = 2048, INW = 5632, DFF = 8192, NLAYER = 4, HD = 128;
constexpr int COL_AQ = 0, COL_AK = 512, COL_AV = 768, COL_BQ = 1024, COL_BK = 1792, COL_BV = 2560, COL_CQ = 3328, COL_CK = 4096, COL_CV = 4864;
constexpr int OCOL_A = 0, OCOL_B = 512, OCOL_C = 1280;
constexpr float DN_ALPHA = 1.681792830507429f;
constexpr float EPS = 1e-6f;
constexpr float ATT_SCALE = 0.08838834764831845f;
#ifndef MK_BF16_RES
#define MK_BF16_RES 1
#endif
#ifndef MK_FUSE_PREP
#define MK_FUSE_PREP 1
#endif
#ifndef MK_BOUNDED_A
#define MK_BOUNDED_A 1
#endif
#ifndef MK_FIN_PHASES
#define MK_FIN_PHASES 0
#endif
#ifndef MK_TILED_H
#define MK_TILED_H 1
#endif
#ifndef MK_WGM_RES
#define MK_WGM_RES 4
#endif

constexpr size_t MiB = 1u << 20;
constexpr size_t WS_CTL = 0, CTL_ZERO_BYTES = 1 * MiB;
constexpr size_t WS_ROPE_B = 1 * MiB;
constexpr size_t WS_ROPE_A = 3 * MiB;
constexpr size_t WS_LSE    = 4 * MiB;
constexpr size_t WS_WIN    = 6 * MiB;
constexpr size_t WS_WOUT   = 28 * MiB;
constexpr size_t WS_WFF1   = 36 * MiB;
constexpr size_t WS_WFF2   = 68 * MiB;
constexpr size_t WS_XB     = 100 * MiB;
constexpr size_t WS_PROJ   = 292 * MiB;
constexpr size_t WS_O      = 820 * MiB;
constexpr size_t WS_H      = 292 * MiB;
constexpr size_t WS_PART   = 1060 * MiB;
constexpr size_t WS_STAT   = 1072 * MiB;
constexpr size_t WS_VEC    = 1073 * MiB;
constexpr size_t WS_PSB    = 1074 * MiB;
constexpr size_t WS_END    = 1078 * MiB;
constexpr size_t WS_SSQ    = 1012 * MiB;
constexpr size_t WS_RAT    = 1016 * MiB;
static_assert(WS_SSQ == WS_O + (size_t)NTOK * DM * 2 && WS_SSQ - WS_O == (size_t)MK_SSQ_FROM_O_BYTES && WS_SSQ + (size_t)NTOK * 16 * 4 <= WS_RAT && WS_RAT + (size_t)NTOK * 8 * 4 <= WS_PART, "SSQ / RAT placement");
static_assert(WS_PROJ + (size_t)NTOK * INW * 2 == WS_O && WS_O + (size_t)NTOK * DM * 2 <= WS_END && WS_H + (size_t)NTOK * DFF * 2 == WS_PART && WS_XB + (size_t)NTOK * DM * 2 == WS_PROJ, "d_ws map");
constexpr int CW_TMO = 0, CW_CODE = 1, CW_BAR = 4096;
constexpr int CW_ATTQ = 16384;
constexpr int NCOLP = INW + DFF, VEC_CS_IN = 0, VEC_BW_IN = INW, VEC_CS_FF1 = 2 * INW, VEC_BW_FF1 = 2 * INW + DFF, VEC_ONES = 2 * INW + 2 * DFF, VEC_ZEROS = VEC_ONES + DM, VEC_M0 = VEC_ZEROS + DM;
static_assert((size_t)(VEC_M0 + 16) * 4 <= MiB && (size_t)2 * 32 * NCOLP * 4 <= 4 * MiB && (size_t)NTOK * 8 <= MiB, "small buffers");

constexpr int RING_OFF = 0, RING_BYTES = 131072;
constexpr int LDSCTL_OFF = RING_BYTES, MISC_OFF = LDSCTL_OFF + 320;
constexpr int XCH_OFF = RING_BYTES + 1024;
constexpr int KTAB_OFF = XCH_OFF;
constexpr int STG_OFF = XCH_OFF + 8192;
constexpr int LDS_BYTES = 148480;
static_assert(MISC_OFF + 128 <= XCH_OFF && XCH_OFF + 8192 <= LDS_BYTES && KTAB_OFF + 16384 <= LDS_BYTES, "LDS map");

__host__ __device__ __forceinline__ int pinv_A(int c) { const int half = c >> 6, w = c & 63, hi = w >> 5, i = w & 31; return 8 * (half * 8 + (i >> 2)) + hi * 4 + (i & 3); }
__host__ __device__ __forceinline__ int pinv_B(int c) { const int hi = c >> 6, i = c & 63; return 8 * (i >> 2) + hi * 4 + (i & 3); }
__host__ __device__ __forceinline__ int proj_phys_col(int n) {
#if MK_FUSE_PREP
    if (n < COL_AV) return (n & ~127) + pinv_A(n & 127);
    if (n >= COL_BQ && n < COL_BV) return (n & ~127) + pinv_B(n & 127);
#endif
    return n;
}

struct Frame {
    LAS unsigned char* lds;
    volatile LAS unsigned* MISC;
    gu32* ctl;
    int wave;
    int vcu, G;
    int gw, NGW;
    const float *x_prompt, *x_sample, *w_in, *a_q_gain, *a_k_gain, *c_rel_bias, *mix_gain, *w_out, *ln1_g, *ln1_b, *w_ff1, *w_ff2, *ln2_g, *ln2_b;
    float* X;
    bf16 *Win_t, *Wout_t, *Wff1_t, *Wff2_t;
    bf16 *XB, *PROJ, *O, *H;
    float* LSE; float* ROPE_B; float* ROPE_A;
    pg8::f32x2* PART; pg8::f32x2* STAT; float* VEC; float* PSB;
    float* SSQ; float* RAT;
};

constexpr int CW_SB = 32768;
__device__ __forceinline__ void sb_arrive(Frame& F, int k) {
    asm volatile("s_waitcnt vmcnt(0)" ::: "memory");
    __syncthreads();
    if (F.wave == 0 && lane_id() == 0) {
        __builtin_amdgcn_fence(__ATOMIC_RELEASE, "agent");
        asm volatile("s_waitcnt vmcnt(0)" ::: "memory");
        (void)__hip_atomic_fetch_add(F.ctl + CW_SB + 64 * k, 1u, RLX_AGENT);
    }
}
__device__ __forceinline__ void sb_wait(Frame& F, int k) {
    if (F.wave == 0 && lane_id() == 0) {
        gu32* w = F.ctl + CW_SB + 64 * k; const unsigned want = (unsigned)F.G; unsigned sp = 0u;
        while (__hip_atomic_load(w, RLX_AGENT) < want) { __builtin_amdgcn_s_sleep(2);
            if ((++sp & 1023u) == 0u) { if (__hip_atomic_load(F.ctl + CW_TMO, RLX_AGENT) != 0u) break; if (sp > (1u << 22)) { __hip_atomic_store(F.ctl + CW_TMO, 1u, RLX_AGENT); break; } } }
        __builtin_amdgcn_fence(__ATOMIC_ACQUIRE, "agent");
        asm volatile("s_waitcnt vmcnt(0)" ::: "memory");
    }
    __syncthreads();
}

__device__ __forceinline__ float wave_sum(float v) {
    v += xshfl<1>(v); v += xshfl<2>(v); v += xshfl<4>(v); v += xshfl<8>(v); v += xshfl<16>(v); v = xsum32(v);
    return v;
}
__device__ __forceinline__ float wave_max(float v) {
    v = fmaxf(v, xshfl<1>(v)); v = fmaxf(v, xshfl<2>(v)); v = fmaxf(v, xshfl<4>(v)); v = fmaxf(v, xshfl<8>(v)); v = fmaxf(v, xshfl<16>(v)); v = xmax32(v);
    return v;
}
__device__ __forceinline__ float bf2f(unsigned short b) { return __builtin_bit_cast(float, (unsigned)b << 16); }
__device__ __forceinline__ float bflo(unsigned w) { return __builtin_bit_cast(float, w << 16); }
__device__ __forceinline__ float bfhi(unsigned w) { return __builtin_bit_cast(float, w & 0xffff0000u); }

struct ConvItem { const float* W; bf16* WT; const float* g; const float* bvec; float* ps; float* pb; int K, N, kb, n0, perm, pad_; };
struct ConvRegs { f32x4 wv[8]; float gk[8], bk[8]; };
__device__ __forceinline__ void conv_load(const ConvItem& it, ConvRegs& r, int lane) {
    const int k0 = 64 * it.kb, c = lane & 7;
#pragma unroll
    for (int i = 0; i < 8; ++i) r.wv[i] = *(const GAS f32x4*)(it.W + (size_t)(k0 + (lane >> 3) + 8 * i) * it.N + it.n0 + 4 * (lane & 7));
#pragma unroll
    for (int i = 0; i < 8; ++i) { r.gk[i] = it.g ? it.g[k0 + 8 * c + i] : 1.f; r.bk[i] = it.bvec ? it.bvec[k0 + 8 * c + i] : 0.f; }
}
__device__ __forceinline__ void conv_finish(const ConvItem& it, const ConvRegs& r, LAS float* scr, int lane) {
    const int k0 = 64 * it.kb, c = lane & 7;
#pragma unroll
    for (int i = 0; i < 8; ++i) { LAS float* d = scr + ((lane >> 3) + 8 * i) * 33 + 4 * (lane & 7); d[0] = r.wv[i].x; d[1] = r.wv[i].y; d[2] = r.wv[i].z; d[3] = r.wv[i].w; }
    LDS_WAIT(); asm volatile("" ::: "memory");
#pragma unroll
    for (int j = 0; j < 4; ++j) { const int n = (lane >> 3) + 8 * j; const LAS float* s = scr + (8 * c) * 33 + n;
        float w[8];
#pragma unroll
        for (int i = 0; i < 8; ++i) w[i] = s[i * 33];
        v4u o; o.x = pk2(w[0] * r.gk[0], w[1] * r.gk[1]); o.y = pk2(w[2] * r.gk[2], w[3] * r.gk[3]); o.z = pk2(w[4] * r.gk[4], w[5] * r.gk[5]); o.w = pk2(w[6] * r.gk[6], w[7] * r.gk[7]);
        const int nd = it.perm ? proj_phys_col(it.n0 + n) : it.n0 + n;
        if (MK_TILED_W) *(GAS v4u*)(it.WT + ((size_t)(nd >> 8) * (it.K >> 6) + (k0 >> 6)) * 16384 + (nd & 255) * 64 + 8 * c) = o;
        else *(GAS v4u*)(it.WT + (size_t)nd * it.K + k0 + 8 * c) = o;
        if (it.ps) { float sa = ((bflo(o.x) + bfhi(o.x)) + (bflo(o.y) + bfhi(o.y))) + ((bflo(o.z) + bfhi(o.z)) + (bflo(o.w) + bfhi(o.w)));
            float sb = 0.f;
#pragma unroll
            for (int i = 0; i < 8; ++i) sb += w[i] * r.bk[i];
            sa += xshfl<1>(sa); sa += xshfl<2>(sa); sa += xshfl<4>(sa); sb += xshfl<1>(sb); sb += xshfl<2>(sb); sb += xshfl<4>(sb);
            if (c == 0) { it.ps[(size_t)it.kb * NCOLP + nd] = sa; it.pb[(size_t)it.kb * NCOLP + nd] = sb; } } }
    LDS_WAIT(); asm volatile("" ::: "memory");
}
__device__ __forceinline__ void convert_weights(Frame& F, int l, int l_in, int which, int gw, int ngw) {
    const int lane = lane_id();
    LAS float* scr = (LAS float*)(F.lds + RING_OFF + F.wave * 16384);
    constexpr int I_IN = (DM / 64) * (INW / 32), I_OUT = (DM / 64) * (DM / 32), I_F1 = (DM / 64) * (DFF / 32), I_F2 = (DFF / 64) * (DM / 32);
    const int n_in = (which & 1) ? I_IN : 0, n_rest = (which & 2) ? (I_OUT + I_F1 + I_F2) : 0, n_all = n_in + n_rest;
    const float* w_in = F.w_in + (size_t)l_in * DM * INW; const float* w_out = F.w_out + (size_t)l * DM * DM;
    const float* w_ff1 = F.w_ff1 + (size_t)l * DM * DFF; const float* w_ff2 = F.w_ff2 + (size_t)l * DFF * DM;
    const float* gin = (l_in > 0) ? F.ln2_g + (size_t)(l_in - 1) * DM : nullptr; const float* bin = (l_in > 0) ? F.ln2_b + (size_t)(l_in - 1) * DM : nullptr;
    float* ps = F.PSB; float* pb = F.PSB + (size_t)32 * NCOLP;
#define CONV_MAKE(IT, idx) do { int r_ = (idx); \
        if (r_ < n_in) { const int nblk_ = INW / 32; IT.W = w_in; IT.WT = F.Win_t; IT.g = gin; IT.bvec = bin; IT.ps = ps; IT.pb = pb; IT.K = DM; IT.N = INW; IT.kb = r_ / nblk_; IT.n0 = 32 * (r_ % nblk_); IT.perm = 1; } \
        else { r_ -= n_in; \
          if (r_ < I_OUT) { const int nblk_ = DM / 32; IT.W = w_out; IT.WT = F.Wout_t; IT.g = MK_MIXFOLD ? F.mix_gain + (size_t)l * DM : nullptr; IT.bvec = nullptr; IT.ps = nullptr; IT.pb = nullptr; IT.K = DM; IT.N = DM; IT.kb = r_ / nblk_; IT.n0 = 32 * (r_ % nblk_); IT.perm = 0; } \
          else { r_ -= I_OUT; \
            if (r_ < I_F1) { const int nblk_ = DFF / 32; IT.W = w_ff1; IT.WT = F.Wff1_t; IT.g = F.ln1_g + (size_t)l * DM; IT.bvec = F.ln1_b + (size_t)l * DM; IT.ps = ps + INW; IT.pb = pb + INW; IT.K = DM; IT.N = DFF; IT.kb = r_ / nblk_; IT.n0 = 32 * (r_ % nblk_); IT.perm = 0; } \
            else { r_ -= I_F1; const int nblk_ = DM / 32; IT.W = w_ff2; IT.WT = F.Wff2_t; IT.g = nullptr; IT.bvec = nullptr; IT.ps = nullptr; IT.pb = nullptr; IT.K = DFF; IT.N = DM; IT.kb = r_ / nblk_; IT.n0 = 32 * (r_ % nblk_); IT.perm = 0; } } } } while (0)
    if (gw >= n_all) return;
    ConvItem cur; cur.pad_ = 0; ConvRegs rn; CONV_MAKE(cur, gw); conv_load(cur, rn, lane);
    for (int it = gw; it < n_all; it += ngw) {
        ConvRegs rc = rn; ConvItem nxt = cur; const bool has_next = it + ngw < n_all;
        if (has_next) { CONV_MAKE(nxt, it + ngw); conv_load(nxt, rn, lane); }
        asm volatile("" ::: "memory");
        conv_finish(cur, rc, scr, lane);
        cur = nxt;
    }
#undef CONV_MAKE
}
__device__ __forceinline__ void reduce_colsums(Frame& F, int which) {
    const int lane = lane_id();
    const float* ps = F.PSB; const float* pb = F.PSB + (size_t)32 * NCOLP;
    for (int n = F.gw * 64 + lane; n < NCOLP; n += F.NGW * 64) {
        const bool is_in = n < INW; if (is_in ? !(which & 1) : !(which & 2)) continue;
        float a = 0.f, c = 0.f;
#pragma unroll 8
        for (int kb = 0; kb < 32; ++kb) { a += ps[(size_t)kb * NCOLP + n]; c += pb[(size_t)kb * NCOLP + n]; }
        if (is_in) { F.VEC[VEC_CS_IN + n] = a; F.VEC[VEC_BW_IN + n] = c; } else { F.VEC[VEC_CS_FF1 + n - INW] = a; F.VEC[VEC_BW_FF1 + n - INW] = c; }
    }
}
__device__ __forceinline__ void phase_finalize_stats(Frame& F) {
    const int lane = lane_id();
    for (int m = F.gw * 64 + lane; m < NTOK; m += F.NGW * 64) {
        const f32x4* p = (const f32x4*)(F.PART + (size_t)m * 32); float s = 0.f, q = 0.f;
#pragma unroll
        for (int i = 0; i < 16; ++i) { const f32x4 v = p[i]; s += v.x + v.z; q += v.y + v.w; }
        const float mean = s * (1.f / DM); const float var = fmaxf(q * (1.f / DM) - mean * mean, 0.f);
        F.STAT[m] = (pg8::f32x2){mean, 1.f / sqrtf(var + EPS)};
    }
}
struct StatRegs { f32x4 v[8]; };
__device__ __forceinline__ void stats_load(Frame& F, int pm, StatRegs& r) {
    const int tid = F.wave * 64 + lane_id(); const int row = pm * 256 + (tid >> 1), half = tid & 1;
    const f32x4* p = (const f32x4*)(F.PART + (size_t)row * 32 + half * 16);
#pragma unroll
    for (int i = 0; i < 8; ++i) r.v[i] = p[i];
}
__device__ __forceinline__ void stats_finish(Frame& F, int pm, const StatRegs& r) {
    const int tid = F.wave * 64 + lane_id(); const int row = pm * 256 + (tid >> 1), half = tid & 1;
    float s = 0.f, q = 0.f;
#pragma unroll
    for (int i = 0; i < 8; ++i) { const f32x4 v = r.v[i]; s += v.x + v.z; q += v.y + v.w; }
    s += xshfl<1>(s); q += xshfl<1>(q);
    const float mean = s * (1.f / DM); const float var = fmaxf(q * (1.f / DM) - mean * mean, 0.f);
    if (half == 0) F.STAT[row] = (pg8::f32x2){mean, 1.f / sqrtf(var + EPS)};
}
__device__ __forceinline__ void stats_panel(Frame& F, int pm) { StatRegs r; stats_load(F, pm, r); stats_finish(F, pm, r); }
#define STATS_PREAMBLE(S) do { pg8::Unit u_; int last_ = -1; for (int i_ = 0; (S).next(i_, u_); ++i_) if (u_.pm != last_) { last_ = u_.pm; stats_panel(F, u_.pm); } \
        asm volatile("s_waitcnt vmcnt(0)" ::: "memory"); __syncthreads(); } while (0)

struct RatRegs { f32x4 s0, s1, s2, s3, l0, l1; };
__device__ __forceinline__ void rat_load(Frame& F, int pm, RatRegs& r) {
    const int row = pm * 256 + (F.wave & 3) * 64 + lane_id();
    const f32x4* sp = (const f32x4*)(F.SSQ + (size_t)row * 16); r.s0 = sp[0]; r.s1 = sp[1]; r.s2 = sp[2]; r.s3 = sp[3];
    const f32x4* lp = (const f32x4*)(F.LSE + (size_t)row * 8); r.l0 = lp[0]; r.l1 = lp[1];
}
__device__ __forceinline__ void softmax3(float a0, float a1, float a2, float& p0, float& p1, float& p2) {
    const float mx = fmaxf(a0, fmaxf(a1, a2)); const float e0 = __expf(a0 - mx), e1 = __expf(a1 - mx), e2 = __expf(a2 - mx); const float inv = 1.0f / (e0 + e1 + e2); p0 = e0 * inv; p1 = e1 * inv; p2 = e2 * inv;
}
__device__ __forceinline__ void rat_finish(Frame& F, int pm, const RatRegs& r) {
    const int row = pm * 256 + (F.wave & 3) * 64 + lane_id();
    const f32x4 s0 = r.s0, s1 = r.s1, s2 = r.s2, s3 = r.s3, l0 = r.l0, l1 = r.l1;
    float al0, al1, al2, al3, al4, al5;
    softmax3(l0.x, l0.z, l1.x, al0, al2, al4); softmax3(l0.y, l0.w, l1.y, al1, al3, al5);
    const float wB = ((al0 * al0 * s1.x + al1 * al1 * s1.y) + (al2 * al2 * s1.z + al3 * al3 * s1.w)) + (al4 * al4 * s2.x + al5 * al5 * s2.y);
    const float rA = 1.0f / sqrtf(((s0.x + s0.y) + (s0.z + s0.w)) * (1.0f / 512.f) + EPS), rB = 1.0f / sqrtf(wB * (1.0f / 768.f) + EPS);
    const float rC = 1.0f / sqrtf(((s2.z + s2.w) + (s3.x + s3.y) + (s3.z + s3.w)) * (1.0f / 768.f) + EPS);
    const float g0 = rA, g1 = fmaxf(al0, 1e-20f) * rB, g2 = fmaxf(al1, 1e-20f) * rB, g3 = fmaxf(al2, 1e-20f) * rB, g4 = fmaxf(al3, 1e-20f) * rB, g5 = fmaxf(al4, 1e-20f) * rB, g6 = fmaxf(al5, 1e-20f) * rB, g7 = rC;
    f32x4* op = (f32x4*)(F.RAT + (size_t)row * 8);
    op[0] = (f32x4){g0 / g1, g1 / g2, g2 / g3, g3 / g4}; op[1] = (f32x4){g4 / g5, g5 / g6, g6 / g7, g7};
}
#define RAT_PREAMBLE(S) do { const int h_ = F.wave >> 2; \
        for (int i0_ = 0; ; i0_ += 6) { pg8::Unit u0_, u1_, u2_, ud_; const bool k0_ = (S).next(i0_ + h_, u0_), k1_ = (S).next(i0_ + 2 + h_, u1_), k2_ = (S).next(i0_ + 4 + h_, u2_); \
            if (k0_) { const int q0_ = u0_.pm, q1_ = k1_ ? u1_.pm : q0_, q2_ = k2_ ? u2_.pm : q0_;     \
                RatRegs r0_, r1_, r2_; rat_load(F, q0_, r0_); rat_load(F, q1_, r1_); rat_load(F, q2_, r2_); \
                asm volatile("" ::: "memory"); \
                rat_finish(F, q0_, r0_); rat_finish(F, q1_, r1_); rat_finish(F, q2_, r2_); } \
            if (!(S).next(i0_ + 6, ud_)) break; } \
        asm volatile("s_waitcnt vmcnt(0)" ::: "memory"); __syncthreads(); } while (0)

__device__ __forceinline__ void sincos_d(double a, float& c, float& s) {
    const double k = __builtin_rint(a * 0.6366197723675814);
    const double r = __builtin_fma(-k, 1.5707963267948966, a) - k * 6.123233995736766e-17;
    const double r2 = r * r;
    double sp = -1.0 / 1307674368000.0;
    sp = sp * r2 + 1.0 / 6227020800.0; sp = sp * r2 - 1.0 / 39916800.0; sp = sp * r2 + 1.0 / 362880.0; sp = sp * r2 - 1.0 / 5040.0; sp = sp * r2 + 1.0 / 120.0; sp = sp * r2 - 1.0 / 6.0; sp = sp * r2 + 1.0;
    sp *= r;
    double cp = 1.0 / 20922789888000.0;
    cp = cp * r2 - 1.0 / 87178291200.0; cp = cp * r2 + 1.0 / 479001600.0; cp = cp * r2 - 1.0 / 3628800.0; cp = cp * r2 + 1.0 / 40320.0; cp = cp * r2 - 1.0 / 720.0; cp = cp * r2 + 1.0 / 24.0; cp = cp * r2 - 0.5; cp = cp * r2 + 1.0;
    const int q = ((int)k) & 3;
    const double ss = (q == 0) ? sp : (q == 1) ? cp : (q == 2) ? -sp : -cp;
    const double cc = (q == 0) ? cp : (q == 1) ? -sp : (q == 2) ? -cp : sp;
    c = (float)cc; s = (float)ss;
}

__device__ __forceinline__ void phase_prologue(Frame& F) {
    const int lane = lane_id();
    const int gt = F.gw * 64 + lane, NGT = F.NGW * 64;
    for (int e = gt; e < SEQ * 64 + 64 * 32; e += NGT) {
        int t, i; double inv = 1.0; float* dst;
        if (e < SEQ * 64) { t = e >> 6; i = e & 63; dst = F.ROPE_B + 2 * (size_t)e; for (int j = 0; j < i; ++j) inv *= 0.8659643233600653; }
        else { const int e2 = e - SEQ * 64; t = e2 >> 5; i = e2 & 31; dst = F.ROPE_A + 2 * (size_t)e2; for (int j = 0; j < 2 * i; ++j) inv *= 0.8659643233600653; }
        float c, s; sincos_d((double)t * inv, c, s);
        dst[0] = c; dst[1] = s;
    }
    { f32x4 xn[8];
#define PRO_LOAD(m_) do { const float* src_ = ((m_) < NTOK_P) ? F.x_prompt + (size_t)(m_) * DM : F.x_sample + (size_t)((m_) - NTOK_P) * DM; \
        _Pragma("unroll") for (int j = 0; j < 8; ++j) xn[j] = __builtin_nontemporal_load((const f32x4*)src_ + lane + 64 * j); } while (0)
      if (F.gw < NTOK) PRO_LOAD(F.gw);
      for (int m = F.gw; m < NTOK; m += F.NGW) {
        f32x4 xc[8];
#pragma unroll
        for (int j = 0; j < 8; ++j) xc[j] = xn[j];
        if (m + F.NGW < NTOK) PRO_LOAD(m + F.NGW);
        asm volatile("" ::: "memory");
        GAS unsigned long long* o8 = (GAS unsigned long long*)(F.XB + (size_t)m * DM) + lane;
#pragma unroll
        for (int j = 0; j < 8; ++j) o8[64 * j] = (unsigned long long)pk2(xc[j].x, xc[j].y) | ((unsigned long long)pk2(xc[j].z, xc[j].w) << 32);
        if (lane == 0) F.STAT[m] = (pg8::f32x2){0.f, 1.f};
      }
#undef PRO_LOAD
    }
    for (int e = gt; e < DM; e += NGT) { F.VEC[VEC_ONES + e] = 1.f; F.VEC[VEC_ZEROS + e] = 0.f; }
    if (F.gw < NLAYER) {
        const float* gq = F.a_q_gain + F.gw * HD; const float* gk = F.a_k_gain + F.gw * HD;
        const float mq = wave_max(fmaxf(fabsf(gq[2 * lane]), fabsf(gq[2 * lane + 1]))), mk = wave_max(fmaxf(fabsf(gk[2 * lane]), fabsf(gk[2 * lane + 1])));
        if (lane == 0) F.VEC[VEC_M0 + F.gw] = 128.f * mq * mk * 1.05f; }
    for (int e = gt; e < 2 * INW; e += NGT) F.VEC[VEC_CS_IN + e] = 0.f;
    convert_weights(F, 0, 0, 1, F.gw, F.NGW);
}

__device__ __forceinline__ void phase_prep(Frame& F, int l) {
    const int lane = lane_id();
    const float* gq = F.a_q_gain + l * HD; const float* gk = F.a_k_gain + l * HD;
    const long NIT = (long)NTOK * 18 * 8;
    for (long ti = (long)F.gw * 64 + lane; ti < NIT; ti += (long)F.NGW * 64) {
        const int c = (int)(ti & 7); const int th = (int)(ti >> 3); const int m = th / 18, hs = th - m * 18; const int t = m & (SEQ - 1);
        int col, lo_off, hi_off; const float* tab; const float* gain = nullptr;
        if (hs < 6) {
            col = (hs < 4) ? COL_AQ + hs * HD : COL_AK + (hs - 4) * HD; gain = (hs < 4) ? gq : gk;
            const int cc = c & 3, half = c >> 2; lo_off = half * 64 + cc * 8; hi_off = lo_off + 32;
            const int pos = half ? (t & 63) : (t >> 6); tab = F.ROPE_A + 2 * (size_t)(pos * 32 + cc * 8);
        } else {
            col = (hs < 12) ? COL_BQ + (hs - 6) * HD : COL_BK + (hs - 12) * HD;
            lo_off = c * 8; hi_off = 64 + c * 8; tab = F.ROPE_B + 2 * (size_t)(t * 64 + c * 8);
        }
        bf16* p = F.PROJ + (size_t)m * INW + col;
        const v4u lo4 = *(const v4u*)(p + lo_off), hi4 = *(const v4u*)(p + hi_off);
        float lo[8], hv[8];
        lo[0] = bflo(lo4.x); lo[1] = bfhi(lo4.x); lo[2] = bflo(lo4.y); lo[3] = bfhi(lo4.y); lo[4] = bflo(lo4.z); lo[5] = bfhi(lo4.z); lo[6] = bflo(lo4.w); lo[7] = bfhi(lo4.w);
        hv[0] = bflo(hi4.x); hv[1] = bfhi(hi4.x); hv[2] = bflo(hi4.y); hv[3] = bfhi(hi4.y); hv[4] = bflo(hi4.z); hv[5] = bfhi(hi4.z); hv[6] = bflo(hi4.w); hv[7] = bfhi(hi4.w);
        float ss = 0.f;
#pragma unroll
        for (int j = 0; j < 8; ++j) ss += lo[j] * lo[j] + hv[j] * hv[j];
        ss += xshfl<1>(ss); ss += xshfl<2>(ss); ss += xshfl<4>(ss);
        if (hs < 6) { const float rs = 1.0f / sqrtf(ss * (1.0f / HD) + EPS);
#pragma unroll
            for (int j = 0; j < 8; ++j) { lo[j] = lo[j] * rs * gain[lo_off + j]; hv[j] = hv[j] * rs * gain[hi_off + j]; } }
        float ol[8], oh[8];
#pragma unroll
        for (int j = 0; j < 8; ++j) { const float cs = tab[2 * j], sn = tab[2 * j + 1]; ol[j] = lo[j] * cs - hv[j] * sn; oh[j] = hv[j] * cs + lo[j] * sn; }
        v4u w; w.x = pk2(ol[0], ol[1]); w.y = pk2(ol[2], ol[3]); w.z = pk2(ol[4], ol[5]); w.w = pk2(ol[6], ol[7]); *(v4u*)(p + lo_off) = w;
        w.x = pk2(oh[0], oh[1]); w.y = pk2(oh[2], oh[3]); w.z = pk2(oh[4], oh[5]); w.w = pk2(oh[6], oh[7]); *(v4u*)(p + hi_off) = w;
    }
}

#ifndef MK_RING3_A
#define MK_RING3_A 0
#endif
struct CfgA {
    static constexpr int NT = SEQ / 64; static constexpr bool HAS_LSE = false;
    float negm0C;
    const bf16* proj; bf16* obuf; unsigned qbase, kvbase, obase; int kcol, vcol;
    __device__ __forceinline__ unsigned q_off(int row) const { return qbase + (unsigned)row * INW; }
    __device__ __forceinline__ unsigned kv_off(int t, int row) const { return kvbase + (unsigned)(t * 64 + row) * INW; }
    __device__ __forceinline__ bool active(int, int) const { return true; }
    __device__ __forceinline__ void mask(att::f32x16&, att::f32x16&, int, int, int, int) const {}
    __device__ __forceinline__ unsigned o_off(int row) const { return obase + (unsigned)row * DM; }
    __device__ __forceinline__ void store_lse(int, float) const {}
};
__device__ __forceinline__ CfgA make_cfgA(Frame& F, int u, float negm0C) {
    const int x = F.vcu / (F.G / 8), j = F.vcu % (F.G / 8);
    int combo, hq2, qb;
    if (F.G == 256) { const int i = u / 256; combo = i * 8 + x; hq2 = j >> 4; qb = j & 15; } else { combo = u / 32; hq2 = (u >> 4) & 1; qb = u & 15; }
    const int s = combo >> 1, kvh = combo & 1, hq = kvh * 2 + hq2;
    const unsigned row0 = (unsigned)s * SEQ;
    CfgA cfg; cfg.negm0C = negm0C; cfg.proj = F.PROJ; cfg.obuf = F.O; cfg.qbase = (row0 + (unsigned)qb * 256) * INW + COL_AQ + hq * HD; cfg.kvbase = row0 * INW; cfg.kcol = COL_AK + kvh * HD; cfg.vcol = COL_AV + kvh * HD;
    cfg.obase = (row0 + (unsigned)qb * 256) * DM + OCOL_A + hq * HD;
    return cfg;
}
template <bool BOUNDED> __device__ __forceinline__ void phase_attn_A_(Frame& F, char* lds, float negm0C) {
    att::Pre pre; bool have = false;
    for (int u = F.vcu; u < NSEQ * 4 * 16; u += F.G) {
        const CfgA cfg = make_cfgA(F, u, negm0C); const bool hn = u + F.G < NSEQ * 4 * 16; const CfgA nx = make_cfgA(F, hn ? u + F.G : u, negm0C);
        if (MK_RING3_A) att::attn_unit3<CfgA, BOUNDED>(cfg, lds, F.wave, pre, have, &nx); else att::attn_unit<CfgA, 2, BOUNDED>(cfg, lds, F.wave, pre, have, &nx);
        have = MK_PREFETCH_UNIT != 0;
    }
}
__device__ __forceinline__ void phase_attn_A(Frame& F, int l, char* lds) {
    const float m0 = F.VEC[VEC_M0 + l];
    if (MK_BOUNDED_A && m0 * ATT_SCALE <= 40.f) phase_attn_A_<true>(F, lds, -m0 * ATT_SCALE * 1.4426950408889634f); else phase_attn_A_<false>(F, lds, 0.f);
}

#ifndef MK_WAVE_BC
#define MK_WAVE_BC 0
#endif
#ifndef MK_C16
#define MK_C16 1
#endif
#if MK_C16
#define MK_CFG_C CfgC16
#define MK_UNIT_C att::attn_unit_h<CfgC16, 2>
#else
#define MK_CFG_C CfgC
#define MK_UNIT_C ATT_UNIT_BC(CfgC)
#endif
#ifndef MK_PIPE_BC
#define MK_PIPE_BC 1
#endif
#if MK_WAVE_BC
#define ATT_UNIT_BC(C) att::attn_unit_wave<C>
#elif MK_PIPE_BC
#define ATT_UNIT_BC(C) att::attn_unit<C, 1>
#else
#define ATT_UNIT_BC(C) att::attn_unit_simple<C>
#endif
struct CfgB {
    static constexpr int NT = 6; static constexpr bool HAS_LSE = true;
    static constexpr float negm0C = 0.f;
    const bf16* proj; bf16* obuf; float* lse; unsigned tok0; int sh, s0, L, hb; int kcol, vcol;
    __device__ __forceinline__ unsigned q_off(int row) const { return (tok0 + ((unsigned)(s0 + row) << sh)) * INW + COL_BQ + hb * HD; }
    __device__ __forceinline__ unsigned kv_off(int t, int row) const { int pos = s0 - 64 + 64 * t + row; pos = min(max(pos, 0), L - 1); return (tok0 + ((unsigned)pos << sh)) * INW; }
    __device__ __forceinline__ bool active(int t, int wid) const { return (t >= (wid >> 1)) && (t <= (wid >> 1) + 2) && (t >= t_begin()) && (t < t_end()); }
    __device__ __forceinline__ int t_begin() const { return s0 == 0 ? 1 : 0; }
    __device__ __forceinline__ int t_end() const { return s0 + 256 == L ? 5 : 6; }
    __device__ __forceinline__ void mask(att::f32x16& p0, att::f32x16& p1, int t, int wid, int r32, int hi) const {
        if (t == (wid >> 1) + 1) return;
        const int d0 = 64 * t - 64 - 32 * wid - r32 + 4 * hi;
#pragma unroll
        for (int r = 0; r < 16; ++r) { const int d = d0 + (r & 3) + 8 * (r >> 2);
            if (d < -64 || d > 64) p0[r] = -__builtin_inff();
            if (d + 32 < -64 || d + 32 > 64) p1[r] = -__builtin_inff(); }
    }
    __device__ __forceinline__ unsigned o_off(int row) const { return (tok0 + ((unsigned)(s0 + row) << sh)) * DM + OCOL_B + hb * HD; }
    __device__ __forceinline__ void store_lse(int row, float v) const { lse[(size_t)(tok0 + ((unsigned)(s0 + row) << sh)) * 8 + hb] = v; }
};
struct CfgC {
    static constexpr int NT = 12; static constexpr bool HAS_LSE = false;
    static constexpr float negm0C = 0.f;
    const bf16* proj; bf16* obuf; const float* bias;
    unsigned tokq; unsigned tokk; int R0, kr0, hc; int kcol, vcol;
    __device__ __forceinline__ unsigned q_off(int row) const { return (tokq + (unsigned)row) * INW + COL_CQ + hc * HD; }
    __device__ __forceinline__ unsigned kv_off(int t, int row) const { return (tokk + (unsigned)(t * 64 + row)) * INW; }
    __device__ __forceinline__ bool active(int t, int wid) const { const int r = R0 + (wid >> 1), r0 = min(max(r - 4, 0), 56), kr = kr0 + t; return kr >= r0 && kr < r0 + 8; }
    __device__ __forceinline__ int t_begin() const { return min(max(R0 - 4, 0), 56) - kr0; }
    __device__ __forceinline__ int t_end() const { return min(max(R0 - 1, 0), 56) + 8 - kr0; }
    __device__ __forceinline__ void mask(att::f32x16& p0, att::f32x16& p1, int t, int wid, int r32, int hi) const {
        const int r = R0 + (wid >> 1), kr = kr0 + t, qc = (wid & 1) * 32 + r32, sc = min(max(qc - 8, 0), 48);
        const int w0 = 4 * hi - sc;
        const float* bp = bias + (kr - r + 7) * 31 + (sc - qc + 15) + w0;
#pragma unroll
        for (int rr = 0; rr < 16; ++rr) { const int c = (rr & 3) + 8 * (rr >> 2);
            p0[rr] = ((unsigned)(w0 + c) < 16u) ? p0[rr] + bp[c] : -__builtin_inff();
            p1[rr] = ((unsigned)(w0 + c + 32) < 16u) ? p1[rr] + bp[c + 32] : -__builtin_inff(); }
    }
    __device__ __forceinline__ unsigned o_off(int row) const { return (tokq + (unsigned)row) * DM + OCOL_C + hc * HD; }
    __device__ __forceinline__ void store_lse(int, float) const {}
};
struct CfgC16 {
    static constexpr int NT = 12; static constexpr bool HAS_LSE = false; static constexpr float negm0C = 0.f;
    const bf16* proj; bf16* obuf; const float* bias;
    unsigned tokq; unsigned tokk; int R0, kr0, hc; int kcol, vcol;
    __device__ __forceinline__ int qtok(int idx) const { const int w = idx >> 5, rl = idx & 31; return (2 * (w >> 2) + (rl >> 4)) * 64 + 16 * (w & 3) + (rl & 15); }
    __device__ __forceinline__ unsigned q_off(int idx) const { return (tokq + (unsigned)qtok(idx)) * INW + COL_CQ + hc * HD; }
    __device__ __forceinline__ unsigned kv_off(int t, int row) const { return (tokk + (unsigned)(t * 64 + row)) * INW; }
    __device__ __forceinline__ int kwin(int wid) const { return min(max(16 * (wid & 3) - 8, 0), 32); }
    __device__ __forceinline__ bool active(int t, int wid) const { const int r = R0 + 2 * (wid >> 2), lo = min(max(r - 4, 0), 56), hi_ = min(max(r - 3, 0), 56) + 8, kr = kr0 + t; return kr >= lo && kr < hi_; }
    __device__ __forceinline__ void mask16(att::f32x16& p0, int t, int wid, int r32, int hi) const {
        const int r = R0 + 2 * (wid >> 2) + (r32 >> 4), kr = kr0 + t, qc = 16 * (wid & 3) + (r32 & 15), sc = min(max(qc - 8, 0), 48), r0 = min(max(r - 4, 0), 56);
        const bool rowok = (unsigned)(kr - r0) < 8u;
        const int w0 = kwin(wid) + 4 * hi - sc;
        const float* bp = bias + (kr - r + 7) * 31 + (sc - qc + 15) + w0;
#pragma unroll
        for (int rr = 0; rr < 16; ++rr) { const int cofs = (rr & 3) + 8 * (rr >> 2);
            p0[rr] = (rowok && (unsigned)(w0 + cofs) < 16u) ? p0[rr] + bp[cofs] : -__builtin_inff(); }
    }
    __device__ __forceinline__ unsigned o_off(int idx) const { return (tokq + (unsigned)qtok(idx)) * DM + OCOL_C + hc * HD; }
    __device__ __forceinline__ void store_lse(int, float) const {}
};
constexpr int ATT_BIAS_OFF = 106496;
constexpr int ATT_BIAS_OFF_OLD = 69632;
static_assert(att::OSTAGE_OFF >= (int)att::SHM_ATTN && att::OSTAGE_OFF + 8 * 4096 <= ATT_BIAS_OFF && ATT_BIAS_OFF + 6 * 15 * 31 * 4 + 512 <= RING_BYTES, "O stage / bias table placement");
__device__ __forceinline__ CfgB make_cfgB(Frame& F, int u) {
    const int s = u / 96, rem = u - s * 96, hb = rem >> 4, k = rem & 15;
    const int g = hb >> 1, sh = 2 * g, L = SEQ >> sh, nblk = L >> 8;
    const int r = k / nblk, blk = k - r * nblk;
    CfgB cfg; cfg.proj = F.PROJ; cfg.obuf = F.O; cfg.lse = F.LSE; cfg.tok0 = (unsigned)s * SEQ + r; cfg.sh = sh; cfg.s0 = blk * 256; cfg.L = L; cfg.hb = hb;
    cfg.kcol = COL_BK + hb * HD; cfg.vcol = COL_BV + hb * HD;
    return cfg;
}
__device__ __forceinline__ void phase_attn_B(Frame& F, char* lds) {
    att::Pre pre; bool have = false;
    for (int u = F.vcu; u < 1152; u += F.G) {
        const CfgB cfg = make_cfgB(F, u); const bool hn = u + F.G < 1152; const CfgB nx = make_cfgB(F, hn ? u + F.G : u);
        att::attn_unit<CfgB, 1>(cfg, lds, F.wave, pre, have, &nx); have = MK_PREFETCH_UNIT != 0;
    }
}
__device__ __forceinline__ CfgC16 make_cfgC(Frame& F, int v, const float* bl) {
    const int s = v / 96, rem = v - s * 96, hc = rem >> 4, blk = rem & 15;
    const int R0 = blk * 4, kr0 = min(max(R0 - 4, 0), 52);
    CfgC16 cfg; cfg.proj = F.PROJ; cfg.obuf = F.O; cfg.bias = bl; cfg.tokq = (unsigned)s * SEQ + R0 * 64; cfg.tokk = (unsigned)s * SEQ + kr0 * 64; cfg.R0 = R0; cfg.kr0 = kr0; cfg.hc = hc;
    cfg.kcol = COL_CK + hc * HD; cfg.vcol = COL_CV + hc * HD;
    return cfg;
}
__device__ __forceinline__ void phase_attn_C(Frame& F, int l, char* lds) {
    att::Pre pre; bool have = false; float* bl = (float*)(lds + ATT_BIAS_OFF);
    { const float* rel = F.c_rel_bias + (size_t)l * 6 * (15 * 31);
      for (int e = F.wave * 64 + lane_id(); e < 6 * 15 * 31; e += NWAVES * 64) bl[e] = rel[e] * (1.0f / ATT_SCALE);
      __syncthreads(); }
    for (int v = F.G - 1 - F.vcu; v < 1152; v += F.G) {
        CfgC16 cfg = make_cfgC(F, v, bl); cfg.bias = bl + cfg.hc * (15 * 31); const bool hn = v + F.G < 1152; const CfgC16 nx = make_cfgC(F, hn ? v + F.G : v, bl);
        att::attn_unit_h<CfgC16, 2>(cfg, lds, F.wave, pre, have, &nx); have = MK_PREFETCH_UNIT != 0;
    }
}

#ifndef MK_DYN_BC
#define MK_DYN_BC 0
#endif
__device__ __forceinline__ void phase_attn_BC_dyn(Frame& F, int l, char* lds) {
    att::Pre pre; float* bl = (float*)(lds + ATT_BIAS_OFF);
    { const float* rel = F.c_rel_bias + (size_t)l * 6 * (15 * 31);
      for (int e = F.wave * 64 + lane_id(); e < 6 * 15 * 31; e += NWAVES * 64) bl[e] = rel[e] * (1.0f / ATT_SCALE); }
    gu32* head = F.ctl + CW_ATTQ + 64 * l;
    volatile LAS unsigned* slot = F.MISC + 16;
    const bool t0 = (F.wave == 0) && (lane_id() == 0);
    unsigned nq = 0u;
    if (t0) nq = __hip_atomic_fetch_add(head, 1u, RLX_AGENT);
    for (;;) {
        if (t0) *slot = nq;
        __syncthreads();
        const unsigned q = *slot;
        __syncthreads();
        if (q >= 2304u) break;
        if (t0) nq = __hip_atomic_fetch_add(head, 1u, RLX_AGENT);
        if (q < 1152u) {
            CfgC16 cfg = make_cfgC(F, (int)q, bl); cfg.bias = bl + cfg.hc * (15 * 31);
            att::attn_unit_h<CfgC16, 2>(cfg, lds, F.wave, pre, false, &cfg);
        } else {
            const CfgB cfg = make_cfgB(F, (int)q - 1152);
            att::attn_unit<CfgB, 1>(cfg, lds, F.wave, pre, false, &cfg);
        }
    }
}

__device__ __forceinline__ float dot8(v4u a, v4u b) {
    return bflo(a.x) * bflo(b.x) + bfhi(a.x) * bfhi(b.x) + bflo(a.y) * bflo(b.y) + bfhi(a.y) * bfhi(b.y) + bflo(a.z) * bflo(b.z) + bfhi(a.z) * bfhi(b.z) + bflo(a.w) * bflo(b.w) + bfhi(a.w) * bfhi(b.w);
}
__device__ __forceinline__ void naive_B(Frame& F, int m, int hb) {
    const int lane = lane_id(); const int t = m & (SEQ - 1); const size_t sbase = (size_t)(m - t);
    const int g = hb >> 1, sh = 2 * g, dil = 1 << sh, i = t >> sh, r = t & (dil - 1), L = SEQ >> sh;
    const bf16* qp = F.PROJ + (size_t)m * INW + COL_BQ + hb * HD;
    const bf16* kb = F.PROJ + sbase * INW + COL_BK + hb * HD; const bf16* vb = F.PROJ + sbase * INW + COL_BV + hb * HD;
    float dot[3] = {0.f, 0.f, 0.f}; bool valid[3]; const bf16* kp[3];
#pragma unroll
    for (int j3 = 0; j3 < 3; ++j3) { const int jj = lane + 64 * j3, ik = i - 64 + jj; valid[j3] = (jj <= 128) && (ik >= 0) && (ik < L);
        const int ikc = valid[j3] ? ik : i; kp[j3] = kb + (size_t)(ikc * dil + r) * INW; }
#pragma unroll
    for (int ch = 0; ch < 16; ++ch) { const v4u qv = *(const v4u*)(qp + ch * 8);
#pragma unroll
        for (int j3 = 0; j3 < 3; ++j3) { const v4u kv = *(const v4u*)(kp[j3] + ch * 8); dot[j3] += dot8(qv, kv); } }
    float s[3];
#pragma unroll
    for (int j3 = 0; j3 < 3; ++j3) s[j3] = valid[j3] ? dot[j3] * ATT_SCALE : -__builtin_inff();
    const float mx = wave_max(fmaxf(s[0], fmaxf(s[1], s[2])));
    float p[3];
#pragma unroll
    for (int j3 = 0; j3 < 3; ++j3) p[j3] = valid[j3] ? __expf(s[j3] - mx) : 0.f;
    const float lsum = wave_sum(p[0] + p[1] + p[2]);
    float a0 = 0.f, a1 = 0.f;
#pragma unroll
    for (int j3 = 0; j3 < 3; ++j3) {
        const int nj = (j3 == 2) ? 1 : 64;
        for (int jl = 0; jl < nj; ++jl) { const float pj = __shfl(p[j3], jl); const int ik = i - 64 + jl + 64 * j3;
            if (ik >= 0 && ik < L) { const unsigned w = *(const unsigned*)(vb + (size_t)(ik * dil + r) * INW + 2 * lane); a0 += pj * bflo(w); a1 += pj * bfhi(w); } } }
    const float rl = 1.0f / lsum;
    *(unsigned*)(F.O + (size_t)m * DM + OCOL_B + hb * HD + 2 * lane) = pk2(a0 * rl, a1 * rl);
    if (lane == 0) F.LSE[(size_t)m * 8 + hb] = mx + __logf(lsum);
}
__device__ __forceinline__ void naive_C(Frame& F, int l, int m, int hc) {
    const int lane = lane_id(); const int t = m & (SEQ - 1); const size_t sbase = (size_t)(m - t);
    const int r = t >> 6, c = t & 63; const int r0 = min(max(r - 4, 0), 56), sc = min(max(c - 8, 0), 48);
    const bf16* qp = F.PROJ + (size_t)m * INW + COL_CQ + hc * HD;
    const bf16* kb = F.PROJ + sbase * INW + COL_CK + hc * HD; const bf16* vb = F.PROJ + sbase * INW + COL_CV + hc * HD;
    const float* rel = F.c_rel_bias + ((size_t)l * 6 + hc) * (15 * 31);
    float dot[2] = {0.f, 0.f}; const bf16* kp[2]; float bias[2];
#pragma unroll
    for (int j2 = 0; j2 < 2; ++j2) { const int kk = lane + 64 * j2, jr = kk >> 4, jc = kk & 15; kp[j2] = kb + (size_t)((r0 + jr) * 64 + sc + jc) * INW;
        bias[j2] = rel[(r0 + jr - r + 7) * 31 + (sc + jc - c + 15)]; }
#pragma unroll
    for (int ch = 0; ch < 16; ++ch) { const v4u qv = *(const v4u*)(qp + ch * 8);
#pragma unroll
        for (int j2 = 0; j2 < 2; ++j2) { const v4u kv = *(const v4u*)(kp[j2] + ch * 8); dot[j2] += dot8(qv, kv); } }
    const float s0 = dot[0] * ATT_SCALE + bias[0], s1 = dot[1] * ATT_SCALE + bias[1];
    const float mx = wave_max(fmaxf(s0, s1));
    const float p0 = __expf(s0 - mx), p1 = __expf(s1 - mx);
    const float lsum = wave_sum(p0 + p1);
    float a0 = 0.f, a1 = 0.f;
    for (int kk = 0; kk < 128; ++kk) { const float pj = (kk < 64) ? __shfl(p0, kk) : __shfl(p1, kk - 64); const int jr = kk >> 4, jc = kk & 15;
        const unsigned w = *(const unsigned*)(vb + (size_t)((r0 + jr) * 64 + sc + jc) * INW + 2 * lane); a0 += pj * bflo(w); a1 += pj * bfhi(w); }
    const float rl = 1.0f / lsum;
    *(unsigned*)(F.O + (size_t)m * DM + OCOL_C + hc * HD + 2 * lane) = pk2(a0 * rl, a1 * rl);
}
__device__ __forceinline__ void phase_attn_BC_naive(Frame& F, int l) {
    for (int it = F.gw; it < NTOK * 12; it += F.NGW) { const int m = it / 12, h = it - m * 12;
        if (h < 6) naive_B(F, m, h); else naive_C(F, l, m, h - 6); }
}

__device__ __forceinline__ void phase_mix(Frame& F, int l) {
    const int lane = lane_id();
    const float* gain = F.mix_gain + (size_t)l * DM;
    f32x4 gv[4][2];
#pragma unroll
    for (int j = 0; j < 4; ++j) { gv[j][0] = *(const f32x4*)(gain + 8 * lane + 512 * j); gv[j][1] = *(const f32x4*)(gain + 8 * lane + 512 * j + 4); }
    v4u wn[4]; float ln[6];
#define MIX_LOAD(m_) do { const bf16* row_ = F.O + (size_t)(m_) * DM; const float* lse_ = F.LSE + (size_t)(m_) * 8; \
        _Pragma("unroll") for (int j = 0; j < 4; ++j) wn[j] = *(const v4u*)(row_ + 8 * lane + 512 * j); \
        _Pragma("unroll") for (int h = 0; h < 6; ++h) ln[h] = lse_[h]; } while (0)
    if (F.gw < NTOK) MIX_LOAD(F.gw);
    for (int m = F.gw; m < NTOK; m += F.NGW) {
        bf16* row = F.O + (size_t)m * DM;
        v4u wc[4]; float lc[6];
#pragma unroll
        for (int j = 0; j < 4; ++j) wc[j] = wn[j];
#pragma unroll
        for (int h = 0; h < 6; ++h) lc[h] = ln[h];
        if (m + F.NGW < NTOK) MIX_LOAD(m + F.NGW);
        asm volatile("" ::: "memory");
        float al[6];
#pragma unroll
        for (int h = 0; h < 2; ++h) { const float l0 = lc[h], l1 = lc[2 + h], l2 = lc[4 + h]; const float mx = fmaxf(l0, fmaxf(l1, l2));
            const float e0 = __expf(l0 - mx), e1 = __expf(l1 - mx), e2 = __expf(l2 - mx); const float inv = 1.0f / (e0 + e1 + e2); al[h] = e0 * inv; al[2 + h] = e1 * inv; al[4 + h] = e2 * inv; }
        float v[4][8]; float ssA = 0.f, ssB = 0.f, ssC = 0.f;
#pragma unroll
        for (int j = 0; j < 4; ++j) { const int col = 8 * lane + 512 * j; const v4u w = wc[j];
            v[j][0] = bflo(w.x); v[j][1] = bfhi(w.x); v[j][2] = bflo(w.y); v[j][3] = bfhi(w.y); v[j][4] = bflo(w.z); v[j][5] = bfhi(w.z); v[j][6] = bflo(w.w); v[j][7] = bfhi(w.w);
            float a = 1.f;
            if (col >= OCOL_B && col < OCOL_C) { const int hb = (col - OCOL_B) >> 7; a = (hb == 0) ? al[0] : (hb == 1) ? al[1] : (hb == 2) ? al[2] : (hb == 3) ? al[3] : (hb == 4) ? al[4] : al[5]; }
            float ss = 0.f;
#pragma unroll
            for (int e = 0; e < 8; ++e) { v[j][e] *= a; ss += v[j][e] * v[j][e]; }
            if (col < OCOL_B) ssA += ss; else if (col < OCOL_C) ssB += ss; else ssC += ss; }
        ssA = wave_sum(ssA); ssB = wave_sum(ssB); ssC = wave_sum(ssC);
        const float rA = 1.0f / sqrtf(ssA * (1.0f / 512.f) + EPS), rB = 1.0f / sqrtf(ssB * (1.0f / 768.f) + EPS), rC = 1.0f / sqrtf(ssC * (1.0f / 768.f) + EPS);
#pragma unroll
        for (int j = 0; j < 4; ++j) { const int col = 8 * lane + 512 * j; const float rr = (col < OCOL_B) ? rA : (col < OCOL_C) ? rB : rC;
            const f32x4 g0 = gv[j][0], g1 = gv[j][1];
            v4u w; w.x = pk2(v[j][0] * rr * g0.x, v[j][1] * rr * g0.y); w.y = pk2(v[j][2] * rr * g0.z, v[j][3] * rr * g0.w);
            w.z = pk2(v[j][4] * rr * g1.x, v[j][5] * rr * g1.y); w.w = pk2(v[j][6] * rr * g1.z, v[j][7] * rr * g1.w);
            *(v4u*)(row + col) = w; }
    }
#undef MIX_LOAD
}

__device__ __forceinline__ void fin_rows(const bf16* XB, const pg8::f32x2* PART, float* X, const float* g, const float* b, int m0, int mstride, int mend) {
    static_assert(MK_BF16_RES && !MK_FIN_PHASES, "the final LayerNorm reads the bf16 residual stream and the raw row partials");
    const int lane = lane_id();
    f32x4 gg[8], bb[8];
#pragma unroll
    for (int j = 0; j < 8; ++j) { gg[j] = *((const f32x4*)g + lane + 64 * j); bb[j] = *((const f32x4*)b + lane + 64 * j); }
    unsigned long long zA[8], zB[8]; pg8::f32x2 pA, pB;
#define FLN_LOAD(Z, P, m_) do { const GAS unsigned long long* zb_ = (const GAS unsigned long long*)(XB + (size_t)(m_) * DM) + lane; \
        _Pragma("unroll") for (int j = 0; j < 8; ++j) Z[j] = zb_[64 * j]; P = (lane < 32) ? PART[(size_t)(m_) * 32 + lane] : (pg8::f32x2){0.f, 0.f}; } while (0)
#define FLN_ROW(ZC, PC, m_) do { GAS f32x4* xr = (GAS f32x4*)(X + (size_t)(m_) * DM) + lane; \
        const float s = wave_sum(PC.x), q = wave_sum(PC.y); \
        const float mean = s * (1.f / DM); const float var = fmaxf(q * (1.f / DM) - mean * mean, 0.f); const float rstd = 1.f / sqrtf(var + EPS); \
        _Pragma("unroll") for (int j = 0; j < 8; ++j) { const unsigned lo = (unsigned)ZC[j], hi = (unsigned)(ZC[j] >> 32); \
            const f32x4 z = {bflo(lo), bfhi(lo), bflo(hi), bfhi(hi)}; \
            __builtin_nontemporal_store((z - mean) * rstd * gg[j] + bb[j], (f32x4*)(xr + 64 * j)); } } while (0)
    if (m0 < mend) FLN_LOAD(zA, pA, m0);
    if (m0 + mstride < mend) FLN_LOAD(zB, pB, m0 + mstride);
    for (int m = m0; m < mend; m += 2 * mstride) {
        unsigned long long zc[8]; pg8::f32x2 pc = pA;
#pragma unroll
        for (int j = 0; j < 8; ++j) zc[j] = zA[j];
        if (m + 2 * mstride < mend) FLN_LOAD(zA, pA, m + 2 * mstride);
        asm volatile("" ::: "memory");
        FLN_ROW(zc, pc, m);
        if (m + mstride < mend) {
            pc = pB;
#pragma unroll
            for (int j = 0; j < 8; ++j) zc[j] = zB[j];
            if (m + 3 * mstride < mend) FLN_LOAD(zB, pB, m + 3 * mstride);
            asm volatile("" ::: "memory");
            FLN_ROW(zc, pc, m + mstride);
        }
    }
#undef FLN_LOAD
#undef FLN_ROW
}
__device__ __forceinline__ void phase_final_ln(Frame& F, const float* g, const float* b) { fin_rows(F.XB, F.PART, F.X, g, b, F.gw, F.NGW, NTOK); }

struct FinalOrder {
    pg8::StaticOrder s; const bf16* XB; const pg8::f32x2* PART; float* X; const float* g; const float* b; gu32* cnt; int wave;
    __device__ __forceinline__ bool next(int i, pg8::Unit& u) const { return s.next(i, u); }
    __device__ __forceinline__ void a_ready(const pg8::Unit&) const {}
    __device__ __forceinline__ void done(const pg8::Unit& u) const {
        asm volatile("s_waitcnt vmcnt(0)" ::: "memory"); __syncthreads();
        if (wave == 0 && lane_id() == 0) {
            __builtin_amdgcn_fence(__ATOMIC_RELEASE, "agent"); asm volatile("s_waitcnt vmcnt(0)" ::: "memory");
            gu32* w = cnt + 64 * u.pm; (void)__hip_atomic_fetch_add(w, 1u, RLX_AGENT);
            unsigned sp = 0u; while (__hip_atomic_load(w, RLX_AGENT) < (unsigned)(DM / 256)) { __builtin_amdgcn_s_sleep(1); if (++sp > (1u << 22)) break; }
            __builtin_amdgcn_fence(__ATOMIC_ACQUIRE, "agent"); asm volatile("s_waitcnt vmcnt(0)" ::: "memory");
        }
        __syncthreads();
        const int base = u.pm * 256 + u.pn * 32;
        fin_rows(XB, PART, X, g, b, base + wave, 8, base + 32);
    }
};
#ifndef MK_FUSE_FINAL
#define MK_FUSE_FINAL 0
#endif
constexpr int CW_FIN = 65536;

__device__ __forceinline__ void phase_prep_copy(Frame& F) {
    const int lane = lane_id();
    const long NIT = (long)NTOK * 18 * 8;
    for (long ti = (long)F.gw * 64 + lane; ti < NIT; ti += (long)F.NGW * 64) {
        const int c = (int)(ti & 7); const int th = (int)(ti >> 3); const int m = th / 18, hs = th - m * 18; const int t = m & (SEQ - 1);
        int col, lo_off, hi_off; const float* tab;
        if (hs < 6) { col = (hs < 4) ? COL_AQ + hs * HD : COL_AK + (hs - 4) * HD; const int cc = c & 3, half = c >> 2; lo_off = half * 64 + cc * 8; hi_off = lo_off + 32; const int pos = half ? (t & 63) : (t >> 6); tab = F.ROPE_A + 2 * (size_t)(pos * 32 + cc * 8); }
        else { col = (hs < 12) ? COL_BQ + (hs - 6) * HD : COL_BK + (hs - 12) * HD; lo_off = c * 8; hi_off = 64 + c * 8; tab = F.ROPE_B + 2 * (size_t)(t * 64 + c * 8); }
        bf16* p = F.PROJ + (size_t)m * INW + col;
        v4u lo4 = *(const v4u*)(p + lo_off), hi4 = *(const v4u*)(p + hi_off);
        const f32x4 t0 = *(const f32x4*)tab, t1 = *(const f32x4*)(tab + 4), t2 = *(const f32x4*)(tab + 8), t3 = *(const f32x4*)(tab + 12);
        if (t0.x + t1.x + t2.x + t3.x > 1e30f) lo4.x ^= 1u;
        *(v4u*)(p + lo_off) = lo4; *(v4u*)(p + hi_off) = hi4;
    }
}
__device__ __forceinline__ void phase_mix_copy(Frame& F) {
    const int lane = lane_id();
    for (int m = F.gw; m < NTOK; m += F.NGW) {
        bf16* row = F.O + (size_t)m * DM; const float* lse = F.LSE + (size_t)m * 8; const float l0 = lse[0] + lse[5];
        v4u w[4];
#pragma unroll
        for (int j = 0; j < 4; ++j) w[j] = *(const v4u*)(row + 8 * lane + 512 * j);
        if (l0 > 1e30f) w[0].x ^= 1u;
#pragma unroll
        for (int j = 0; j < 4; ++j) *(v4u*)(row + 8 * lane + 512 * j) = w[j];
    }
}

#ifndef MK_NAIVE_BC
#define MK_NAIVE_BC 0
#endif
#if MK_NAIVE_BC
#define ATTN_BC(F, l, lds) phase_attn_BC_naive(F, l)
#else
#define ATTN_BC(F, l, lds) do { if (MK_DYN_BC) phase_attn_BC_dyn(F, l, lds); else { phase_attn_B(F, lds); phase_attn_C(F, l, lds); } } while (0)
#endif
#ifndef MK_DUP_ENDS
#define MK_DUP_ENDS 0
#endif
#ifndef MK_HALVES
#define MK_HALVES 0
#endif
#ifndef MK_SB_EAGER
#define MK_SB_EAGER 0
#endif
#ifndef MK_DUP_ALL
#define MK_DUP_ALL 0
#endif
#ifndef MK_DUP_GEMM
#define MK_DUP_GEMM 0
#endif
#ifndef MK_STAGGER_OUT
#define MK_STAGGER_OUT 0
#endif
#ifndef MK_STAGGER_IN
#define MK_STAGGER_IN 0
#endif
#ifndef MK_DUP_RES
#define MK_DUP_RES 0
#endif
#ifndef MK_DUP_BAR
#define MK_DUP_BAR 0
#endif
#ifndef MK_XCD_EXTRA
#define MK_XCD_EXTRA -1
#endif
#ifndef MK_DUP_KLOOP
#define MK_DUP_KLOOP 0
#endif
#ifndef MK_DUP_THIN
#define MK_DUP_THIN 0
#endif
#ifndef MK_DUP_ATTN
#define MK_DUP_ATTN 0
#endif
#ifndef MK_PER_PHASE
#define MK_PER_PHASE 0
#endif
constexpr int PH_PER_LAYER = 9, N_PHASES = 2 + PH_PER_LAYER * NLAYER;
struct Args { const float* in[14]; float* out; unsigned char* ws; int ph_lo, ph_hi; };
static_assert(sizeof(Args) == 14 * 8 + 8 + 8 + 8, "Args has no padding");

__global__ void __launch_bounds__(NWAVES * 64, 2) trunk_fwd(Args args) {
    extern __shared__ __attribute__((aligned(16))) unsigned char lds[];
    Frame F;
    F.lds = (LAS unsigned char*)lds;
    F.MISC = (volatile LAS unsigned*)(F.lds + MISC_OFF);
    F.wave = __builtin_amdgcn_readfirstlane((int)threadIdx.x >> 6);
    F.G = gridDim.x; { const int bx = blockIdx.x; F.vcu = (F.G % 8 == 0) ? (bx % 8) * (F.G / 8) + bx / 8 : bx; }
    F.gw = F.vcu * NWAVES + F.wave; F.NGW = F.G * NWAVES;
    unsigned char* ws = args.ws;
    F.ctl = (gu32*)(ws + WS_CTL);
    F.x_prompt = args.in[0]; F.x_sample = args.in[1]; F.w_in = args.in[2]; F.a_q_gain = args.in[3]; F.a_k_gain = args.in[4]; F.c_rel_bias = args.in[5]; F.mix_gain = args.in[6];
    F.w_out = args.in[7]; F.ln1_g = args.in[8]; F.ln1_b = args.in[9]; F.w_ff1 = args.in[10]; F.w_ff2 = args.in[11]; F.ln2_g = args.in[12]; F.ln2_b = args.in[13];
    F.X = args.out;
    F.Win_t = (bf16*)(ws + WS_WIN); F.Wout_t = (bf16*)(ws + WS_WOUT); F.Wff1_t = (bf16*)(ws + WS_WFF1); F.Wff2_t = (bf16*)(ws + WS_WFF2);
    F.XB = (bf16*)(ws + WS_XB); F.PROJ = (bf16*)(ws + WS_PROJ); F.O = (bf16*)(ws + WS_O); F.H = (bf16*)(ws + WS_H);
    F.LSE = (float*)(ws + WS_LSE); F.ROPE_B = (float*)(ws + WS_ROPE_B); F.ROPE_A = (float*)(ws + WS_ROPE_A);
    F.PART = (pg8::f32x2*)(ws + WS_PART); F.STAT = (pg8::f32x2*)(ws + WS_STAT); F.VEC = (float*)(ws + WS_VEC); F.PSB = (float*)(ws + WS_PSB); F.SSQ = (float*)(ws + WS_SSQ); F.RAT = (float*)(ws + WS_RAT);
    for (int u = F.wave * 64 + lane_id(); u < (LDS_BYTES - LDSCTL_OFF) / 4; u += NWAVES * 64) ((LAS unsigned*)(F.lds + LDSCTL_OFF))[u] = 0u;
    __syncthreads();
    XcdBarrier bar; bar.bar = (unsigned*)(F.ctl + CW_BAR); bar.x = 0; bar.st = nullptr;
    if (!MK_PER_PHASE) bar = xcd_barrier_post((unsigned*)(F.ctl + CW_BAR), F.MISC + 8, F.wave == 0 && lane_id() == 0);
    const int lo = args.ph_lo, hi = args.ph_hi;
#define IN(k) (lo <= (k) && (k) < hi)
#define STAGGER(ticks) do { if ((ticks) > 0) { const unsigned long long t0_ = __builtin_amdgcn_s_memrealtime(); const unsigned long long dl_ = (unsigned long long)((F.vcu & 7) >> 1) * (unsigned long long)(ticks); while (__builtin_amdgcn_s_memrealtime() - t0_ < dl_) __builtin_amdgcn_s_sleep(8); } } while (0)
#define SEAM(k) do { if (IN(k) && IN((k) + 1)) { if (MK_PER_PHASE) { if (F.wave == 0 && lane_id() == 0) __hip_atomic_store(F.ctl + CW_TMO, 0xBADBA0u, RLX_AGENT); } else { xcd_barrier(bar, F.wave == 0 && lane_id() == 0); if (MK_DUP_BAR) xcd_barrier(bar, F.wave == 0 && lane_id() == 0); } } } while (0)

    if (IN(0)) { phase_prologue(F); if (MK_DUP_ENDS & 1) phase_prologue(F); } SEAM(0);
#if MK_FUSE_PREP
#define INPROJ_EPI(l) pg8::EpiInProj E{F.PROJ, INW, F.STAT, F.VEC + VEC_CS_IN, F.VEC + VEC_BW_IN, F.a_q_gain + l * HD, F.a_k_gain + l * HD, F.ROPE_A, F.ROPE_B, (LAS float*)(F.lds + XCH_OFF), \
                (MK_BOUNDED_A && F.VEC[VEC_M0 + l] * ATT_SCALE <= 40.f) ? ATT_SCALE * 1.4426950408889634f : 1.f}; \
            pg8::gemm_phase<pg8::EpiInProj, pg8::StaticOrder, true, true>(F.lds + RING_OFF, g, S, E, F.wave)
#define PREP_PHASE(l) do {} while (0)
#else
#define INPROJ_EPI(l) pg8::EpiBf16Fold<0> E{F.PROJ, INW, F.STAT, F.VEC + VEC_CS_IN, F.VEC + VEC_BW_IN}; \
            pg8::gemm_phase<pg8::EpiBf16Fold<0>, pg8::StaticOrder, true, true>(F.lds + RING_OFF, g, S, E, F.wave)
#define PREP_PHASE(l) phase_prep(F, l)
#endif
#if MK_BF16_RES
#define RES_EPI_OUT(l) pg8::EpiResLnFoldB E{F.XB, DM, F.STAT, (l == 0) ? F.VEC + VEC_ONES : F.ln2_g + (size_t)(l - 1) * DM, (l == 0) ? F.VEC + VEC_ZEROS : F.ln2_b + (size_t)(l - 1) * DM, F.PART, DN_ALPHA}; \
            pg8::gemm_phase<pg8::EpiResLnFoldB, pg8::StaticOrder, true, true, false, MK_MIXFOLD != 0>(F.lds + RING_OFF, g, S, E, F.wave)
#define RES_EPI_FF2(l) pg8::EpiResLnFoldB E{F.XB, DM, F.STAT, F.ln1_g + (size_t)l * DM, F.ln1_b + (size_t)l * DM, F.PART, DN_ALPHA}; \
            pg8::gemm_phase<pg8::EpiResLnFoldB, pg8::StaticOrder, true, true, MK_TILED_H != 0>(F.lds + RING_OFF, g, S, E, F.wave)
#else
#define RES_EPI_OUT(l) pg8::EpiResLnFold E{(l == 0) ? F.x_prompt : F.X, (l == 0) ? F.x_sample : F.X + (size_t)NTOK_P * DM, NTOK_P / 256, F.X, F.XB, DM, F.STAT, \
                                (l == 0) ? F.VEC + VEC_ONES : F.ln2_g + (size_t)(l - 1) * DM, (l == 0) ? F.VEC + VEC_ZEROS : F.ln2_b + (size_t)(l - 1) * DM, F.PART, DN_ALPHA}; \
            pg8::gemm_phase<pg8::EpiResLnFold, pg8::StaticOrder, true, true>(F.lds + RING_OFF, g, S, E, F.wave)
#define RES_EPI_FF2(l) pg8::EpiResLnFold E{F.X, F.X + (size_t)NTOK_P * DM, NTOK_P / 256, F.X, F.XB, DM, F.STAT, F.ln1_g + (size_t)l * DM, F.ln1_b + (size_t)l * DM, F.PART, DN_ALPHA}; \
            pg8::gemm_phase<pg8::EpiResLnFold, pg8::StaticOrder, true, true, MK_TILED_H != 0>(F.lds + RING_OFF, g, S, E, F.wave)
#endif
#define LAYER_BODY(l) do { \
        const int pb = 1 + PH_PER_LAYER * l; \
        if (IN(pb + 0)) { \
            STAGGER(MK_STAGGER_IN); pg8::Gemm g{F.XB, F.Win_t, NTOK, INW, DM, nullptr, 0, STG_OFF - RING_OFF}; pg8::StaticOrder S; S.init(NTOK, INW, F.G, (int)blockIdx.x); \
            if (!MK_FIN_PHASES && l > 0) STATS_PREAMBLE(S); \
            { INPROJ_EPI(l); } if (MK_DUP_ALL) { INPROJ_EPI(l); } \
            if (MK_DUP_KLOOP & 1) { pg8::EpiNull EN{F.LSE}; pg8::gemm_phase<pg8::EpiNull, pg8::StaticOrder, true, true>(F.lds + RING_OFF, g, S, EN, F.wave); } \
            for (int rep = 0; rep < 1 + MK_DUP_ALL; ++rep) if (F.G == 256 && blockIdx.x >= 128) convert_weights(F, l, 0, 2, ((int)blockIdx.x - 128) * NWAVES + F.wave, 128 * NWAVES); \
        } SEAM(pb + 0); \
        if (IN(pb + 1)) { PREP_PHASE(l); } if (!MK_FUSE_PREP) SEAM(pb + 1); \
        if (IN(pb + 2)) { phase_attn_A(F, l, (char*)lds + RING_OFF); ATTN_BC(F, l, (char*)lds + RING_OFF); if ((MK_DUP_ATTN & 1) || MK_DUP_ALL) { phase_attn_A(F, l, (char*)lds + RING_OFF); } if ((MK_DUP_ATTN & 2) || MK_DUP_ALL) { ATTN_BC(F, l, (char*)lds + RING_OFF); } \
            for (int rep = 0; rep < 1 + MK_DUP_ALL; ++rep) if (l + 1 < NLAYER && F.G == 256 && F.vcu < 128) convert_weights(F, l, l + 1, 1, F.vcu * NWAVES + F.wave, 128 * NWAVES); \
            if (MK_MIXFOLD && F.G != 256) convert_weights(F, l, l + 1, ((l + 1 < NLAYER) ? 1 : 0) | 2, F.gw, F.NGW); } SEAM(pb + 2); \
        if (!MK_MIXFOLD) { if (IN(pb + 3)) { if (MK_DUP_ALL) phase_mix_copy(F); phase_mix(F, l); if (!MK_FIN_PHASES) reduce_colsums(F, (l + 1 < NLAYER) ? 3 : 2); if (F.G != 256) convert_weights(F, l, l + 1, ((l + 1 < NLAYER) ? 1 : 0) | 2, F.gw, F.NGW); } SEAM(pb + 3); } \
        if (IN(pb + 4)) { \
            STAGGER(MK_STAGGER_OUT); pg8::Gemm g{F.O, F.Wout_t, NTOK, DM, DM, F.RAT, KTAB_OFF - RING_OFF}; pg8::StaticOrder S; S.init(NTOK, DM, F.G, (int)blockIdx.x, MK_WGM_RES); \
            if (MK_MIXFOLD) { reduce_colsums(F, (l + 1 < NLAYER) ? 3 : 2); RAT_PREAMBLE(S); } \
            { RES_EPI_OUT(l); } if (MK_DUP_ALL) { pg8::EpiResCopyB EC{F.XB, DM}; pg8::gemm_phase<pg8::EpiResCopyB, pg8::StaticOrder, true, true>(F.lds + RING_OFF, g, S, EC, F.wave); } \
            if (MK_DUP_KLOOP & 2) { pg8::EpiNull EN{F.LSE}; pg8::gemm_phase<pg8::EpiNull, pg8::StaticOrder, true, true>(F.lds + RING_OFF, g, S, EN, F.wave); } \
        } SEAM(pb + 4); \
        if (MK_FIN_PHASES) { if (IN(pb + 5)) { for (int rep = 0; rep < 1 + MK_DUP_ALL; ++rep) { phase_finalize_stats(F); reduce_colsums(F, (l + 1 < NLAYER) ? 3 : 2); } } SEAM(pb + 5); } \
        if (IN(pb + 6)) { \
            STAGGER(MK_STAGGER_IN); pg8::Gemm g{F.XB, F.Wff1_t, NTOK, DFF, DM, nullptr, 0, STG_OFF - RING_OFF}; pg8::StaticOrder S; S.init(NTOK, DFF, F.G, (int)blockIdx.x); \
            if (!MK_FIN_PHASES) STATS_PREAMBLE(S); \
            pg8::EpiBf16Fold<3, MK_TILED_H != 0> E{F.H, DFF, F.STAT, F.VEC + VEC_CS_FF1, F.VEC + VEC_BW_FF1}; \
            pg8::gemm_phase<pg8::EpiBf16Fold<3, MK_TILED_H != 0>, pg8::StaticOrder, true, true>(F.lds + RING_OFF, g, S, E, F.wave); \
            if (MK_DUP_ALL) pg8::gemm_phase<pg8::EpiBf16Fold<3, MK_TILED_H != 0>, pg8::StaticOrder, true, true>(F.lds + RING_OFF, g, S, E, F.wave); \
            if (MK_DUP_KLOOP & 4) { pg8::EpiNull EN{F.LSE}; pg8::gemm_phase<pg8::EpiNull, pg8::StaticOrder, true, true>(F.lds + RING_OFF, g, S, EN, F.wave); } \
            if (MK_XCD_EXTRA >= 0 && (int)(blockIdx.x & 7) == MK_XCD_EXTRA) { pg8::StaticOrder S1; S1.init(256, 256, 1, 0); pg8::gemm_phase<pg8::EpiBf16Fold<3, MK_TILED_H != 0>, pg8::StaticOrder, true, true>(F.lds + RING_OFF, g, S1, E, F.wave); } \
        } SEAM(pb + 6); \
        if (IN(pb + 7)) { \
            STAGGER(MK_STAGGER_OUT); pg8::Gemm g{F.H, F.Wff2_t, NTOK, DM, DFF}; pg8::StaticOrder S; S.init(NTOK, DM, F.G, (int)blockIdx.x, MK_WGM_RES); \
            if (MK_FUSE_FINAL && l == NLAYER - 1 && F.G == 256) { FinalOrder SF; SF.s = S; SF.XB = F.XB; SF.PART = F.PART; SF.X = F.X; SF.g = F.ln2_g + (size_t)(NLAYER - 1) * DM; SF.b = F.ln2_b + (size_t)(NLAYER - 1) * DM; SF.cnt = F.ctl + CW_FIN; SF.wave = F.wave; \
                pg8::EpiResLnFoldB E{F.XB, DM, F.STAT, F.ln1_g + (size_t)l * DM, F.ln1_b + (size_t)l * DM, F.PART, DN_ALPHA}; \
                pg8::gemm_phase<pg8::EpiResLnFoldB, FinalOrder, true, true, MK_TILED_H != 0>(F.lds + RING_OFF, g, SF, E, F.wave); } \
            else { RES_EPI_FF2(l); } if (MK_DUP_ALL) { pg8::EpiResCopyB EC{F.XB, DM}; pg8::gemm_phase<pg8::EpiResCopyB, pg8::StaticOrder, true, true, MK_TILED_H != 0>(F.lds + RING_OFF, g, S, EC, F.wave); } \
            if (MK_DUP_KLOOP & 8) { pg8::EpiNull EN{F.LSE}; pg8::gemm_phase<pg8::EpiNull, pg8::StaticOrder, true, true, MK_TILED_H != 0>(F.lds + RING_OFF, g, S, EN, F.wave); } \
        } if (!(MK_FUSE_FINAL && l == NLAYER - 1 && F.G == 256)) SEAM(pb + 7); \
        if (MK_FIN_PHASES) { if (IN(pb + 8)) { for (int rep = 0; rep < 1 + MK_DUP_ALL; ++rep) phase_finalize_stats(F); } SEAM(pb + 8); } \
    } while (0)
#if !MK_HALVES
    LAYER_BODY(0); LAYER_BODY(1); LAYER_BODY(2); LAYER_BODY(3);
#else
#define SBK(l, i) ((l) * 6 + (i))
#define ROT_C(r) (((F.G & (F.G - 1)) == 0 && F.G >= 256) ? (((int)blockIdx.x + 64 * (r)) & (F.G - 1)) : (int)blockIdx.x)
#define SB_ARRIVE(k) do { sb_arrive(F, (k)); if (MK_SB_EAGER) sb_wait(F, (k)); } while (0)
#define SB_WAIT(k) do { if (!MK_SB_EAGER) sb_wait(F, (k)); } while (0)
#define GEMM_IN_H(l, h) do { pg8::Gemm g{F.XB, F.Win_t, NTOK, INW, DM}; pg8::HalfOrder S; S.init(NTOK / 2, INW, F.G, ROT_C((2 * (l) + (h)) & 3), pg8::WGM, (NTOK / 512) * (h)); \
            if ((l) > 0) STATS_PREAMBLE(S); \
            pg8::EpiInProj E{F.PROJ, INW, F.STAT, F.VEC + VEC_CS_IN, F.VEC + VEC_BW_IN, F.a_q_gain + (l) * HD, F.a_k_gain + (l) * HD, F.ROPE_A, F.ROPE_B, (LAS float*)(F.lds + XCH_OFF), \
                (MK_BOUNDED_A && F.VEC[VEC_M0 + (l)] * ATT_SCALE <= 40.f) ? ATT_SCALE * 1.4426950408889634f : 1.f}; \
            pg8::gemm_phase<pg8::EpiInProj, pg8::HalfOrder, true, true>(F.lds + RING_OFF, g, S, E, F.wave); } while (0)
#define GEMM_OUT_H(l, h) do { pg8::Gemm g{F.O, F.Wout_t, NTOK, DM, DM}; pg8::HalfOrder S; S.init(NTOK / 2, DM, F.G, (int)blockIdx.x, MK_WGM_RES, (NTOK / 512) * (h)); \
            pg8::EpiResLnFoldB E{F.XB, DM, F.STAT, ((l) == 0) ? F.VEC + VEC_ONES : F.ln2_g + (size_t)((l) - 1) * DM, ((l) == 0) ? F.VEC + VEC_ZEROS : F.ln2_b + (size_t)((l) - 1) * DM, F.PART, DN_ALPHA}; \
            pg8::gemm_phase<pg8::EpiResLnFoldB, pg8::HalfOrder, true, true>(F.lds + RING_OFF, g, S, E, F.wave); } while (0)
#define GEMM_FF1_H(l, h) do { pg8::Gemm g{F.XB, F.Wff1_t, NTOK, DFF, DM}; pg8::HalfOrder S; S.init(NTOK / 2, DFF, F.G, (int)blockIdx.x, pg8::WGM, (NTOK / 512) * (h)); \
            STATS_PREAMBLE(S); \
            pg8::EpiBf16Fold<3, MK_TILED_H != 0> E{F.H, DFF, F.STAT, F.VEC + VEC_CS_FF1, F.VEC + VEC_BW_FF1}; \
            pg8::gemm_phase<pg8::EpiBf16Fold<3, MK_TILED_H != 0>, pg8::HalfOrder, true, true>(F.lds + RING_OFF, g, S, E, F.wave); } while (0)
#define GEMM_FF2_H(l, h) do { pg8::Gemm g{F.H, F.Wff2_t, NTOK, DM, DFF}; pg8::HalfOrder S; S.init(NTOK / 2, DM, F.G, (int)blockIdx.x, MK_WGM_RES, (NTOK / 512) * (h)); \
            pg8::EpiResLnFoldB E{F.XB, DM, F.STAT, F.ln1_g + (size_t)(l) * DM, F.ln1_b + (size_t)(l) * DM, F.PART, DN_ALPHA}; \
            pg8::gemm_phase<pg8::EpiResLnFoldB, pg8::HalfOrder, true, true, MK_TILED_H != 0>(F.lds + RING_OFF, g, S, E, F.wave); } while (0)
#define XBAR() xcd_barrier(bar, F.wave == 0 && lane_id() == 0)
#define LAYER_BODY_H(l) do { \
        if ((l) > 0) SB_WAIT(SBK((l) - 1, 4)); GEMM_IN_H(l, 0); \
        if ((l) > 0) SB_WAIT(SBK((l) - 1, 5)); GEMM_IN_H(l, 1); \
        if (F.G == 256 && (((int)blockIdx.x >> 7) ^ ((l) & 1)) == 1) convert_weights(F, l, 0, 2, ((int)blockIdx.x & 127) * NWAVES + F.wave, 128 * NWAVES);     \
        XBAR(); \
        phase_attn_A(F, l, (char*)lds + RING_OFF); phase_attn_B(F, (char*)lds + RING_OFF); phase_attn_C(F, l, (char*)lds + RING_OFF); \
        if ((l) + 1 < NLAYER && F.vcu < F.G / 2) convert_weights(F, l, (l) + 1, 1, F.vcu * NWAVES + F.wave, (F.G / 2) * NWAVES); \
        if (F.G != 256) convert_weights(F, l, 0, 2, F.gw, F.NGW); \
        XBAR(); \
        phase_mix(F, l); reduce_colsums(F, ((l) + 1 < NLAYER) ? 3 : 2); \
        XBAR(); \
        GEMM_OUT_H(l, 0); SB_ARRIVE(SBK(l, 0)); \
        GEMM_OUT_H(l, 1); SB_ARRIVE(SBK(l, 1)); \
        SB_WAIT(SBK(l, 0)); GEMM_FF1_H(l, 0); SB_ARRIVE(SBK(l, 2)); \
        SB_WAIT(SBK(l, 1)); GEMM_FF1_H(l, 1); SB_ARRIVE(SBK(l, 3)); \
        SB_WAIT(SBK(l, 2)); GEMM_FF2_H(l, 0); SB_ARRIVE(SBK(l, 4)); \
        SB_WAIT(SBK(l, 3)); GEMM_FF2_H(l, 1); SB_ARRIVE(SBK(l, 5)); \
    } while (0)
    LAYER_BODY_H(0); LAYER_BODY_H(1); LAYER_BODY_H(2); LAYER_BODY_H(3);
    SB_WAIT(SBK(NLAYER - 1, 4)); SB_WAIT(SBK(NLAYER - 1, 5));
#undef LAYER_BODY_H
#endif
#undef LAYER_BODY
    if (IN(N_PHASES - 1) && !(MK_FUSE_FINAL && F.G == 256)) { phase_final_ln(F, F.ln2_g + (size_t)(NLAYER - 1) * DM, F.ln2_b + (size_t)(NLAYER - 1) * DM); if (MK_DUP_ENDS & 2) phase_final_ln(F, F.ln2_g + (size_t)(NLAYER - 1) * DM, F.ln2_b + (size_t)(NLAYER - 1) * DM); }

#undef IN
#undef SEAM
}

extern "C" void kernel_launch(void* const* d_in, const int* in_sizes, int n_in, void* d_out, int out_size, void* d_ws, size_t ws_size, hipStream_t stream) {
    static int grid = 0;
    if (grid == 0) {
        if (n_in != 14 || in_sizes[0] != NTOK_P * DM || out_size != NTOK * DM || ws_size < WS_END) { fprintf(stderr, "kernel_launch: shape/workspace mismatch (n_in %d, out %d, ws %zu < %zu); nothing launched\n", n_in, out_size, ws_size, (size_t)WS_END); grid = -1; return; }
        int dev = 0, cus = 0, per_cu = 0;
        if (hipGetDevice(&dev) != hipSuccess || hipDeviceGetAttribute(&cus, hipDeviceAttributeMultiprocessorCount, dev) != hipSuccess) { grid = -1; return; }
        if (hipFuncSetAttribute((const void*)trunk_fwd, hipFuncAttributeMaxDynamicSharedMemorySize, LDS_BYTES) != hipSuccess) { fprintf(stderr, "kernel_launch: hipFuncSetAttribute failed\n"); grid = -1; return; }
        if (hipOccupancyMaxActiveBlocksPerMultiprocessor(&per_cu, (const void*)trunk_fwd, NWAVES * 64, LDS_BYTES) != hipSuccess || per_cu < 1) { fprintf(stderr, "kernel_launch: occupancy query says %d blocks per CU\n", per_cu); }
        (void)hipGetLastError();
        grid = cus;
    }
    if (grid < 0) return;
    if (hipMemsetAsync((char*)d_ws + WS_CTL, 0, CTL_ZERO_BYTES, stream) != hipSuccess) return;
    Args a{};
    for (int i = 0; i < 14; ++i) a.in[i] = (const float*)d_in[i];
    a.out = (float*)d_out; a.ws = (unsigned char*)d_ws;
#if MK_PER_PHASE
    for (int p = 0; p < N_PHASES; ++p) { a.ph_lo = p; a.ph_hi = p + 1; hipLaunchKernelGGL(trunk_fwd, dim3(grid), dim3(NWAVES * 64), LDS_BYTES, stream, a); }
#else
    a.ph_lo = 0; a.ph_hi = N_PHASES;
    hipLaunchKernelGGL(trunk_fwd, dim3(grid), dim3(NWAVES * 64), LDS_BYTES, stream, a);
#endif
    const hipError_t le = hipPeekAtLastError();
    if (le != hipSuccess) fprintf(stderr, "kernel_launch: launch failed: %s\n", hipGetErrorName(le));
}
```

```cpp
#include <hip/hip_runtime.h>
#include <hip/hip_bf16.h>
#include <cstdio>
#include <cstdint>
#include <cmath>
__device__ __forceinline__ int lane_id() { int l; asm volatile("v_mbcnt_lo_u32_b32 %0, -1, 0\n\tv_mbcnt_hi_u32_b32 %0, -1, %0" : "=v"(l)); return l; }
template <int M> __device__ __forceinline__ float xshfl(float v) { static_assert(M >= 1 && M < 32, "xshfl: xor mask 1..31"); return __builtin_bit_cast(float, __builtin_amdgcn_ds_swizzle(__builtin_bit_cast(int, v), (M << 10) | 0x1f)); }
__device__ __forceinline__ float rowsum16(float v) {
    v += __builtin_bit_cast(float, __builtin_amdgcn_update_dpp(0, __builtin_bit_cast(int, v), 0xB1, 0xF, 0xF, true));
    v += __builtin_bit_cast(float, __builtin_amdgcn_update_dpp(0, __builtin_bit_cast(int, v), 0x4E, 0xF, 0xF, true));
    v += __builtin_bit_cast(float, __builtin_amdgcn_update_dpp(0, __builtin_bit_cast(int, v), 0x141, 0xF, 0xF, true));
    v += __builtin_bit_cast(float, __builtin_amdgcn_update_dpp(0, __builtin_bit_cast(int, v), 0x140, 0xF, 0xF, true));
    return v;
}
__device__ __forceinline__ void xswap32(float& a, float& b) { asm volatile("s_nop 1\n\tv_permlane32_swap_b32 %0, %1" : "+v"(a), "+v"(b)); }
__device__ __forceinline__ float xsum32(float v) { float a = v, b = v; xswap32(a, b); return a + b; }
__device__ __forceinline__ float xmax32(float v) { float a = v, b = v; xswap32(a, b); return fmaxf(a, b); }
#ifndef MK_MIXFOLD
#define MK_MIXFOLD 1
#endif
#define MK_SSQ_FROM_O_BYTES ((1012L - 820L) << 20)
#ifndef MK_EPI_STAGE
#define MK_EPI_STAGE 1
#endif
#ifndef MK_EPI_STAGE_RES
#define MK_EPI_STAGE_RES 0
#endif
#ifndef MK_NT_H
#define MK_NT_H 1
#endif
#ifndef MK_NT_PROJ
#define MK_NT_PROJ 0
#endif
#ifndef MK_NT_HLOAD
#define MK_NT_HLOAD 0
#endif
#ifndef MK_TILED_W
#define MK_TILED_W 0
#endif
namespace pg8 {
#define PG8_LAS __attribute__((address_space(3)))
typedef unsigned short bf16_t;
typedef short bf16x8 __attribute__((ext_vector_type(8)));
typedef float f32x4 __attribute__((ext_vector_type(4)));
typedef unsigned u32x4 __attribute__((ext_vector_type(4)));
constexpr int BM = 256, BK = 64, HALF = 128, HTB = HALF * BK * 2  , STAGE_BYTES = 8 * HTB, NXCD = 8, WGM = 8;

__host__ __device__ __forceinline__ int lds_byte(int r, int c) { const int st = (r >> 4) * 2 + (c >> 5), rr = r & 15, cc = c & 31, ob = rr * 64 + cc * 2; return st * 1024 + (ob ^ (((ob >> 9) & 1) << 5)); }
__host__ __device__ __forceinline__ void stage_rc(int b, int& R, int& C) { const int st = b / 1024, sb = b % 1024, swz = sb ^ (((sb >> 9) & 1) << 5); R = (st >> 1) * 16 + swz / 64; C = (st & 1) * 32 + (swz % 64) / 2; }
__host__ __device__ __forceinline__ int perm32(int rho) { const int n = rho >> 4, i = rho & 15; return 8 * (i >> 2) + 4 * n + (i & 3); }

struct Unit { int pm, pn; };
struct Gemm { const bf16_t* A; const bf16_t* Bt; int M, N, K; const float* rat = nullptr; int ktab_off = 0; int stg_off = 0; };

struct StaticOrder {
    int nM, nN, nwg, G, c, wgm;
    __host__ __device__ __forceinline__ void init(int M, int N, int G_, int c_, int wgm_ = WGM) { nM = M / BM; nN = N / BM; nwg = nM * nN; G = G_; c = c_; wgm = wgm_; }
    __host__ __device__ __forceinline__ bool next(int i, Unit& u) const {
        const long L = (long)i * G + c; if (L >= nwg) return false;
        int wgid = (int)L; { const int q = nwg / NXCD, r = nwg % NXCD, xcd = wgid % NXCD, off = wgid / NXCD; wgid = (xcd < r ? xcd * (q + 1) : r * (q + 1) + (xcd - r) * q) + off; }
        const int nig = wgm * nN, gid = wgid / nig, fm = gid * wgm, gsz = (nM - fm) < wgm ? (nM - fm) : wgm;
        u.pm = fm + ((wgid % nig) % gsz); u.pn = (wgid % nig) / gsz; return true;
    }
    __device__ __forceinline__ void a_ready(const Unit&) const {}
    __device__ __forceinline__ void done(const Unit&) const {}
};

struct HalfOrder {
    StaticOrder s; int pmb;
    __host__ __device__ __forceinline__ void init(int Mh, int N, int G_, int c_, int wgm_, int pmb_) { s.init(Mh, N, G_, c_, wgm_); pmb = pmb_; }
    __host__ __device__ __forceinline__ bool next(int i, Unit& u) const { const bool ok = s.next(i, u); u.pm += pmb; return ok; }
    __device__ __forceinline__ void a_ready(const Unit&) const {}
    __device__ __forceinline__ void done(const Unit&) const {}
};
__device__ __forceinline__ unsigned cvt_pk_bf16(float lo, float hi) { unsigned r; asm volatile("v_cvt_pk_bf16_f32 %0, %1, %2" : "=v"(r) : "v"(lo), "v"(hi)); return r; }
typedef float f32x2 __attribute__((ext_vector_type(2)));
__device__ __forceinline__ f32x2 gelu_pk(f32x2 v) {
    const f32x2 av = __builtin_elementwise_abs(v), d = av * 0.2316418882f + 1.0f;
    f32x2 t; t.x = __builtin_amdgcn_rcpf(d.x); t.y = __builtin_amdgcn_rcpf(d.y);
    f32x2 q = t * 0.5307027145f + (-0.7265760135f); q = q * t + 0.7107068705f; q = q * t + (-0.142248368f); q = q * t + 0.127414796f; q = q * t;
    const f32x2 s = (v * v) * (-0.72134752044f);
    f32x2 e; e.x = __builtin_amdgcn_exp2f(s.x); e.y = __builtin_amdgcn_exp2f(s.y);
    const f32x2 m = v * (q * e), r = v - m;
    f32x2 o; o.x = v.x < 0.f ? m.x : r.x; o.y = v.y < 0.f ? m.y : r.y; return o;
}

template <int ACT  > struct EpiBf16 {
    static constexpr bool PERM = true, AFTER_DRAIN = false, LDS_STAGE = false; static constexpr int MIN_VMEM = 0;     static_assert(ACT == 0 || ACT == 1, "EpiBf16: ACT is 0 (none) or 1 (gelu_pk)");
    bf16_t* O; int ldc; const float* bias; int split_cols; size_t split_stride; float scale0;
    __device__ __forceinline__ void operator()(const f32x4 (&acc)[2][2][4][2], const Unit& u, int wr, int wc, int fr, int fq) const {
        const int row0 = u.pm * BM + wr * 64 + fr; int colt = u.pn * BM; bf16_t* base = O;
        float sc = 1.f; if (split_cols) { const int t = colt / split_cols; base += (size_t)t * split_stride; colt -= t * split_cols; if (t == 0) sc = scale0; }
        const int col0 = colt + wc * 32 + 8 * fq, bcol0 = u.pn * BM + wc * 32 + 8 * fq;
        f32x4 bv[2][2];
#pragma unroll
        for (int bj = 0; bj < 2; ++bj)
#pragma unroll
            for (int n = 0; n < 2; ++n) bv[bj][n] = bias ? *(const f32x4*)(bias + bcol0 + bj * HALF + 4 * n) : (f32x4){0.f, 0.f, 0.f, 0.f};
#pragma unroll
        for (int ai = 0; ai < 2; ++ai)
#pragma unroll
            for (int m = 0; m < 4; ++m) { bf16_t* rowp = base + (size_t)(row0 + ai * HALF + m * 16) * ldc + col0;
#pragma unroll
                for (int bj = 0; bj < 2; ++bj) { f32x4 v0 = acc[ai][bj][m][0] + bv[bj][0], v1 = acc[ai][bj][m][1] + bv[bj][1];
                    if (ACT == 1) { f32x2 a = gelu_pk((f32x2){v0[0], v0[1]}), b = gelu_pk((f32x2){v0[2], v0[3]}), c = gelu_pk((f32x2){v1[0], v1[1]}), d = gelu_pk((f32x2){v1[2], v1[3]});
                        v0 = (f32x4){a.x, a.y, b.x, b.y}; v1 = (f32x4){c.x, c.y, d.x, d.y}; }
                    v0 = v0 * sc; v1 = v1 * sc; u32x4 w; w.x = cvt_pk_bf16(v0[0], v0[1]); w.y = cvt_pk_bf16(v0[2], v0[3]); w.z = cvt_pk_bf16(v1[0], v1[1]); w.w = cvt_pk_bf16(v1[2], v1[3]);
                    *(u32x4*)(rowp + bj * HALF) = w; } }
    }
};


struct EpiRelu2Bf16 {
    static constexpr bool PERM = true, AFTER_DRAIN = false, LDS_STAGE = false; static constexpr int MIN_VMEM = 0;
    bf16_t* O; int ldc;
    __device__ __forceinline__ void operator()(const f32x4 (&acc)[2][2][4][2], const Unit& u, int wr, int wc, int fr, int fq) const {
        const int row0 = u.pm * BM + wr * 64 + fr; const int col0 = u.pn * BM + wc * 32 + 8 * fq;
#pragma unroll
        for (int ai = 0; ai < 2; ++ai)
#pragma unroll
            for (int m = 0; m < 4; ++m) { bf16_t* rowp = O + (size_t)(row0 + ai * HALF + m * 16) * ldc + col0;
#pragma unroll
                for (int bj = 0; bj < 2; ++bj) { f32x4 v0 = acc[ai][bj][m][0], v1 = acc[ai][bj][m][1];
#pragma unroll
                    for (int e = 0; e < 4; ++e) { const float a = fmaxf(v0[e], 0.f), b = fmaxf(v1[e], 0.f); v0[e] = a * a; v1[e] = b * b; }
                    u32x4 w; w.x = cvt_pk_bf16(v0[0], v0[1]); w.y = cvt_pk_bf16(v0[2], v0[3]); w.z = cvt_pk_bf16(v1[0], v1[1]); w.w = cvt_pk_bf16(v1[2], v1[3]);
                    *(u32x4*)(rowp + bj * HALF) = w; } }
    }
};
struct EpiResF32 {
    static constexpr bool PERM = false, AFTER_DRAIN = false, LDS_STAGE = false; static constexpr int MIN_VMEM = 0;
    const float* X; float* Z; int ldc; float alpha;
    __device__ __forceinline__ void operator()(const f32x4 (&acc)[2][2][4][2], const Unit& u, int wr, int wc, int fr, int fq) const {
        const int row0 = u.pm * BM + wr * 64 + fr, col0 = u.pn * BM + wc * 32 + 4 * fq;
#pragma unroll
        for (int ai = 0; ai < 2; ++ai)
#pragma unroll
            for (int m = 0; m < 4; ++m) { const size_t off = (size_t)(row0 + ai * HALF + m * 16) * ldc + col0;
#pragma unroll
                for (int bj = 0; bj < 2; ++bj)
#pragma unroll
                    for (int n = 0; n < 2; ++n) { const f32x4 xv = *(const f32x4*)(X + off + bj * HALF + n * 16);
                        *(f32x4*)(Z + off + bj * HALF + n * 16) = xv * alpha + acc[ai][bj][m][n]; } }
    }
};

template <int ACT, bool TILED = false> struct EpiBf16Fold {
    static constexpr bool PERM = true, AFTER_DRAIN = false, LDS_STAGE = (MK_EPI_STAGE != 0); static constexpr int MIN_VMEM = 16;
    bf16_t* O; int ldc; const f32x2* stat; const float* cs; const float* bw;
    __device__ __forceinline__ void stage(const Unit& u, PG8_LAS unsigned char* buf, int wid) const {
        if (wid < 4) { const int ln = lane_id();
            const char* src = (wid < 2) ? (const char*)(stat + (size_t)u.pm * BM) + (wid * 64 + ln) * 16 : (wid == 2) ? (const char*)(cs + u.pn * BM) + ln * 16 : (const char*)(bw + u.pn * BM) + ln * 16;
            __builtin_amdgcn_global_load_lds((const unsigned*)src, (PG8_LAS unsigned*)(buf + wid * 1024), 16, 0, 0); }
    }
    __device__ __forceinline__ void operator()(const f32x4 (&acc)[2][2][4][2], const Unit& u, int wr, int wc, int fr, int fq, const PG8_LAS unsigned char* sbuf = nullptr) const {
        const int row0 = u.pm * BM + wr * 64 + fr; const int col0 = u.pn * BM + wc * 32 + 8 * fq;
        f32x4 cv[2][2], bv[2][2]; f32x2 st[2][4];
#pragma unroll
        for (int ai = 0; ai < 2; ++ai)
#pragma unroll
            for (int m = 0; m < 4; ++m) st[ai][m] = LDS_STAGE ? ((const PG8_LAS f32x2*)sbuf)[ai * HALF + wr * 64 + m * 16 + fr] : stat[row0 + ai * HALF + m * 16];
#pragma unroll
        for (int bj = 0; bj < 2; ++bj)
#pragma unroll
            for (int n = 0; n < 2; ++n) { const int lc_ = bj * HALF + wc * 32 + 8 * fq + 4 * n;
                cv[bj][n] = LDS_STAGE ? *(const PG8_LAS f32x4*)(sbuf + 2048 + lc_ * 4) : *(const f32x4*)(cs + col0 + bj * HALF + 4 * n); bv[bj][n] = LDS_STAGE ? *(const PG8_LAS f32x4*)(sbuf + 3072 + lc_ * 4) : *(const f32x4*)(bw + col0 + bj * HALF + 4 * n); }
#pragma unroll
        for (int ai = 0; ai < 2; ++ai)
#pragma unroll
            for (int m = 0; m < 4; ++m) { const int row = row0 + ai * HALF + m * 16; const float rs = st[ai][m].y, nm = -st[ai][m].x * st[ai][m].y;
                bf16_t* rowp = TILED ? O + ((size_t)(row >> 8) * (ldc >> 6) + (col0 >> 6)) * 16384 + (row & 255) * 64 + (col0 & 63) : O + (size_t)row * ldc + col0;
#pragma unroll
                for (int bj = 0; bj < 2; ++bj) { f32x4 v0 = acc[ai][bj][m][0] * rs + (cv[bj][0] * nm + bv[bj][0]), v1 = acc[ai][bj][m][1] * rs + (cv[bj][1] * nm + bv[bj][1]);
                    if (ACT == 3) {
#pragma unroll
                        for (int e = 0; e < 4; ++e) { const float a = fmaxf(v0[e], 0.f), b = fmaxf(v1[e], 0.f); v0[e] = a * a; v1[e] = b * b; } }
                    u32x4 w; w.x = cvt_pk_bf16(v0[0], v0[1]); w.y = cvt_pk_bf16(v0[2], v0[3]); w.z = cvt_pk_bf16(v1[0], v1[1]); w.w = cvt_pk_bf16(v1[2], v1[3]);
                    if (TILED && MK_NT_H) __builtin_nontemporal_store(w, (u32x4*)(rowp + bj * 2 * 16384)); else *(u32x4*)(rowp + (TILED ? bj * 2 * 16384 : bj * HALF)) = w; } }
    }
};
struct EpiResLnFold {
    static constexpr bool PERM = false, AFTER_DRAIN = false, LDS_STAGE = false; static constexpr int MIN_VMEM = 0;
    const float* Xp; const float* Xs; int split_pm;
    float* Z; bf16_t* ZB; int ldc; const f32x2* stat; const float* g; const float* b; f32x2* part; float alpha;
    __device__ __forceinline__ void operator()(const f32x4 (&acc)[2][2][4][2], const Unit& u, int wr, int wc, int fr, int fq) const {
        typedef unsigned u32x2v __attribute__((ext_vector_type(2)));
        const int row0 = u.pm * BM + wr * 64 + fr, col0 = u.pn * BM + wc * 32 + 4 * fq;
        const float* xbase = (u.pm < split_pm) ? Xp : Xs - (size_t)split_pm * BM * ldc;
        f32x4 gv[2][2], bv[2][2]; f32x2 st[2][4];
#pragma unroll
        for (int ai = 0; ai < 2; ++ai)
#pragma unroll
            for (int m = 0; m < 4; ++m) st[ai][m] = stat[row0 + ai * HALF + m * 16];
#pragma unroll
        for (int bj = 0; bj < 2; ++bj)
#pragma unroll
            for (int n = 0; n < 2; ++n) { gv[bj][n] = *(const f32x4*)(g + col0 + bj * HALF + n * 16); bv[bj][n] = *(const f32x4*)(b + col0 + bj * HALF + n * 16); }
        f32x4 xv[2][2][2];
#define RLF_LOAD(buf, rg) do { const size_t off_ = (size_t)(row0 + ((rg) >> 2) * HALF + ((rg) & 3) * 16) * ldc + col0; \
            _Pragma("unroll") for (int bj = 0; bj < 2; ++bj) _Pragma("unroll") for (int n = 0; n < 2; ++n) xv[buf][bj][n] = *(const f32x4*)(xbase + off_ + bj * HALF + n * 16); } while (0)
        RLF_LOAD(0, 0);
#pragma unroll
        for (int rg = 0; rg < 8; ++rg) { const int ai = rg >> 2, m = rg & 3, cur = rg & 1;
            if (rg + 1 < 8) RLF_LOAD(cur ^ 1, rg + 1);
            asm volatile("" ::: "memory");
            const int row = row0 + ai * HALF + m * 16; const size_t off = (size_t)row * ldc + col0; const float mu = st[ai][m].x, rs = st[ai][m].y;
            float s = 0.f, q = 0.f;
#pragma unroll
            for (int bj = 0; bj < 2; ++bj)
#pragma unroll
                for (int n = 0; n < 2; ++n) {
                    const f32x4 xn = (xv[cur][bj][n] - mu) * rs * gv[bj][n] + bv[bj][n]; const f32x4 z = xn * alpha + acc[ai][bj][m][n];
                    *(f32x4*)(Z + off + bj * HALF + n * 16) = z;
                    u32x2v w; w.x = cvt_pk_bf16(z[0], z[1]); w.y = cvt_pk_bf16(z[2], z[3]); *(u32x2v*)(ZB + off + bj * HALF + n * 16) = w;
                    s += (z[0] + z[1]) + (z[2] + z[3]); q += (z[0] * z[0] + z[1] * z[1]) + (z[2] * z[2] + z[3] * z[3]); }
            s += xshfl<16>(s); s = xsum32(s); q += xshfl<16>(q); q = xsum32(q);
            if (fq == 0) part[(size_t)row * 32 + u.pn * 4 + wc] = (f32x2){s, q};
            asm volatile("" ::: "memory");
        }
#undef RLF_LOAD
    }
};

struct EpiInProj {
    static constexpr bool PERM = true, AFTER_DRAIN = false, LDS_STAGE = (MK_EPI_STAGE != 0); static constexpr int MIN_VMEM = 16;
    bf16_t* O; int ldc; const f32x2* stat; const float* cs; const float* bw;
    const float* gq; const float* gk; const float* ropeA; const float* ropeB; PG8_LAS float* xch;
    float qscale;
    __device__ __forceinline__ void stage(const Unit& u, PG8_LAS unsigned char* buf, int wid) const {
        if (wid < 4) { const int ln = lane_id();
            const char* src = (wid < 2) ? (const char*)(stat + (size_t)u.pm * BM) + (wid * 64 + ln) * 16 : (wid == 2) ? (const char*)(cs + u.pn * BM) + ln * 16 : (const char*)(bw + u.pn * BM) + ln * 16;
            __builtin_amdgcn_global_load_lds((const unsigned*)src, (PG8_LAS unsigned*)(buf + wid * 1024), 16, 0, 0); }
    }
    __device__ __forceinline__ void operator()(const f32x4 (&acc_)[2][2][4][2], const Unit& u, int wr, int wc, int fr, int fq, const PG8_LAS unsigned char* sbuf = nullptr) const {
        f32x4 (&acc)[2][2][4][2] = const_cast<f32x4 (&)[2][2][4][2]>(acc_);
        const int row0 = u.pm * BM + wr * 64 + fr; const int col0 = u.pn * BM + wc * 32 + 8 * fq;
        const int kind = (u.pn < 3) ? 1 : (u.pn >= 4 && u.pn < 10) ? 2 : 0;
        { f32x4 cv[2][2], bv[2][2]; f32x2 st[2][4];
#pragma unroll
          for (int ai = 0; ai < 2; ++ai)
#pragma unroll
            for (int m = 0; m < 4; ++m) st[ai][m] = LDS_STAGE ? ((const PG8_LAS f32x2*)sbuf)[ai * HALF + wr * 64 + m * 16 + fr] : stat[row0 + ai * HALF + m * 16];
#pragma unroll
          for (int bj = 0; bj < 2; ++bj)
#pragma unroll
            for (int n = 0; n < 2; ++n) { const int lc_ = bj * HALF + wc * 32 + 8 * fq + 4 * n;
                cv[bj][n] = LDS_STAGE ? *(const PG8_LAS f32x4*)(sbuf + 2048 + lc_ * 4) : *(const f32x4*)(cs + col0 + bj * HALF + 4 * n); bv[bj][n] = LDS_STAGE ? *(const PG8_LAS f32x4*)(sbuf + 3072 + lc_ * 4) : *(const f32x4*)(bw + col0 + bj * HALF + 4 * n); }
#pragma unroll
          for (int ai = 0; ai < 2; ++ai)
#pragma unroll
            for (int m = 0; m < 4; ++m) { const float rs = st[ai][m].y, nm = -st[ai][m].x * st[ai][m].y;
#pragma unroll
                for (int bj = 0; bj < 2; ++bj)
#pragma unroll
                    for (int n = 0; n < 2; ++n) acc[ai][bj][m][n] = acc[ai][bj][m][n] * rs + (cv[bj][n] * nm + bv[bj][n]); } }
        if (kind == 0) {
#pragma unroll
            for (int ai = 0; ai < 2; ++ai)
#pragma unroll
                for (int m = 0; m < 4; ++m) { bf16_t* rowp = O + (size_t)(row0 + ai * HALF + m * 16) * ldc + col0;
#pragma unroll
                    for (int bj = 0; bj < 2; ++bj) { const f32x4 v0 = acc[ai][bj][m][0], v1 = acc[ai][bj][m][1];
                        u32x4 w; w.x = cvt_pk_bf16(v0[0], v0[1]); w.y = cvt_pk_bf16(v0[2], v0[3]); w.z = cvt_pk_bf16(v1[0], v1[1]); w.w = cvt_pk_bf16(v1[2], v1[3]);
                        if (MK_NT_PROJ) __builtin_nontemporal_store(w, (u32x4*)(rowp + bj * HALF)); else *(u32x4*)(rowp + bj * HALF) = w; } }
            return;
        }
        const float qs = (u.pn < 2) ? qscale : 1.f;
        const int half = wc >> 1;
        const int i0 = (kind == 1) ? 4 * (4 * (wc & 1) + fq) : 16 * wc + 4 * fq;
        f32x4 g_lo = {1.f, 1.f, 1.f, 1.f}, g_hi = {1.f, 1.f, 1.f, 1.f};
        if (kind == 1) {
            const float* gain = (u.pn < 2) ? gq : gk; g_lo = *(const f32x4*)(gain + 64 * half + i0); g_hi = *(const f32x4*)(gain + 64 * half + i0 + 32);
#pragma unroll
            for (int ai = 0; ai < 2; ++ai)
#pragma unroll
                for (int m = 0; m < 4; ++m)
#pragma unroll
                    for (int bj = 0; bj < 2; ++bj) { const f32x4 a = acc[ai][bj][m][0], b = acc[ai][bj][m][1];
                        float ss = ((a[0] * a[0] + a[1] * a[1]) + (a[2] * a[2] + a[3] * a[3])) + ((b[0] * b[0] + b[1] * b[1]) + (b[2] * b[2] + b[3] * b[3]));
                        ss += xshfl<16>(ss); ss = xsum32(ss);
                        if (fq == 0) xch[((ai * HALF + wr * 64 + m * 16 + fr) * 2 + bj) * 4 + wc] = ss; }
            asm volatile("s_waitcnt lgkmcnt(0)" ::: "memory"); __builtin_amdgcn_s_barrier(); asm volatile("" ::: "memory");
        }
        f32x4 tb[2][2][2];
#define EIP_LOAD(buf, sg) do { _Pragma("unroll") for (int h = 0; h < 2; ++h) { const int rg_ = 2 * (sg) + h; const int t_ = (row0 + (rg_ >> 2) * HALF + (rg_ & 3) * 16) & 4095; \
            const float* tp_ = (kind == 1) ? ropeA + 2 * ((half ? (t_ & 63) : (t_ >> 6)) * 32 + i0) : ropeB + 2 * (t_ * 64 + i0); \
            tb[buf][h][0] = *(const f32x4*)tp_; tb[buf][h][1] = *(const f32x4*)(tp_ + 4); } } while (0)
        EIP_LOAD(0, 0);
#pragma unroll
        for (int sg = 0; sg < 4; ++sg) { const int cur = sg & 1;
            if (sg + 1 < 4) EIP_LOAD(cur ^ 1, sg + 1);
            asm volatile("" ::: "memory");
#pragma unroll
            for (int h = 0; h < 2; ++h) { const int rg = 2 * sg + h, ai = rg >> 2, m = rg & 3; const int rl = ai * HALF + wr * 64 + m * 16 + fr;
                bf16_t* rowp = O + (size_t)(u.pm * BM + rl) * ldc + col0;
                const f32x4 t0 = tb[cur][h][0], t1 = tb[cur][h][1];
                const f32x4 cs4 = {t0[0], t0[2], t1[0], t1[2]}, sn4 = {t0[1], t0[3], t1[1], t1[3]};
#pragma unroll
                for (int bj = 0; bj < 2; ++bj) { f32x4 lo = acc[ai][bj][m][0], hi = acc[ai][bj][m][1];
                    if (kind == 1) { const f32x4 pq = *(const PG8_LAS f32x4*)(xch + (rl * 2 + bj) * 4); const float rs = 1.0f / sqrtf(((pq[0] + pq[1]) + (pq[2] + pq[3])) * (1.0f / 128.f) + 1e-6f);
                        lo = lo * (rs * qs) * g_lo; hi = hi * (rs * qs) * g_hi; }
                    const f32x4 ol = lo * cs4 - hi * sn4, oh = hi * cs4 + lo * sn4;
                    u32x4 w; w.x = cvt_pk_bf16(ol[0], ol[1]); w.y = cvt_pk_bf16(ol[2], ol[3]); w.z = cvt_pk_bf16(oh[0], oh[1]); w.w = cvt_pk_bf16(oh[2], oh[3]);
                    if (MK_NT_PROJ) __builtin_nontemporal_store(w, (u32x4*)(rowp + bj * HALF)); else *(u32x4*)(rowp + bj * HALF) = w; } }
            asm volatile("" ::: "memory");
        }
#undef EIP_LOAD
        if (kind == 1) { asm volatile("s_waitcnt lgkmcnt(0)" ::: "memory"); __builtin_amdgcn_s_barrier(); asm volatile("" ::: "memory"); }
    }
};

struct EpiResLnFoldB {
    static constexpr bool PERM = false, AFTER_DRAIN = false, LDS_STAGE = (MK_EPI_STAGE_RES != 0); static constexpr int MIN_VMEM = 16;
    bf16_t* ZB; int ldc; const f32x2* stat; const float* g; const float* b; f32x2* part; float alpha;
    __device__ __forceinline__ void stage(const Unit& u, PG8_LAS unsigned char* buf, int wid) const {
        if (wid < 4) { const int ln = lane_id();
            const char* src = (wid < 2) ? (const char*)(stat + (size_t)u.pm * BM) + (wid * 64 + ln) * 16 : (wid == 2) ? (const char*)(g + u.pn * BM) + ln * 16 : (const char*)(b + u.pn * BM) + ln * 16;
            __builtin_amdgcn_global_load_lds((const unsigned*)src, (PG8_LAS unsigned*)(buf + wid * 1024), 16, 0, 0); }
    }
    __device__ __forceinline__ void operator()(const f32x4 (&acc)[2][2][4][2], const Unit& u, int wr, int wc, int fr, int fq, const PG8_LAS unsigned char* sbuf = nullptr) const {
        typedef unsigned u32x2v __attribute__((ext_vector_type(2)));
        const int row0 = u.pm * BM + wr * 64 + fr, col0 = u.pn * BM + wc * 32 + 4 * fq;
        f32x4 gv[2][2], bv[2][2]; f32x2 st[3]; u32x2v xv[3][2][2];
#pragma unroll
        for (int bj = 0; bj < 2; ++bj)
#pragma unroll
            for (int n = 0; n < 2; ++n) { const int lc_ = wc * 32 + 4 * fq + bj * HALF + n * 16;
                gv[bj][n] = LDS_STAGE ? *(const PG8_LAS f32x4*)(sbuf + 2048 + lc_ * 4) : *(const f32x4*)(g + col0 + bj * HALF + n * 16); bv[bj][n] = LDS_STAGE ? *(const PG8_LAS f32x4*)(sbuf + 3072 + lc_ * 4) : *(const f32x4*)(b + col0 + bj * HALF + n * 16); }
#define RLB_LOAD(buf, rg) do { const int row_ = row0 + ((rg) >> 2) * HALF + ((rg) & 3) * 16; const size_t off_ = (size_t)row_ * ldc + col0; st[buf] = LDS_STAGE ? ((const PG8_LAS f32x2*)sbuf)[wr * 64 + fr + ((rg) >> 2) * HALF + ((rg) & 3) * 16] : stat[row_]; \
            _Pragma("unroll") for (int bj = 0; bj < 2; ++bj) _Pragma("unroll") for (int n = 0; n < 2; ++n) xv[buf][bj][n] = *(const u32x2v*)(ZB + off_ + bj * HALF + n * 16); } while (0)
        RLB_LOAD(0, 0); RLB_LOAD(1, 1);
#pragma unroll
        for (int rg = 0; rg < 8; ++rg) { const int cur = rg % 3, ai = rg >> 2, m = rg & 3;
            if (rg + 2 < 8) RLB_LOAD((rg + 2) % 3, rg + 2);
            asm volatile("" ::: "memory");
            const int row = row0 + ai * HALF + m * 16; const size_t off = (size_t)row * ldc + col0; const float mu = st[cur].x, rs = st[cur].y;
            float s = 0.f, q = 0.f;
#pragma unroll
            for (int bj = 0; bj < 2; ++bj)
#pragma unroll
                for (int n = 0; n < 2; ++n) { const u32x2v xw = xv[cur][bj][n];
                    const f32x4 xf = {__builtin_bit_cast(float, xw.x << 16), __builtin_bit_cast(float, xw.x & 0xffff0000u), __builtin_bit_cast(float, xw.y << 16), __builtin_bit_cast(float, xw.y & 0xffff0000u)};
                    const f32x4 xn = (xf - mu) * rs * gv[bj][n] + bv[bj][n]; const f32x4 z = xn * alpha + acc[ai][bj][m][n];
                    u32x2v w; w.x = cvt_pk_bf16(z[0], z[1]); w.y = cvt_pk_bf16(z[2], z[3]); *(u32x2v*)(ZB + off + bj * HALF + n * 16) = w;
                    s += (z[0] + z[1]) + (z[2] + z[3]); q += (z[0] * z[0] + z[1] * z[1]) + (z[2] * z[2] + z[3] * z[3]); }
            s += xshfl<16>(s); s = xsum32(s); q += xshfl<16>(q); q = xsum32(q);
            if (fq == 0) part[(size_t)row * 32 + u.pn * 4 + wc] = (f32x2){s, q};
            asm volatile("" ::: "memory");
        }
#undef RLB_LOAD
    }
};

struct EpiNull {
    static constexpr bool PERM = true, AFTER_DRAIN = false, LDS_STAGE = false; static constexpr int MIN_VMEM = 0;
    float* sink;
    __device__ __forceinline__ void operator()(const f32x4 (&acc)[2][2][4][2], const Unit& u, int wr, int wc, int fr, int fq) const {
        float s = 0.f;
#pragma unroll
        for (int ai = 0; ai < 2; ++ai)
#pragma unroll
            for (int bj = 0; bj < 2; ++bj)
#pragma unroll
                for (int m = 0; m < 4; ++m)
#pragma unroll
                    for (int n = 0; n < 2; ++n) s += (acc[ai][bj][m][n][0] + acc[ai][bj][m][n][1]) + (acc[ai][bj][m][n][2] + acc[ai][bj][m][n][3]);
        if (s == 1.2345678e33f) sink[u.pm * 8 + u.pn + wr + wc + fr + fq] = s;
    }
};

struct EpiResCopy {
    static constexpr bool PERM = false, AFTER_DRAIN = false, LDS_STAGE = false; static constexpr int MIN_VMEM = 0;
    float* Z; bf16_t* ZB; int ldc;
    __device__ __forceinline__ void operator()(const f32x4 (&acc)[2][2][4][2], const Unit& u, int wr, int wc, int fr, int fq) const {
        typedef unsigned u32x2v __attribute__((ext_vector_type(2)));
        const int row0 = u.pm * BM + wr * 64 + fr, col0 = u.pn * BM + wc * 32 + 4 * fq;
        float s = 0.f;
#pragma unroll
        for (int ai = 0; ai < 2; ++ai)
#pragma unroll
            for (int bj = 0; bj < 2; ++bj)
#pragma unroll
                for (int m = 0; m < 4; ++m)
#pragma unroll
                    for (int n = 0; n < 2; ++n) s += acc[ai][bj][m][n][0] + acc[ai][bj][m][n][3];
        const bool never = (s == 1.2345678e33f);
        f32x4 xv[2][2][2]; u32x2v bvv[2][2][2];
#define RC_LOAD(buf, rg) do { const size_t off_ = (size_t)(row0 + ((rg) >> 2) * HALF + ((rg) & 3) * 16) * ldc + col0; \
            _Pragma("unroll") for (int bj = 0; bj < 2; ++bj) _Pragma("unroll") for (int n = 0; n < 2; ++n) { xv[buf][bj][n] = *(const f32x4*)(Z + off_ + bj * HALF + n * 16); bvv[buf][bj][n] = *(const u32x2v*)(ZB + off_ + bj * HALF + n * 16); } } while (0)
        RC_LOAD(0, 0);
#pragma unroll
        for (int rg = 0; rg < 8; ++rg) { const int ai = rg >> 2, m = rg & 3, cur = rg & 1;
            if (rg + 1 < 8) RC_LOAD(cur ^ 1, rg + 1);
            asm volatile("" ::: "memory");
            const size_t off = (size_t)(row0 + ai * HALF + m * 16) * ldc + col0;
#pragma unroll
            for (int bj = 0; bj < 2; ++bj)
#pragma unroll
                for (int n = 0; n < 2; ++n) { f32x4 z = xv[cur][bj][n]; if (never) z[0] = s; *(f32x4*)(Z + off + bj * HALF + n * 16) = z; *(u32x2v*)(ZB + off + bj * HALF + n * 16) = bvv[cur][bj][n]; }
            asm volatile("" ::: "memory");
        }
#undef RC_LOAD
    }
};

struct EpiResCopyB {
    static constexpr bool PERM = false, AFTER_DRAIN = false, LDS_STAGE = false; static constexpr int MIN_VMEM = 0;
    bf16_t* ZB; int ldc;
    __device__ __forceinline__ void operator()(const f32x4 (&acc)[2][2][4][2], const Unit& u, int wr, int wc, int fr, int fq) const {
        typedef unsigned u32x2v __attribute__((ext_vector_type(2)));
        const int row0 = u.pm * BM + wr * 64 + fr, col0 = u.pn * BM + wc * 32 + 4 * fq;
        float s = 0.f;
#pragma unroll
        for (int ai = 0; ai < 2; ++ai)
#pragma unroll
            for (int bj = 0; bj < 2; ++bj)
#pragma unroll
                for (int m = 0; m < 4; ++m)
#pragma unroll
                    for (int n = 0; n < 2; ++n) s += acc[ai][bj][m][n][0] + acc[ai][bj][m][n][3];
        const bool never = (s == 1.2345678e33f);
        u32x2v xv[2][2][2];
#define RCB_LOAD(buf, rg) do { const size_t off_ = (size_t)(row0 + ((rg) >> 2) * HALF + ((rg) & 3) * 16) * ldc + col0; \
            _Pragma("unroll") for (int bj = 0; bj < 2; ++bj) _Pragma("unroll") for (int n = 0; n < 2; ++n) xv[buf][bj][n] = *(const u32x2v*)(ZB + off_ + bj * HALF + n * 16); } while (0)
        RCB_LOAD(0, 0);
#pragma unroll
        for (int rg = 0; rg < 8; ++rg) { const int ai = rg >> 2, m = rg & 3, cur = rg & 1;
            if (rg + 1 < 8) RCB_LOAD(cur ^ 1, rg + 1);
            asm volatile("" ::: "memory");
            const size_t off = (size_t)(row0 + ai * HALF + m * 16) * ldc + col0;
#pragma unroll
            for (int bj = 0; bj < 2; ++bj)
#pragma unroll
                for (int n = 0; n < 2; ++n) { u32x2v z = xv[cur][bj][n]; if (never) z.x ^= 1u; *(u32x2v*)(ZB + off + bj * HALF + n * 16) = z; }
            asm volatile("" ::: "memory");
        }
#undef RCB_LOAD
    }
};

template <class Epi, class Sched, bool ALIGN_EPI = false, bool SP2 = false, bool TILED_A = false, bool KSCALE = false>
__device__ __forceinline__ void gemm_phase(PG8_LAS unsigned char* lds, const Gemm g, const Sched& S, const Epi& E, const int wid  ) {
    const int wr = wid >> 2, wc = wid & 3;
    const int K = g.K, nt = K / BK;
    unsigned voffA[2], voffB[2]; int aoff, boff;
#define PG8_LANE_OFFS() do { const int ln_ = lane_id(), td_ = wid * 64 + ln_; \
        _Pragma("unroll") for (int i = 0; i < 2; ++i) { int R, C; stage_rc(td_ * 16 + i * 8192, R, C); const int Rb = Epi::PERM ? ((R & ~31) + perm32(R & 31)) : R; \
            voffA[i] = (unsigned)(R * (TILED_A ? 64 : K) + C) * 2u; voffB[i] = (unsigned)(Rb * (MK_TILED_W ? 64 : K) + C) * 2u; } \
        aoff = lds_byte(wr * 64 + (ln_ & 15), (ln_ >> 4) * 8); boff = lds_byte(wc * 32 + (ln_ & 15), (ln_ >> 4) * 8); } while (0)
    PG8_LANE_OFFS();
    const size_t kstep = (size_t)(BK * 2);
    const size_t hstep = (size_t)HALF * K * 2;
    const size_t tstep = 2 * hstep;
    const size_t kstepA = TILED_A ? (size_t)32768 : kstep, hstepA = TILED_A ? (size_t)HALF * 64 * 2 : hstep;
    const size_t kstepB = MK_TILED_W ? (size_t)32768 : kstep, hstepB = MK_TILED_W ? (size_t)HALF * 64 * 2 : hstep;
    const unsigned ldsw = (unsigned)wid * 1024u;
#define PG8_SA(b, h) (((b) * 2 + (h)) * HTB)
#define PG8_SB(b, h) ((4 + (b) * 2 + (h)) * HTB)
#define PG8_STAGE(bufoff, gbase, voff) do { _Pragma("unroll") for (int _i = 0; _i < 2; ++_i) \
        __builtin_amdgcn_global_load_lds((const unsigned*)((const char*)(gbase) + (voff)[_i]), (PG8_LAS unsigned*)(lds + (bufoff) + ldsw + _i * 8192), 16, 0, 0); } while (0)
#define PG8_STAGE_A(bufoff, gbase, voff) do { _Pragma("unroll") for (int _i = 0; _i < 2; ++_i) { \
        if constexpr (TILED_A && MK_NT_HLOAD) __builtin_amdgcn_global_load_lds((const unsigned*)((const char*)(gbase) + (voff)[_i]), (PG8_LAS unsigned*)(lds + (bufoff) + ldsw + _i * 8192), 16, 0, 2); \
        else __builtin_amdgcn_global_load_lds((const unsigned*)((const char*)(gbase) + (voff)[_i]), (PG8_LAS unsigned*)(lds + (bufoff) + ldsw + _i * 8192), 16, 0, 0); } } while (0)
#define PG8_LDA(dst, b, h) do { _Pragma("unroll") for (int m = 0; m < 4; ++m) _Pragma("unroll") for (int k = 0; k < 2; ++k) dst[m][k] = *(const PG8_LAS bf16x8*)(lds + PG8_SA(b, h) + aoff + m * 2048 + k * 1024); } while (0)
#define PG8_LDB(dst, b, h) do { _Pragma("unroll") for (int n = 0; n < 2; ++n) _Pragma("unroll") for (int k = 0; k < 2; ++k) dst[n][k] = *(const PG8_LAS bf16x8*)(lds + PG8_SB(b, h) + boff + n * 2048 + k * 1024); } while (0)
#define PG8_MMA(ai, bj, At, Bt) do { __builtin_amdgcn_s_setprio(1); _Pragma("unroll") for (int m = 0; m < 4; ++m) _Pragma("unroll") for (int n = 0; n < 2; ++n) _Pragma("unroll") for (int k = 0; k < 2; ++k) \
        acc[ai][bj][m][n] = __builtin_amdgcn_mfma_f32_16x16x32_bf16(Bt[n][k], At[m][k], acc[ai][bj][m][n], 0, 0, 0); __builtin_amdgcn_s_setprio(0); } while (0)
#define PG8_WAIT_V(n) asm volatile("s_waitcnt vmcnt(" #n ")" ::: "memory")
#define PG8_WAIT_L(n) asm volatile("s_waitcnt lgkmcnt(" #n ")" ::: "memory")
#define PG8_BAR __builtin_amdgcn_s_barrier()
#define PG8_SCHED __builtin_amdgcn_sched_barrier(0)
#define PG8_KTAB_DMA(pm_, bsel_) do { const int ln_ = lane_id(); \
        __builtin_amdgcn_global_load_lds((const unsigned*)((const char*)g.rat + (size_t)(pm_) * (256 * 32) + (size_t)((wid * 64 + ln_) * 16)), (PG8_LAS unsigned*)(lds + g.ktab_off + (bsel_) * 8192 + wid * 1024), 16, 0, 0); } while (0)
#define PG8_RESCALE(seg_, bsel_) do { const int ln_ = lane_id(); const PG8_LAS float* tp_ = (const PG8_LAS float*)(lds + g.ktab_off + (bsel_) * 8192 + (wr * 64 + (ln_ & 15)) * 32) + (seg_); \
        _Pragma("unroll") for (int ai = 0; ai < 2; ++ai) _Pragma("unroll") for (int m = 0; m < 4; ++m) { const float r_ = tp_[(ai * 128 + m * 16) * 8]; \
            _Pragma("unroll") for (int bj = 0; bj < 2; ++bj) _Pragma("unroll") for (int n = 0; n < 2; ++n) acc[ai][bj][m][n] *= r_; } } while (0)
    Unit cur, nxt; int ui = 0;
    if (!S.next(0, cur)) return;
    if constexpr (KSCALE) PG8_KTAB_DMA(cur.pm, 0);
    if constexpr (Epi::LDS_STAGE) E.stage(cur, lds + g.stg_off, wid);
    f32x4 acc[2][2][4][2];
#pragma unroll
    for (int a = 0; a < 2; ++a)
#pragma unroll
        for (int b = 0; b < 2; ++b)
#pragma unroll
            for (int m = 0; m < 4; ++m)
#pragma unroll
                for (int n = 0; n < 2; ++n) { acc[a][b][m][n] = (f32x4){0.f, 0.f, 0.f, 0.f}; asm volatile("" : "+v"(acc[a][b][m][n])); }
    bf16x8 At[4][2], B0[2][2], B1[2][2];
    const char* cA = (const char*)g.A + (size_t)cur.pm * tstep; const char* cB = (const char*)g.Bt + (size_t)cur.pn * tstep;
    S.a_ready(cur);
    if constexpr (SP2) {
        PG8_STAGE(PG8_SB(0, 0), cB, voffB); PG8_STAGE(PG8_SB(0, 1), cB + hstepB, voffB); PG8_STAGE_A(PG8_SA(0, 0), cA, voffA); PG8_STAGE_A(PG8_SA(0, 1), cA + hstepA, voffA);
        if (wr == 1) PG8_BAR;
        PG8_WAIT_V(2); PG8_BAR;
        PG8_STAGE(PG8_SB(1, 0), cB + kstepB, voffB); PG8_STAGE_A(PG8_SA(1, 0), cA + kstepA, voffA); PG8_STAGE(PG8_SB(1, 1), cB + hstepB + kstepB, voffB);
        PG8_WAIT_V(6);
        PG8_BAR;
    } else {
        PG8_STAGE(PG8_SB(0, 0), cB, voffB); PG8_STAGE_A(PG8_SA(0, 0), cA, voffA); PG8_STAGE(PG8_SB(0, 1), cB + hstepB, voffB); PG8_STAGE_A(PG8_SA(0, 1), cA + hstepA, voffA);
        if (wr == 1) PG8_BAR;
        PG8_WAIT_V(4); PG8_BAR;
        PG8_STAGE(PG8_SB(1, 0), cB + kstepB, voffB); PG8_STAGE_A(PG8_SA(1, 0), cA + kstepA, voffA); PG8_STAGE(PG8_SB(1, 1), cB + hstepB + kstepB, voffB);
        PG8_WAIT_V(6); PG8_BAR;
    }
    for (;;) {
        const bool has_next = S.next(ui + 1, nxt);
        const char* nA = has_next ? (const char*)g.A + (size_t)nxt.pm * tstep : cA; const char* nB = has_next ? (const char*)g.Bt + (size_t)nxt.pn * tstep : cB;
        static_assert(SP2, "this copy of the body keeps only the two-super-phase K-loop");
#define PG8_TRIP(t, W) do { \
            const bool last = ((t) == nt - 2); \
            const char* a1 = cA + (size_t)((t) + 1) * kstepA; \
            const char* a2 = last ? nA : cA + (size_t)((t) + 2) * kstepA; const char* b2 = last ? nB : cB + (size_t)((t) + 2) * kstepB; \
            const char* a3 = a2 + kstepA; const char* b3 = b2 + kstepB; \
            if (last && has_next) S.a_ready(nxt); \
              \
            PG8_LDB(B0, 0, 0); PG8_LDB(B1, 0, 1); PG8_SCHED; PG8_LDA(At, 0, 0); PG8_STAGE_A(PG8_SA(1, 1), a1 + hstepA, voffA); \
            W; PG8_WAIT_L(0); PG8_BAR; PG8_MMA(0, 0, At, B0); PG8_MMA(0, 1, At, B1); PG8_BAR; PG8_SCHED; \
              \
            PG8_LDA(At, 0, 1); PG8_STAGE(PG8_SB(0, 0), b2, voffB); PG8_STAGE(PG8_SB(0, 1), b2 + hstepB, voffB); PG8_STAGE_A(PG8_SA(0, 0), a2, voffA); \
            W; PG8_WAIT_L(0); PG8_BAR; PG8_MMA(1, 0, At, B0); PG8_MMA(1, 1, At, B1); PG8_BAR; PG8_SCHED; \
              \
            PG8_LDB(B0, 1, 0); PG8_LDB(B1, 1, 1); PG8_SCHED; PG8_LDA(At, 1, 0); PG8_STAGE_A(PG8_SA(0, 1), a2 + hstepA, voffA); \
            PG8_WAIT_V(8); PG8_WAIT_L(0); PG8_BAR; PG8_MMA(0, 0, At, B0); PG8_MMA(0, 1, At, B1); PG8_BAR; PG8_SCHED; \
              \
            PG8_LDA(At, 1, 1); PG8_STAGE(PG8_SB(1, 0), b3, voffB); PG8_STAGE(PG8_SB(1, 1), b3 + hstepB, voffB); PG8_STAGE_A(PG8_SA(1, 0), a3, voffA); \
            PG8_WAIT_V(8); PG8_WAIT_L(0); PG8_BAR; PG8_MMA(1, 0, At, B0); PG8_MMA(1, 1, At, B1); PG8_BAR; PG8_SCHED; } while (0)
#define PG8_WAIT_W(z) asm volatile("s_cmp_eq_u32 %0, 0\n\ts_cbranch_scc1 .Lpg8r%=\n\ts_waitcnt vmcnt(8)\n\ts_branch .Lpg8d%=\n.Lpg8r%=:\n\ts_waitcnt vmcnt(%1)\n.Lpg8d%=:" :: "s"(z), "n"(8 + Epi::MIN_VMEM) : "memory", "scc")
        if constexpr (KSCALE) { int t = 0;
            for (int seg = 0; seg < 8; ++seg) { const int tend = (seg == 0) ? 8 : (seg == 7) ? nt : 8 + 2 * seg;
                for (; t < tend; t += 2) { const int z_ = __builtin_amdgcn_readfirstlane(t + (ui == 0 ? 1 : 0)); PG8_TRIP(t, PG8_WAIT_W(z_)); }
                PG8_RESCALE(seg, ui & 1); } }
        else if constexpr (Epi::MIN_VMEM > 0) { for (int t = 0; t < nt; t += 2) { const int z_ = __builtin_amdgcn_readfirstlane(t + (ui == 0 ? 1 : 0)); PG8_TRIP(t, PG8_WAIT_W(z_)); } }
        else { for (int t = 0; t < nt; t += 2) { PG8_TRIP(t, PG8_WAIT_V(8)); } }
#undef PG8_WAIT_W
#undef PG8_TRIP
        if constexpr (ALIGN_EPI) { if (wr == 0) PG8_BAR; }
        if constexpr (!Epi::AFTER_DRAIN) { const int le_ = lane_id(); if constexpr (Epi::LDS_STAGE) E(acc, cur, wr, wc, le_ & 15, le_ >> 4, lds + g.stg_off + (ui & 1) * 4096); else E(acc, cur, wr, wc, le_ & 15, le_ >> 4); S.done(cur); }
        if (!has_next) break;
#pragma unroll
        for (int a = 0; a < 2; ++a)
#pragma unroll
            for (int b = 0; b < 2; ++b)
#pragma unroll
                for (int m = 0; m < 4; ++m)
#pragma unroll
                    for (int n = 0; n < 2; ++n) { acc[a][b][m][n] = (f32x4){0.f, 0.f, 0.f, 0.f}; asm volatile("" : "+v"(acc[a][b][m][n])); }
        cur = nxt; cA = nA; cB = nB; ++ui; PG8_LANE_OFFS();
        if constexpr (KSCALE) PG8_KTAB_DMA(cur.pm, ui & 1);
        if constexpr (Epi::LDS_STAGE) E.stage(cur, lds + g.stg_off + (ui & 1) * 4096, wid);
        if constexpr (ALIGN_EPI) { if (wr == 1) PG8_BAR; }
    }
    PG8_WAIT_V(0);
    if constexpr (!ALIGN_EPI) { if (wr == 0) PG8_BAR; }
    PG8_BAR;
    if constexpr (Epi::AFTER_DRAIN) { const int le_ = lane_id(); E.fused(acc, cur, wr, wc, le_ & 15, le_ >> 4, lds, wid, le_); S.done(cur); }
#undef PG8_KTAB_DMA
#undef PG8_RESCALE
#undef PG8_SA
#undef PG8_SB
#undef PG8_STAGE
#undef PG8_LANE_OFFS
#undef PG8_STAGE_A
#undef PG8_LDA
#undef PG8_LDB
#undef PG8_MMA
#undef PG8_WAIT_V
#undef PG8_WAIT_L
#undef PG8_BAR
#undef PG8_SCHED
}
}
#define GAS __attribute__((address_space(1)))
#define LAS __attribute__((address_space(3)))
typedef unsigned short bf16;
typedef unsigned v4u __attribute__((ext_vector_type(4)));
typedef float f32x4 __attribute__((ext_vector_type(4)));
typedef short bf16x8 __attribute__((ext_vector_type(8)));
typedef GAS unsigned gu32;
typedef GAS unsigned long long gu64;
#define RLX_AGENT __ATOMIC_RELAXED, __HIP_MEMORY_SCOPE_AGENT
#define LDS_WAIT() asm volatile("s_waitcnt lgkmcnt(0)" ::: "memory")
#define VM_WAIT() asm volatile("s_waitcnt vmcnt(0)" ::: "memory")
__device__ __forceinline__ unsigned long long rt() { return __builtin_amdgcn_s_memrealtime(); }
__device__ __forceinline__ unsigned f2bf(float f) { unsigned u = __builtin_bit_cast(unsigned, f); return (u + 0x7fffu + ((u >> 16) & 1u)) >> 16; }
__device__ __forceinline__ unsigned pk2(float lo, float hi) { return f2bf(lo) | (f2bf(hi) << 16); }

#define XB_TMO      128
#define XB_XCNT(j)  (256  + 64 * (j))
#define XB_XSUB(j)  (1280 + 64 * (j))
#define XB_XGEN(j)  (2304 + 64 * (j))
#define XB_TOP      3328
#define XB_TOPGEN   3392
#define XCD_BAR_WORDS 3456
#define XB_SPIN_CAP (1u << 18)

__device__ __forceinline__ unsigned xb_ld(unsigned* p)              { return __hip_atomic_load(p, __ATOMIC_RELAXED, __HIP_MEMORY_SCOPE_AGENT); }
__device__ __forceinline__ unsigned xb_add(unsigned* p, unsigned v) { return __hip_atomic_fetch_add(p, v, __ATOMIC_RELAXED, __HIP_MEMORY_SCOPE_AGENT); }
__device__ __forceinline__ unsigned xb_xcc_id() { return (unsigned)__builtin_amdgcn_s_getreg((3 << 11) | 20) & 0xFu; }
#define XB_SPIN(cond, bar) do { unsigned _sp = 0; while (cond) { __builtin_amdgcn_s_sleep(1); \
    if ((++_sp & 255u) == 0u) { if (xb_ld(&(bar)[XB_TMO])) break; if (_sp > XB_SPIN_CAP) { atomicAdd(&(bar)[XB_TMO], 1u); break; } } } } while (0)

struct XcdBarrier {
    unsigned* bar; unsigned x;
    volatile LAS unsigned* st;
};

__device__ __forceinline__ XcdBarrier xcd_barrier_post(unsigned* bar, volatile LAS unsigned* st, const bool t0  ) {
    XcdBarrier b; b.bar = bar; b.x = xb_xcc_id(); b.st = st;
    if (t0) (void)xb_add(&bar[XB_XCNT(b.x)], 1u);
    return b;
}
__device__ __forceinline__ void xcd_barrier_complete(unsigned* bar, unsigned x, unsigned& nloc, unsigned& nx) {
    const unsigned G = gridDim.x * gridDim.y * gridDim.z;
    unsigned sum, cnt, mine, sp = 0u;
    for (;;) {
        sum = 0u; cnt = 0u; mine = 0u;
#pragma unroll
        for (unsigned j = 0; j < 16; ++j) { const unsigned c = xb_ld(&bar[XB_XCNT(j)]); sum += c; cnt += (c > 0u) ? 1u : 0u; mine = (j == x) ? c : mine; }
        if (sum == G) break;
        __builtin_amdgcn_s_sleep(1);
        if ((++sp & 255u) == 0u) { if (xb_ld(&bar[XB_TMO])) break; if (sp > XB_SPIN_CAP) { atomicAdd(&bar[XB_TMO], 1u); break; } }
    }
    nloc = mine > 0u ? mine : 1u; nx = cnt > 0u ? cnt : 1u;
}

__device__ __forceinline__ void xcd_barrier(const XcdBarrier& b, const bool t0  ) {
    asm volatile("s_waitcnt vmcnt(0)" ::: "memory");
    __syncthreads();
    if (t0) {
        unsigned* bar = b.bar;
        __builtin_amdgcn_s_waitcnt(0);
        unsigned nloc = b.st[0], nx = b.st[1];
        if (nloc == 0u) { xcd_barrier_complete(bar, b.x, nloc, nx); b.st[0] = nloc; b.st[1] = nx; }
        const unsigned old = xb_add(&bar[XB_XSUB(b.x)], 1u);
        const unsigned gen = old / nloc;
        if (old + 1u == (gen + 1u) * nloc) {
            __builtin_amdgcn_fence(__ATOMIC_RELEASE, "agent");
            asm volatile("s_waitcnt vmcnt(0)" ::: "memory");
            const unsigned og = xb_add(&bar[XB_TOP], 1u);
            const unsigned tg = og / nx;
            if (og + 1u == (tg + 1u) * nx) xb_add(&bar[XB_TOPGEN], 1u);
            else XB_SPIN(xb_ld(&bar[XB_TOPGEN]) == tg, bar);
            __builtin_amdgcn_fence(__ATOMIC_ACQUIRE, "agent");
            xb_add(&bar[XB_XGEN(b.x)], 1u);
            asm volatile("s_waitcnt vmcnt(0)" ::: "memory");
        } else {
            XB_SPIN(xb_ld(&bar[XB_XGEN(b.x)]) == gen, bar);
            __builtin_amdgcn_fence(__ATOMIC_ACQUIRE, "agent");
            asm volatile("s_waitcnt vmcnt(0)" ::: "memory");
        }
    }
    __syncthreads();
}
namespace att {
typedef unsigned short bf16;
constexpr int NW = 8, QBLK = 32, KVBLK = 64, D = 128;
constexpr float SCALE = 0.088388347648318440f;
constexpr float THR = 8.f;
using bf16x8 = __attribute__((ext_vector_type(8))) short;
using s16x4  = __attribute__((ext_vector_type(4))) short;
using f32x16 = __attribute__((ext_vector_type(16))) float;
using f32x8  = __attribute__((ext_vector_type(8))) float;
using u32x4  = __attribute__((ext_vector_type(4))) unsigned;
#define KSWZ(row, colB) ((row) * 256 + ((colB) ^ (((row) & 7) << 4)))
#define SBAR() __builtin_amdgcn_sched_barrier(0)
__device__ __forceinline__ int crow(int r, int hi) { return (r & 3) + 8 * (r >> 2) + 4 * hi; }
__device__ __forceinline__ unsigned cvtpk(float lo, float hi) {
  unsigned r; asm volatile("v_cvt_pk_bf16_f32 %0, %1, %2" : "=v"(r) : "v"(lo), "v"(hi)); return r;
}
__device__ __forceinline__ float ssq8(const u32x4 v) {
  float q = 0.f;
#pragma unroll
  for (int e = 0; e < 4; ++e) { const float a = __builtin_bit_cast(float, v[e] << 16), b = __builtin_bit_cast(float, v[e] & 0xffff0000u); q += a * a + b * b; }
  return q;
}
__device__ __forceinline__ void partialSM(f32x16& p0, f32x16& p1, float& m_reg, float& mn, float& alpha) {
  constexpr float C = SCALE * 1.4426950408889634f;
  float pmax = p0[0]; for (int r = 1; r < 16; ++r) pmax = fmaxf(pmax, p0[r]); for (int r = 0; r < 16; ++r) pmax = fmaxf(pmax, p1[r]);
  { auto rr = __builtin_amdgcn_permlane32_swap(__float_as_uint(pmax), __float_as_uint(pmax), false, false);
    pmax = fmaxf(__uint_as_float(rr[0]), __uint_as_float(rr[1])); }
  if (__builtin_expect(__all(pmax - m_reg <= THR / SCALE), 1)) { mn = m_reg; alpha = 1.f; }
  else { mn = fmaxf(m_reg, pmax); alpha = __builtin_amdgcn_exp2f((m_reg - mn) * C); m_reg = mn; }
  float mnC = -mn * C;
  for (int r = 0; r < 16; ++r) p0[r] = fmaf(p0[r], C, mnC); for (int r = 0; r < 16; ++r) p1[r] = fmaf(p1[r], C, mnC);
  for (int r = 0; r < 16; ++r) p0[r] = __builtin_amdgcn_exp2f(p0[r]);
}
__device__ __forceinline__ void boundedSM(f32x16& p0, f32x16& p1) {
  for (int r = 0; r < 16; ++r) p0[r] = __builtin_amdgcn_exp2f(p0[r]);
}
__device__ __forceinline__ void finishSM(f32x16& p0, f32x16& p1, float alpha, float& l_reg, bf16x8& pa0, bf16x8& pa1, bf16x8& pa2, bf16x8& pa3) {
  for (int r = 0; r < 16; ++r) p1[r] = __builtin_amdgcn_exp2f(p1[r]);
  float ps = 0; for (int r = 0; r < 16; ++r) ps += p0[r]; for (int r = 0; r < 16; ++r) ps += p1[r];
  { auto rr = __builtin_amdgcn_permlane32_swap(__float_as_uint(ps), __float_as_uint(ps), false, false);
    ps = __uint_as_float(rr[0]) + __uint_as_float(rr[1]); }
  l_reg = l_reg * alpha + ps;
#define PK4(P, BASE, OUT) do { unsigned a0 = cvtpk(P[BASE + 0], P[BASE + 1]), a1 = cvtpk(P[BASE + 2], P[BASE + 3]);   \
    unsigned b0 = cvtpk(P[BASE + 4], P[BASE + 5]), b1 = cvtpk(P[BASE + 6], P[BASE + 7]);                              \
    auto r0 = __builtin_amdgcn_permlane32_swap(a0, b0, false, false); auto r1 = __builtin_amdgcn_permlane32_swap(a1, b1, false, false); \
    u32x4 w = {r0[0], r1[0], r0[1], r1[1]}; OUT = *reinterpret_cast<bf16x8*>(&w); } while (0)
  PK4(p0, 0, pa0); PK4(p0, 8, pa1); PK4(p1, 0, pa2); PK4(p1, 8, pa3);
#undef PK4
}
__device__ __forceinline__ void partialSM1(f32x16& p0, float& m_reg, float& mn, float& alpha) {
  constexpr float C = SCALE * 1.4426950408889634f;
  float pmax = p0[0]; for (int r = 1; r < 16; ++r) pmax = fmaxf(pmax, p0[r]);
  { auto rr = __builtin_amdgcn_permlane32_swap(__float_as_uint(pmax), __float_as_uint(pmax), false, false);
    pmax = fmaxf(__uint_as_float(rr[0]), __uint_as_float(rr[1])); }
  if (__builtin_expect(__all(pmax - m_reg <= THR / SCALE), 1)) { mn = m_reg; alpha = 1.f; }
  else { mn = fmaxf(m_reg, pmax); alpha = __builtin_amdgcn_exp2f((m_reg - mn) * C); m_reg = mn; }
  float mnC = -mn * C;
  for (int r = 0; r < 16; ++r) p0[r] = fmaf(p0[r], C, mnC);
  for (int r = 0; r < 16; ++r) p0[r] = __builtin_amdgcn_exp2f(p0[r]);
}
__device__ __forceinline__ void finishSM1(f32x16& p0, float alpha, float& l_reg, bf16x8& pa0, bf16x8& pa1) {
  float ps = 0; for (int r = 0; r < 16; ++r) ps += p0[r];
  { auto rr = __builtin_amdgcn_permlane32_swap(__float_as_uint(ps), __float_as_uint(ps), false, false);
    ps = __uint_as_float(rr[0]) + __uint_as_float(rr[1]); }
  l_reg = l_reg * alpha + ps;
#define PK4(P, BASE, OUT) do { unsigned a0 = cvtpk(P[BASE + 0], P[BASE + 1]), a1 = cvtpk(P[BASE + 2], P[BASE + 3]);   \
    unsigned b0 = cvtpk(P[BASE + 4], P[BASE + 5]), b1 = cvtpk(P[BASE + 6], P[BASE + 7]);                              \
    auto r0 = __builtin_amdgcn_permlane32_swap(a0, b0, false, false); auto r1 = __builtin_amdgcn_permlane32_swap(a1, b1, false, false); \
    u32x4 w = {r0[0], r1[0], r0[1], r1[1]}; OUT = *reinterpret_cast<bf16x8*>(&w); } while (0)
  PK4(p0, 0, pa0); PK4(p0, 8, pa1);
#undef PK4
}
__device__ __forceinline__ void qkt(f32x16& p0, f32x16& p1, const bf16* Ks, const bf16x8* qr, int r32, int hi, float init = 0.f) {
  for (int r = 0; r < 16; ++r) { p0[r] = init; p1[r] = init; }
  for (int d0 = 0; d0 < 8; ++d0) { int cb = (d0 * 16 + hi * 8) * 2;
    bf16x8 b0 = *reinterpret_cast<const bf16x8*>((const char*)Ks + KSWZ(r32, cb));
    bf16x8 b1 = *reinterpret_cast<const bf16x8*>((const char*)Ks + KSWZ(32 + r32, cb));
    p0 = __builtin_amdgcn_mfma_f32_32x32x16_bf16(b0, qr[d0], p0, 0, 0, 0);
    p1 = __builtin_amdgcn_mfma_f32_32x32x16_bf16(b1, qr[d0], p1, 0, 0, 0); }
}
__device__ __forceinline__ int v_st(int k, int c) { const int kk = (k & ~0xC) | ((k & 4) << 1) | ((k & 8) >> 1); return ((kk >> 3) * 4 + (c >> 5)) * 512 + ((kk & 7) * 32 + (c & 31)) * 2; }
__device__ __forceinline__ int v_rd_base(int lane) { return ((lane & 3) << 3) | (((lane >> 2) & 3) << 6) | (((lane >> 4) & 1) << 5) | (((lane >> 5) & 1) << 8); }
constexpr int v_rd_off(int d0, int ks, int half) { return d0 * 512 + ks * 4096 + half * 2048; }
template <int OFF> __device__ __forceinline__ s16x4 tr_read(int vb) {
  s16x4 r; asm volatile("ds_read_b64_tr_b16 %0, %1 offset:%2" : "=&v"(r) : "v"(vb), "i"(OFF) : "memory"); return r;
}
template <int D0> __device__ __forceinline__ void pv_one(f32x16& od, int vb, bf16x8 pa0, bf16x8 pa1, bf16x8 pa2, bf16x8 pa3) {
  const s16x4 l0 = tr_read<v_rd_off(D0, 0, 0)>(vb), h0 = tr_read<v_rd_off(D0, 0, 1)>(vb), l1 = tr_read<v_rd_off(D0, 1, 0)>(vb), h1 = tr_read<v_rd_off(D0, 1, 1)>(vb);
  const s16x4 l2 = tr_read<v_rd_off(D0, 2, 0)>(vb), h2 = tr_read<v_rd_off(D0, 2, 1)>(vb), l3 = tr_read<v_rd_off(D0, 3, 0)>(vb), h3 = tr_read<v_rd_off(D0, 3, 1)>(vb);
  asm volatile("s_waitcnt lgkmcnt(0)" ::: "memory"); SBAR();
#define PK(L, H) (bf16x8){L[0], L[1], L[2], L[3], H[0], H[1], H[2], H[3]}
  od = __builtin_amdgcn_mfma_f32_32x32x16_bf16(pa0, PK(l0, h0), od, 0, 0, 0);
  od = __builtin_amdgcn_mfma_f32_32x32x16_bf16(pa1, PK(l1, h1), od, 0, 0, 0);
  od = __builtin_amdgcn_mfma_f32_32x32x16_bf16(pa2, PK(l2, h2), od, 0, 0, 0);
  od = __builtin_amdgcn_mfma_f32_32x32x16_bf16(pa3, PK(l3, h3), od, 0, 0, 0);
#undef PK
}
__device__ __forceinline__ void pv_d0(f32x16* o, int vb, bf16x8 pa0, bf16x8 pa1, bf16x8 pa2, bf16x8 pa3) {
  pv_one<0>(o[0], vb, pa0, pa1, pa2, pa3); pv_one<1>(o[1], vb, pa0, pa1, pa2, pa3); pv_one<2>(o[2], vb, pa0, pa1, pa2, pa3); pv_one<3>(o[3], vb, pa0, pa1, pa2, pa3);
}

__device__ __forceinline__ void qkt32(f32x16& p0, const bf16* Ks, const bf16x8* qr, int krow, int hi) {
  for (int r = 0; r < 16; ++r) p0[r] = 0.f;
  for (int d0 = 0; d0 < 8; ++d0) { int cb = (d0 * 16 + hi * 8) * 2;
    bf16x8 b0 = *reinterpret_cast<const bf16x8*>((const char*)Ks + KSWZ(krow, cb));
    p0 = __builtin_amdgcn_mfma_f32_32x32x16_bf16(b0, qr[d0], p0, 0, 0, 0); }
}
template <int D0> __device__ __forceinline__ void pv_one2(f32x16& od, int vb, bf16x8 pa0, bf16x8 pa1) {
  const s16x4 l0 = tr_read<v_rd_off(D0, 0, 0)>(vb), h0 = tr_read<v_rd_off(D0, 0, 1)>(vb), l1 = tr_read<v_rd_off(D0, 1, 0)>(vb), h1 = tr_read<v_rd_off(D0, 1, 1)>(vb);
  asm volatile("s_waitcnt lgkmcnt(0)" ::: "memory"); SBAR();
#define PK(L, H) (bf16x8){L[0], L[1], L[2], L[3], H[0], H[1], H[2], H[3]}
  od = __builtin_amdgcn_mfma_f32_32x32x16_bf16(pa0, PK(l0, h0), od, 0, 0, 0);
  od = __builtin_amdgcn_mfma_f32_32x32x16_bf16(pa1, PK(l1, h1), od, 0, 0, 0);
#undef PK
}
__device__ __forceinline__ void pv_d0h(f32x16* o, int vb, bf16x8 pa0, bf16x8 pa1) {
  pv_one2<0>(o[0], vb, pa0, pa1); pv_one2<1>(o[1], vb, pa0, pa1); pv_one2<2>(o[2], vb, pa0, pa1); pv_one2<3>(o[3], vb, pa0, pa1);
}

constexpr size_t SHM_V = KVBLK * D * 2, SHM_K = KVBLK * D * 2, SHM_ATTN = 2 * SHM_V + 2 * SHM_K + NW * 64 * 4;
constexpr float NEG_INF = -__builtin_inff();
constexpr int OSTAGE_OFF = 73728;

#ifndef MK_PREFETCH_UNIT
#define MK_PREFETCH_UNIT 0
#endif
struct Pre { bf16x8 qr[8]; bf16x8 vs0, vs1, ks0, ks1; };
template <class Cfg, int SD = 2  ,
          bool BOUNDED = false  >
__device__ __forceinline__ void attn_unit(const Cfg& cfg, char* lds, const int wid  , Pre& pre, const bool have_pre  , const Cfg* nxt  ) {
  const int lane = lane_id(), tid = wid * 64 + lane, r32 = lane & 31, hi = lane >> 5;
  bf16* V_lds = (bf16*)lds; bf16* K_lds = (bf16*)(lds + 2 * SHM_V);
  float* ws = (float*)(lds + 2 * SHM_V + 2 * SHM_K) + wid * 64; float* li_l = ws; float* al_l = ws + 32;
  float m_reg = -1e30f, l_reg = 0; f32x16 o[4] = {}; bf16x8 qr[8];
  const bf16* Qw = cfg.proj + cfg.q_off(wid * QBLK + r32) + hi * 8;
  if (have_pre) {
#pragma unroll
    for (int d0 = 0; d0 < 8; ++d0) qr[d0] = pre.qr[d0];
  } else {
#pragma unroll
    for (int d0 = 0; d0 < 8; ++d0) qr[d0] = *reinterpret_cast<const bf16x8*>(Qw + d0 * 16);
  }
  const int sr = tid >> 4, sc = (tid & 15) * 8, vst0 = v_st(sr, sc), vst1 = v_st(32 + sr, sc);
  const int vb0 = (int)(uintptr_t)V_lds + v_rd_base(lane);
  struct { bf16x8 vs0, vs1, ks0, ks1; } sr_[SD];
#define SLOAD(i, t) do { const unsigned o0_ = cfg.kv_off((t), sr) + sc, o1_ = cfg.kv_off((t), 32 + sr) + sc; \
    sr_[i].vs0 = *reinterpret_cast<const bf16x8*>(cfg.proj + cfg.vcol + o0_); sr_[i].vs1 = *reinterpret_cast<const bf16x8*>(cfg.proj + cfg.vcol + o1_); \
    sr_[i].ks0 = *reinterpret_cast<const bf16x8*>(cfg.proj + cfg.kcol + o0_); sr_[i].ks1 = *reinterpret_cast<const bf16x8*>(cfg.proj + cfg.kcol + o1_); } while (0)
#define SWRITE(b, i) do { *(bf16x8*)((char*)V_lds + (b) * SHM_V + vst0) = sr_[i].vs0;          \
    *(bf16x8*)((char*)V_lds + (b) * SHM_V + vst1) = sr_[i].vs1; int kc = sc * 2;               \
    *(bf16x8*)((char*)K_lds + (b) * SHM_K + KSWZ(sr, kc)) = sr_[i].ks0;                       \
    *(bf16x8*)((char*)K_lds + (b) * SHM_K + KSWZ(32 + sr, kc)) = sr_[i].ks1; } while (0)
#define SWAIT() do { if constexpr (SD == 2) asm volatile("s_waitcnt vmcnt(4)" ::: "memory"); else asm volatile("s_waitcnt vmcnt(0)" ::: "memory"); } while (0)
#define RESC(a) do { if (!BOUNDED && __any((a) < 1.f)) { if (hi == 0) al_l[r32] = (a); asm volatile("s_waitcnt lgkmcnt(0)" ::: "memory"); \
    for (int d = 0; d < 4; ++d) for (int r = 0; r < 16; ++r) o[d][r] *= al_l[crow(r, hi)]; } } while (0)
#define QK(P0, P1, KB, T, MN, AL) do { if (cfg.active((T), wid)) { qkt(P0, P1, (KB), qr, r32, hi, BOUNDED ? cfg.negm0C : 0.f); cfg.mask(P0, P1, (T), wid, r32, hi); if constexpr (BOUNDED) { boundedSM(P0, P1); AL = 1.f; } else partialSM(P0, P1, m_reg, MN, AL); } else { AL = 1.f; } } while (0)
#define QK1(P0, P1, KB, T) do { if (cfg.active((T), wid)) { qkt(P0, P1, (KB), qr, r32, hi, BOUNDED ? cfg.negm0C : 0.f); cfg.mask(P0, P1, (T), wid, r32, hi); } } while (0)
#define PSM(P0, P1, T, MN, AL) do { if (cfg.active((T), wid)) { if constexpr (BOUNDED) { boundedSM(P0, P1); AL = 1.f; } else partialSM(P0, P1, m_reg, MN, AL); } else { AL = 1.f; } } while (0)
#define FPV(P0, P1, AL, VB, T) do { if (cfg.active((T), wid)) { finishSM(P0, P1, AL, l_reg, pa0, pa1, pa2, pa3); SBAR(); pv_d0(o, (VB), pa0, pa1, pa2, pa3); } } while (0)
  f32x16 pA0, pA1, pB0, pB1; float mnA, mnB, alA, alB; bf16x8 pa0, pa1, pa2, pa3; const int NT = Cfg::NT;
  constexpr int SE = 0, SO = SD - 1;
  if (have_pre) { sr_[SE].vs0 = pre.vs0; sr_[SE].vs1 = pre.vs1; sr_[SE].ks0 = pre.ks0; sr_[SE].ks1 = pre.ks1; } else SLOAD(SE, 0);
  asm volatile("s_waitcnt vmcnt(0)" ::: "memory"); SWRITE(0, SE); __syncthreads();
  QK(pA0, pA1, K_lds, 0, mnA, alA);
  SLOAD(SO, 1); if constexpr (SD == 2) { if (2 < NT) SLOAD(SE, 2); }
  SWAIT(); SWRITE(1, SO); __syncthreads();
  for (int j = 1; j + 1 < NT; j += 2) {
    SBAR(); QK1(pB0, pB1, (bf16*)((char*)K_lds + SHM_K), j);
    if (cfg.active(j - 1, wid)) { finishSM(pA0, pA1, alA, l_reg, pa0, pa1, pa2, pa3); } SBAR();
    SLOAD(SO, j + SD); SBAR();
    if (cfg.active(j - 1, wid)) { pv_d0(o, vb0, pa0, pa1, pa2, pa3); }
    PSM(pB0, pB1, j, mnB, alB);
    __syncthreads(); SWAIT(); SWRITE(0, SE);
    RESC(alB); __syncthreads();
    SBAR(); QK1(pA0, pA1, K_lds, j + 1);
    if (cfg.active(j, wid)) { finishSM(pB0, pB1, alB, l_reg, pa0, pa1, pa2, pa3); } SBAR();
    if (SD == 1 || j + 3 < NT) SLOAD(SE, j + 1 + SD); SBAR();
    if (cfg.active(j, wid)) { pv_d0(o, vb0 + (int)SHM_V, pa0, pa1, pa2, pa3); }
    PSM(pA0, pA1, j + 1, mnA, alA);
    __syncthreads(); SWAIT(); SWRITE(1, SO);
    RESC(alA); __syncthreads();
  }
  SBAR(); QK1(pB0, pB1, (bf16*)((char*)K_lds + SHM_K), NT - 1);
  if (cfg.active(NT - 2, wid)) { finishSM(pA0, pA1, alA, l_reg, pa0, pa1, pa2, pa3); SBAR(); pv_d0(o, vb0, pa0, pa1, pa2, pa3); }
  PSM(pB0, pB1, NT - 1, mnB, alB);
  __syncthreads(); RESC(alB);
  if (cfg.active(NT - 1, wid)) { finishSM(pB0, pB1, alB, l_reg, pa0, pa1, pa2, pa3); SBAR(); pv_d0(o, vb0 + (int)SHM_V, pa0, pa1, pa2, pa3); }
  if (hi == 0) li_l[r32] = l_reg; asm volatile("s_waitcnt lgkmcnt(0)" ::: "memory");
  if (Cfg::HAS_LSE) { if (hi == 0) cfg.store_lse(wid * QBLK + r32, m_reg * SCALE + __logf(l_reg)); }
  if (MK_PREFETCH_UNIT) {
    const bf16* Qn = nxt->proj + nxt->q_off(wid * QBLK + r32) + hi * 8;
#pragma unroll
    for (int d0 = 0; d0 < 8; ++d0) pre.qr[d0] = *reinterpret_cast<const bf16x8*>(Qn + d0 * 16);
    const unsigned o0_ = nxt->kv_off(0, sr) + sc, o1_ = nxt->kv_off(0, 32 + sr) + sc;
    pre.vs0 = *reinterpret_cast<const bf16x8*>(nxt->proj + nxt->vcol + o0_); pre.vs1 = *reinterpret_cast<const bf16x8*>(nxt->proj + nxt->vcol + o1_);
    pre.ks0 = *reinterpret_cast<const bf16x8*>(nxt->proj + nxt->kcol + o0_); pre.ks1 = *reinterpret_cast<const bf16x8*>(nxt->proj + nxt->kcol + o1_);
    asm volatile("" ::: "memory");
  }
  { bf16* stg = (bf16*)(lds + OSTAGE_OFF) + wid * 2048;
#pragma unroll
    for (int hh = 0; hh < 2; ++hh) {
#pragma unroll
      for (int r8 = 0; r8 < 8; ++r8) { const int r = 8 * hh + r8; const int orow = crow(r, hi); const float rl = __builtin_amdgcn_rcpf(li_l[orow]);
#pragma unroll
        for (int d0 = 0; d0 < 4; ++d0) stg[(orow & 15) * 128 + d0 * 32 + r32] = (bf16)(cvtpk(o[d0][r] * rl, 0.f) & 0xffffu); }
      asm volatile("s_waitcnt lgkmcnt(0)" ::: "memory");
#pragma unroll
      for (int j = 0; j < 4; ++j) { const int row = (lane >> 4) + 4 * j, ch = lane & 15; const u32x4 v = *(const u32x4*)(stg + row * 128 + ch * 8);
        const unsigned oo_ = cfg.o_off(wid * QBLK + 16 * hh + row); *(u32x4*)(cfg.obuf + oo_ + ch * 8) = v;
        if (MK_MIXFOLD) { const float q_ = rowsum16(ssq8(v));
          if (ch == 0) ((float*)((char*)cfg.obuf + MK_SSQ_FROM_O_BYTES))[(oo_ >> 11) * 16 + ((oo_ & 2047u) >> 7)] = q_; } }
      asm volatile("s_waitcnt lgkmcnt(0)" ::: "memory");
    } }
  __syncthreads();
#undef SLOAD
#undef SWRITE
#undef SWAIT
#undef RESC
#undef QK
#undef QK1
#undef PSM
#undef FPV
}

template <class Cfg, bool BOUNDED = false>
__device__ __forceinline__ void attn_unit3(const Cfg& cfg, char* lds, const int wid  , Pre& pre, const bool have_pre  , const Cfg* nxt  ) {
  const int lane = lane_id(), tid = wid * 64 + lane, r32 = lane & 31, hi = lane >> 5;
  constexpr int SD = 2;
  bf16* V_lds = (bf16*)lds; bf16* K_lds = (bf16*)(lds + 3 * SHM_V);
  float* ws = (float*)(lds + 3 * SHM_V + 3 * SHM_K) + wid * 64; float* li_l = ws; float* al_l = ws + 32;
  float m_reg = -1e30f, l_reg = 0; f32x16 o[4] = {}; bf16x8 qr[8];
  const bf16* Qw = cfg.proj + cfg.q_off(wid * QBLK + r32) + hi * 8;
  if (have_pre) {
#pragma unroll
    for (int d0 = 0; d0 < 8; ++d0) qr[d0] = pre.qr[d0];
  } else {
#pragma unroll
    for (int d0 = 0; d0 < 8; ++d0) qr[d0] = *reinterpret_cast<const bf16x8*>(Qw + d0 * 16);
  }
  const int sr = tid >> 4, sc = (tid & 15) * 8, vst0 = v_st(sr, sc), vst1 = v_st(32 + sr, sc);
  const int vb0 = (int)(uintptr_t)V_lds + v_rd_base(lane);
  struct { bf16x8 vs0, vs1, ks0, ks1; } sr_[SD];
#define SLOAD(i, t) do { const unsigned o0_ = cfg.kv_off((t), sr) + sc, o1_ = cfg.kv_off((t), 32 + sr) + sc; \
    sr_[i].vs0 = *reinterpret_cast<const bf16x8*>(cfg.proj + cfg.vcol + o0_); sr_[i].vs1 = *reinterpret_cast<const bf16x8*>(cfg.proj + cfg.vcol + o1_); \
    sr_[i].ks0 = *reinterpret_cast<const bf16x8*>(cfg.proj + cfg.kcol + o0_); sr_[i].ks1 = *reinterpret_cast<const bf16x8*>(cfg.proj + cfg.kcol + o1_); } while (0)
#define SWRITE(b, i) do { *(bf16x8*)((char*)V_lds + (b) * SHM_V + vst0) = sr_[i].vs0;          \
    *(bf16x8*)((char*)V_lds + (b) * SHM_V + vst1) = sr_[i].vs1; int kc = sc * 2;               \
    *(bf16x8*)((char*)K_lds + (b) * SHM_K + KSWZ(sr, kc)) = sr_[i].ks0;                       \
    *(bf16x8*)((char*)K_lds + (b) * SHM_K + KSWZ(32 + sr, kc)) = sr_[i].ks1; } while (0)
#define SWAIT() do { if constexpr (SD == 2) asm volatile("s_waitcnt vmcnt(4)" ::: "memory"); else asm volatile("s_waitcnt vmcnt(0)" ::: "memory"); } while (0)
#define RESC(a) do { if (!BOUNDED && __any((a) < 1.f)) { if (hi == 0) al_l[r32] = (a); asm volatile("s_waitcnt lgkmcnt(0)" ::: "memory"); \
    for (int d = 0; d < 4; ++d) for (int r = 0; r < 16; ++r) o[d][r] *= al_l[crow(r, hi)]; } } while (0)
#define QK(P0, P1, KB, T, MN, AL) do { if (cfg.active((T), wid)) { qkt(P0, P1, (KB), qr, r32, hi, BOUNDED ? cfg.negm0C : 0.f); cfg.mask(P0, P1, (T), wid, r32, hi); if constexpr (BOUNDED) { boundedSM(P0, P1); AL = 1.f; } else partialSM(P0, P1, m_reg, MN, AL); } else { AL = 1.f; } } while (0)
#define QK1(P0, P1, KB, T) do { if (cfg.active((T), wid)) { qkt(P0, P1, (KB), qr, r32, hi, BOUNDED ? cfg.negm0C : 0.f); cfg.mask(P0, P1, (T), wid, r32, hi); } } while (0)
#define PSM(P0, P1, T, MN, AL) do { if (cfg.active((T), wid)) { if constexpr (BOUNDED) { boundedSM(P0, P1); AL = 1.f; } else partialSM(P0, P1, m_reg, MN, AL); } else { AL = 1.f; } } while (0)
#define FPV(P0, P1, AL, VB, T) do { if (cfg.active((T), wid)) { finishSM(P0, P1, AL, l_reg, pa0, pa1, pa2, pa3); SBAR(); pv_d0(o, (VB), pa0, pa1, pa2, pa3); } } while (0)
  f32x16 pA0, pA1, pB0, pB1; float mnA, mnB, alA, alB; bf16x8 pa0, pa1, pa2, pa3; const int NT = Cfg::NT;
  constexpr int SE = 0, SO = SD - 1;
  if (have_pre) { sr_[SE].vs0 = pre.vs0; sr_[SE].vs1 = pre.vs1; sr_[SE].ks0 = pre.ks0; sr_[SE].ks1 = pre.ks1; } else SLOAD(SE, 0);
  asm volatile("s_waitcnt vmcnt(0)" ::: "memory"); SWRITE(0, SE); __syncthreads();
  QK(pA0, pA1, K_lds, 0, mnA, alA);
  SLOAD(SO, 1); if constexpr (SD == 2) { if (2 < NT) SLOAD(SE, 2); }
  SWAIT(); SWRITE(1, SO); __syncthreads();
  int bt = 1;
#define KB3(b_) ((bf16*)((char*)K_lds + (b_) * (int)SHM_K))
#define VB3(b_) (vb0 + (b_) * (int)SHM_V)
  for (int j = 1; j + 1 < NT; j += 2) {
    const int bn = (bt == 2) ? 0 : bt + 1, bm = (bt == 0) ? 2 : bt - 1;
    SBAR(); QK1(pB0, pB1, KB3(bt), j);
    if (cfg.active(j - 1, wid)) { finishSM(pA0, pA1, alA, l_reg, pa0, pa1, pa2, pa3); } SBAR();
    SLOAD(SO, j + SD); SBAR();
    if (cfg.active(j - 1, wid)) { pv_d0(o, VB3(bm), pa0, pa1, pa2, pa3); }
    PSM(pB0, pB1, j, mnB, alB);
    SWAIT(); SWRITE(bn, SE);
    RESC(alB); __syncthreads();
    SBAR(); QK1(pA0, pA1, KB3(bn), j + 1);
    if (cfg.active(j, wid)) { finishSM(pB0, pB1, alB, l_reg, pa0, pa1, pa2, pa3); } SBAR();
    if (j + 3 < NT) SLOAD(SE, j + 1 + SD); SBAR();
    if (cfg.active(j, wid)) { pv_d0(o, VB3(bt), pa0, pa1, pa2, pa3); }
    PSM(pA0, pA1, j + 1, mnA, alA);
    SWAIT(); SWRITE(bm, SO);
    RESC(alA); __syncthreads();
    bt = bm;
  }
  { const int bm = (bt == 0) ? 2 : bt - 1;
    SBAR(); QK1(pB0, pB1, KB3(bt), NT - 1);
    if (cfg.active(NT - 2, wid)) { finishSM(pA0, pA1, alA, l_reg, pa0, pa1, pa2, pa3); SBAR(); pv_d0(o, VB3(bm), pa0, pa1, pa2, pa3); }
    PSM(pB0, pB1, NT - 1, mnB, alB);
    RESC(alB);
    if (cfg.active(NT - 1, wid)) { finishSM(pB0, pB1, alB, l_reg, pa0, pa1, pa2, pa3); SBAR(); pv_d0(o, VB3(bt), pa0, pa1, pa2, pa3); } }
#undef KB3
#undef VB3
  if (hi == 0) li_l[r32] = l_reg; asm volatile("s_waitcnt lgkmcnt(0)" ::: "memory");
  if (Cfg::HAS_LSE) { if (hi == 0) cfg.store_lse(wid * QBLK + r32, m_reg * SCALE + __logf(l_reg)); }
  if (MK_PREFETCH_UNIT) {
    const bf16* Qn = nxt->proj + nxt->q_off(wid * QBLK + r32) + hi * 8;
#pragma unroll
    for (int d0 = 0; d0 < 8; ++d0) pre.qr[d0] = *reinterpret_cast<const bf16x8*>(Qn + d0 * 16);
    const unsigned o0_ = nxt->kv_off(0, sr) + sc, o1_ = nxt->kv_off(0, 32 + sr) + sc;
    pre.vs0 = *reinterpret_cast<const bf16x8*>(nxt->proj + nxt->vcol + o0_); pre.vs1 = *reinterpret_cast<const bf16x8*>(nxt->proj + nxt->vcol + o1_);
    pre.ks0 = *reinterpret_cast<const bf16x8*>(nxt->proj + nxt->kcol + o0_); pre.ks1 = *reinterpret_cast<const bf16x8*>(nxt->proj + nxt->kcol + o1_);
    asm volatile("" ::: "memory");
  }
  __syncthreads();
  { bf16* stg = (bf16*)lds + wid * 2048;
#pragma unroll
    for (int hh = 0; hh < 2; ++hh) {
#pragma unroll
      for (int r8 = 0; r8 < 8; ++r8) { const int r = 8 * hh + r8; const int orow = crow(r, hi); const float rl = __builtin_amdgcn_rcpf(li_l[orow]);
#pragma unroll
        for (int d0 = 0; d0 < 4; ++d0) stg[(orow & 15) * 128 + d0 * 32 + r32] = (bf16)(cvtpk(o[d0][r] * rl, 0.f) & 0xffffu); }
      asm volatile("s_waitcnt lgkmcnt(0)" ::: "memory");
#pragma unroll
      for (int j = 0; j < 4; ++j) { const int row = (lane >> 4) + 4 * j, ch = lane & 15; const u32x4 v = *(const u32x4*)(stg + row * 128 + ch * 8);
        const unsigned oo_ = cfg.o_off(wid * QBLK + 16 * hh + row); *(u32x4*)(cfg.obuf + oo_ + ch * 8) = v;
        if (MK_MIXFOLD) { const float q_ = rowsum16(ssq8(v));
          if (ch == 0) ((float*)((char*)cfg.obuf + MK_SSQ_FROM_O_BYTES))[(oo_ >> 11) * 16 + ((oo_ & 2047u) >> 7)] = q_; } }
      asm volatile("s_waitcnt lgkmcnt(0)" ::: "memory");
    } }
  __syncthreads();
#undef SLOAD
#undef SWRITE
#undef SWAIT
#undef RESC
#undef QK
#undef QK1
#undef PSM
#undef FPV
}

template <class Cfg, int SD = 2>
__device__ __forceinline__ void attn_unit_h(const Cfg& cfg, char* lds, const int wid  , Pre& pre, const bool have_pre  , const Cfg* nxt  ) {
  const int lane = lane_id(), tid = wid * 64 + lane, r32 = lane & 31, hi = lane >> 5;
  bf16* V_lds = (bf16*)lds; bf16* K_lds = (bf16*)(lds + 2 * SHM_V);
  float* ws = (float*)(lds + 2 * SHM_V + 2 * SHM_K) + wid * 64; float* li_l = ws; float* al_l = ws + 32;
  float m_reg = -1e30f, l_reg = 0; f32x16 o[4] = {}; bf16x8 qr[8];
  const bf16* Qw = cfg.proj + cfg.q_off(wid * QBLK + r32) + hi * 8;
  if (have_pre) {
#pragma unroll
    for (int d0 = 0; d0 < 8; ++d0) qr[d0] = pre.qr[d0];
  } else {
#pragma unroll
    for (int d0 = 0; d0 < 8; ++d0) qr[d0] = *reinterpret_cast<const bf16x8*>(Qw + d0 * 16);
  }
  const int sr = tid >> 4, sc = (tid & 15) * 8, vst0 = v_st(sr, sc), vst1 = v_st(32 + sr, sc);
  const int krow = cfg.kwin(wid) + r32;
  const int Ga = (cfg.kwin(wid) >> 3) + hi;
  const int vb0 = (int)(uintptr_t)V_lds + (v_rd_base(lane) & ~256) + ((Ga >> 1) << 12) + ((Ga & 1) << 8);
  struct { bf16x8 vs0, vs1, ks0, ks1; } sr_[SD];
#define SLOAD(i, t) do { const unsigned o0_ = cfg.kv_off((t), sr) + sc, o1_ = cfg.kv_off((t), 32 + sr) + sc; \
    sr_[i].vs0 = *reinterpret_cast<const bf16x8*>(cfg.proj + cfg.vcol + o0_); sr_[i].vs1 = *reinterpret_cast<const bf16x8*>(cfg.proj + cfg.vcol + o1_); \
    sr_[i].ks0 = *reinterpret_cast<const bf16x8*>(cfg.proj + cfg.kcol + o0_); sr_[i].ks1 = *reinterpret_cast<const bf16x8*>(cfg.proj + cfg.kcol + o1_); } while (0)
#define SWRITE(b, i) do { *(bf16x8*)((char*)V_lds + (b) * SHM_V + vst0) = sr_[i].vs0;          \
    *(bf16x8*)((char*)V_lds + (b) * SHM_V + vst1) = sr_[i].vs1; int kc = sc * 2;               \
    *(bf16x8*)((char*)K_lds + (b) * SHM_K + KSWZ(sr, kc)) = sr_[i].ks0;                       \
    *(bf16x8*)((char*)K_lds + (b) * SHM_K + KSWZ(32 + sr, kc)) = sr_[i].ks1; } while (0)
#define SWAIT() do { if constexpr (SD == 2) asm volatile("s_waitcnt vmcnt(4)" ::: "memory"); else asm volatile("s_waitcnt vmcnt(0)" ::: "memory"); } while (0)
#define RESC(a) do { if (__any((a) < 1.f)) { if (hi == 0) al_l[r32] = (a); asm volatile("s_waitcnt lgkmcnt(0)" ::: "memory"); \
    for (int d = 0; d < 4; ++d) for (int r = 0; r < 16; ++r) o[d][r] *= al_l[crow(r, hi)]; } } while (0)
#define QK(P0, KB, T, MN, AL) do { if (cfg.active((T), wid)) { qkt32(P0, (KB), qr, krow, hi); cfg.mask16(P0, (T), wid, r32, hi); partialSM1(P0, m_reg, MN, AL); } else { AL = 1.f; } } while (0)
#define QK1(P0, KB, T) do { if (cfg.active((T), wid)) { qkt32(P0, (KB), qr, krow, hi); cfg.mask16(P0, (T), wid, r32, hi); } } while (0)
#define PSM(P0, T, MN, AL) do { if (cfg.active((T), wid)) { partialSM1(P0, m_reg, MN, AL); } else { AL = 1.f; } } while (0)
  f32x16 pA0, pB0; float mnA, mnB, alA, alB; bf16x8 pa0, pa1; const int NT = Cfg::NT;
  constexpr int SE = 0, SO = SD - 1;
  if (have_pre) { sr_[SE].vs0 = pre.vs0; sr_[SE].vs1 = pre.vs1; sr_[SE].ks0 = pre.ks0; sr_[SE].ks1 = pre.ks1; } else SLOAD(SE, 0);
  asm volatile("s_waitcnt vmcnt(0)" ::: "memory"); SWRITE(0, SE); __syncthreads();
  QK(pA0, K_lds, 0, mnA, alA);
  SLOAD(SO, 1); if constexpr (SD == 2) { if (2 < NT) SLOAD(SE, 2); }
  SWAIT(); SWRITE(1, SO); __syncthreads();
  for (int j = 1; j + 1 < NT; j += 2) {
    SBAR(); QK1(pB0, (bf16*)((char*)K_lds + SHM_K), j);
    if (cfg.active(j - 1, wid)) { finishSM1(pA0, alA, l_reg, pa0, pa1); } SBAR();
    SLOAD(SO, j + SD); SBAR();
    if (cfg.active(j - 1, wid)) { pv_d0h(o, vb0, pa0, pa1); }
    PSM(pB0, j, mnB, alB);
    __syncthreads(); SWAIT(); SWRITE(0, SE);
    RESC(alB); __syncthreads();
    SBAR(); QK1(pA0, K_lds, j + 1);
    if (cfg.active(j, wid)) { finishSM1(pB0, alB, l_reg, pa0, pa1); } SBAR();
    if (SD == 1 || j + 3 < NT) SLOAD(SE, j + 1 + SD); SBAR();
    if (cfg.active(j, wid)) { pv_d0h(o, vb0 + (int)SHM_V, pa0, pa1); }
    PSM(pA0, j + 1, mnA, alA);
    __syncthreads(); SWAIT(); SWRITE(1, SO);
    RESC(alA); __syncthreads();
  }
  SBAR(); QK1(pB0, (bf16*)((char*)K_lds + SHM_K), NT - 1);
  if (cfg.active(NT - 2, wid)) { finishSM1(pA0, alA, l_reg, pa0, pa1); SBAR(); pv_d0h(o, vb0, pa0, pa1); }
  PSM(pB0, NT - 1, mnB, alB);
  __syncthreads(); RESC(alB);
  if (cfg.active(NT - 1, wid)) { finishSM1(pB0, alB, l_reg, pa0, pa1); SBAR(); pv_d0h(o, vb0 + (int)SHM_V, pa0, pa1); }
  if (hi == 0) li_l[r32] = l_reg; asm volatile("s_waitcnt lgkmcnt(0)" ::: "memory");
  if (Cfg::HAS_LSE) { if (hi == 0) cfg.store_lse(wid * QBLK + r32, m_reg * SCALE + __logf(l_reg)); }
  if (MK_PREFETCH_UNIT) {
    const bf16* Qn = nxt->proj + nxt->q_off(wid * QBLK + r32) + hi * 8;
#pragma unroll
    for (int d0 = 0; d0 < 8; ++d0) pre.qr[d0] = *reinterpret_cast<const bf16x8*>(Qn + d0 * 16);
    const unsigned o0_ = nxt->kv_off(0, sr) + sc, o1_ = nxt->kv_off(0, 32 + sr) + sc;
    pre.vs0 = *reinterpret_cast<const bf16x8*>(nxt->proj + nxt->vcol + o0_); pre.vs1 = *reinterpret_cast<const bf16x8*>(nxt->proj + nxt->vcol + o1_);
    pre.ks0 = *reinterpret_cast<const bf16x8*>(nxt->proj + nxt->kcol + o0_); pre.ks1 = *reinterpret_cast<const bf16x8*>(nxt->proj + nxt->kcol + o1_);
    asm volatile("" ::: "memory");
  }
  { bf16* stg = (bf16*)(lds + OSTAGE_OFF) + wid * 2048;
#pragma unroll
    for (int hh = 0; hh < 2; ++hh) {
#pragma unroll
      for (int r8 = 0; r8 < 8; ++r8) { const int r = 8 * hh + r8; const int orow = crow(r, hi); const float rl = __builtin_amdgcn_rcpf(li_l[orow]);
#pragma unroll
        for (int d0 = 0; d0 < 4; ++d0) stg[(orow & 15) * 128 + d0 * 32 + r32] = (bf16)(cvtpk(o[d0][r] * rl, 0.f) & 0xffffu); }
      asm volatile("s_waitcnt lgkmcnt(0)" ::: "memory");
#pragma unroll
      for (int j = 0; j < 4; ++j) { const int row = (lane >> 4) + 4 * j, ch = lane & 15; const u32x4 v = *(const u32x4*)(stg + row * 128 + ch * 8);
        const unsigned oo_ = cfg.o_off(wid * QBLK + 16 * hh + row); *(u32x4*)(cfg.obuf + oo_ + ch * 8) = v;
        if (MK_MIXFOLD) { const float q_ = rowsum16(ssq8(v));
          if (ch == 0) ((float*)((char*)cfg.obuf + MK_SSQ_FROM_O_BYTES))[(oo_ >> 11) * 16 + ((oo_ & 2047u) >> 7)] = q_; } }
      asm volatile("s_waitcnt lgkmcnt(0)" ::: "memory");
    } }
  __syncthreads();
#undef SLOAD
#undef SWRITE
#undef SWAIT
#undef RESC
#undef QK
#undef QK1
#undef PSM
}

template <class Cfg>
__device__ __forceinline__ void attn_unit_simple(const Cfg& cfg, char* lds, const int wid  ) {
  const int lane = lane_id(), tid = wid * 64 + lane, r32 = lane & 31, hi = lane >> 5;
  bf16* V_lds = (bf16*)lds; bf16* K_lds = (bf16*)(lds + 2 * SHM_V);
  float* ws = (float*)(lds + 2 * SHM_V + 2 * SHM_K) + wid * 64; float* li_l = ws; float* al_l = ws + 32;
  float m_reg = -1e30f, l_reg = 0; f32x16 o[4] = {}; bf16x8 qr[8];
  const bf16* Qw = cfg.proj + cfg.q_off(wid * QBLK + r32) + hi * 8;
#pragma unroll
  for (int d0 = 0; d0 < 8; ++d0) qr[d0] = *reinterpret_cast<const bf16x8*>(Qw + d0 * 16);
  const int sr = tid >> 4, sc = (tid & 15) * 8, vst0 = v_st(sr, sc), vst1 = v_st(32 + sr, sc);
  const int vb0 = (int)(uintptr_t)V_lds + v_rd_base(lane);
  bf16x8 vs0, vs1, ks0, ks1;
#define SLOAD1(t) do { const unsigned o0_ = cfg.kv_off((t), sr) + sc, o1_ = cfg.kv_off((t), 32 + sr) + sc; \
    vs0 = *reinterpret_cast<const bf16x8*>(cfg.proj + cfg.vcol + o0_); vs1 = *reinterpret_cast<const bf16x8*>(cfg.proj + cfg.vcol + o1_); \
    ks0 = *reinterpret_cast<const bf16x8*>(cfg.proj + cfg.kcol + o0_); ks1 = *reinterpret_cast<const bf16x8*>(cfg.proj + cfg.kcol + o1_); } while (0)
#define SWRITE1(b) do { *(bf16x8*)((char*)V_lds + (b) * SHM_V + vst0) = vs0; *(bf16x8*)((char*)V_lds + (b) * SHM_V + vst1) = vs1; const int kc = sc * 2; \
    *(bf16x8*)((char*)K_lds + (b) * SHM_K + KSWZ(sr, kc)) = ks0; *(bf16x8*)((char*)K_lds + (b) * SHM_K + KSWZ(32 + sr, kc)) = ks1; } while (0)
  const int tb = cfg.t_begin(), te = cfg.t_end();
  SLOAD1(tb); asm volatile("s_waitcnt vmcnt(0)" ::: "memory"); SWRITE1(tb & 1); __syncthreads();
  for (int t = tb; t < te; ++t) {
    const int b = t & 1;
    if (t + 1 < te) SLOAD1(t + 1);
    SBAR();
    if (cfg.active(t, wid)) {
      f32x16 p0, p1; float mn, al; bf16x8 pa0, pa1, pa2, pa3;
      qkt(p0, p1, (bf16*)((char*)K_lds + b * SHM_K), qr, r32, hi);
      cfg.mask(p0, p1, t, wid, r32, hi);
      partialSM(p0, p1, m_reg, mn, al);
      if (__any(al < 1.f)) { if (hi == 0) al_l[r32] = al; asm volatile("s_waitcnt lgkmcnt(0)" ::: "memory");
#pragma unroll
        for (int d = 0; d < 4; ++d)
#pragma unroll
          for (int r = 0; r < 16; ++r) o[d][r] *= al_l[crow(r, hi)]; }
      finishSM(p0, p1, al, l_reg, pa0, pa1, pa2, pa3); SBAR();
      pv_d0(o, vb0 + b * (int)SHM_V, pa0, pa1, pa2, pa3);
    }
    SBAR();
    if (t + 1 < te) { asm volatile("s_waitcnt vmcnt(0)" ::: "memory"); SWRITE1(b ^ 1); }
    __syncthreads();
  }
  if (hi == 0) li_l[r32] = l_reg; asm volatile("s_waitcnt lgkmcnt(0)" ::: "memory");
  if (Cfg::HAS_LSE) { if (hi == 0) cfg.store_lse(wid * QBLK + r32, m_reg * SCALE + __logf(l_reg)); }
  { bf16* stg = (bf16*)(lds + OSTAGE_OFF) + wid * 2048;
#pragma unroll
    for (int hh = 0; hh < 2; ++hh) {
#pragma unroll
      for (int r8 = 0; r8 < 8; ++r8) { const int r = 8 * hh + r8; const int orow = crow(r, hi); const float rl = __builtin_amdgcn_rcpf(li_l[orow]);
#pragma unroll
        for (int d0 = 0; d0 < 4; ++d0) stg[(orow & 15) * 128 + d0 * 32 + r32] = (bf16)(cvtpk(o[d0][r] * rl, 0.f) & 0xffffu); }
      asm volatile("s_waitcnt lgkmcnt(0)" ::: "memory");
#pragma unroll
      for (int j = 0; j < 4; ++j) { const int row = (lane >> 4) + 4 * j, ch = lane & 15; const u32x4 v = *(const u32x4*)(stg + row * 128 + ch * 8);
        const unsigned oo_ = cfg.o_off(wid * QBLK + 16 * hh + row); *(u32x4*)(cfg.obuf + oo_ + ch * 8) = v;
        if (MK_MIXFOLD) { const float q_ = rowsum16(ssq8(v));
          if (ch == 0) ((float*)((char*)cfg.obuf + MK_SSQ_FROM_O_BYTES))[(oo_ >> 11) * 16 + ((oo_ & 2047u) >> 7)] = q_; } }
      asm volatile("s_waitcnt lgkmcnt(0)" ::: "memory");
    } }
  __syncthreads();
#undef SLOAD1
#undef SWRITE1
}

template <class Cfg>
__device__ __forceinline__ void attn_unit_wave(const Cfg& cfg, char* lds, const int wid  ) {
  const int lane = lane_id(), r32 = lane & 31, hi = lane >> 5;
  char* Vw = lds + wid * 8192;
  float* ws = (float*)(lds + 2 * SHM_V + 2 * SHM_K) + wid * 64; float* li_l = ws; float* al_l = ws + 32;
  float m_reg = -1e30f, l_reg = 0; f32x16 o[4] = {}; bf16x8 qr[8];
  const bf16* Qw = cfg.proj + cfg.q_off(wid * QBLK + r32) + hi * 8;
#pragma unroll
  for (int d0 = 0; d0 < 8; ++d0) qr[d0] = *reinterpret_cast<const bf16x8*>(Qw + d0 * 16);
  const int vkey = lane >> 4, vch = (lane & 15) * 8;
  const int vb0 = (int)(uintptr_t)Vw + v_rd_base(lane);
  const int tb = cfg.t_begin(), te = cfg.t_end();
  for (int t = tb; t < te; ++t) {
    if (!cfg.active(t, wid)) continue;
    bf16x8 kf[16], vf[8];
    { const bf16* k0p = cfg.proj + cfg.kcol + cfg.kv_off(t, r32) + hi * 8; const bf16* k1p = cfg.proj + cfg.kcol + cfg.kv_off(t, 32 + r32) + hi * 8;
#pragma unroll
      for (int d0 = 0; d0 < 8; ++d0) { kf[2 * d0] = *reinterpret_cast<const bf16x8*>(k0p + d0 * 16); kf[2 * d0 + 1] = *reinterpret_cast<const bf16x8*>(k1p + d0 * 16); } }
#pragma unroll
    for (int j = 0; j < 8; ++j) vf[j] = *reinterpret_cast<const bf16x8*>(cfg.proj + cfg.vcol + cfg.kv_off(t, vkey + 4 * j) + vch);
    f32x16 p0 = {}, p1 = {};
#pragma unroll
    for (int d0 = 0; d0 < 8; ++d0) { p0 = __builtin_amdgcn_mfma_f32_32x32x16_bf16(kf[2 * d0], qr[d0], p0, 0, 0, 0); p1 = __builtin_amdgcn_mfma_f32_32x32x16_bf16(kf[2 * d0 + 1], qr[d0], p1, 0, 0, 0); }
    cfg.mask(p0, p1, t, wid, r32, hi);
    float mn, al; bf16x8 pa0, pa1, pa2, pa3;
    partialSM(p0, p1, m_reg, mn, al);
    if (__any(al < 1.f)) { if (hi == 0) al_l[r32] = al; asm volatile("s_waitcnt lgkmcnt(0)" ::: "memory");
#pragma unroll
      for (int d = 0; d < 4; ++d)
#pragma unroll
        for (int r = 0; r < 16; ++r) o[d][r] *= al_l[crow(r, hi)]; }
    finishSM(p0, p1, al, l_reg, pa0, pa1, pa2, pa3);
#pragma unroll
    for (int j = 0; j < 8; ++j) *(bf16x8*)(Vw + v_st(vkey + 4 * j, vch)) = vf[j];
#pragma unroll
    for (int j = 0; j < 8; ++j) vf[j] = *reinterpret_cast<const bf16x8*>(cfg.proj + cfg.vcol + cfg.kv_off(t, 32 + vkey + 4 * j) + vch);
    asm volatile("s_waitcnt lgkmcnt(0)" ::: "memory"); SBAR();
#define PVW(D0, PA, PB) do { const s16x4 l0 = tr_read<v_rd_off(D0, 0, 0)>(vb0), h0 = tr_read<v_rd_off(D0, 0, 1)>(vb0), l1 = tr_read<v_rd_off(D0, 1, 0)>(vb0), h1 = tr_read<v_rd_off(D0, 1, 1)>(vb0); \
      asm volatile("s_waitcnt lgkmcnt(0)" ::: "memory"); SBAR(); \
      o[D0] = __builtin_amdgcn_mfma_f32_32x32x16_bf16(PA, ((bf16x8){l0[0], l0[1], l0[2], l0[3], h0[0], h0[1], h0[2], h0[3]}), o[D0], 0, 0, 0); \
      o[D0] = __builtin_amdgcn_mfma_f32_32x32x16_bf16(PB, ((bf16x8){l1[0], l1[1], l1[2], l1[3], h1[0], h1[1], h1[2], h1[3]}), o[D0], 0, 0, 0); } while (0)
    PVW(0, pa0, pa1); PVW(1, pa0, pa1); PVW(2, pa0, pa1); PVW(3, pa0, pa1);
    SBAR();
#pragma unroll
    for (int j = 0; j < 8; ++j) *(bf16x8*)(Vw + v_st(vkey + 4 * j, vch)) = vf[j];
    asm volatile("s_waitcnt lgkmcnt(0)" ::: "memory"); SBAR();
    PVW(0, pa2, pa3); PVW(1, pa2, pa3); PVW(2, pa2, pa3); PVW(3, pa2, pa3);
    SBAR();
#undef PVW
  }
  if (hi == 0) li_l[r32] = l_reg; asm volatile("s_waitcnt lgkmcnt(0)" ::: "memory");
  if (Cfg::HAS_LSE) { if (hi == 0) cfg.store_lse(wid * QBLK + r32, m_reg * SCALE + __logf(l_reg)); }
  { bf16* stg = (bf16*)(lds + OSTAGE_OFF) + wid * 2048;
#pragma unroll
    for (int hh = 0; hh < 2; ++hh) {
#pragma unroll
      for (int r8 = 0; r8 < 8; ++r8) { const int r = 8 * hh + r8; const int orow = crow(r, hi); const float rl = __builtin_amdgcn_rcpf(li_l[orow]);
#pragma unroll
        for (int d0 = 0; d0 < 4; ++d0) stg[(orow & 15) * 128 + d0 * 32 + r32] = (bf16)(cvtpk(o[d0][r] * rl, 0.f) & 0xffffu); }
      asm volatile("s_waitcnt lgkmcnt(0)" ::: "memory");
#pragma unroll
      for (int j = 0; j < 4; ++j) { const int row = (lane >> 4) + 4 * j, ch = lane & 15; const u32x4 v = *(const u32x4*)(stg + row * 128 + ch * 8);
        const unsigned oo_ = cfg.o_off(wid * QBLK + 16 * hh + row); *(u32x4*)(cfg.obuf + oo_ + ch * 8) = v;
        if (MK_MIXFOLD) { const float q_ = rowsum16(ssq8(v));
          if (ch == 0) ((float*)((char*)cfg.obuf + MK_SSQ_FROM_O_BYTES))[(oo_ >> 11) * 16 + ((oo_ & 2047u) >> 7)] = q_; } }
      asm volatile("s_waitcnt lgkmcnt(0)" ::: "memory");
    } }
}
#undef KSWZ
#undef SBAR
}

constexpr int NWAVES = 8;
constexpr int NTOK = 49152, SEQ = 4096, NSEQ = 12, NTOK_P = 16384;
constexpr int DM = 2048, INW = 5632, DFF = 8192, NLAYER = 4, HD = 128;
constexpr int COL_AQ = 0, COL_AK = 512, COL_AV = 768, COL_BQ = 1024, COL_BK = 1792, COL_BV = 2560, COL_CQ = 3328, COL_CK = 4096, COL_CV = 4864;
constexpr int OCOL_A = 0, OCOL_B = 512, OCOL_C = 1280;
constexpr float DN_ALPHA = 1.681792830507429f;
constexpr float EPS = 1e-6f;
constexpr float ATT_SCALE = 0.08838834764831845f;
#ifndef MK_BF16_RES
#define MK_BF16_RES 1
#endif
#ifndef MK_FUSE_PREP
#define MK_FUSE_PREP 1
#endif
#ifndef MK_BOUNDED_A
#define MK_BOUNDED_A 1
#endif
#ifndef MK_FIN_PHASES
#define MK_FIN_PHASES 0
#endif
#ifndef MK_TILED_H
#define MK_TILED_H 1
#endif
#ifndef MK_WGM_RES
#define MK_WGM_RES 4
#endif

constexpr size_t MiB = 1u << 20;
constexpr size_t WS_CTL = 0, CTL_ZERO_BYTES = 1 * MiB;
constexpr size_t WS_ROPE_B = 1 * MiB;
constexpr size_t WS_ROPE_A = 3 * MiB;
constexpr size_t WS_LSE    = 4 * MiB;
constexpr size_t WS_WIN    = 6 * MiB;
constexpr size_t WS_WOUT   = 28 * MiB;
constexpr size_t WS_WFF1   = 36 * MiB;
constexpr size_t WS_WFF2   = 68 * MiB;
constexpr size_t WS_XB     = 100 * MiB;
constexpr size_t WS_PROJ   = 292 * MiB;
constexpr size_t WS_O      = 820 * MiB;
constexpr size_t WS_H      = 292 * MiB;
constexpr size_t WS_PART   = 1060 * MiB;
constexpr size_t WS_STAT   = 1072 * MiB;
constexpr size_t WS_VEC    = 1073 * MiB;
constexpr size_t WS_PSB    = 1074 * MiB;
constexpr size_t WS_END    = 1078 * MiB;
constexpr size_t WS_SSQ    = 1012 * MiB;
constexpr size_t WS_RAT    = 1016 * MiB;
static_assert(WS_SSQ == WS_O + (size_t)NTOK * DM * 2 && WS_SSQ - WS_O == (size_t)MK_SSQ_FROM_O_BYTES && WS_SSQ + (size_t)NTOK * 16 * 4 <= WS_RAT && WS_RAT + (size_t)NTOK * 8 * 4 <= WS_PART, "SSQ / RAT placement");
static_assert(WS_PROJ + (size_t)NTOK * INW * 2 == WS_O && WS_O + (size_t)NTOK * DM * 2 <= WS_END && WS_H + (size_t)NTOK * DFF * 2 == WS_PART && WS_XB + (size_t)NTOK * DM * 2 == WS_PROJ, "d_ws map");
constexpr int CW_TMO = 0, CW_CODE = 1, CW_BAR = 4096;
constexpr int CW_ATTQ = 16384;
constexpr int NCOLP = INW + DFF, VEC_CS_IN = 0, VEC_BW_IN = INW, VEC_CS_FF1 = 2 * INW, VEC_BW_FF1 = 2 * INW + DFF, VEC_ONES = 2 * INW + 2 * DFF, VEC_ZEROS = VEC_ONES + DM, VEC_M0 = VEC_ZEROS + DM;
static_assert((size_t)(VEC_M0 + 16) * 4 <= MiB && (size_t)2 * 32 * NCOLP * 4 <= 4 * MiB && (size_t)NTOK * 8 <= MiB, "small buffers");

constexpr int RING_OFF = 0, RING_BYTES = 131072;
constexpr int LDSCTL_OFF = RING_BYTES, MISC_OFF = LDSCTL_OFF + 320;
constexpr int XCH_OFF = RING_BYTES + 1024;
constexpr int KTAB_OFF = XCH_OFF;
constexpr int STG_OFF = XCH_OFF + 8192;
constexpr int STG2_OFF = XCH_OFF + 16384;
constexpr int LDS_BYTES = 156672;
static_assert(MISC_OFF + 128 <= XCH_OFF && XCH_OFF + 8192 <= LDS_BYTES && KTAB_OFF + 16384 <= LDS_BYTES && STG2_OFF + 8192 <= LDS_BYTES && LDS_BYTES <= 163840, "LDS map");

__host__ __device__ __forceinline__ int pinv_A(int c) { const int half = c >> 6, w = c & 63, hi = w >> 5, i = w & 31; return 8 * (half * 8 + (i >> 2)) + hi * 4 + (i & 3); }
__host__ __device__ __forceinline__ int pinv_B(int c) { const int hi = c >> 6, i = c & 63; return 8 * (i >> 2) + hi * 4 + (i & 3); }
__host__ __device__ __forceinline__ int proj_phys_col(int n) {
#if MK_FUSE_PREP
    if (n < COL_AV) return (n & ~127) + pinv_A(n & 127);
    if (n >= COL_BQ && n < COL_BV) return (n & ~127) + pinv_B(n & 127);
#endif
    return n;
}

struct Frame {
    LAS unsigned char* lds;
    volatile LAS unsigned* MISC;
    gu32* ctl;
    int wave;
    int vcu, G;
    int gw, NGW;
    const float *x_prompt, *x_sample, *w_in, *a_q_gain, *a_k_gain, *c_rel_bias, *mix_gain, *w_out, *ln1_g, *ln1_b, *w_ff1, *w_ff2, *ln2_g, *ln2_b;
    float* X;
    bf16 *Win_t, *Wout_t, *Wff1_t, *Wff2_t;
    bf16 *XB, *PROJ, *O, *H;
    float* LSE; float* ROPE_B; float* ROPE_A;
    pg8::f32x2* PART; pg8::f32x2* STAT; float* VEC; float* PSB;
    float* SSQ; float* RAT;
};

constexpr int CW_SB = 32768;
__device__ __forceinline__ void sb_arrive(Frame& F, int k) {
    asm volatile("s_waitcnt vmcnt(0)" ::: "memory");
    __syncthreads();
    if (F.wave == 0 && lane_id() == 0) {
        __builtin_amdgcn_fence(__ATOMIC_RELEASE, "agent");
        asm volatile("s_waitcnt vmcnt(0)" ::: "memory");
        (void)__hip_atomic_fetch_add(F.ctl + CW_SB + 64 * k, 1u, RLX_AGENT);
    }
}
__device__ __forceinline__ void sb_wait(Frame& F, int k) {
    if (F.wave == 0 && lane_id() == 0) {
        gu32* w = F.ctl + CW_SB + 64 * k; const unsigned want = (unsigned)F.G; unsigned sp = 0u;
        while (__hip_atomic_load(w, RLX_AGENT) < want) { __builtin_amdgcn_s_sleep(2);
            if ((++sp & 1023u) == 0u) { if (__hip_atomic_load(F.ctl + CW_TMO, RLX_AGENT) != 0u) break; if (sp > (1u << 22)) { __hip_atomic_store(F.ctl + CW_TMO, 1u, RLX_AGENT); break; } } }
        __builtin_amdgcn_fence(__ATOMIC_ACQUIRE, "agent");
        asm volatile("s_waitcnt vmcnt(0)" ::: "memory");
    }
    __syncthreads();
}

__device__ __forceinline__ float wave_sum(float v) {
    v += xshfl<1>(v); v += xshfl<2>(v); v += xshfl<4>(v); v += xshfl<8>(v); v += xshfl<16>(v); v = xsum32(v);
    return v;
}
__device__ __forceinline__ float wave_max(float v) {
    v = fmaxf(v, xshfl<1>(v)); v = fmaxf(v, xshfl<2>(v)); v = fmaxf(v, xshfl<4>(v)); v = fmaxf(v, xshfl<8>(v)); v = fmaxf(v, xshfl<16>(v)); v = xmax32(v);
    return v;
}
__device__ __forceinline__ float bf2f(unsigned short b) { return __builtin_bit_cast(float, (unsigned)b << 16); }
__device__ __forceinline__ float bflo(unsigned w) { return __builtin_bit_cast(float, w << 16); }
__device__ __forceinline__ float bfhi(unsigned w) { return __builtin_bit_cast(float, w & 0xffff0000u); }

struct ConvItem { const float* W; bf16* WT; const float* g; const float* bvec; float* ps; float* pb; int K, N, kb, n0, perm, pad_; };
struct ConvRegs { f32x4 wv[8]; float gk[8], bk[8]; };
__device__ __forceinline__ void conv_load(const ConvItem& it, ConvRegs& r, int lane) {
    const int k0 = 64 * it.kb, c = lane & 7;
#pragma unroll
    for (int i = 0; i < 8; ++i) r.wv[i] = *(const GAS f32x4*)(it.W + (size_t)(k0 + (lane >> 3) + 8 * i) * it.N + it.n0 + 4 * (lane & 7));
#pragma unroll
    for (int i = 0; i < 8; ++i) { r.gk[i] = it.g ? it.g[k0 + 8 * c + i] : 1.f; r.bk[i] = it.bvec ? it.bvec[k0 + 8 * c + i] : 0.f; }
}
__device__ __forceinline__ void conv_finish(const ConvItem& it, const ConvRegs& r, LAS float* scr, int lane) {
    const int k0 = 64 * it.kb, c = lane & 7;
#pragma unroll
    for (int i = 0; i < 8; ++i) { LAS float* d = scr + ((lane >> 3) + 8 * i) * 33 + 4 * (lane & 7); d[0] = r.wv[i].x; d[1] = r.wv[i].y; d[2] = r.wv[i].z; d[3] = r.wv[i].w; }
    LDS_WAIT(); asm volatile("" ::: "memory");
#pragma unroll
    for (int j = 0; j < 4; ++j) { const int n = (lane >> 3) + 8 * j; const LAS float* s = scr + (8 * c) * 33 + n;
        float w[8];
#pragma unroll
        for (int i = 0; i < 8; ++i) w[i] = s[i * 33];
        v4u o; o.x = pk2(w[0] * r.gk[0], w[1] * r.gk[1]); o.y = pk2(w[2] * r.gk[2], w[3] * r.gk[3]); o.z = pk2(w[4] * r.gk[4], w[5] * r.gk[5]); o.w = pk2(w[6] * r.gk[6], w[7] * r.gk[7]);
        const int nd = it.perm ? proj_phys_col(it.n0 + n) : it.n0 + n;
        if (MK_TILED_W) *(GAS v4u*)(it.WT + ((size_t)(nd >> 8) * (it.K >> 6) + (k0 >> 6)) * 16384 + (nd & 255) * 64 + 8 * c) = o;
        else *(GAS v4u*)(it.WT + (size_t)nd * it.K + k0 + 8 * c) = o;
        if (it.ps) { float sa = ((bflo(o.x) + bfhi(o.x)) + (bflo(o.y) + bfhi(o.y))) + ((bflo(o.z) + bfhi(o.z)) + (bflo(o.w) + bfhi(o.w)));
            float sb = 0.f;
#pragma unroll
            for (int i = 0; i < 8; ++i) sb += w[i] * r.bk[i];
            sa += xshfl<1>(sa); sa += xshfl<2>(sa); sa += xshfl<4>(sa); sb += xshfl<1>(sb); sb += xshfl<2>(sb); sb += xshfl<4>(sb);
            if (c == 0) { it.ps[(size_t)it.kb * NCOLP + nd] = sa; it.pb[(size_t)it.kb * NCOLP + nd] = sb; } } }
    LDS_WAIT(); asm volatile("" ::: "memory");
}
__device__ __forceinline__ void convert_weights(Frame& F, int l, int l_in, int which, int gw, int ngw) {
    const int lane = lane_id();
    LAS float* scr = (LAS float*)(F.lds + RING_OFF + F.wave * 16384);
    constexpr int I_IN = (DM / 64) * (INW / 32), I_OUT = (DM / 64) * (DM / 32), I_F1 = (DM / 64) * (DFF / 32), I_F2 = (DFF / 64) * (DM / 32);
    const int n_in = (which & 1) ? I_IN : 0, n_rest = (which & 2) ? (I_OUT + I_F1 + I_F2) : 0, n_all = n_in + n_rest;
    const float* w_in = F.w_in + (size_t)l_in * DM * INW; const float* w_out = F.w_out + (size_t)l * DM * DM;
    const float* w_ff1 = F.w_ff1 + (size_t)l * DM * DFF; const float* w_ff2 = F.w_ff2 + (size_t)l * DFF * DM;
    const float* gin = (l_in > 0) ? F.ln2_g + (size_t)(l_in - 1) * DM : nullptr; const float* bin = (l_in > 0) ? F.ln2_b + (size_t)(l_in - 1) * DM : nullptr;
    float* ps = F.PSB; float* pb = F.PSB + (size_t)32 * NCOLP;
#define CONV_MAKE(IT, idx) do { int r_ = (idx); \
        if (r_ < n_in) { const int nblk_ = INW / 32; IT.W = w_in; IT.WT = F.Win_t; IT.g = gin; IT.bvec = bin; IT.ps = ps; IT.pb = pb; IT.K = DM; IT.N = INW; IT.kb = r_ / nblk_; IT.n0 = 32 * (r_ % nblk_); IT.perm = 1; } \
        else { r_ -= n_in; \
          if (r_ < I_OUT) { const int nblk_ = DM / 32; IT.W = w_out; IT.WT = F.Wout_t; IT.g = MK_MIXFOLD ? F.mix_gain + (size_t)l * DM : nullptr; IT.bvec = nullptr; IT.ps = nullptr; IT.pb = nullptr; IT.K = DM; IT.N = DM; IT.kb = r_ / nblk_; IT.n0 = 32 * (r_ % nblk_); IT.perm = 0; } \
          else { r_ -= I_OUT; \
            if (r_ < I_F1) { const int nblk_ = DFF / 32; IT.W = w_ff1; IT.WT = F.Wff1_t; IT.g = F.ln1_g + (size_t)l * DM; IT.bvec = F.ln1_b + (size_t)l * DM; IT.ps = ps + INW; IT.pb = pb + INW; IT.K = DM; IT.N = DFF; IT.kb = r_ / nblk_; IT.n0 = 32 * (r_ % nblk_); IT.perm = 0; } \
            else { r_ -= I_F1; const int nblk_ = DM / 32; IT.W = w_ff2; IT.WT = F.Wff2_t; IT.g = nullptr; IT.bvec = nullptr; IT.ps = nullptr; IT.pb = nullptr; IT.K = DFF; IT.N = DM; IT.kb = r_ / nblk_; IT.n0 = 32 * (r_ % nblk_); IT.perm = 0; } } } } while (0)
    if (gw >= n_all) return;
    ConvItem cur; cur.pad_ = 0; ConvRegs rn; CONV_MAKE(cur, gw); conv_load(cur, rn, lane);
    for (int it = gw; it < n_all; it += ngw) {
        ConvRegs rc = rn; ConvItem nxt = cur; const bool has_next = it + ngw < n_all;
        if (has_next) { CONV_MAKE(nxt, it + ngw); conv_load(nxt, rn, lane); }
        asm volatile("" ::: "memory");
        conv_finish(cur, rc, scr, lane);
        cur = nxt;
    }
#undef CONV_MAKE
}
__device__ __forceinline__ void reduce_colsums(Frame& F, int which) {
    const int lane = lane_id();
    const float* ps = F.PSB; const float* pb = F.PSB + (size_t)32 * NCOLP;
    for (int n = F.gw * 64 + lane; n < NCOLP; n += F.NGW * 64) {
        const bool is_in = n < INW; if (is_in ? !(which & 1) : !(which & 2)) continue;
        float a = 0.f, c = 0.f;
#pragma unroll 8
        for (int kb = 0; kb < 32; ++kb) { a += ps[(size_t)kb * NCOLP + n]; c += pb[(size_t)kb * NCOLP + n]; }
        if (is_in) { F.VEC[VEC_CS_IN + n] = a; F.VEC[VEC_BW_IN + n] = c; } else { F.VEC[VEC_CS_FF1 + n - INW] = a; F.VEC[VEC_BW_FF1 + n - INW] = c; }
    }
}
__device__ __forceinline__ void phase_finalize_stats(Frame& F) {
    const int lane = lane_id();
    for (int m = F.gw * 64 + lane; m < NTOK; m += F.NGW * 64) {
        const f32x4* p = (const f32x4*)(F.PART + (size_t)m * 32); float s = 0.f, q = 0.f;
#pragma unroll
        for (int i = 0; i < 16; ++i) { const f32x4 v = p[i]; s += v.x + v.z; q += v.y + v.w; }
        const float mean = s * (1.f / DM); const float var = fmaxf(q * (1.f / DM) - mean * mean, 0.f);
        F.STAT[m] = (pg8::f32x2){mean, 1.f / sqrtf(var + EPS)};
    }
}
struct StatRegs { f32x4 v[8]; };
__device__ __forceinline__ void stats_load(Frame& F, int pm, StatRegs& r) {
    const int tid = F.wave * 64 + lane_id(); const int row = pm * 256 + (tid >> 1), half = tid & 1;
    const f32x4* p = (const f32x4*)(F.PART + (size_t)row * 32 + half * 16);
#pragma unroll
    for (int i = 0; i < 8; ++i) r.v[i] = p[i];
}
__device__ __forceinline__ void stats_finish(Frame& F, int pm, const StatRegs& r) {
    const int tid = F.wave * 64 + lane_id(); const int row = pm * 256 + (tid >> 1), half = tid & 1;
    float s = 0.f, q = 0.f;
#pragma unroll
    for (int i = 0; i < 8; ++i) { const f32x4 v = r.v[i]; s += v.x + v.z; q += v.y + v.w; }
    s += xshfl<1>(s); q += xshfl<1>(q);
    const float mean = s * (1.f / DM); const float var = fmaxf(q * (1.f / DM) - mean * mean, 0.f);
    if (half == 0) F.STAT[row] = (pg8::f32x2){mean, 1.f / sqrtf(var + EPS)};
}
__device__ __forceinline__ void stats_panel(Frame& F, int pm) { StatRegs r; stats_load(F, pm, r); stats_finish(F, pm, r); }
#define STATS_PREAMBLE(S) do { pg8::Unit u_; int i_ = 0, last_ = -1; bool more_ = (S).next(0, u_); \
        while (more_) { int p0_ = -1, p1_ = -1, p2_ = -1; \
            while (more_ && p2_ < 0) { if (u_.pm != last_) { last_ = u_.pm; if (p0_ < 0) p0_ = u_.pm; else if (p1_ < 0) p1_ = u_.pm; else p2_ = u_.pm; } ++i_; more_ = (S).next(i_, u_); } \
            if (p0_ >= 0) { if (p1_ < 0) p1_ = p0_; if (p2_ < 0) p2_ = p0_;              \
                StatRegs r0_, r1_, r2_; stats_load(F, p0_, r0_); stats_load(F, p1_, r1_); stats_load(F, p2_, r2_); \
                asm volatile("" ::: "memory"); \
                stats_finish(F, p0_, r0_); stats_finish(F, p1_, r1_); stats_finish(F, p2_, r2_); } } \
        asm volatile("s_waitcnt vmcnt(0)" ::: "memory"); __syncthreads(); } while (0)

struct RatRegs { f32x4 s0, s1, s2, s3, l0, l1; };
__device__ __forceinline__ void rat_load(Frame& F, int pm, RatRegs& r) {
    const int row = pm * 256 + (F.wave & 3) * 64 + lane_id();
    const f32x4* sp = (const f32x4*)(F.SSQ + (size_t)row * 16); r.s0 = sp[0]; r.s1 = sp[1]; r.s2 = sp[2]; r.s3 = sp[3];
    const f32x4* lp = (const f32x4*)(F.LSE + (size_t)row * 8); r.l0 = lp[0]; r.l1 = lp[1];
}
__device__ __forceinline__ void softmax3(float a0, float a1, float a2, float& p0, float& p1, float& p2) {
    const float mx = fmaxf(a0, fmaxf(a1, a2)); const float e0 = __expf(a0 - mx), e1 = __expf(a1 - mx), e2 = __expf(a2 - mx); const float inv = 1.0f / (e0 + e1 + e2); p0 = e0 * inv; p1 = e1 * inv; p2 = e2 * inv;
}
__device__ __forceinline__ void rat_finish(Frame& F, int pm, const RatRegs& r) {
    const int row = pm * 256 + (F.wave & 3) * 64 + lane_id();
    const f32x4 s0 = r.s0, s1 = r.s1, s2 = r.s2, s3 = r.s3, l0 = r.l0, l1 = r.l1;
    float al0, al1, al2, al3, al4, al5;
    softmax3(l0.x, l0.z, l1.x, al0, al2, al4); softmax3(l0.y, l0.w, l1.y, al1, al3, al5);
    const float wB = ((al0 * al0 * s1.x + al1 * al1 * s1.y) + (al2 * al2 * s1.z + al3 * al3 * s1.w)) + (al4 * al4 * s2.x + al5 * al5 * s2.y);
    const float rA = 1.0f / sqrtf(((s0.x + s0.y) + (s0.z + s0.w)) * (1.0f / 512.f) + EPS), rB = 1.0f / sqrtf(wB * (1.0f / 768.f) + EPS);
    const float rC = 1.0f / sqrtf(((s2.z + s2.w) + (s3.x + s3.y) + (s3.z + s3.w)) * (1.0f / 768.f) + EPS);
    const float g0 = rA, g1 = fmaxf(al0, 1e-20f) * rB, g2 = fmaxf(al1, 1e-20f) * rB, g3 = fmaxf(al2, 1e-20f) * rB, g4 = fmaxf(al3, 1e-20f) * rB, g5 = fmaxf(al4, 1e-20f) * rB, g6 = fmaxf(al5, 1e-20f) * rB, g7 = rC;
    f32x4* op = (f32x4*)(F.RAT + (size_t)row * 8);
    op[0] = (f32x4){g0 / g1, g1 / g2, g2 / g3, g3 / g4}; op[1] = (f32x4){g4 / g5, g5 / g6, g6 / g7, g7};
}
#define RAT_PREAMBLE(S) do { const int h_ = F.wave >> 2; \
        for (int i0_ = 0; ; i0_ += 6) { pg8::Unit u0_, u1_, u2_, ud_; const bool k0_ = (S).next(i0_ + h_, u0_), k1_ = (S).next(i0_ + 2 + h_, u1_), k2_ = (S).next(i0_ + 4 + h_, u2_); \
            if (k0_) { const int q0_ = u0_.pm, q1_ = k1_ ? u1_.pm : q0_, q2_ = k2_ ? u2_.pm : q0_;     \
                RatRegs r0_, r1_, r2_; rat_load(F, q0_, r0_); rat_load(F, q1_, r1_); rat_load(F, q2_, r2_); \
                asm volatile("" ::: "memory"); \
                rat_finish(F, q0_, r0_); rat_finish(F, q1_, r1_); rat_finish(F, q2_, r2_); } \
            if (!(S).next(i0_ + 6, ud_)) break; } \
        asm volatile("s_waitcnt vmcnt(0)" ::: "memory"); __syncthreads(); } while (0)

__device__ __forceinline__ void sincos_d(double a, float& c, float& s) {
    const double k = __builtin_rint(a * 0.6366197723675814);
    const double r = __builtin_fma(-k, 1.5707963267948966, a) - k * 6.123233995736766e-17;
    const double r2 = r * r;
    double sp = -1.0 / 1307674368000.0;
    sp = sp * r2 + 1.0 / 6227020800.0; sp = sp * r2 - 1.0 / 39916800.0; sp = sp * r2 + 1.0 / 362880.0; sp = sp * r2 - 1.0 / 5040.0; sp = sp * r2 + 1.0 / 120.0; sp = sp * r2 - 1.0 / 6.0; sp = sp * r2 + 1.0;
    sp *= r;
    double cp = 1.0 / 20922789888000.0;
    cp = cp * r2 - 1.0 / 87178291200.0; cp = cp * r2 + 1.0 / 479001600.0; cp = cp * r2 - 1.0 / 3628800.0; cp = cp * r2 + 1.0 / 40320.0; cp = cp * r2 - 1.0 / 720.0; cp = cp * r2 + 1.0 / 24.0; cp = cp * r2 - 0.5; cp = cp * r2 + 1.0;
    const int q = ((int)k) & 3;
    const double ss = (q == 0) ? sp : (q == 1) ? cp : (q == 2) ? -sp : -cp;
    const double cc = (q == 0) ? cp : (q == 1) ? -sp : (q == 2) ? -cp : sp;
    c = (float)cc; s = (float)ss;
}

__device__ __forceinline__ void phase_prologue(Frame& F) {
    const int lane = lane_id();
    const int gt = F.gw * 64 + lane, NGT = F.NGW * 64;
    for (int e = gt; e < SEQ * 64 + 64 * 32; e += NGT) {
        int t, i; double inv = 1.0; float* dst;
        if (e < SEQ * 64) { t = e >> 6; i = e & 63; dst = F.ROPE_B + 2 * (size_t)e; for (int j = 0; j < i; ++j) inv *= 0.8659643233600653; }
        else { const int e2 = e - SEQ * 64; t = e2 >> 5; i = e2 & 31; dst = F.ROPE_A + 2 * (size_t)e2; for (int j = 0; j < 2 * i; ++j) inv *= 0.8659643233600653; }
        float c, s; sincos_d((double)t * inv, c, s);
        dst[0] = c; dst[1] = s;
    }
    { f32x4 xn[8];
#define PRO_LOAD(m_) do { const float* src_ = ((m_) < NTOK_P) ? F.x_prompt + (size_t)(m_) * DM : F.x_sample + (size_t)((m_) - NTOK_P) * DM; \
        _Pragma("unroll") for (int j = 0; j < 8; ++j) xn[j] = __builtin_nontemporal_load((const f32x4*)src_ + lane + 64 * j); } while (0)
      if (F.gw < NTOK) PRO_LOAD(F.gw);
      for (int m = F.gw; m < NTOK; m += F.NGW) {
        f32x4 xc[8];
#pragma unroll
        for (int j = 0; j < 8; ++j) xc[j] = xn[j];
        if (m + F.NGW < NTOK) PRO_LOAD(m + F.NGW);
        asm volatile("" ::: "memory");
        GAS unsigned long long* o8 = (GAS unsigned long long*)(F.XB + (size_t)m * DM) + lane;
#pragma unroll
        for (int j = 0; j < 8; ++j) o8[64 * j] = (unsigned long long)pk2(xc[j].x, xc[j].y) | ((unsigned long long)pk2(xc[j].z, xc[j].w) << 32);
        if (lane == 0) F.STAT[m] = (pg8::f32x2){0.f, 1.f};
      }
#undef PRO_LOAD
    }
    for (int e = gt; e < DM; e += NGT) { F.VEC[VEC_ONES + e] = 1.f; F.VEC[VEC_ZEROS + e] = 0.f; }
    if (F.gw < NLAYER) {
        const float* gq = F.a_q_gain + F.gw * HD; const float* gk = F.a_k_gain + F.gw * HD;
        const float mq = wave_max(fmaxf(fabsf(gq[2 * lane]), fabsf(gq[2 * lane + 1]))), mk = wave_max(fmaxf(fabsf(gk[2 * lane]), fabsf(gk[2 * lane + 1])));
        if (lane == 0) F.VEC[VEC_M0 + F.gw] = 128.f * mq * mk * 1.05f; }
    for (int e = gt; e < 2 * INW; e += NGT) F.VEC[VEC_CS_IN + e] = 0.f;
    convert_weights(F, 0, 0, 1, F.gw, F.NGW);
}

__device__ __forceinline__ void phase_prep(Frame& F, int l) {
    const int lane = lane_id();
    const float* gq = F.a_q_gain + l * HD; const float* gk = F.a_k_gain + l * HD;
    const long NIT = (long)NTOK * 18 * 8;
    for (long ti = (long)F.gw * 64 + lane; ti < NIT; ti += (long)F.NGW * 64) {
        const int c = (int)(ti & 7); const int th = (int)(ti >> 3); const int m = th / 18, hs = th - m * 18; const int t = m & (SEQ - 1);
        int col, lo_off, hi_off; const float* tab; const float* gain = nullptr;
        if (hs < 6) {
            col = (hs < 4) ? COL_AQ + hs * HD : COL_AK + (hs - 4) * HD; gain = (hs < 4) ? gq : gk;
            const int cc = c & 3, half = c >> 2; lo_off = half * 64 + cc * 8; hi_off = lo_off + 32;
            const int pos = half ? (t & 63) : (t >> 6); tab = F.ROPE_A + 2 * (size_t)(pos * 32 + cc * 8);
        } else {
            col = (hs < 12) ? COL_BQ + (hs - 6) * HD : COL_BK + (hs - 12) * HD;
            lo_off = c * 8; hi_off = 64 + c * 8; tab = F.ROPE_B + 2 * (size_t)(t * 64 + c * 8);
        }
        bf16* p = F.PROJ + (size_t)m * INW + col;
        const v4u lo4 = *(const v4u*)(p + lo_off), hi4 = *(const v4u*)(p + hi_off);
        float lo[8], hv[8];
        lo[0] = bflo(lo4.x); lo[1] = bfhi(lo4.x); lo[2] = bflo(lo4.y); lo[3] = bfhi(lo4.y); lo[4] = bflo(lo4.z); lo[5] = bfhi(lo4.z); lo[6] = bflo(lo4.w); lo[7] = bfhi(lo4.w);
        hv[0] = bflo(hi4.x); hv[1] = bfhi(hi4.x); hv[2] = bflo(hi4.y); hv[3] = bfhi(hi4.y); hv[4] = bflo(hi4.z); hv[5] = bfhi(hi4.z); hv[6] = bflo(hi4.w); hv[7] = bfhi(hi4.w);
        float ss = 0.f;
#pragma unroll
        for (int j = 0; j < 8; ++j) ss += lo[j] * lo[j] + hv[j] * hv[j];
        ss += xshfl<1>(ss); ss += xshfl<2>(ss); ss += xshfl<4>(ss);
        if (hs < 6) { const float rs = 1.0f / sqrtf(ss * (1.0f / HD) + EPS);
#pragma unroll
            for (int j = 0; j < 8; ++j) { lo[j] = lo[j] * rs * gain[lo_off + j]; hv[j] = hv[j] * rs * gain[hi_off + j]; } }
        float ol[8], oh[8];
#pragma unroll
        for (int j = 0; j < 8; ++j) { const float cs = tab[2 * j], sn = tab[2 * j + 1]; ol[j] = lo[j] * cs - hv[j] * sn; oh[j] = hv[j] * cs + lo[j] * sn; }
        v4u w; w.x = pk2(ol[0], ol[1]); w.y = pk2(ol[2], ol[3]); w.z = pk2(ol[4], ol[5]); w.w = pk2(ol[6], ol[7]); *(v4u*)(p + lo_off) = w;
        w.x = pk2(oh[0], oh[1]); w.y = pk2(oh[2], oh[3]); w.z = pk2(oh[4], oh[5]); w.w = pk2(oh[6], oh[7]); *(v4u*)(p + hi_off) = w;
    }
}

#ifndef MK_RING3_A
#define MK_RING3_A 0
#endif
struct CfgA {
    static constexpr int NT = SEQ / 64; static constexpr bool HAS_LSE = false;
    float negm0C;
    const bf16* proj; bf16* obuf; unsigned qbase, kvbase, obase; int kcol, vcol;
    __device__ __forceinline__ unsigned q_off(int row) const { return qbase + (unsigned)row * INW; }
    __device__ __forceinline__ unsigned kv_off(int t, int row) const { return kvbase + (unsigned)(t * 64 + row) * INW; }
    __device__ __forceinline__ bool active(int, int) const { return true; }
    __device__ __forceinline__ void mask(att::f32x16&, att::f32x16&, int, int, int, int) const {}
    __device__ __forceinline__ unsigned o_off(int row) const { return obase + (unsigned)row * DM; }
    __device__ __forceinline__ void store_lse(int, float) const {}
};
__device__ __forceinline__ CfgA make_cfgA(Frame& F, int u, float negm0C) {
    const int x = F.vcu / (F.G / 8), j = F.vcu % (F.G / 8);
    int combo, hq2, qb;
    if (F.G == 256) { const int i = u / 256; combo = i * 8 + x; hq2 = j >> 4; qb = j & 15; } else { combo = u / 32; hq2 = (u >> 4) & 1; qb = u & 15; }
    const int s = combo >> 1, kvh = combo & 1, hq = kvh * 2 + hq2;
    const unsigned row0 = (unsigned)s * SEQ;
    CfgA cfg; cfg.negm0C = negm0C; cfg.proj = F.PROJ; cfg.obuf = F.O; cfg.qbase = (row0 + (unsigned)qb * 256) * INW + COL_AQ + hq * HD; cfg.kvbase = row0 * INW; cfg.kcol = COL_AK + kvh * HD; cfg.vcol = COL_AV + kvh * HD;
    cfg.obase = (row0 + (unsigned)qb * 256) * DM + OCOL_A + hq * HD;
    return cfg;
}
template <bool BOUNDED> __device__ __forceinline__ void phase_attn_A_(Frame& F, char* lds, float negm0C) {
    att::Pre pre; bool have = false;
    for (int u = F.vcu; u < NSEQ * 4 * 16; u += F.G) {
        const CfgA cfg = make_cfgA(F, u, negm0C); const bool hn = u + F.G < NSEQ * 4 * 16; const CfgA nx = make_cfgA(F, hn ? u + F.G : u, negm0C);
        if (MK_RING3_A) att::attn_unit3<CfgA, BOUNDED>(cfg, lds, F.wave, pre, have, &nx); else att::attn_unit<CfgA, 2, BOUNDED>(cfg, lds, F.wave, pre, have, &nx);
        have = MK_PREFETCH_UNIT != 0;
    }
}
__device__ __forceinline__ void phase_attn_A(Frame& F, int l, char* lds) {
    const float m0 = F.VEC[VEC_M0 + l];
    if (MK_BOUNDED_A && m0 * ATT_SCALE <= 40.f) phase_attn_A_<true>(F, lds, -m0 * ATT_SCALE * 1.4426950408889634f); else phase_attn_A_<false>(F, lds, 0.f);
}

#ifndef MK_WAVE_BC
#define MK_WAVE_BC 0
#endif
#ifndef MK_C16
#define MK_C16 1
#endif
#if MK_C16
#define MK_CFG_C CfgC16
#define MK_UNIT_C att::attn_unit_h<CfgC16, 2>
#else
#define MK_CFG_C CfgC
#define MK_UNIT_C ATT_UNIT_BC(CfgC)
#endif
#ifndef MK_PIPE_BC
#define MK_PIPE_BC 1
#endif
#if MK_WAVE_BC
#define ATT_UNIT_BC(C) att::attn_unit_wave<C>
#elif MK_PIPE_BC
#define ATT_UNIT_BC(C) att::attn_unit<C, 1>
#else
#define ATT_UNIT_BC(C) att::attn_unit_simple<C>
#endif
struct CfgB {
    static constexpr int NT = 6; static constexpr bool HAS_LSE = true;
    static constexpr float negm0C = 0.f;
    const bf16* proj; bf16* obuf; float* lse; unsigned tok0; int sh, s0, L, hb; int kcol, vcol;
    __device__ __forceinline__ unsigned q_off(int row) const { return (tok0 + ((unsigned)(s0 + row) << sh)) * INW + COL_BQ + hb * HD; }
    __device__ __forceinline__ unsigned kv_off(int t, int row) const { int pos = s0 - 64 + 64 * t + row; pos = min(max(pos, 0), L - 1); return (tok0 + ((unsigned)pos << sh)) * INW; }
    __device__ __forceinline__ bool active(int t, int wid) const { return (t >= (wid >> 1)) && (t <= (wid >> 1) + 2) && (t >= t_begin()) && (t < t_end()); }
    __device__ __forceinline__ int t_begin() const { return s0 == 0 ? 1 : 0; }
    __device__ __forceinline__ int t_end() const { return s0 + 256 == L ? 5 : 6; }
    __device__ __forceinline__ void mask(att::f32x16& p0, att::f32x16& p1, int t, int wid, int r32, int hi) const {
        if (t == (wid >> 1) + 1) return;
        const int d0 = 64 * t - 64 - 32 * wid - r32 + 4 * hi;
#pragma unroll
        for (int r = 0; r < 16; ++r) { const int d = d0 + (r & 3) + 8 * (r >> 2);
            if (d < -64 || d > 64) p0[r] = -__builtin_inff();
            if (d + 32 < -64 || d + 32 > 64) p1[r] = -__builtin_inff(); }
    }
    __device__ __forceinline__ unsigned o_off(int row) const { return (tok0 + ((unsigned)(s0 + row) << sh)) * DM + OCOL_B + hb * HD; }
    __device__ __forceinline__ void store_lse(int row, float v) const { lse[(size_t)(tok0 + ((unsigned)(s0 + row) << sh)) * 8 + hb] = v; }
};
struct CfgC {
    static constexpr int NT = 12; static constexpr bool HAS_LSE = false;
    static constexpr float negm0C = 0.f;
    const bf16* proj; bf16* obuf; const float* bias;
    unsigned tokq; unsigned tokk; int R0, kr0, hc; int kcol, vcol;
    __device__ __forceinline__ unsigned q_off(int row) const { return (tokq + (unsigned)row) * INW + COL_CQ + hc * HD; }
    __device__ __forceinline__ unsigned kv_off(int t, int row) const { return (tokk + (unsigned)(t * 64 + row)) * INW; }
    __device__ __forceinline__ bool active(int t, int wid) const { const int r = R0 + (wid >> 1), r0 = min(max(r - 4, 0), 56), kr = kr0 + t; return kr >= r0 && kr < r0 + 8; }
    __device__ __forceinline__ int t_begin() const { return min(max(R0 - 4, 0), 56) - kr0; }
    __device__ __forceinline__ int t_end() const { return min(max(R0 - 1, 0), 56) + 8 - kr0; }
    __device__ __forceinline__ void mask(att::f32x16& p0, att::f32x16& p1, int t, int wid, int r32, int hi) const {
        const int r = R0 + (wid >> 1), kr = kr0 + t, qc = (wid & 1) * 32 + r32, sc = min(max(qc - 8, 0), 48);
        const int w0 = 4 * hi - sc;
        const float* bp = bias + (kr - r + 7) * 31 + (sc - qc + 15) + w0;
#pragma unroll
        for (int rr = 0; rr < 16; ++rr) { const int c = (rr & 3) + 8 * (rr >> 2);
            p0[rr] = ((unsigned)(w0 + c) < 16u) ? p0[rr] + bp[c] : -__builtin_inff();
            p1[rr] = ((unsigned)(w0 + c + 32) < 16u) ? p1[rr] + bp[c + 32] : -__builtin_inff(); }
    }
    __device__ __forceinline__ unsigned o_off(int row) const { return (tokq + (unsigned)row) * DM + OCOL_C + hc * HD; }
    __device__ __forceinline__ void store_lse(int, float) const {}
};
struct CfgC16 {
    static constexpr int NT = 12; static constexpr bool HAS_LSE = false; static constexpr float negm0C = 0.f;
    const bf16* proj; bf16* obuf; const float* bias;
    unsigned tokq; unsigned tokk; int R0, kr0, hc; int kcol, vcol;
    __device__ __forceinline__ int qtok(int idx) const { const int w = idx >> 5, rl = idx & 31; return (2 * (w >> 2) + (rl >> 4)) * 64 + 16 * (w & 3) + (rl & 15); }
    __device__ __forceinline__ unsigned q_off(int idx) const { return (tokq + (unsigned)qtok(idx)) * INW + COL_CQ + hc * HD; }
    __device__ __forceinline__ unsigned kv_off(int t, int row) const { return (tokk + (unsigned)(t * 64 + row)) * INW; }
    __device__ __forceinline__ int kwin(int wid) const { return min(max(16 * (wid & 3) - 8, 0), 32); }
    __device__ __forceinline__ bool active(int t, int wid) const { const int r = R0 + 2 * (wid >> 2), lo = min(max(r - 4, 0), 56), hi_ = min(max(r - 3, 0), 56) + 8, kr = kr0 + t; return kr >= lo && kr < hi_; }
    __device__ __forceinline__ void mask16(att::f32x16& p0, int t, int wid, int r32, int hi) const {
        const int r = R0 + 2 * (wid >> 2) + (r32 >> 4), kr = kr0 + t, qc = 16 * (wid & 3) + (r32 & 15), sc = min(max(qc - 8, 0), 48), r0 = min(max(r - 4, 0), 56);
        const bool rowok = (unsigned)(kr - r0) < 8u;
        const int w0 = kwin(wid) + 4 * hi - sc;
        const float* bp = bias + (kr - r + 7) * 31 + (sc - qc + 15) + w0;
#pragma unroll
        for (int rr = 0; rr < 16; ++rr) { const int cofs = (rr & 3) + 8 * (rr >> 2);
            p0[rr] = (rowok && (unsigned)(w0 + cofs) < 16u) ? p0[rr] + bp[cofs] : -__builtin_inff(); }
    }
    __device__ __forceinline__ unsigned o_off(int idx) const { return (tokq + (unsigned)qtok(idx)) * DM + OCOL_C + hc * HD; }
    __device__ __forceinline__ void store_lse(int, float) const {}
};
constexpr int ATT_BIAS_OFF = 106496;
constexpr int ATT_BIAS_OFF_OLD = 69632;
static_assert(att::OSTAGE_OFF >= (int)att::SHM_ATTN && att::OSTAGE_OFF + 8 * 4096 <= ATT_BIAS_OFF && ATT_BIAS_OFF + 6 * 15 * 31 * 4 + 512 <= RING_BYTES, "O stage / bias table placement");
__device__ __forceinline__ CfgB make_cfgB(Frame& F, int u) {
    const int s = u / 96, rem = u - s * 96, hb = rem >> 4, k = rem & 15;
    const int g = hb >> 1, sh = 2 * g, L = SEQ >> sh, nblk = L >> 8;
    const int r = k / nblk, blk = k - r * nblk;
    CfgB cfg; cfg.proj = F.PROJ; cfg.obuf = F.O; cfg.lse = F.LSE; cfg.tok0 = (unsigned)s * SEQ + r; cfg.sh = sh; cfg.s0 = blk * 256; cfg.L = L; cfg.hb = hb;
    cfg.kcol = COL_BK + hb * HD; cfg.vcol = COL_BV + hb * HD;
    return cfg;
}
__device__ __forceinline__ void phase_attn_B(Frame& F, char* lds) {
    att::Pre pre; bool have = false;
    for (int u = F.vcu; u < 1152; u += F.G) {
        const CfgB cfg = make_cfgB(F, u); const bool hn = u + F.G < 1152; const CfgB nx = make_cfgB(F, hn ? u + F.G : u);
        att::attn_unit<CfgB, 1>(cfg, lds, F.wave, pre, have, &nx); have = MK_PREFETCH_UNIT != 0;
    }
}
__device__ __forceinline__ CfgC16 make_cfgC(Frame& F, int v, const float* bl) {
    const int s = v / 96, rem = v - s * 96, hc = rem >> 4, blk = rem & 15;
    const int R0 = blk * 4, kr0 = min(max(R0 - 4, 0), 52);
    CfgC16 cfg; cfg.proj = F.PROJ; cfg.obuf = F.O; cfg.bias = bl; cfg.tokq = (unsigned)s * SEQ + R0 * 64; cfg.tokk = (unsigned)s * SEQ + kr0 * 64; cfg.R0 = R0; cfg.kr0 = kr0; cfg.hc = hc;
    cfg.kcol = COL_CK + hc * HD; cfg.vcol = COL_CV + hc * HD;
    return cfg;
}
__device__ __forceinline__ void phase_attn_C(Frame& F, int l, char* lds) {
    att::Pre pre; bool have = false; float* bl = (float*)(lds + ATT_BIAS_OFF);
    { const float* rel = F.c_rel_bias + (size_t)l * 6 * (15 * 31);
      for (int e = F.wave * 64 + lane_id(); e < 6 * 15 * 31; e += NWAVES * 64) bl[e] = rel[e] * (1.0f / ATT_SCALE);
      __syncthreads(); }
    for (int v = F.G - 1 - F.vcu; v < 1152; v += F.G) {
        CfgC16 cfg = make_cfgC(F, v, bl); cfg.bias = bl + cfg.hc * (15 * 31); const bool hn = v + F.G < 1152; const CfgC16 nx = make_cfgC(F, hn ? v + F.G : v, bl);
        att::attn_unit_h<CfgC16, 2>(cfg, lds, F.wave, pre, have, &nx); have = MK_PREFETCH_UNIT != 0;
    }
}

#ifndef MK_DYN_BC
#define MK_DYN_BC 0
#endif
__device__ __forceinline__ void phase_attn_BC_dyn(Frame& F, int l, char* lds) {
    att::Pre pre; float* bl = (float*)(lds + ATT_BIAS_OFF);
    { const float* rel = F.c_rel_bias + (size_t)l * 6 * (15 * 31);
      for (int e = F.wave * 64 + lane_id(); e < 6 * 15 * 31; e += NWAVES * 64) bl[e] = rel[e] * (1.0f / ATT_SCALE); }
    gu32* head = F.ctl + CW_ATTQ + 64 * l;
    volatile LAS unsigned* slot = F.MISC + 16;
    const bool t0 = (F.wave == 0) && (lane_id() == 0);
    unsigned nq = 0u;
    if (t0) nq = __hip_atomic_fetch_add(head, 1u, RLX_AGENT);
    for (;;) {
        if (t0) *slot = nq;
        __syncthreads();
        const unsigned q = *slot;
        __syncthreads();
        if (q >= 2304u) break;
        if (t0) nq = __hip_atomic_fetch_add(head, 1u, RLX_AGENT);
        if (q < 1152u) {
            CfgC16 cfg = make_cfgC(F, (int)q, bl); cfg.bias = bl + cfg.hc * (15 * 31);
            att::attn_unit_h<CfgC16, 2>(cfg, lds, F.wave, pre, false, &cfg);
        } else {
            const CfgB cfg = make_cfgB(F, (int)q - 1152);
            att::attn_unit<CfgB, 1>(cfg, lds, F.wave, pre, false, &cfg);
        }
    }
}

__device__ __forceinline__ float dot8(v4u a, v4u b) {
    return bflo(a.x) * bflo(b.x) + bfhi(a.x) * bfhi(b.x) + bflo(a.y) * bflo(b.y) + bfhi(a.y) * bfhi(b.y) + bflo(a.z) * bflo(b.z) + bfhi(a.z) * bfhi(b.z) + bflo(a.w) * bflo(b.w) + bfhi(a.w) * bfhi(b.w);
}
__device__ __forceinline__ void naive_B(Frame& F, int m, int hb) {
    const int lane = lane_id(); const int t = m & (SEQ - 1); const size_t sbase = (size_t)(m - t);
    const int g = hb >> 1, sh = 2 * g, dil = 1 << sh, i = t >> sh, r = t & (dil - 1), L = SEQ >> sh;
    const bf16* qp = F.PROJ + (size_t)m * INW + COL_BQ + hb * HD;
    const bf16* kb = F.PROJ + sbase * INW + COL_BK + hb * HD; const bf16* vb = F.PROJ + sbase * INW + COL_BV + hb * HD;
    float dot[3] = {0.f, 0.f, 0.f}; bool valid[3]; const bf16* kp[3];
#pragma unroll
    for (int j3 = 0; j3 < 3; ++j3) { const int jj = lane + 64 * j3, ik = i - 64 + jj; valid[j3] = (jj <= 128) && (ik >= 0) && (ik < L);
        const int ikc = valid[j3] ? ik : i; kp[j3] = kb + (size_t)(ikc * dil + r) * INW; }
#pragma unroll
    for (int ch = 0; ch < 16; ++ch) { const v4u qv = *(const v4u*)(qp + ch * 8);
#pragma unroll
        for (int j3 = 0; j3 < 3; ++j3) { const v4u kv = *(const v4u*)(kp[j3] + ch * 8); dot[j3] += dot8(qv, kv); } }
    float s[3];
#pragma unroll
    for (int j3 = 0; j3 < 3; ++j3) s[j3] = valid[j3] ? dot[j3] * ATT_SCALE : -__builtin_inff();
    const float mx = wave_max(fmaxf(s[0], fmaxf(s[1], s[2])));
    float p[3];
#pragma unroll
    for (int j3 = 0; j3 < 3; ++j3) p[j3] = valid[j3] ? __expf(s[j3] - mx) : 0.f;
    const float lsum = wave_sum(p[0] + p[1] + p[2]);
    float a0 = 0.f, a1 = 0.f;
#pragma unroll
    for (int j3 = 0; j3 < 3; ++j3) {
        const int nj = (j3 == 2) ? 1 : 64;
        for (int jl = 0; jl < nj; ++jl) { const float pj = __shfl(p[j3], jl); const int ik = i - 64 + jl + 64 * j3;
            if (ik >= 0 && ik < L) { const unsigned w = *(const unsigned*)(vb + (size_t)(ik * dil + r) * INW + 2 * lane); a0 += pj * bflo(w); a1 += pj * bfhi(w); } } }
    const float rl = 1.0f / lsum;
    *(unsigned*)(F.O + (size_t)m * DM + OCOL_B + hb * HD + 2 * lane) = pk2(a0 * rl, a1 * rl);
    if (lane == 0) F.LSE[(size_t)m * 8 + hb] = mx + __logf(lsum);
}
__device__ __forceinline__ void naive_C(Frame& F, int l, int m, int hc) {
    const int lane = lane_id(); const int t = m & (SEQ - 1); const size_t sbase = (size_t)(m - t);
    const int r = t >> 6, c = t & 63; const int r0 = min(max(r - 4, 0), 56), sc = min(max(c - 8, 0), 48);
    const bf16* qp = F.PROJ + (size_t)m * INW + COL_CQ + hc * HD;
    const bf16* kb = F.PROJ + sbase * INW + COL_CK + hc * HD; const bf16* vb = F.PROJ + sbase * INW + COL_CV + hc * HD;
    const float* rel = F.c_rel_bias + ((size_t)l * 6 + hc) * (15 * 31);
    float dot[2] = {0.f, 0.f}; const bf16* kp[2]; float bias[2];
#pragma unroll
    for (int j2 = 0; j2 < 2; ++j2) { const int kk = lane + 64 * j2, jr = kk >> 4, jc = kk & 15; kp[j2] = kb + (size_t)((r0 + jr) * 64 + sc + jc) * INW;
        bias[j2] = rel[(r0 + jr - r + 7) * 31 + (sc + jc - c + 15)]; }
#pragma unroll
    for (int ch = 0; ch < 16; ++ch) { const v4u qv = *(const v4u*)(qp + ch * 8);
#pragma unroll
        for (int j2 = 0; j2 < 2; ++j2) { const v4u kv = *(const v4u*)(kp[j2] + ch * 8); dot[j2] += dot8(qv, kv); } }
    const float s0 = dot[0] * ATT_SCALE + bias[0], s1 = dot[1] * ATT_SCALE + bias[1];
    const float mx = wave_max(fmaxf(s0, s1));
    const float p0 = __expf(s0 - mx), p1 = __expf(s1 - mx);
    const float lsum = wave_sum(p0 + p1);
    float a0 = 0.f, a1 = 0.f;
    for (int kk = 0; kk < 128; ++kk) { const float pj = (kk < 64) ? __shfl(p0, kk) : __shfl(p1, kk - 64); const int jr = kk >> 4, jc = kk & 15;
        const unsigned w = *(const unsigned*)(vb + (size_t)((r0 + jr) * 64 + sc + jc) * INW + 2 * lane); a0 += pj * bflo(w); a1 += pj * bfhi(w); }
    const float rl = 1.0f / lsum;
    *(unsigned*)(F.O + (size_t)m * DM + OCOL_C + hc * HD + 2 * lane) = pk2(a0 * rl, a1 * rl);
}
__device__ __forceinline__ void phase_attn_BC_naive(Frame& F, int l) {
    for (int it = F.gw; it < NTOK * 12; it += F.NGW) { const int m = it / 12, h = it - m * 12;
        if (h < 6) naive_B(F, m, h); else naive_C(F, l, m, h - 6); }
}

__device__ __forceinline__ void phase_mix(Frame& F, int l) {
    const int lane = lane_id();
    const float* gain = F.mix_gain + (size_t)l * DM;
    f32x4 gv[4][2];
#pragma unroll
    for (int j = 0; j < 4; ++j) { gv[j][0] = *(const f32x4*)(gain + 8 * lane + 512 * j); gv[j][1] = *(const f32x4*)(gain + 8 * lane + 512 * j + 4); }
    v4u wn[4]; float ln[6];
#define MIX_LOAD(m_) do { const bf16* row_ = F.O + (size_t)(m_) * DM; const float* lse_ = F.LSE + (size_t)(m_) * 8; \
        _Pragma("unroll") for (int j = 0; j < 4; ++j) wn[j] = *(const v4u*)(row_ + 8 * lane + 512 * j); \
        _Pragma("unroll") for (int h = 0; h < 6; ++h) ln[h] = lse_[h]; } while (0)
    if (F.gw < NTOK) MIX_LOAD(F.gw);
    for (int m = F.gw; m < NTOK; m += F.NGW) {
        bf16* row = F.O + (size_t)m * DM;
        v4u wc[4]; float lc[6];
#pragma unroll
        for (int j = 0; j < 4; ++j) wc[j] = wn[j];
#pragma unroll
        for (int h = 0; h < 6; ++h) lc[h] = ln[h];
        if (m + F.NGW < NTOK) MIX_LOAD(m + F.NGW);
        asm volatile("" ::: "memory");
        float al[6];
#pragma unroll
        for (int h = 0; h < 2; ++h) { const float l0 = lc[h], l1 = lc[2 + h], l2 = lc[4 + h]; const float mx = fmaxf(l0, fmaxf(l1, l2));
            const float e0 = __expf(l0 - mx), e1 = __expf(l1 - mx), e2 = __expf(l2 - mx); const float inv = 1.0f / (e0 + e1 + e2); al[h] = e0 * inv; al[2 + h] = e1 * inv; al[4 + h] = e2 * inv; }
        float v[4][8]; float ssA = 0.f, ssB = 0.f, ssC = 0.f;
#pragma unroll
        for (int j = 0; j < 4; ++j) { const int col = 8 * lane + 512 * j; const v4u w = wc[j];
            v[j][0] = bflo(w.x); v[j][1] = bfhi(w.x); v[j][2] = bflo(w.y); v[j][3] = bfhi(w.y); v[j][4] = bflo(w.z); v[j][5] = bfhi(w.z); v[j][6] = bflo(w.w); v[j][7] = bfhi(w.w);
            float a = 1.f;
            if (col >= OCOL_B && col < OCOL_C) { const int hb = (col - OCOL_B) >> 7; a = (hb == 0) ? al[0] : (hb == 1) ? al[1] : (hb == 2) ? al[2] : (hb == 3) ? al[3] : (hb == 4) ? al[4] : al[5]; }
            float ss = 0.f;
#pragma unroll
            for (int e = 0; e < 8; ++e) { v[j][e] *= a; ss += v[j][e] * v[j][e]; }
            if (col < OCOL_B) ssA += ss; else if (col < OCOL_C) ssB += ss; else ssC += ss; }
        ssA = wave_sum(ssA); ssB = wave_sum(ssB); ssC = wave_sum(ssC);
        const float rA = 1.0f / sqrtf(ssA * (1.0f / 512.f) + EPS), rB = 1.0f / sqrtf(ssB * (1.0f / 768.f) + EPS), rC = 1.0f / sqrtf(ssC * (1.0f / 768.f) + EPS);
#pragma unroll
        for (int j = 0; j < 4; ++j) { const int col = 8 * lane + 512 * j; const float rr = (col < OCOL_B) ? rA : (col < OCOL_C) ? rB : rC;
            const f32x4 g0 = gv[j][0], g1 = gv[j][1];
            v4u w; w.x = pk2(v[j][0] * rr * g0.x, v[j][1] * rr * g0.y); w.y = pk2(v[j][2] * rr * g0.z, v[j][3] * rr * g0.w);
            w.z = pk2(v[j][4] * rr * g1.x, v[j][5] * rr * g1.y); w.w = pk2(v[j][6] * rr * g1.z, v[j][7] * rr * g1.w);
            *(v4u*)(row + col) = w; }
    }
#undef MIX_LOAD
}

__device__ __forceinline__ void fin_rows(const bf16* XB, const pg8::f32x2* PART, float* X, const float* g, const float* b, int m0, int mstride, int mend) {
    static_assert(MK_BF16_RES && !MK_FIN_PHASES, "the final LayerNorm reads the bf16 residual stream and the raw row partials");
    const int lane = lane_id();
    f32x4 gg[8], bb[8];
#pragma unroll
    for (int j = 0; j < 8; ++j) { gg[j] = *((const f32x4*)g + lane + 64 * j); bb[j] = *((const f32x4*)b + lane + 64 * j); }
    unsigned long long zA[8], zB[8]; pg8::f32x2 pA, pB;
#define FLN_LOAD(Z, P, m_) do { const GAS unsigned long long* zb_ = (const GAS unsigned long long*)(XB + (size_t)(m_) * DM) + lane; \
        _Pragma("unroll") for (int j = 0; j < 8; ++j) Z[j] = zb_[64 * j]; P = (lane < 32) ? PART[(size_t)(m_) * 32 + lane] : (pg8::f32x2){0.f, 0.f}; } while (0)
#define FLN_ROW(ZC, PC, m_) do { GAS f32x4* xr = (GAS f32x4*)(X + (size_t)(m_) * DM) + lane; \
        const float s = wave_sum(PC.x), q = wave_sum(PC.y); \
        const float mean = s * (1.f / DM); const float var = fmaxf(q * (1.f / DM) - mean * mean, 0.f); const float rstd = 1.f / sqrtf(var + EPS); \
        _Pragma("unroll") for (int j = 0; j < 8; ++j) { const unsigned lo = (unsigned)ZC[j], hi = (unsigned)(ZC[j] >> 32); \
            const f32x4 z = {bflo(lo), bfhi(lo), bflo(hi), bfhi(hi)}; \
            __builtin_nontemporal_store((z - mean) * rstd * gg[j] + bb[j], (f32x4*)(xr + 64 * j)); } } while (0)
    if (m0 < mend) FLN_LOAD(zA, pA, m0);
    if (m0 + mstride < mend) FLN_LOAD(zB, pB, m0 + mstride);
    for (int m = m0; m < mend; m += 2 * mstride) {
        unsigned long long zc[8]; pg8::f32x2 pc = pA;
#pragma unroll
        for (int j = 0; j < 8; ++j) zc[j] = zA[j];
        if (m + 2 * mstride < mend) FLN_LOAD(zA, pA, m + 2 * mstride);
        asm volatile("" ::: "memory");
        FLN_ROW(zc, pc, m);
        if (m + mstride < mend) {
            pc = pB;
#pragma unroll
            for (int j = 0; j < 8; ++j) zc[j] = zB[j];
            if (m + 3 * mstride < mend) FLN_LOAD(zB, pB, m + 3 * mstride);
            asm volatile("" ::: "memory");
            FLN_ROW(zc, pc, m + mstride);
        }
    }
#undef FLN_LOAD
#undef FLN_ROW
}
__device__ __forceinline__ void phase_final_ln(Frame& F, const float* g, const float* b) { fin_rows(F.XB, F.PART, F.X, g, b, F.gw, F.NGW, NTOK); }

struct FinalOrder {
    pg8::StaticOrder s; const bf16* XB; const pg8::f32x2* PART; float* X; const float* g; const float* b; gu32* cnt; int wave;
    __device__ __forceinline__ bool next(int i, pg8::Unit& u) const { return s.next(i, u); }
    __device__ __forceinline__ void a_ready(const pg8::Unit&) const {}
    __device__ __forceinline__ void done(const pg8::Unit& u) const {
        asm volatile("s_waitcnt vmcnt(0)" ::: "memory"); __syncthreads();
        if (wave == 0 && lane_id() == 0) {
            __builtin_amdgcn_fence(__ATOMIC_RELEASE, "agent"); asm volatile("s_waitcnt vmcnt(0)" ::: "memory");
            gu32* w = cnt + 64 * u.pm; (void)__hip_atomic_fetch_add(w, 1u, RLX_AGENT);
            unsigned sp = 0u; while (__hip_atomic_load(w, RLX_AGENT) < (unsigned)(DM / 256)) { __builtin_amdgcn_s_sleep(1); if (++sp > (1u << 22)) break; }
            __builtin_amdgcn_fence(__ATOMIC_ACQUIRE, "agent"); asm volatile("s_waitcnt vmcnt(0)" ::: "memory");
        }
        __syncthreads();
        const int base = u.pm * 256 + u.pn * 32;
        fin_rows(XB, PART, X, g, b, base + wave, 8, base + 32);
    }
};
#ifndef MK_FUSE_FINAL
#define MK_FUSE_FINAL 0
#endif
constexpr int CW_FIN = 65536;

__device__ __forceinline__ void phase_prep_copy(Frame& F) {
    const int lane = lane_id();
    const long NIT = (long)NTOK * 18 * 8;
    for (long ti = (long)F.gw * 64 + lane; ti < NIT; ti += (long)F.NGW * 64) {
        const int c = (int)(ti & 7); const int th = (int)(ti >> 3); const int m = th / 18, hs = th - m * 18; const int t = m & (SEQ - 1);
        int col, lo_off, hi_off; const float* tab;
        if (hs < 6) { col = (hs < 4) ? COL_AQ + hs * HD : COL_AK + (hs - 4) * HD; const int cc = c & 3, half = c >> 2; lo_off = half * 64 + cc * 8; hi_off = lo_off + 32; const int pos = half ? (t & 63) : (t >> 6); tab = F.ROPE_A + 2 * (size_t)(pos * 32 + cc * 8); }
        else { col = (hs < 12) ? COL_BQ + (hs - 6) * HD : COL_BK + (hs - 12) * HD; lo_off = c * 8; hi_off = 64 + c * 8; tab = F.ROPE_B + 2 * (size_t)(t * 64 + c * 8); }
        bf16* p = F.PROJ + (size_t)m * INW + col;
        v4u lo4 = *(const v4u*)(p + lo_off), hi4 = *(const v4u*)(p + hi_off);
        const f32x4 t0 = *(const f32x4*)tab, t1 = *(const f32x4*)(tab + 4), t2 = *(const f32x4*)(tab + 8), t3 = *(const f32x4*)(tab + 12);
        if (t0.x + t1.x + t2.x + t3.x > 1e30f) lo4.x ^= 1u;
        *(v4u*)(p + lo_off) = lo4; *(v4u*)(p + hi_off) = hi4;
    }
}
__device__ __forceinline__ void phase_mix_copy(Frame& F) {
    const int lane = lane_id();
    for (int m = F.gw; m < NTOK; m += F.NGW) {
        bf16* row = F.O + (size_t)m * DM; const float* lse = F.LSE + (size_t)m * 8; const float l0 = lse[0] + lse[5];
        v4u w[4];
#pragma unroll
        for (int j = 0; j < 4; ++j) w[j] = *(const v4u*)(row + 8 * lane + 512 * j);
        if (l0 > 1e30f) w[0].x ^= 1u;
#pragma unroll
        for (int j = 0; j < 4; ++j) *(v4u*)(row + 8 * lane + 512 * j) = w[j];
    }
}

#ifndef MK_NAIVE_BC
#define MK_NAIVE_BC 0
#endif
#if MK_NAIVE_BC
#define ATTN_BC(F, l, lds) phase_attn_BC_naive(F, l)
#else
#define ATTN_BC(F, l, lds) do { if (MK_DYN_BC) phase_attn_BC_dyn(F, l, lds); else { phase_attn_B(F, lds); phase_attn_C(F, l, lds); } } while (0)
#endif
#ifndef MK_DUP_ENDS
#define MK_DUP_ENDS 0
#endif
#ifndef MK_HALVES
#define MK_HALVES 0
#endif
#ifndef MK_SB_EAGER
#define MK_SB_EAGER 0
#endif
#ifndef MK_DUP_ALL
#define MK_DUP_ALL 0
#endif
#ifndef MK_DUP_GEMM
#define MK_DUP_GEMM 0
#endif
#ifndef MK_STAGGER_OUT
#define MK_STAGGER_OUT 0
#endif
#ifndef MK_STAGGER_IN
#define MK_STAGGER_IN 0
#endif
#ifndef MK_DUP_RES
#define MK_DUP_RES 0
#endif
#ifndef MK_DUP_BAR
#define MK_DUP_BAR 0
#endif
#ifndef MK_XCD_EXTRA
#define MK_XCD_EXTRA -1
#endif
#ifndef MK_DUP_KLOOP
#define MK_DUP_KLOOP 0
#endif
#ifndef MK_DUP_THIN
#define MK_DUP_THIN 0
#endif
#ifndef MK_DUP_ATTN
#define MK_DUP_ATTN 0
#endif
#ifndef MK_PER_PHASE
#define MK_PER_PHASE 0
#endif
constexpr int PH_PER_LAYER = 9, N_PHASES = 2 + PH_PER_LAYER * NLAYER;
struct Args { const float* in[14]; float* out; unsigned char* ws; int ph_lo, ph_hi; };
static_assert(sizeof(Args) == 14 * 8 + 8 + 8 + 8, "Args has no padding");

__global__ void __launch_bounds__(NWAVES * 64, 2) trunk_fwd(Args args) {
    extern __shared__ __attribute__((aligned(16))) unsigned char lds[];
    Frame F;
    F.lds = (LAS unsigned char*)lds;
    F.MISC = (volatile LAS unsigned*)(F.lds + MISC_OFF);
    F.wave = __builtin_amdgcn_readfirstlane((int)threadIdx.x >> 6);
    F.G = gridDim.x; { const int bx = blockIdx.x; F.vcu = (F.G % 8 == 0) ? (bx % 8) * (F.G / 8) + bx / 8 : bx; }
    F.gw = F.vcu * NWAVES + F.wave; F.NGW = F.G * NWAVES;
    unsigned char* ws = args.ws;
    F.ctl = (gu32*)(ws + WS_CTL);
    F.x_prompt = args.in[0]; F.x_sample = args.in[1]; F.w_in = args.in[2]; F.a_q_gain = args.in[3]; F.a_k_gain = args.in[4]; F.c_rel_bias = args.in[5]; F.mix_gain = args.in[6];
    F.w_out = args.in[7]; F.ln1_g = args.in[8]; F.ln1_b = args.in[9]; F.w_ff1 = args.in[10]; F.w_ff2 = args.in[11]; F.ln2_g = args.in[12]; F.ln2_b = args.in[13];
    F.X = args.out;
    F.Win_t = (bf16*)(ws + WS_WIN); F.Wout_t = (bf16*)(ws + WS_WOUT); F.Wff1_t = (bf16*)(ws + WS_WFF1); F.Wff2_t = (bf16*)(ws + WS_WFF2);
    F.XB = (bf16*)(ws + WS_XB); F.PROJ = (bf16*)(ws + WS_PROJ); F.O = (bf16*)(ws + WS_O); F.H = (bf16*)(ws + WS_H);
    F.LSE = (float*)(ws + WS_LSE); F.ROPE_B = (float*)(ws + WS_ROPE_B); F.ROPE_A = (float*)(ws + WS_ROPE_A);
    F.PART = (pg8::f32x2*)(ws + WS_PART); F.STAT = (pg8::f32x2*)(ws + WS_STAT); F.VEC = (float*)(ws + WS_VEC); F.PSB = (float*)(ws + WS_PSB); F.SSQ = (float*)(ws + WS_SSQ); F.RAT = (float*)(ws + WS_RAT);
    for (int u = F.wave * 64 + lane_id(); u < (LDS_BYTES - LDSCTL_OFF) / 4; u += NWAVES * 64) ((LAS unsigned*)(F.lds + LDSCTL_OFF))[u] = 0u;
    __syncthreads();
    XcdBarrier bar; bar.bar = (unsigned*)(F.ctl + CW_BAR); bar.x = 0; bar.st = nullptr;
    if (!MK_PER_PHASE) bar = xcd_barrier_post((unsigned*)(F.ctl + CW_BAR), F.MISC + 8, F.wave == 0 && lane_id() == 0);
    const int lo = args.ph_lo, hi = args.ph_hi;
#define IN(k) (lo <= (k) && (k) < hi)
#define STAGGER(ticks) do { if ((ticks) > 0) { const unsigned long long t0_ = __builtin_amdgcn_s_memrealtime(); const unsigned long long dl_ = (unsigned long long)((F.vcu & 7) >> 1) * (unsigned long long)(ticks); while (__builtin_amdgcn_s_memrealtime() - t0_ < dl_) __builtin_amdgcn_s_sleep(8); } } while (0)
#define SEAM(k) do { if (IN(k) && IN((k) + 1)) { if (MK_PER_PHASE) { if (F.wave == 0 && lane_id() == 0) __hip_atomic_store(F.ctl + CW_TMO, 0xBADBA0u, RLX_AGENT); } else { xcd_barrier(bar, F.wave == 0 && lane_id() == 0); if (MK_DUP_BAR) xcd_barrier(bar, F.wave == 0 && lane_id() == 0); } } } while (0)

    if (IN(0)) { phase_prologue(F); if (MK_DUP_ENDS & 1) phase_prologue(F); } SEAM(0);
#if MK_FUSE_PREP
#define INPROJ_EPI(l) pg8::EpiInProj E{F.PROJ, INW, F.STAT, F.VEC + VEC_CS_IN, F.VEC + VEC_BW_IN, F.a_q_gain + l * HD, F.a_k_gain + l * HD, F.ROPE_A, F.ROPE_B, (LAS float*)(F.lds + XCH_OFF), \
                (MK_BOUNDED_A && F.VEC[VEC_M0 + l] * ATT_SCALE <= 40.f) ? ATT_SCALE * 1.4426950408889634f : 1.f}; \
            pg8::gemm_phase<pg8::EpiInProj, pg8::StaticOrder, true, true>(F.lds + RING_OFF, g, S, E, F.wave)
#define PREP_PHASE(l) do {} while (0)
#else
#define INPROJ_EPI(l) pg8::EpiBf16Fold<0> E{F.PROJ, INW, F.STAT, F.VEC + VEC_CS_IN, F.VEC + VEC_BW_IN}; \
            pg8::gemm_phase<pg8::EpiBf16Fold<0>, pg8::StaticOrder, true, true>(F.lds + RING_OFF, g, S, E, F.wave)
#define PREP_PHASE(l) phase_prep(F, l)
#endif
#if MK_BF16_RES
#define RES_EPI_OUT(l) pg8::EpiResLnFoldB E{F.XB, DM, F.STAT, (l == 0) ? F.VEC + VEC_ONES : F.ln2_g + (size_t)(l - 1) * DM, (l == 0) ? F.VEC + VEC_ZEROS : F.ln2_b + (size_t)(l - 1) * DM, F.PART, DN_ALPHA}; \
            pg8::gemm_phase<pg8::EpiResLnFoldB, pg8::StaticOrder, true, true, false, MK_MIXFOLD != 0>(F.lds + RING_OFF, g, S, E, F.wave)
#define RES_EPI_FF2(l) pg8::EpiResLnFoldB E{F.XB, DM, F.STAT, F.ln1_g + (size_t)l * DM, F.ln1_b + (size_t)l * DM, F.PART, DN_ALPHA}; \
            pg8::gemm_phase<pg8::EpiResLnFoldB, pg8::StaticOrder, true, true, MK_TILED_H != 0>(F.lds + RING_OFF, g, S, E, F.wave)
#else
#define RES_EPI_OUT(l) pg8::EpiResLnFold E{(l == 0) ? F.x_prompt : F.X, (l == 0) ? F.x_sample : F.X + (size_t)NTOK_P * DM, NTOK_P / 256, F.X, F.XB, DM, F.STAT, \
                                (l == 0) ? F.VEC + VEC_ONES : F.ln2_g + (size_t)(l - 1) * DM, (l == 0) ? F.VEC + VEC_ZEROS : F.ln2_b + (size_t)(l - 1) * DM, F.PART, DN_ALPHA}; \
            pg8::gemm_phase<pg8::EpiResLnFold, pg8::StaticOrder, true, true>(F.lds + RING_OFF, g, S, E, F.wave)
#define RES_EPI_FF2(l) pg8::EpiResLnFold E{F.X, F.X + (size_t)NTOK_P * DM, NTOK_P / 256, F.X, F.XB, DM, F.STAT, F.ln1_g + (size_t)l * DM, F.ln1_b + (size_t)l * DM, F.PART, DN_ALPHA}; \
            pg8::gemm_phase<pg8::EpiResLnFold, pg8::StaticOrder, true, true, MK_TILED_H != 0>(F.lds + RING_OFF, g, S, E, F.wave)
#endif
#define LAYER_BODY(l) do { \
        const int pb = 1 + PH_PER_LAYER * l; \
        if (IN(pb + 0)) { \
            STAGGER(MK_STAGGER_IN); pg8::Gemm g{F.XB, F.Win_t, NTOK, INW, DM, nullptr, 0, STG_OFF - RING_OFF}; pg8::StaticOrder S; S.init(NTOK, INW, F.G, (int)blockIdx.x); \
            if (!MK_FIN_PHASES && l > 0) STATS_PREAMBLE(S); \
            { INPROJ_EPI(l); } if (MK_DUP_ALL) { INPROJ_EPI(l); } \
            if (MK_DUP_KLOOP & 1) { pg8::EpiNull EN{F.LSE}; pg8::gemm_phase<pg8::EpiNull, pg8::StaticOrder, true, true>(F.lds + RING_OFF, g, S, EN, F.wave); } \
            for (int rep = 0; rep < 1 + MK_DUP_ALL; ++rep) if (F.G == 256 && blockIdx.x >= 128) convert_weights(F, l, 0, 2, ((int)blockIdx.x - 128) * NWAVES + F.wave, 128 * NWAVES); \
        } SEAM(pb + 0); \
        if (IN(pb + 1)) { PREP_PHASE(l); } if (!MK_FUSE_PREP) SEAM(pb + 1); \
        if (IN(pb + 2)) { phase_attn_A(F, l, (char*)lds + RING_OFF); ATTN_BC(F, l, (char*)lds + RING_OFF); if ((MK_DUP_ATTN & 1) || MK_DUP_ALL) { phase_attn_A(F, l, (char*)lds + RING_OFF); } if ((MK_DUP_ATTN & 2) || MK_DUP_ALL) { ATTN_BC(F, l, (char*)lds + RING_OFF); } \
            for (int rep = 0; rep < 1 + MK_DUP_ALL; ++rep) if (l + 1 < NLAYER && F.G == 256 && F.vcu < 128) convert_weights(F, l, l + 1, 1, F.vcu * NWAVES + F.wave, 128 * NWAVES); \
            if (MK_MIXFOLD && F.G != 256) convert_weights(F, l, l + 1, ((l + 1 < NLAYER) ? 1 : 0) | 2, F.gw, F.NGW); } SEAM(pb + 2); \
        if (!MK_MIXFOLD) { if (IN(pb + 3)) { if (MK_DUP_ALL) phase_mix_copy(F); phase_mix(F, l); if (!MK_FIN_PHASES) reduce_colsums(F, (l + 1 < NLAYER) ? 3 : 2); if (F.G != 256) convert_weights(F, l, l + 1, ((l + 1 < NLAYER) ? 1 : 0) | 2, F.gw, F.NGW); } SEAM(pb + 3); } \
        if (IN(pb + 4)) { \
            STAGGER(MK_STAGGER_OUT); pg8::Gemm g{F.O, F.Wout_t, NTOK, DM, DM, F.RAT, KTAB_OFF - RING_OFF, STG2_OFF - RING_OFF}; pg8::StaticOrder S; S.init(NTOK, DM, F.G, (int)blockIdx.x, MK_WGM_RES); \
            if (MK_MIXFOLD) { reduce_colsums(F, (l + 1 < NLAYER) ? 3 : 2); RAT_PREAMBLE(S); } \
            { RES_EPI_OUT(l); } if (MK_DUP_ALL) { pg8::EpiResCopyB EC{F.XB, DM}; pg8::gemm_phase<pg8::EpiResCopyB, pg8::StaticOrder, true, true>(F.lds + RING_OFF, g, S, EC, F.wave); } \
            if (MK_DUP_KLOOP & 2) { pg8::EpiNull EN{F.LSE}; pg8::gemm_phase<pg8::EpiNull, pg8::StaticOrder, true, true>(F.lds + RING_OFF, g, S, EN, F.wave); } \
        } SEAM(pb + 4); \
        if (MK_FIN_PHASES) { if (IN(pb + 5)) { for (int rep = 0; rep < 1 + MK_DUP_ALL; ++rep) { phase_finalize_stats(F); reduce_colsums(F, (l + 1 < NLAYER) ? 3 : 2); } } SEAM(pb + 5); } \
        if (IN(pb + 6)) { \
            STAGGER(MK_STAGGER_IN); pg8::Gemm g{F.XB, F.Wff1_t, NTOK, DFF, DM, nullptr, 0, STG_OFF - RING_OFF}; pg8::StaticOrder S; S.init(NTOK, DFF, F.G, (int)blockIdx.x); \
            if (!MK_FIN_PHASES) STATS_PREAMBLE(S); \
            pg8::EpiBf16Fold<3, MK_TILED_H != 0> E{F.H, DFF, F.STAT, F.VEC + VEC_CS_FF1, F.VEC + VEC_BW_FF1}; \
            pg8::gemm_phase<pg8::EpiBf16Fold<3, MK_TILED_H != 0>, pg8::StaticOrder, true, true>(F.lds + RING_OFF, g, S, E, F.wave); \
            if (MK_DUP_ALL) pg8::gemm_phase<pg8::EpiBf16Fold<3, MK_TILED_H != 0>, pg8::StaticOrder, true, true>(F.lds + RING_OFF, g, S, E, F.wave); \
            if (MK_DUP_KLOOP & 4) { pg8::EpiNull EN{F.LSE}; pg8::gemm_phase<pg8::EpiNull, pg8::StaticOrder, true, true>(F.lds + RING_OFF, g, S, EN, F.wave); } \
            if (MK_XCD_EXTRA >= 0 && (int)(blockIdx.x & 7) == MK_XCD_EXTRA) { pg8::StaticOrder S1; S1.init(256, 256, 1, 0); pg8::gemm_phase<pg8::EpiBf16Fold<3, MK_TILED_H != 0>, pg8::StaticOrder, true, true>(F.lds + RING_OFF, g, S1, E, F.wave); } \
        } SEAM(pb + 6); \
        if (IN(pb + 7)) { \
            STAGGER(MK_STAGGER_OUT); pg8::Gemm g{F.H, F.Wff2_t, NTOK, DM, DFF, nullptr, 0, STG_OFF - RING_OFF}; pg8::StaticOrder S; S.init(NTOK, DM, F.G, (int)blockIdx.x, MK_WGM_RES); \
            if (MK_FUSE_FINAL && l == NLAYER - 1 && F.G == 256) { FinalOrder SF; SF.s = S; SF.XB = F.XB; SF.PART = F.PART; SF.X = F.X; SF.g = F.ln2_g + (size_t)(NLAYER - 1) * DM; SF.b = F.ln2_b + (size_t)(NLAYER - 1) * DM; SF.cnt = F.ctl + CW_FIN; SF.wave = F.wave; \
                pg8::EpiResLnFoldB E{F.XB, DM, F.STAT, F.ln1_g + (size_t)l * DM, F.ln1_b + (size_t)l * DM, F.PART, DN_ALPHA}; \
                pg8::gemm_phase<pg8::EpiResLnFoldB, FinalOrder, true, true, MK_TILED_H != 0>(F.lds + RING_OFF, g, SF, E, F.wave); } \
            else { RES_EPI_FF2(l); } if (MK_DUP_ALL) { pg8::EpiResCopyB EC{F.XB, DM}; pg8::gemm_phase<pg8::EpiResCopyB, pg8::StaticOrder, true, true, MK_TILED_H != 0>(F.lds + RING_OFF, g, S, EC, F.wave); } \
            if (MK_DUP_KLOOP & 8) { pg8::EpiNull EN{F.LSE}; pg8::gemm_phase<pg8::EpiNull, pg8::StaticOrder, true, true, MK_TILED_H != 0>(F.lds + RING_OFF, g, S, EN, F.wave); } \
        } if (!(MK_FUSE_FINAL && l == NLAYER - 1 && F.G == 256)) SEAM(pb + 7); \
        if (MK_FIN_PHASES) { if (IN(pb + 8)) { for (int rep = 0; rep < 1 + MK_DUP_ALL; ++rep) phase_finalize_stats(F); } SEAM(pb + 8); } \
    } while (0)
#if !MK_HALVES
    LAYER_BODY(0); LAYER_BODY(1); LAYER_BODY(2); LAYER_BODY(3);
#else
#define SBK(l, i) ((l) * 6 + (i))
#define ROT_C(r) (((F.G & (F.G - 1)) == 0 && F.G >= 256) ? (((int)blockIdx.x + 64 * (r)) & (F.G - 1)) : (int)blockIdx.x)
#define SB_ARRIVE(k) do { sb_arrive(F, (k)); if (MK_SB_EAGER) sb_wait(F, (k)); } while (0)
#define SB_WAIT(k) do { if (!MK_SB_EAGER) sb_wait(F, (k)); } while (0)
#define GEMM_IN_H(l, h) do { pg8::Gemm g{F.XB, F.Win_t, NTOK, INW, DM}; pg8::HalfOrder S; S.init(NTOK / 2, INW, F.G, ROT_C((2 * (l) + (h)) & 3), pg8::WGM, (NTOK / 512) * (h)); \
            if ((l) > 0) STATS_PREAMBLE(S); \
            pg8::EpiInProj E{F.PROJ, INW, F.STAT, F.VEC + VEC_CS_IN, F.VEC + VEC_BW_IN, F.a_q_gain + (l) * HD, F.a_k_gain + (l) * HD, F.ROPE_A, F.ROPE_B, (LAS float*)(F.lds + XCH_OFF), \
                (MK_BOUNDED_A && F.VEC[VEC_M0 + (l)] * ATT_SCALE <= 40.f) ? ATT_SCALE * 1.4426950408889634f : 1.f}; \
            pg8::gemm_phase<pg8::EpiInProj, pg8::HalfOrder, true, true>(F.lds + RING_OFF, g, S, E, F.wave); } while (0)
#define GEMM_OUT_H(l, h) do { pg8::Gemm g{F.O, F.Wout_t, NTOK, DM, DM}; pg8::HalfOrder S; S.init(NTOK / 2, DM, F.G, (int)blockIdx.x, MK_WGM_RES, (NTOK / 512) * (h)); \
            pg8::EpiResLnFoldB E{F.XB, DM, F.STAT, ((l) == 0) ? F.VEC + VEC_ONES : F.ln2_g + (size_t)((l) - 1) * DM, ((l) == 0) ? F.VEC + VEC_ZEROS : F.ln2_b + (size_t)((l) - 1) * DM, F.PART, DN_ALPHA}; \
            pg8::gemm_phase<pg8::EpiResLnFoldB, pg8::HalfOrder, true, true>(F.lds + RING_OFF, g, S, E, F.wave); } while (0)
#define GEMM_FF1_H(l, h) do { pg8::Gemm g{F.XB, F.Wff1_t, NTOK, DFF, DM}; pg8::HalfOrder S; S.init(NTOK / 2, DFF, F.G, (int)blockIdx.x, pg8::WGM, (NTOK / 512) * (h)); \
            STATS_PREAMBLE(S); \
            pg8::EpiBf16Fold<3, MK_TILED_H != 0> E{F.H, DFF, F.STAT, F.VEC + VEC_CS_FF1, F.VEC + VEC_BW_FF1}; \
            pg8::gemm_phase<pg8::EpiBf16Fold<3, MK_TILED_H != 0>, pg8::HalfOrder, true, true>(F.lds + RING_OFF, g, S, E, F.wave); } while (0)
#define GEMM_FF2_H(l, h) do { pg8::Gemm g{F.H, F.Wff2_t, NTOK, DM, DFF, nullptr, 0, STG_OFF - RING_OFF}; pg8::HalfOrder S; S.init(NTOK / 2, DM, F.G, (int)blockIdx.x, MK_WGM_RES, (NTOK / 512) * (h)); \
            pg8::EpiResLnFoldB E{F.XB, DM, F.STAT, F.ln1_g + (size_t)(l) * DM, F.ln1_b + (size_t)(l) * DM, F.PART, DN_ALPHA}; \
            pg8::gemm_phase<pg8::EpiResLnFoldB, pg8::HalfOrder, true, true, MK_TILED_H != 0>(F.lds + RING_OFF, g, S, E, F.wave); } while (0)
#define XBAR() xcd_barrier(bar, F.wave == 0 && lane_id() == 0)
#define LAYER_BODY_H(l) do { \
        if ((l) > 0) SB_WAIT(SBK((l) - 1, 4)); GEMM_IN_H(l, 0); \
        if ((l) > 0) SB_WAIT(SBK((l) - 1, 5)); GEMM_IN_H(l, 1); \
        if (F.G == 256 && (((int)blockIdx.x >> 7) ^ ((l) & 1)) == 1) convert_weights(F, l, 0, 2, ((int)blockIdx.x & 127) * NWAVES + F.wave, 128 * NWAVES);     \
        XBAR(); \
        phase_attn_A(F, l, (char*)lds + RING_OFF); phase_attn_B(F, (char*)lds + RING_OFF); phase_attn_C(F, l, (char*)lds + RING_OFF); \
        if ((l) + 1 < NLAYER && F.vcu < F.G / 2) convert_weights(F, l, (l) + 1, 1, F.vcu * NWAVES + F.wave, (F.G / 2) * NWAVES); \
        if (F.G != 256) convert_weights(F, l, 0, 2, F.gw, F.NGW); \
        XBAR(); \
        phase_mix(F, l); reduce_colsums(F, ((l) + 1 < NLAYER) ? 3 : 2); \
        XBAR(); \
        GEMM_OUT_H(l, 0); SB_ARRIVE(SBK(l, 0)); \
        GEMM_OUT_H(l, 1); SB_ARRIVE(SBK(l, 1)); \
        SB_WAIT(SBK(l, 0)); GEMM_FF1_H(l, 0); SB_ARRIVE(SBK(l, 2)); \
        SB_WAIT(SBK(l, 1)); GEMM_FF1_H(l, 1); SB_ARRIVE(SBK(l, 3)); \
        SB_WAIT(SBK(l, 2)); GEMM_FF2_H(l, 0); SB_ARRIVE(SBK(l, 4)); \
        SB_WAIT(SBK(l, 3)); GEMM_FF2_H(l, 1); SB_ARRIVE(SBK(l, 5)); \
    } while (0)
    LAYER_BODY_H(0); LAYER_BODY_H(1); LAYER_BODY_H(2); LAYER_BODY_H(3);
    SB_WAIT(SBK(NLAYER - 1, 4)); SB_WAIT(SBK(NLAYER - 1, 5));
#undef LAYER_BODY_H
#endif
#undef LAYER_BODY
    if (IN(N_PHASES - 1) && !(MK_FUSE_FINAL && F.G == 256)) { phase_final_ln(F, F.ln2_g + (size_t)(NLAYER - 1) * DM, F.ln2_b + (size_t)(NLAYER - 1) * DM); if (MK_DUP_ENDS & 2) phase_final_ln(F, F.ln2_g + (size_t)(NLAYER - 1) * DM, F.ln2_b + (size_t)(NLAYER - 1) * DM); }

#undef IN
#undef SEAM
}

extern "C" void kernel_launch(void* const* d_in, const int* in_sizes, int n_in, void* d_out, int out_size, void* d_ws, size_t ws_size, hipStream_t stream) {
    static int grid = 0;
    if (grid == 0) {
        if (n_in != 14 || in_sizes[0] != NTOK_P * DM || out_size != NTOK * DM || ws_size < WS_END) { fprintf(stderr, "kernel_launch: shape/workspace mismatch (n_in %d, out %d, ws %zu < %zu); nothing launched\n", n_in, out_size, ws_size, (size_t)WS_END); grid = -1; return; }
        int dev = 0, cus = 0, per_cu = 0;
        if (hipGetDevice(&dev) != hipSuccess || hipDeviceGetAttribute(&cus, hipDeviceAttributeMultiprocessorCount, dev) != hipSuccess) { grid = -1; return; }
        if (hipFuncSetAttribute((const void*)trunk_fwd, hipFuncAttributeMaxDynamicSharedMemorySize, LDS_BYTES) != hipSuccess) { fprintf(stderr, "kernel_launch: hipFuncSetAttribute failed\n"); grid = -1; return; }
        if (hipOccupancyMaxActiveBlocksPerMultiprocessor(&per_cu, (const void*)trunk_fwd, NWAVES * 64, LDS_BYTES) != hipSuccess || per_cu < 1) { fprintf(stderr, "kernel_launch: occupancy query says %d blocks per CU\n", per_cu); }
        (void)hipGetLastError();
        grid = cus;
    }
    if (grid < 0) return;
    if (hipMemsetAsync((char*)d_ws + WS_CTL, 0, CTL_ZERO_BYTES, stream) != hipSuccess) return;
    Args a{};
    for (int i = 0; i < 14; ++i) a.in[i] = (const float*)d_in[i];
    a.out = (float*)d_out; a.ws = (unsigned char*)d_ws;
#if MK_PER_PHASE
    for (int p = 0; p < N_PHASES; ++p) { a.ph_lo = p; a.ph_hi = p + 1; hipLaunchKernelGGL(trunk_fwd, dim3(grid), dim3(NWAVES * 64), LDS_BYTES, stream, a); }
#else
    a.ph_lo = 0; a.ph_hi = N_PHASES;
    hipLaunchKernelGGL(trunk_fwd, dim3(grid), dim3(NWAVES * 64), LDS_BYTES, stream, a);
#endif
    const hipError_t le = hipPeekAtLastError();
    if (le != hipSuccess) fprintf(stderr, "kernel_launch: launch failed: %s\n", hipGetErrorName(le));
}
```
